# Optimizing an MI355X kernel written in HIP

```python
import math
import jax, jax.numpy as jnp
from jax import lax
import numpy as np

D_MODEL = 2048
BATCH = 1
SEQ = 8192
DEPTH = 2

HEAD_DIM = 128
SB_HEADS = 8
FOX_HEADS = 8
SB_WIDTH = SB_HEADS * HEAD_DIM
FOX_WIDTH = FOX_HEADS * HEAD_DIM
N_META = 16
BLOCK_Q = 128
N_PAD = BLOCK_Q - N_META
PREFIX = N_PAD + N_META
N_EXPERTS = 16
N_GROUPS = 4
EXPERTS_PER_GROUP = N_EXPERTS // N_GROUPS
TOP_K = 2
EXPERT_FF = 1024
MOE_BLOCK = 256
ALPHA = (2 * DEPTH) ** 0.25
BETA = (8 * DEPTH) ** -0.25
LN_EPS = 1e-5
NEG = -1e30

_Q_SB = SB_WIDTH
_K_SB = 2 * SB_WIDTH
_V_SB = 3 * SB_WIDTH
_Q_FX = _V_SB + FOX_WIDTH
_K_FX = _V_SB + 2 * FOX_WIDTH
_V_FX = _V_SB + 3 * FOX_WIDTH
_F_FX = _V_FX + FOX_HEADS
_G_SB = _F_FX + D_MODEL
IN_COLS = _G_SB + D_MODEL
SPLITS = (_Q_SB, _K_SB, _V_SB, _Q_FX, _K_FX, _V_FX, _F_FX, _G_SB)

kernel_name = "stickbreak_fox_grouped_moe_hybrid"


def layer_norm(x, g, b):
    xf = x.astype(jnp.float32)
    mu = jnp.mean(xf, axis=-1, keepdims=True)
    var = jnp.mean(jnp.square(xf - mu), axis=-1, keepdims=True)
    y = (xf - mu) * lax.rsqrt(var + LN_EPS) * g.astype(jnp.float32) + b.astype(jnp.float32)
    return y.astype(x.dtype)


def split_heads(t, n_heads):
    b, l, _ = t.shape
    return t.reshape(b, l, n_heads, HEAD_DIM).transpose(0, 2, 1, 3)


def merge_heads(t):
    b, h, l, d = t.shape
    return t.transpose(0, 2, 1, 3).reshape(b, l, h * d)


def stick_breaking_attention(q, k, v, key_valid):
    b, h, l, dh = q.shape
    scale = dh ** -0.5
    kpos = jnp.arange(l)

    def block(i):
        qb = lax.dynamic_slice_in_dim(q, i * BLOCK_Q, BLOCK_Q, axis=2)
        qpos = i * BLOCK_Q + jnp.arange(BLOCK_Q)
        vis = (kpos[None, :] < qpos[:, None]) & key_valid[None, :]
        z = jnp.einsum('bhqd,bhkd->bhqk', qb, k, preferred_element_type=jnp.float32) * scale
        log_beta = jax.nn.log_sigmoid(z)
        log_keep = jnp.where(vis, jax.nn.log_sigmoid(-z), 0.0)
        suffix = lax.cumsum(log_keep, axis=3, reverse=True)
        after = jnp.concatenate([suffix[..., 1:], jnp.zeros_like(suffix[..., :1])], axis=3)
        w = jnp.where(vis, jnp.exp(log_beta + after), 0.0)
        return jnp.einsum('bhqk,bhkd->bhqd', w.astype(v.dtype), v)

    out = lax.map(block, jnp.arange(l // BLOCK_Q))
    return out.transpose(1, 2, 0, 3, 4).reshape(b, h, l, dh)


def forgetting_attention(q, k, v, log_f_cum, key_valid):
    b, h, l, dh = q.shape
    scale = dh ** -0.5
    kpos = jnp.arange(l)

    def block(i):
        qb = lax.dynamic_slice_in_dim(q, i * BLOCK_Q, BLOCK_Q, axis=2)
        cq = lax.dynamic_slice_in_dim(log_f_cum, i * BLOCK_Q, BLOCK_Q, axis=2)
        qpos = i * BLOCK_Q + jnp.arange(BLOCK_Q)
        vis = (kpos[None, :] <= qpos[:, None]) & key_valid[None, :]
        s = jnp.einsum('bhqd,bhkd->bhqk', qb, k, preferred_element_type=jnp.float32) * scale
        s = s + cq[..., :, None] - log_f_cum[..., None, :]
        p = jax.nn.softmax(jnp.where(vis, s, NEG), axis=-1)
        return jnp.einsum('bhqk,bhkd->bhqd', p.astype(v.dtype), v)

    out = lax.map(block, jnp.arange(l // BLOCK_Q))
    return out.transpose(1, 2, 0, 3, 4).reshape(b, h, l, dh)


def hybrid_mixer(h, w_in, b_forget, w_branch_sb, w_branch_fox, w_out, key_valid):
    proj = h @ w_in
    q_sb, k_sb, v_sb, q_fx, k_fx, v_fx, f_logit, g_sb, g_fx = jnp.split(proj, SPLITS, axis=-1)
    log_f = jax.nn.log_sigmoid((f_logit + b_forget).astype(jnp.float32))
    log_f = jnp.where(key_valid[None, :, None], log_f, 0.0)
    log_f_cum = jnp.cumsum(log_f, axis=1).transpose(0, 2, 1)
    y_sb = stick_breaking_attention(split_heads(q_sb, SB_HEADS), split_heads(k_sb, SB_HEADS),
                                    split_heads(v_sb, SB_HEADS), key_valid)
    y_fx = forgetting_attention(split_heads(q_fx, FOX_HEADS), split_heads(k_fx, FOX_HEADS),
                                split_heads(v_fx, FOX_HEADS), log_f_cum, key_valid)
    merged = (jax.nn.sigmoid(g_sb) * (merge_heads(y_sb) @ w_branch_sb)
              + jax.nn.sigmoid(g_fx) * (merge_heads(y_fx) @ w_branch_fox))
    return merged @ w_out


def grouped_top2_route(hf, w_router, router_bias):
    n = hf.shape[0]
    aff = jax.nn.sigmoid(jnp.dot(hf, w_router, preferred_element_type=jnp.float32))
    sel = aff + router_bias.astype(jnp.float32)
    grp_score = lax.top_k(sel.reshape(n, N_GROUPS, EXPERTS_PER_GROUP), TOP_K)[0].sum(-1)
    best_group = jnp.argmax(grp_score, axis=-1)
    in_group = (jnp.arange(N_EXPERTS) // EXPERTS_PER_GROUP)[None, :] == best_group[:, None]
    _, idx = lax.top_k(jnp.where(in_group, sel, -jnp.inf), TOP_K)
    w = jnp.take_along_axis(aff, idx, axis=-1)
    return idx, w / jnp.sum(w, axis=-1, keepdims=True)


def moe_ffn(h, w_router, router_bias, w_gate, w_up, w_down):
    b, l, d = h.shape
    n = b * l
    hf = h.reshape(n, d)
    idx, wts = grouped_top2_route(hf, w_router, router_bias)
    n_slots = n * TOP_K
    slot_e = idx.reshape(-1)
    slot_tok = jnp.repeat(jnp.arange(n, dtype=jnp.int32), TOP_K)
    slot_w = wts.reshape(-1)
    order = jnp.argsort(slot_e)
    e_sorted = slot_e[order]
    counts = jnp.bincount(slot_e, length=N_EXPERTS)
    padded = (counts + MOE_BLOCK - 1) // MOE_BLOCK * MOE_BLOCK
    start = jnp.cumsum(counts) - counts
    pend = jnp.cumsum(padded)
    pstart = pend - padded
    dest = pstart[e_sorted] + jnp.arange(n_slots) - start[e_sorted]
    n_blocks = -(-(n_slots + N_EXPERTS * (MOE_BLOCK - 1)) // MOE_BLOCK)
    p = n_blocks * MOE_BLOCK
    buf_tok = jnp.zeros((p,), jnp.int32).at[dest].set(slot_tok[order])
    buf_w = jnp.zeros((p,), h.dtype).at[dest].set(slot_w[order].astype(h.dtype))
    block_e = jnp.minimum(jnp.searchsorted(pend, jnp.arange(n_blocks) * MOE_BLOCK, side='right'),
                          N_EXPERTS - 1)
    xin = hf[buf_tok].reshape(n_blocks, MOE_BLOCK, d)

    def expert_block(args):
        xb, e = args
        return (jax.nn.silu(xb @ w_gate[e]) * (xb @ w_up[e])) @ w_down[e]

    yb = lax.map(expert_block, (xin, block_e)).reshape(p, d)
    y = jnp.zeros((n, d), h.dtype).at[buf_tok].add(yb * buf_w[:, None])
    return y.reshape(b, l, d)


def setup_inputs(seed: int = 0) -> dict:
    key = jax.random.key(seed)
    ks = jax.random.split(key, 20)
    f32 = jnp.float32
    d = D_MODEL
    col_scale = jnp.concatenate([
        jnp.ones((2 * SB_WIDTH,), f32), jnp.full((SB_WIDTH,), BETA, f32),
        jnp.ones((2 * FOX_WIDTH,), f32), jnp.full((FOX_WIDTH,), BETA, f32),
        jnp.ones((FOX_HEADS + 2 * d,), f32)])
    return {
        "x": jax.random.normal(ks[0], (BATCH, SEQ, d), f32),
        "meta_tokens": jax.random.normal(ks[1], (N_META, d), f32),
        "ln_in_g": 1.0 + 0.02 * jax.random.normal(ks[2], (d,), f32),
        "ln_in_b": 0.02 * jax.random.normal(ks[3], (d,), f32),
        "w_in": jax.random.normal(ks[4], (DEPTH, d, IN_COLS), f32) * (d ** -0.5) * col_scale,
        "b_forget": jax.random.uniform(ks[5], (DEPTH, FOX_HEADS), f32, 1.0, 4.0),
        "w_branch_sb": jax.random.normal(ks[6], (DEPTH, SB_WIDTH, d), f32) * SB_WIDTH ** -0.5,
        "w_branch_fox": jax.random.normal(ks[7], (DEPTH, FOX_WIDTH, d), f32) * FOX_WIDTH ** -0.5,
        "w_out": jax.random.normal(ks[8], (DEPTH, d, d), f32) * (d ** -0.5) * BETA,
        "ln_mix_g": 1.0 + 0.02 * jax.random.normal(ks[9], (DEPTH, d), f32),
        "ln_mix_b": 0.02 * jax.random.normal(ks[10], (DEPTH, d), f32),
        "w_router": jax.random.normal(ks[11], (d, N_EXPERTS), f32) * d ** -0.5,
        "router_bias": 0.01 * jax.random.normal(ks[12], (N_EXPERTS,), f32),
        "w_gate": jax.random.normal(ks[13], (DEPTH, N_EXPERTS, d, EXPERT_FF), f32) * d ** -0.5,
        "w_up": jax.random.normal(ks[14], (DEPTH, N_EXPERTS, d, EXPERT_FF), f32) * d ** -0.5,
        "w_down": jax.random.normal(ks[15], (DEPTH, N_EXPERTS, EXPERT_FF, d), f32) * (EXPERT_FF ** -0.5) * BETA,
        "ln_ffn_g": 1.0 + 0.02 * jax.random.normal(ks[16], (DEPTH, d), f32),
        "ln_ffn_b": 0.02 * jax.random.normal(ks[17], (DEPTH, d), f32),
    }


def reference(x, meta_tokens, ln_in_g, ln_in_b, w_in, b_forget, w_branch_sb, w_branch_fox, w_out,
              ln_mix_g, ln_mix_b, w_router, router_bias, w_gate, w_up, w_down, ln_ffn_g, ln_ffn_b):
    b, s, d = x.shape
    l = s + PREFIX
    pad = jnp.zeros((b, N_PAD, d), x.dtype)
    meta = jnp.broadcast_to(meta_tokens.astype(x.dtype)[None], (b, N_META, d))
    h = jnp.concatenate([pad, meta, x], axis=1)
    key_valid = jnp.arange(l) >= N_PAD
    h = layer_norm(h, ln_in_g, ln_in_b)
    for i in range(DEPTH):
        mix = hybrid_mixer(h, w_in[i], b_forget[i], w_branch_sb[i], w_branch_fox[i], w_out[i], key_valid)
        h = layer_norm(ALPHA * h + mix, ln_mix_g[i], ln_mix_b[i])
        ffn = moe_ffn(h, w_router, router_bias, w_gate[i], w_up[i], w_down[i])
        h = layer_norm(ALPHA * h + ffn, ln_ffn_g[i], ln_ffn_b[i])
    return h[:, PREFIX:, :]
```

```cpp
#include <hip/hip_runtime.h>
#include <cstdio>
#include <cstdint>

#define GAS __attribute__((address_space(1)))
#define LAS __attribute__((address_space(3)))
typedef unsigned short bf16;
typedef float f32x4 __attribute__((ext_vector_type(4)));
typedef float f32x2 __attribute__((ext_vector_type(2)));
typedef unsigned u32x4 __attribute__((ext_vector_type(4)));
typedef unsigned u32x2 __attribute__((ext_vector_type(2)));
typedef GAS unsigned gu32;

constexpr int DM = 2048, SEQ = 8192, NMETA = 16, NTOK = SEQ + NMETA, MROWS = 8448;
constexpr int HD = 128, NHEAD = 8;
constexpr int QKV_N = 6144, G_N = 4096, INP_N = 10240, INP_SRC = 10248, FCOL = 6144;
constexpr int NE = 16, FF = 1024, NSLOT_MAX = 20480;
constexpr float ALPHA = 1.4142135623730951f, LN_EPS = 1e-5f;
constexpr float LOG2E = 1.4426950408889634f;
constexpr float QSCALE = 0.08838834764831845f * 1.4426950408889634f;
constexpr int NLAYER = 2, NPHASE = 1 + 8 * NLAYER;
enum { PH_A = 0, PH_B = 1, PH_C = 2, PH_D = 3, PH_E = 4, PH_F = 5, PH_G = 6, PH_H = 7 };

constexpr size_t MiB = 1u << 20;
constexpr size_t WS_CTL = 0, CTL_ZERO_BYTES = 1 * MiB;
constexpr size_t WS_WIN = 2 * MiB, WIN_L = 40 * MiB;
constexpr size_t WS_WB = 82 * MiB, WB_L = 8 * MiB;
constexpr size_t WS_WOUT = 98 * MiB, WOUT_L = 8 * MiB;
constexpr size_t WS_WGU = 114 * MiB, WGU_L = 128 * MiB, WGU_E = 8 * MiB;
constexpr size_t WS_WD = 370 * MiB, WD_L = 64 * MiB, WD_E = 4 * MiB;
constexpr size_t WS_HF = 498 * MiB;
constexpr size_t WS_HB = 564 * MiB;
constexpr size_t WS_RB = 597 * MiB;
constexpr size_t WS_QKV = 663 * MiB;
constexpr size_t WS_GB = 762 * MiB;
constexpr size_t WS_YB = 828 * MiB;
constexpr size_t WS_MG = 861 * MiB;
constexpr size_t WS_ACT = 663 * MiB;
constexpr size_t WS_OSL = 703 * MiB;
constexpr size_t WS_LOGF = 894 * MiB;
constexpr size_t WS_CUM = 895 * MiB;
constexpr size_t WS_ELIST = 896 * MiB;
constexpr size_t WS_TOKI = 897 * MiB;
constexpr size_t WS_END = 898 * MiB;
constexpr int CW_CNT = 1024;
constexpr int CW_BAR = 8192;
#define XCD_BAR_WORDS 3456
constexpr int MAX_LAUNCH = 20;
static_assert((CW_BAR + MAX_LAUNCH * XCD_BAR_WORDS) * 4 <= (int)CTL_ZERO_BYTES, "ctl");

constexpr int NWAVES = 8, NTHREADS = 512;
constexpr int RING_BYTES = 131072, MISC_OFF = RING_BYTES + 320, LDS_BYTES = 147456;

__device__ __forceinline__ unsigned f2bf(float f) { unsigned u = __builtin_bit_cast(unsigned, f); return (u + 0x7fffu + ((u >> 16) & 1u)) >> 16; }
__device__ __forceinline__ unsigned pk2(float lo, float hi) { return f2bf(lo) | (f2bf(hi) << 16); }
__device__ __forceinline__ float bflo(unsigned w) { return __builtin_bit_cast(float, w << 16); }
__device__ __forceinline__ float bfhi(unsigned w) { return __builtin_bit_cast(float, w & 0xffff0000u); }
__device__ __forceinline__ float bf2f(bf16 b) { return __builtin_bit_cast(float, ((unsigned)b) << 16); }
__device__ __forceinline__ float wave_sum(float v) {
#pragma unroll
    for (int o = 1; o < 64; o <<= 1) v += __shfl_xor(v, o);
    return v;
}
__device__ __forceinline__ float wave_max(float v) {
#pragma unroll
    for (int o = 1; o < 64; o <<= 1) v = fmaxf(v, __shfl_xor(v, o));
    return v;
}
__device__ __forceinline__ int row_of_p(int p) { return p < NMETA ? SEQ + p : p - NMETA; }
__device__ __forceinline__ float sigmoidf_(float x) { return 1.0f / (1.0f + __expf(-x)); }
__device__ __forceinline__ float dot8(u32x4 a, u32x4 b, float acc) {
    acc = fmaf(bflo(a.x), bflo(b.x), acc); acc = fmaf(bfhi(a.x), bfhi(b.x), acc);
    acc = fmaf(bflo(a.y), bflo(b.y), acc); acc = fmaf(bfhi(a.y), bfhi(b.y), acc);
    acc = fmaf(bflo(a.z), bflo(b.z), acc); acc = fmaf(bfhi(a.z), bfhi(b.z), acc);
    acc = fmaf(bflo(a.w), bflo(b.w), acc); acc = fmaf(bfhi(a.w), bfhi(b.w), acc);
    return acc;
}

struct Args { const float* in[18]; float* out; unsigned char* ws; int ph_lo, ph_hi; unsigned naive; int li; };
enum { I_X = 0, I_META, I_LNIN_G, I_LNIN_B, I_WIN, I_BF, I_WBSB, I_WBFX, I_WOUT, I_LNMIX_G, I_LNMIX_B, I_WR, I_RB, I_WG, I_WU, I_WD, I_LNFFN_G, I_LNFFN_B };

__device__ __forceinline__ int moe_cnt(const unsigned* ctl, int layer, int e) { return (int)ctl[CW_CNT + (layer * NE + e) * 64]; }
__device__ __forceinline__ bool moe_find(const unsigned* ctl, int layer, int s0, int& e_out, int& cnt_out, int& ps_out) {
    int acc = 0; e_out = -1; cnt_out = 0; ps_out = 0;
#pragma unroll
    for (int e = 0; e < NE; ++e) { const int c = moe_cnt(ctl, layer, e), nb = (c + 255) >> 8;
        if (e_out < 0 && s0 < (acc + nb) * 256) { e_out = e; cnt_out = c; ps_out = acc * 256; }
        acc += nb; }
    return e_out >= 0;
}
__device__ __forceinline__ int moe_pstart(const unsigned* ctl, int layer, int ex) {
    int acc = 0, r = 0;
#pragma unroll
    for (int e = 0; e < NE; ++e) { const int c = moe_cnt(ctl, layer, e); if (e == ex) r = acc * 256; acc += (c + 255) >> 8; }
    return r;
}

__device__ __forceinline__ void inproj_store(unsigned char* ws, int row, int n, float v) {
    if (n < QKV_N) { const bool isq = (n < 1024) || (n >= 3072 && n < 4096); ((bf16*)(ws + WS_QKV))[(size_t)row * QKV_N + n] = (bf16)f2bf(isq ? v * QSCALE : v); }
    else ((bf16*)(ws + WS_GB))[(size_t)row * G_N + (n - QKV_N)] = (bf16)f2bf(sigmoidf_(v));
}

__device__ __forceinline__ void dot4(const bf16* a0, const bf16* a1, const bf16* a2, const bf16* a3, const bf16* b, int K, float (&acc)[4]) {
    for (int k = 0; k < K; k += 8) {
        const u32x4 bv = *(const u32x4*)(b + k);
        acc[0] = dot8(*(const u32x4*)(a0 + k), bv, acc[0]); acc[1] = dot8(*(const u32x4*)(a1 + k), bv, acc[1]);
        acc[2] = dot8(*(const u32x4*)(a2 + k), bv, acc[2]); acc[3] = dot8(*(const u32x4*)(a3 + k), bv, acc[3]);
    }
}
__global__ void __launch_bounds__(256) naive_inproj(Args a, int layer) {
    const int n = blockIdx.x * 256 + threadIdx.x, r0 = blockIdx.y * 4;
    const bf16* A = (const bf16*)(a.ws + WS_HB) + (size_t)r0 * DM; const bf16* B = (const bf16*)(a.ws + WS_WIN + layer * WIN_L) + (size_t)n * DM;
    float acc[4] = {0.f, 0.f, 0.f, 0.f};
    dot4(A, A + DM, A + 2 * DM, A + 3 * DM, B, DM, acc);
    for (int i = 0; i < 4; ++i) inproj_store(a.ws, r0 + i, n, acc[i]);
}
__global__ void __launch_bounds__(256) naive_branch(Args a, int layer) {
    const int n = blockIdx.x * 256 + threadIdx.x, r0 = blockIdx.y * 4;
    const bf16* A = (const bf16*)(a.ws + WS_YB) + (size_t)r0 * DM; const bf16* B = (const bf16*)(a.ws + WS_WB + layer * WB_L) + (size_t)n * DM;
    float s[4] = {0.f, 0.f, 0.f, 0.f}, f[4] = {0.f, 0.f, 0.f, 0.f};
    dot4(A, A + DM, A + 2 * DM, A + 3 * DM, B, 1024, s);
    dot4(A + 1024, A + DM + 1024, A + 2 * DM + 1024, A + 3 * DM + 1024, B + 1024, 1024, f);
    const bf16* G = (const bf16*)(a.ws + WS_GB);
    for (int i = 0; i < 4; ++i) { const size_t r = r0 + i; const float gs = bf2f(G[r * G_N + n]), gf = bf2f(G[r * G_N + DM + n]);
        ((bf16*)(a.ws + WS_MG))[r * DM + n] = (bf16)f2bf(gs * s[i] + gf * f[i]); }
}
__global__ void __launch_bounds__(256) naive_outproj(Args a, int layer) {
    const int n = blockIdx.x * 256 + threadIdx.x, r0 = blockIdx.y * 4;
    const bf16* A = (const bf16*)(a.ws + WS_MG) + (size_t)r0 * DM; const bf16* B = (const bf16*)(a.ws + WS_WOUT + layer * WOUT_L) + (size_t)n * DM;
    float acc[4] = {0.f, 0.f, 0.f, 0.f};
    dot4(A, A + DM, A + 2 * DM, A + 3 * DM, B, DM, acc);
    const float* HF = (const float*)(a.ws + WS_HF); float* R = (float*)(a.ws + WS_RB);
    for (int i = 0; i < 4; ++i) { const size_t o = (size_t)(r0 + i) * DM + n; R[o] = ALPHA * HF[o] + acc[i]; }
}
__global__ void __launch_bounds__(256) naive_moe_gu(Args a, int layer) {
    const int j = blockIdx.x * 256 + threadIdx.x, s0 = blockIdx.y * 4;
    int e, cnt, ps; if (!moe_find((const unsigned*)(a.ws + WS_CTL), layer, s0, e, cnt, ps)) return;
    const int* elist = (const int*)(a.ws + WS_ELIST) + (size_t)e * MROWS;
    const bf16* HB = (const bf16*)(a.ws + WS_HB);
    const int rank = s0 - ps;
    const bf16* ap0 = HB + (size_t)(rank + 0 < cnt ? elist[rank + 0] : 0) * DM; const bf16* ap1 = HB + (size_t)(rank + 1 < cnt ? elist[rank + 1] : 0) * DM;
    const bf16* ap2 = HB + (size_t)(rank + 2 < cnt ? elist[rank + 2] : 0) * DM; const bf16* ap3 = HB + (size_t)(rank + 3 < cnt ? elist[rank + 3] : 0) * DM;
    const bf16* W = (const bf16*)(a.ws + WS_WGU + layer * WGU_L + e * WGU_E);
    const int rg = 256 * (j >> 7) + (j & 127);
    float g[4] = {0.f, 0.f, 0.f, 0.f}, u[4] = {0.f, 0.f, 0.f, 0.f};
    dot4(ap0, ap1, ap2, ap3, W + (size_t)rg * DM, DM, g);
    dot4(ap0, ap1, ap2, ap3, W + (size_t)(rg + 128) * DM, DM, u);
    bf16* act = (bf16*)(a.ws + WS_ACT);
#pragma unroll
    for (int i = 0; i < 4; ++i) act[(size_t)(s0 + i) * FF + j] = (bf16)f2bf(g[i] * sigmoidf_(g[i]) * u[i]);
}
__global__ void __launch_bounds__(256) naive_moe_down(Args a, int layer) {
    const int n = blockIdx.x * 256 + threadIdx.x, s0 = blockIdx.y * 4;
    int e, cnt, ps; if (!moe_find((const unsigned*)(a.ws + WS_CTL), layer, s0, e, cnt, ps)) return;
    const bf16* A = (const bf16*)(a.ws + WS_ACT) + (size_t)s0 * FF; const bf16* B = (const bf16*)(a.ws + WS_WD + layer * WD_L + e * WD_E) + (size_t)n * FF;
    float acc[4] = {0.f, 0.f, 0.f, 0.f};
    dot4(A, A + FF, A + 2 * FF, A + 3 * FF, B, FF, acc);
    bf16* O = (bf16*)(a.ws + WS_OSL);
#pragma unroll
    for (int i = 0; i < 4; ++i) O[(size_t)(s0 + i) * DM + n] = (bf16)f2bf(acc[i]);
}
__global__ void __launch_bounds__(256) naive_attn(Args a, int nq) {
    const int lane = threadIdx.x & 63, widx = blockIdx.x * 4 + (threadIdx.x >> 6);
    const int th = widx / nq, pq = nq - 1 - (widx % nq);
    if (th >= 16) return;
    const int type = th >> 3, head = th & 7;
    const bf16* QKV = (const bf16*)(a.ws + WS_QKV);
    const int qcol = (type ? 3072 : 0) + head * HD, kcol = qcol + 1024, vcol = qcol + 2048;
    const int rowq = row_of_p(pq);
    u32x4 q[16];
#pragma unroll
    for (int i = 0; i < 16; ++i) q[i] = *(const u32x4*)(QKV + (size_t)rowq * QKV_N + qcol + 8 * i);
    const float* cum = (const float*)(a.ws + WS_CUM) + (size_t)head * MROWS;
    float o0 = 0.f, o1 = 0.f, carry = 0.f, m = -1e30f, l = 0.f;
    const float cq = type ? cum[pq] : 0.f;
    for (int phi = type ? pq : pq - 1; phi >= 0; phi -= 64) {
        const int p = phi - lane; const bool valid = p >= 0; const int pr = row_of_p(valid ? p : 0);
        float u = 0.f;
        const bf16* kp = QKV + (size_t)pr * QKV_N + kcol;
#pragma unroll
        for (int i = 0; i < 16; ++i) u = dot8(q[i], *(const u32x4*)(kp + 8 * i), u);
        float w;
        if (type == 0) {
            const float aa = exp2f(-fabsf(u)), b = log2f(1.0f + aa);
            float lk = fminf(-u, 0.f) - b; const float lb = lk + u;
            if (!valid) lk = 0.f;
            float inc = lk;
#pragma unroll
            for (int off = 1; off < 64; off <<= 1) { const float t = __shfl_up(inc, off); if (lane >= off) inc += t; }
            const float after = carry + inc - lk;
            w = valid ? exp2f(lb + after) : 0.f;
            carry += __shfl(inc, 63);
        } else {
            const float s = valid ? u + cq - cum[valid ? p : 0] : -__builtin_inff();
            const float cm = wave_max(s), mn = fmaxf(m, cm), alpha = exp2f(m - mn);
            w = valid ? exp2f(s - mn) : 0.f;
            l = l * alpha + wave_sum(w); o0 *= alpha; o1 *= alpha; m = mn;
        }
        for (int j = 0; j < 64; ++j) {
            const float wj = __shfl(w, j); const int prj = __shfl(pr, j);
            const unsigned vv = *(const unsigned*)(QKV + (size_t)prj * QKV_N + vcol + 2 * lane);
            o0 = fmaf(wj, bflo(vv), o0); o1 = fmaf(wj, bfhi(vv), o1);
        }
    }
    if (type) { const float rl = 1.0f / l; o0 *= rl; o1 *= rl; }
    *(unsigned*)((bf16*)(a.ws + WS_YB) + (size_t)rowq * DM + type * 1024 + head * HD + 2 * lane) = pk2(o0, o1);
}

#define XB_TMO      128
#define XB_XCNT(j)  (256  + 64 * (j))
#define XB_XSUB(j)  (1280 + 64 * (j))
#define XB_XGEN(j)  (2304 + 64 * (j))
#define XB_TOP      3328
#define XB_TOPGEN   3392
#define XB_SPIN_CAP (1u << 18)
__device__ __forceinline__ unsigned xb_ld(unsigned* p)              { return __hip_atomic_load(p, __ATOMIC_RELAXED, __HIP_MEMORY_SCOPE_AGENT); }
__device__ __forceinline__ unsigned xb_add(unsigned* p, unsigned v) { return __hip_atomic_fetch_add(p, v, __ATOMIC_RELAXED, __HIP_MEMORY_SCOPE_AGENT); }
__device__ __forceinline__ unsigned xb_xcc_id() { return (unsigned)__builtin_amdgcn_s_getreg((3 << 11) | 20) & 0xFu; }
#define XB_SPIN(cond, bar) do { unsigned _sp = 0; while (cond) { __builtin_amdgcn_s_sleep(1); \
    if ((++_sp & 255u) == 0u) { if (xb_ld(&(bar)[XB_TMO])) break; if (_sp > XB_SPIN_CAP) { atomicAdd(&(bar)[XB_TMO], 1u); break; } } } } while (0)
struct XcdBarrier { unsigned* bar; unsigned x; volatile LAS unsigned* st; };
__device__ __forceinline__ XcdBarrier xcd_barrier_post(unsigned* bar, volatile LAS unsigned* st) {
    XcdBarrier b; b.bar = bar; b.x = xb_xcc_id(); b.st = st;
    if (threadIdx.x == 0) (void)xb_add(&bar[XB_XCNT(b.x)], 1u);
    return b;
}
__device__ __forceinline__ void xcd_barrier_complete(unsigned* bar, unsigned x, unsigned& nloc, unsigned& nx) {
    const unsigned G = gridDim.x * gridDim.y * gridDim.z;
    unsigned sum, cnt, mine, sp = 0u;
    for (;;) {
        sum = 0u; cnt = 0u; mine = 0u;
#pragma unroll
        for (unsigned j = 0; j < 16; ++j) { const unsigned c = xb_ld(&bar[XB_XCNT(j)]); sum += c; cnt += (c > 0u) ? 1u : 0u; mine = (j == x) ? c : mine; }
        if (sum == G) break;
        __builtin_amdgcn_s_sleep(1);
        if ((++sp & 255u) == 0u) { if (xb_ld(&bar[XB_TMO])) break; if (sp > XB_SPIN_CAP) { atomicAdd(&bar[XB_TMO], 1u); break; } }
    }
    nloc = mine > 0u ? mine : 1u; nx = cnt > 0u ? cnt : 1u;
}
__device__ __forceinline__ void xcd_barrier(const XcdBarrier& b) {
    asm volatile("s_waitcnt vmcnt(0)" ::: "memory");
    __syncthreads();
    if (threadIdx.x == 0) {
        unsigned* bar = b.bar;
        __builtin_amdgcn_s_waitcnt(0);
        unsigned nloc = b.st[0], nx = b.st[1];
        if (nloc == 0u) { xcd_barrier_complete(bar, b.x, nloc, nx); b.st[0] = nloc; b.st[1] = nx; }
        const unsigned old = xb_add(&bar[XB_XSUB(b.x)], 1u);
        const unsigned gen = old / nloc;
        if (old + 1u == (gen + 1u) * nloc) {
            __builtin_amdgcn_fence(__ATOMIC_RELEASE, "agent");
            asm volatile("s_waitcnt vmcnt(0)" ::: "memory");
            const unsigned og = xb_add(&bar[XB_TOP], 1u);
            const unsigned tg = og / nx;
            if (og + 1u == (tg + 1u) * nx) xb_add(&bar[XB_TOPGEN], 1u);
            else XB_SPIN(xb_ld(&bar[XB_TOPGEN]) == tg, bar);
            __builtin_amdgcn_fence(__ATOMIC_ACQUIRE, "agent");
            xb_add(&bar[XB_XGEN(b.x)], 1u);
            asm volatile("s_waitcnt vmcnt(0)" ::: "memory");
        } else {
            XB_SPIN(xb_ld(&bar[XB_XGEN(b.x)]) == gen, bar);
            __builtin_amdgcn_fence(__ATOMIC_ACQUIRE, "agent");
            asm volatile("s_waitcnt vmcnt(0)" ::: "memory");
        }
    }
    __syncthreads();
}

struct Frame {
    LAS unsigned char* lds; unsigned char* ws; unsigned* ctl;
    int tid, lane, wave, G, gw, NGW;
    const float* in[18]; float* out;
};
#define LDS_WAIT() asm volatile("s_waitcnt lgkmcnt(0)" ::: "memory")

__device__ __forceinline__ void transpose_item(const float* W, size_t ldw, bf16* WT, size_t ldt, LAS float* scr, int lane) {
#pragma unroll 8
    for (int i = 0; i < 32; ++i) { const int kk = 2 * i + (lane >> 5); scr[kk * 33 + (lane & 31)] = W[(size_t)kk * ldw + (lane & 31)]; }
    LDS_WAIT(); asm volatile("" ::: "memory");
    const int c = lane & 7;
#pragma unroll
    for (int j = 0; j < 4; ++j) { const int n = (lane >> 3) + 8 * j; const LAS float* s = scr + (8 * c) * 33 + n;
        u32x4 o; o.x = pk2(s[0 * 33], s[1 * 33]); o.y = pk2(s[2 * 33], s[3 * 33]); o.z = pk2(s[4 * 33], s[5 * 33]); o.w = pk2(s[6 * 33], s[7 * 33]);
        *(u32x4*)(WT + (size_t)n * ldt + 8 * c) = o; }
    LDS_WAIT(); asm volatile("" ::: "memory");
}
__device__ __forceinline__ void convert_item(Frame& F, int it, LAS float* scr) {
    constexpr int I_IN = 32 * 320, I_BS = 16 * 64, I_OUT = 32 * 64, I_GE = 32 * 32, I_DE = 16 * 64;
    constexpr int PER_LAYER = I_IN + 2 * I_BS + I_OUT + NE * (2 * I_GE + I_DE);
    const int l = it / PER_LAYER; int r = it % PER_LAYER;
    if (r < I_IN) { const int kb = r / 320, nb = r % 320, nd = 32 * nb, ns = nd + (nd >= FCOL ? 8 : 0);
        transpose_item(F.in[I_WIN] + (size_t)l * DM * INP_SRC + (size_t)(64 * kb) * INP_SRC + ns, INP_SRC, (bf16*)(F.ws + WS_WIN + l * WIN_L) + (size_t)nd * DM + 64 * kb, DM, scr, F.lane); return; }
    r -= I_IN;
    if (r < 2 * I_BS) { const int which = r / I_BS; r %= I_BS; const int kb = r / 64, nb = r % 64;
        transpose_item((which ? F.in[I_WBFX] : F.in[I_WBSB]) + (size_t)l * 1024 * DM + (size_t)(64 * kb) * DM + 32 * nb, DM, (bf16*)(F.ws + WS_WB + l * WB_L) + (size_t)(32 * nb) * DM + which * 1024 + 64 * kb, DM, scr, F.lane); return; }
    r -= 2 * I_BS;
    if (r < I_OUT) { const int kb = r / 64, nb = r % 64;
        transpose_item(F.in[I_WOUT] + (size_t)l * DM * DM + (size_t)(64 * kb) * DM + 32 * nb, DM, (bf16*)(F.ws + WS_WOUT + l * WOUT_L) + (size_t)(32 * nb) * DM + 64 * kb, DM, scr, F.lane); return; }
    r -= I_OUT;
    const int e = r / (2 * I_GE + I_DE); r %= (2 * I_GE + I_DE);
    if (r < 2 * I_GE) { const int which = r / I_GE; r %= I_GE; const int kb = r / 32, nb = r % 32, n0 = 32 * nb, rho = 256 * (n0 >> 7) + (n0 & 127) + which * 128;
        transpose_item((which ? F.in[I_WU] : F.in[I_WG]) + ((size_t)(l * NE + e) * DM + 64 * kb) * FF + n0, FF, (bf16*)(F.ws + WS_WGU + l * WGU_L + e * WGU_E) + (size_t)rho * DM + 64 * kb, DM, scr, F.lane); return; }
    r -= 2 * I_GE;
    { const int kb = r / 64, nb = r % 64;
        transpose_item(F.in[I_WD] + ((size_t)(l * NE + e) * FF + 64 * kb) * DM + 32 * nb, DM, (bf16*)(F.ws + WS_WD + l * WD_L + e * WD_E) + (size_t)(32 * nb) * FF + 64 * kb, FF, scr, F.lane); }
}
constexpr int N_CONVERT_ITEMS = NLAYER * (32 * 320 + 2 * 16 * 64 + 32 * 64 + NE * (2 * 32 * 32 + 16 * 64));

__device__ __forceinline__ int tab_rowpos(int c) { return (c & 3) * 512 + (c >> 8) * 64 + ((c >> 2) & 63); }
template <int NC> __device__ __forceinline__ void stage_table(Frame& F, const float* src, size_t pitch) {
    constexpr int CH = NC / 4;
    for (int ci = F.tid; ci < DM * CH; ci += NTHREADS) { const int c = ci / CH, q = ci % CH;
        const f32x4 v = *(const f32x4*)(src + (size_t)c * pitch + 4 * q);
        const int sw = (NC == 16) ? ((c >> 4) & 3) : ((c >> 5) & 1);
        *(LAS f32x4*)(F.lds + tab_rowpos(c) * (NC * 4) + ((q ^ sw) << 4)) = v; }
    LDS_WAIT(); __syncthreads();
}
template <int NC> __device__ __forceinline__ void table_dot(Frame& F, const f32x4 (&y)[8], float (&acc)[NC]) {
    constexpr int CH = NC / 4; const int l = F.lane; const int sw = (NC == 16) ? ((l >> 2) & 3) : ((l >> 3) & 1);
#pragma unroll
    for (int e = 0; e < NC; ++e) acc[e] = 0.f;
#pragma unroll
    for (int j = 0; j < 8; ++j)
#pragma unroll
        for (int i = 0; i < 4; ++i) { const float yv = y[j][i]; const int rp = i * 512 + j * 64 + l; if (i == 0) asm volatile("" ::: "memory");
#pragma unroll
            for (int q = 0; q < CH; ++q) { const f32x4 w = *(const LAS f32x4*)(F.lds + rp * (NC * 4) + ((q ^ sw) << 4));
                acc[4 * q + 0] = fmaf(yv, w.x, acc[4 * q + 0]); acc[4 * q + 1] = fmaf(yv, w.y, acc[4 * q + 1]); acc[4 * q + 2] = fmaf(yv, w.z, acc[4 * q + 2]); acc[4 * q + 3] = fmaf(yv, w.w, acc[4 * q + 3]); } }
#pragma unroll
    for (int e = 0; e < NC; ++e) acc[e] = wave_sum(acc[e]);
}
__device__ __forceinline__ void ln_row(Frame& F, f32x4 (&v)[8], const float* g, const float* b) {
    float s = 0.f;
#pragma unroll
    for (int j = 0; j < 8; ++j) s += (v[j].x + v[j].y) + (v[j].z + v[j].w);
    const float mean = wave_sum(s) * (1.f / DM); float s2 = 0.f;
#pragma unroll
    for (int j = 0; j < 8; ++j) { v[j] = v[j] - mean; s2 += (v[j].x * v[j].x + v[j].y * v[j].y) + (v[j].z * v[j].z + v[j].w * v[j].w); }
    const float rstd = 1.0f / sqrtf(wave_sum(s2) * (1.f / DM) + LN_EPS);
#pragma unroll
    for (int j = 0; j < 8; ++j) { const f32x4 gv = *(const f32x4*)(g + 256 * j + 4 * F.lane), bv = *(const f32x4*)(b + 256 * j + 4 * F.lane); v[j] = v[j] * rstd * gv + bv; }
}
__device__ __forceinline__ void store_h(Frame& F, int row, const f32x4 (&y)[8]) {
    float* hf = (float*)(F.ws + WS_HF) + (size_t)row * DM; bf16* hb = (bf16*)(F.ws + WS_HB) + (size_t)row * DM;
#pragma unroll
    for (int j = 0; j < 8; ++j) { *(f32x4*)(hf + 256 * j + 4 * F.lane) = y[j]; u32x2 w; w.x = pk2(y[j].x, y[j].y); w.y = pk2(y[j].z, y[j].w); *(u32x2*)(hb + 256 * j + 4 * F.lane) = w; }
}
__device__ __forceinline__ void store_logf(Frame& F, int row, const f32x4 (&y)[8], const float* bfor) {
    float acc[8]; table_dot<8>(F, y, acc);
    if (F.lane < 8) { float a = acc[0];
#pragma unroll
        for (int h = 1; h < 8; ++h) a = (F.lane == h) ? acc[h] : a;
        const float x = a + bfor[F.lane];
        const float ls = fminf(x, 0.f) - log1pf(__expf(-fabsf(x)));
        ((float*)(F.ws + WS_LOGF))[(size_t)row * 8 + F.lane] = ls; }
}

__device__ __forceinline__ void phase_prologue(Frame& F) {
    LAS float* scr = (LAS float*)(F.lds + F.wave * 16384);
    for (int it = F.gw; it < N_CONVERT_ITEMS; it += F.NGW) convert_item(F, it, scr);
    __syncthreads();
    stage_table<8>(F, F.in[I_WIN] + FCOL, INP_SRC);
    for (int row = F.gw; row < NTOK; row += F.NGW) {
        const float* src = row < SEQ ? F.in[I_X] + (size_t)row * DM : F.in[I_META] + (size_t)(row - SEQ) * DM;
        f32x4 v[8];
#pragma unroll
        for (int j = 0; j < 8; ++j) v[j] = *(const f32x4*)(src + 256 * j + 4 * F.lane);
        ln_row(F, v, F.in[I_LNIN_G], F.in[I_LNIN_B]);
        store_h(F, row, v);
        store_logf(F, row, v, F.in[I_BF]);
    }
    for (int row = NTOK + F.gw; row < MROWS; row += F.NGW) { bf16* hb = (bf16*)(F.ws + WS_HB) + (size_t)row * DM;
#pragma unroll
        for (int j = 0; j < 4; ++j) *(u32x4*)(hb + 512 * j + 8 * F.lane) = (u32x4){0u, 0u, 0u, 0u}; }
    __syncthreads();
}
__device__ __forceinline__ void phase_cumsum(Frame& F) {
    if (blockIdx.x >= NHEAD) return;
    const int h = blockIdx.x; const float* logf = (const float*)(F.ws + WS_LOGF); float* cum = (float*)(F.ws + WS_CUM) + (size_t)h * MROWS;
    constexpr int PER = 17; const int p0 = F.tid * PER;
    float loc[PER]; float s = 0.f;
#pragma unroll
    for (int i = 0; i < PER; ++i) { const int p = p0 + i; const float v = p < NTOK ? logf[(size_t)row_of_p(p) * 8 + h] : 0.f; s += v; loc[i] = s; }
    float inc = s;
#pragma unroll
    for (int off = 1; off < 64; off <<= 1) { const float t = __shfl_up(inc, off); if (F.lane >= off) inc += t; }
    LAS float* wt = (LAS float*)(F.lds);
    if (F.lane == 63) wt[F.wave] = inc;
    LDS_WAIT(); __syncthreads();
    float base = inc - s;
    for (int w = 0; w < F.wave; ++w) base += wt[w];
#pragma unroll
    for (int i = 0; i < PER; ++i) { const int p = p0 + i; if (p < NTOK) cum[p] = (base + loc[i]) * LOG2E; }
    LDS_WAIT(); __syncthreads();
}
__device__ __forceinline__ void phase_ln_router(Frame& F, int layer) {
    stage_table<16>(F, F.in[I_WR], 16);
    const float* g = F.in[I_LNMIX_G] + layer * DM; const float* b = F.in[I_LNMIX_B] + layer * DM;
    const float* rbias = F.in[I_RB];
    for (int row = F.gw; row < NTOK; row += F.NGW) {
        const float* src = (const float*)(F.ws + WS_RB) + (size_t)row * DM;
        f32x4 v[8];
#pragma unroll
        for (int j = 0; j < 8; ++j) v[j] = *(const f32x4*)(src + 256 * j + 4 * F.lane);
        ln_row(F, v, g, b);
        store_h(F, row, v);
        float lg[16]; table_dot<16>(F, v, lg);
        float aff[16], sel[16];
#pragma unroll
        for (int e = 0; e < 16; ++e) { aff[e] = 1.0f / (1.0f + __expf(-lg[e])); sel[e] = aff[e] + rbias[e]; }
        int bg = 0; float bs = -__builtin_inff();
#pragma unroll
        for (int gi = 0; gi < 4; ++gi) { const float a0 = sel[4 * gi], a1 = sel[4 * gi + 1], a2 = sel[4 * gi + 2], a3 = sel[4 * gi + 3];
            const float h1 = fmaxf(a0, a1), l1 = fminf(a0, a1), h2 = fmaxf(a2, a3), l2 = fminf(a2, a3);
            const float top = fmaxf(h1, h2), sec = fmaxf(fminf(h1, h2), fmaxf(l1, l2)), sc = top + sec;
            if (sc > bs) { bs = sc; bg = gi; } }
        float s4[4], a4[4];
#pragma unroll
        for (int i = 0; i < 4; ++i) { s4[i] = sel[i]; a4[i] = aff[i]; }
#pragma unroll
        for (int gi = 1; gi < 4; ++gi) if (bg == gi) {
#pragma unroll
            for (int i = 0; i < 4; ++i) { s4[i] = sel[4 * gi + i]; a4[i] = aff[4 * gi + i]; } }
        int i1 = 0; float m1 = s4[0];
#pragma unroll
        for (int i = 1; i < 4; ++i) if (s4[i] > m1) { m1 = s4[i]; i1 = i; }
        int i2 = -1; float m2 = -__builtin_inff();
#pragma unroll
        for (int i = 0; i < 4; ++i) if (i != i1 && s4[i] > m2) { m2 = s4[i]; i2 = i; }
        float af1 = a4[0], af2 = a4[0];
#pragma unroll
        for (int i = 1; i < 4; ++i) { if (i1 == i) af1 = a4[i]; if (i2 == i) af2 = a4[i]; }
        const float wsum = af1 + af2, w1 = af1 / wsum, w2 = af2 / wsum;
        const int e1 = 4 * bg + i1, e2 = 4 * bg + i2;
        if (F.lane == 0) {
            const int r1 = (int)atomicAdd(F.ctl + CW_CNT + (layer * NE + e1) * 64, 1u), r2 = (int)atomicAdd(F.ctl + CW_CNT + (layer * NE + e2) * 64, 1u);
            int* el = (int*)(F.ws + WS_ELIST); el[(size_t)e1 * MROWS + r1] = row; el[(size_t)e2 * MROWS + r2] = row;
            int* ti = (int*)(F.ws + WS_TOKI) + (size_t)row * 8;
            ti[0] = e1; ti[1] = e2; ti[2] = r1; ti[3] = r2; ti[4] = __builtin_bit_cast(int, w1); ti[5] = __builtin_bit_cast(int, w2);
        }
    }
    __syncthreads();
}
__device__ __forceinline__ void phase_ln_final(Frame& F, int layer) {
    const bool last = layer == NLAYER - 1;
    if (!last) stage_table<8>(F, F.in[I_WIN] + (size_t)(layer + 1) * DM * INP_SRC + FCOL, INP_SRC);
    const float* g = F.in[I_LNFFN_G] + layer * DM; const float* b = F.in[I_LNFFN_B] + layer * DM;
    const int nrows = last ? SEQ : NTOK;
    for (int row = F.gw; row < nrows; row += F.NGW) {
        const int* ti = (const int*)(F.ws + WS_TOKI) + (size_t)row * 8;
        const int e1 = ti[0], e2 = ti[1], r1 = ti[2], r2 = ti[3]; const float w1 = __builtin_bit_cast(float, ti[4]), w2 = __builtin_bit_cast(float, ti[5]);
        const int ps1 = moe_pstart(F.ctl, layer, e1), ps2 = moe_pstart(F.ctl, layer, e2);
        const bf16* o1 = (const bf16*)(F.ws + WS_OSL) + (size_t)(ps1 + r1) * DM; const bf16* o2 = (const bf16*)(F.ws + WS_OSL) + (size_t)(ps2 + r2) * DM;
        const float* hf = (const float*)(F.ws + WS_HF) + (size_t)row * DM;
        f32x4 v[8];
#pragma unroll
        for (int j = 0; j < 8; ++j) { const f32x4 hv = *(const f32x4*)(hf + 256 * j + 4 * F.lane);
            const u32x2 a = *(const u32x2*)(o1 + 256 * j + 4 * F.lane), c = *(const u32x2*)(o2 + 256 * j + 4 * F.lane);
            v[j].x = ALPHA * hv.x + w1 * bflo(a.x) + w2 * bflo(c.x); v[j].y = ALPHA * hv.y + w1 * bfhi(a.x) + w2 * bfhi(c.x);
            v[j].z = ALPHA * hv.z + w1 * bflo(a.y) + w2 * bflo(c.y); v[j].w = ALPHA * hv.w + w1 * bfhi(a.y) + w2 * bfhi(c.y); }
        ln_row(F, v, g, b);
        if (last) { float* o = F.out + (size_t)row * DM;
#pragma unroll
            for (int j = 0; j < 8; ++j) *(f32x4*)(o + 256 * j + 4 * F.lane) = v[j]; }
        else { store_h(F, row, v); store_logf(F, row, v, F.in[I_BF] + (layer + 1) * NHEAD); }
    }
    __syncthreads();
}

__global__ void __launch_bounds__(NTHREADS, 2) mk_fwd(Args args) {
    extern __shared__ __attribute__((aligned(16))) unsigned char lds_raw[];
    Frame F;
    F.lds = (LAS unsigned char*)lds_raw; F.ws = args.ws; F.ctl = (unsigned*)(args.ws + WS_CTL);
    F.tid = threadIdx.x; F.lane = F.tid & 63; F.wave = __builtin_amdgcn_readfirstlane(F.tid >> 6);
    F.G = gridDim.x; F.gw = blockIdx.x * NWAVES + F.wave; F.NGW = F.G * NWAVES;
#pragma unroll
    for (int i = 0; i < 18; ++i) F.in[i] = args.in[i];
    F.out = args.out;
    volatile LAS unsigned* MISC = (volatile LAS unsigned*)(F.lds + MISC_OFF);
    for (int u = F.tid; u < (LDS_BYTES - RING_BYTES) / 4; u += NTHREADS) ((LAS unsigned*)(F.lds + RING_BYTES))[u] = 0u;
    __syncthreads();
    XcdBarrier bar = xcd_barrier_post(F.ctl + CW_BAR + args.li * XCD_BAR_WORDS, MISC + 8);
    const int lo = args.ph_lo, hi = args.ph_hi; const unsigned naive = args.naive;
#define IN(k) (lo <= (k) && (k) < hi)
#define SEAM(k) do { if (IN(k) && IN((k) + 1)) xcd_barrier(bar); } while (0)
#define NAIVE(t) ((naive >> (t)) & 1u)
    if (IN(0)) { phase_prologue(F); SEAM(0); }
    for (int l = 0; l < NLAYER; ++l) {
        const int pb = 1 + 8 * l;
        if (IN(pb + PH_A)) { phase_cumsum(F); SEAM(pb + PH_A); }
        if (IN(pb + PH_B)) { SEAM(pb + PH_B); }
        if (IN(pb + PH_C)) { SEAM(pb + PH_C); }
        if (IN(pb + PH_D)) { SEAM(pb + PH_D); }
        if (IN(pb + PH_E)) { phase_ln_router(F, l); SEAM(pb + PH_E); }
        if (IN(pb + PH_F)) { SEAM(pb + PH_F); }
        if (IN(pb + PH_G)) { SEAM(pb + PH_G); }
        if (IN(pb + PH_H)) { phase_ln_final(F, l); SEAM(pb + PH_H); }
    }
#undef IN
#undef SEAM
#undef NAIVE
}

#ifndef NAIVE_MASK
#define NAIVE_MASK 0x6Fu
#endif
static void launch_naive(int type, int layer, const Args& a, hipStream_t stream) {
    switch (type) {
    case PH_A: hipLaunchKernelGGL(naive_inproj, dim3(INP_N / 256, MROWS / 4), dim3(256), 0, stream, a, layer); break;
    case PH_B: { const int nq = NTOK; hipLaunchKernelGGL(naive_attn, dim3((16 * nq + 3) / 4), dim3(256), 0, stream, a, nq); } break;
    case PH_C: hipLaunchKernelGGL(naive_branch, dim3(DM / 256, MROWS / 4), dim3(256), 0, stream, a, layer); break;
    case PH_D: hipLaunchKernelGGL(naive_outproj, dim3(DM / 256, MROWS / 4), dim3(256), 0, stream, a, layer); break;
    case PH_F: hipLaunchKernelGGL(naive_moe_gu, dim3(FF / 256, NSLOT_MAX / 4), dim3(256), 0, stream, a, layer); break;
    case PH_G: hipLaunchKernelGGL(naive_moe_down, dim3(DM / 256, NSLOT_MAX / 4), dim3(256), 0, stream, a, layer); break;
    default: break;
    }
}
extern "C" void kernel_launch(void* const* d_in, const int* in_sizes, int n_in, void* d_out, int out_size, void* d_ws, size_t ws_size, hipStream_t stream) {
    static int grid = 0;
    if (grid == 0) {
        if (n_in != 18 || out_size != SEQ * DM || ws_size < WS_END) { fprintf(stderr, "kernel_launch: unexpected shapes (n_in %d out %d ws %zu)\n", n_in, out_size, ws_size); grid = -1; return; }
        int dev = 0, cus = 0;
        if (hipGetDevice(&dev) != hipSuccess || hipDeviceGetAttribute(&cus, hipDeviceAttributeMultiprocessorCount, dev) != hipSuccess) { grid = -1; return; }
        if (hipFuncSetAttribute((const void*)mk_fwd, hipFuncAttributeMaxDynamicSharedMemorySize, LDS_BYTES) != hipSuccess) { fprintf(stderr, "kernel_launch: hipFuncSetAttribute failed\n"); grid = -1; return; }
        int per_cu = 0;
        if (hipOccupancyMaxActiveBlocksPerMultiprocessor(&per_cu, (const void*)mk_fwd, NTHREADS, LDS_BYTES) != hipSuccess || per_cu < 1) fprintf(stderr, "kernel_launch: occupancy query says %d\n", per_cu);
        (void)hipGetLastError();
        grid = cus;
    }
    if (grid < 0) return;
    (void)hipMemsetAsync((char*)d_ws + WS_CTL, 0, CTL_ZERO_BYTES, stream);
    Args a{};
    for (int i = 0; i < 18; ++i) a.in[i] = (const float*)d_in[i];
    a.out = (float*)d_out; a.ws = (unsigned char*)d_ws; a.naive = NAIVE_MASK;
    int li = 0, lo = 0;
    auto flush = [&](int hi) { if (hi > lo) { a.ph_lo = lo; a.ph_hi = hi; a.li = li++; hipLaunchKernelGGL(mk_fwd, dim3(grid), dim3(NTHREADS), LDS_BYTES, stream, a); } lo = hi; };
    for (int ph = 1; ph < NPHASE; ++ph) {
        const int type = (ph - 1) & 7, layer = (ph - 1) >> 3;
        if ((NAIVE_MASK >> type) & 1u) {
            if (type == PH_A) flush(ph + 1); else { flush(ph); lo = ph + 1; }
            launch_naive(type, layer, a, stream); }
    }
    flush(NPHASE);
}
```

```cpp
#include <hip/hip_runtime.h>
#include <cstdio>
#include <cstdint>

#define GAS __attribute__((address_space(1)))
#define LAS __attribute__((address_space(3)))
typedef unsigned short bf16;
typedef float f32x4 __attribute__((ext_vector_type(4)));
typedef float f32x2 __attribute__((ext_vector_type(2)));
typedef unsigned u32x4 __attribute__((ext_vector_type(4)));
typedef unsigned u32x2 __attribute__((ext_vector_type(2)));
typedef GAS unsigned gu32;

constexpr int DM = 2048, SEQ = 8192, NMETA = 16, NTOK = SEQ + NMETA, MROWS = 8448;
constexpr int HD = 128, NHEAD = 8;
constexpr int QKV_N = 6144, G_N = 4096, INP_N = 10240, INP_SRC = 10248, FCOL = 6144;
constexpr int NE = 16, FF = 1024, NSLOT_MAX = 20480;
constexpr float ALPHA = 1.4142135623730951f, LN_EPS = 1e-5f;
constexpr float LOG2E = 1.4426950408889634f;
constexpr float QSCALE = 0.08838834764831845f * 1.4426950408889634f;
constexpr int NLAYER = 2, NPHASE = 1 + 8 * NLAYER;
enum { PH_A = 0, PH_B = 1, PH_C = 2, PH_D = 3, PH_E = 4, PH_F = 5, PH_G = 6, PH_H = 7 };

constexpr size_t MiB = 1u << 20;
constexpr size_t WS_CTL = 0, CTL_ZERO_BYTES = 1 * MiB;
constexpr size_t WS_WIN = 2 * MiB, WIN_L = 40 * MiB;
constexpr size_t WS_WB = 82 * MiB, WB_L = 8 * MiB;
constexpr size_t WS_WOUT = 98 * MiB, WOUT_L = 8 * MiB;
constexpr size_t WS_WGU = 114 * MiB, WGU_L = 128 * MiB, WGU_E = 8 * MiB;
constexpr size_t WS_WD = 370 * MiB, WD_L = 64 * MiB, WD_E = 4 * MiB;
constexpr size_t WS_HF = 498 * MiB;
constexpr size_t WS_HB = 564 * MiB;
constexpr size_t WS_RB = 597 * MiB;
constexpr size_t WS_QKV = 663 * MiB;
constexpr size_t WS_GB = 762 * MiB;
constexpr size_t WS_YB = 828 * MiB;
constexpr size_t WS_MG = 861 * MiB;
constexpr size_t WS_ACT = 663 * MiB;
constexpr size_t WS_OSL = 703 * MiB;
constexpr size_t WS_LOGF = 894 * MiB;
constexpr size_t WS_CUM = 895 * MiB;
constexpr size_t WS_ELIST = 896 * MiB;
constexpr size_t WS_TOKI = 897 * MiB;
constexpr size_t WS_END = 898 * MiB;
constexpr int CW_CNT = 1024;
constexpr int CW_BAR = 8192;
#define XCD_BAR_WORDS 3456
constexpr int MAX_LAUNCH = 20;
static_assert((CW_BAR + MAX_LAUNCH * XCD_BAR_WORDS) * 4 <= (int)CTL_ZERO_BYTES, "ctl");

constexpr int NWAVES = 8, NTHREADS = 512;
constexpr int RING_BYTES = 131072, MISC_OFF = RING_BYTES + 320, LDS_BYTES = 147456;

__device__ __forceinline__ unsigned f2bf(float f) { unsigned u = __builtin_bit_cast(unsigned, f); return (u + 0x7fffu + ((u >> 16) & 1u)) >> 16; }
__device__ __forceinline__ unsigned pk2(float lo, float hi) { return f2bf(lo) | (f2bf(hi) << 16); }
__device__ __forceinline__ float bflo(unsigned w) { return __builtin_bit_cast(float, w << 16); }
__device__ __forceinline__ float bfhi(unsigned w) { return __builtin_bit_cast(float, w & 0xffff0000u); }
__device__ __forceinline__ float bf2f(bf16 b) { return __builtin_bit_cast(float, ((unsigned)b) << 16); }
__device__ __forceinline__ float wave_sum(float v) {
#pragma unroll
    for (int o = 1; o < 64; o <<= 1) v += __shfl_xor(v, o);
    return v;
}
__device__ __forceinline__ float wave_max(float v) {
#pragma unroll
    for (int o = 1; o < 64; o <<= 1) v = fmaxf(v, __shfl_xor(v, o));
    return v;
}
__device__ __forceinline__ int row_of_p(int p) { return p < NMETA ? SEQ + p : p - NMETA; }
__device__ __forceinline__ float sigmoidf_(float x) { return 1.0f / (1.0f + __expf(-x)); }
__device__ __forceinline__ float dot8(u32x4 a, u32x4 b, float acc) {
    acc = fmaf(bflo(a.x), bflo(b.x), acc); acc = fmaf(bfhi(a.x), bfhi(b.x), acc);
    acc = fmaf(bflo(a.y), bflo(b.y), acc); acc = fmaf(bfhi(a.y), bfhi(b.y), acc);
    acc = fmaf(bflo(a.z), bflo(b.z), acc); acc = fmaf(bfhi(a.z), bfhi(b.z), acc);
    acc = fmaf(bflo(a.w), bflo(b.w), acc); acc = fmaf(bfhi(a.w), bfhi(b.w), acc);
    return acc;
}

struct Args { const float* in[18]; float* out; unsigned char* ws; int ph_lo, ph_hi; unsigned naive; int li; };
enum { I_X = 0, I_META, I_LNIN_G, I_LNIN_B, I_WIN, I_BF, I_WBSB, I_WBFX, I_WOUT, I_LNMIX_G, I_LNMIX_B, I_WR, I_RB, I_WG, I_WU, I_WD, I_LNFFN_G, I_LNFFN_B };

__device__ __forceinline__ int moe_cnt(const unsigned* ctl, int layer, int e) { return (int)ctl[CW_CNT + (layer * NE + e) * 64]; }
__device__ __forceinline__ bool moe_find(const unsigned* ctl, int layer, int s0, int& e_out, int& cnt_out, int& ps_out) {
    int acc = 0; e_out = -1; cnt_out = 0; ps_out = 0;
#pragma unroll
    for (int e = 0; e < NE; ++e) { const int c = moe_cnt(ctl, layer, e), nb = (c + 255) >> 8;
        if (e_out < 0 && s0 < (acc + nb) * 256) { e_out = e; cnt_out = c; ps_out = acc * 256; }
        acc += nb; }
    return e_out >= 0;
}
__device__ __forceinline__ int moe_pstart(const unsigned* ctl, int layer, int ex) {
    int acc = 0, r = 0;
#pragma unroll
    for (int e = 0; e < NE; ++e) { const int c = moe_cnt(ctl, layer, e); if (e == ex) r = acc * 256; acc += (c + 255) >> 8; }
    return r;
}

__device__ __forceinline__ void inproj_store(unsigned char* ws, int row, int n, float v) {
    if (n < QKV_N) { const bool isq = (n < 1024) || (n >= 3072 && n < 4096); ((bf16*)(ws + WS_QKV))[(size_t)row * QKV_N + n] = (bf16)f2bf(isq ? v * QSCALE : v); }
    else ((bf16*)(ws + WS_GB))[(size_t)row * G_N + (n - QKV_N)] = (bf16)f2bf(sigmoidf_(v));
}

__device__ __forceinline__ void dot4(const bf16* a0, const bf16* a1, const bf16* a2, const bf16* a3, const bf16* b, int K, float (&acc)[4]) {
    for (int k = 0; k < K; k += 8) {
        const u32x4 bv = *(const u32x4*)(b + k);
        acc[0] = dot8(*(const u32x4*)(a0 + k), bv, acc[0]); acc[1] = dot8(*(const u32x4*)(a1 + k), bv, acc[1]);
        acc[2] = dot8(*(const u32x4*)(a2 + k), bv, acc[2]); acc[3] = dot8(*(const u32x4*)(a3 + k), bv, acc[3]);
    }
}
__global__ void __launch_bounds__(256) naive_inproj(Args a, int layer) {
    const int n = blockIdx.x * 256 + threadIdx.x, r0 = blockIdx.y * 4;
    const bf16* A = (const bf16*)(a.ws + WS_HB) + (size_t)r0 * DM; const bf16* B = (const bf16*)(a.ws + WS_WIN + layer * WIN_L) + (size_t)n * DM;
    float acc[4] = {0.f, 0.f, 0.f, 0.f};
    dot4(A, A + DM, A + 2 * DM, A + 3 * DM, B, DM, acc);
    for (int i = 0; i < 4; ++i) inproj_store(a.ws, r0 + i, n, acc[i]);
}
__global__ void __launch_bounds__(256) naive_branch(Args a, int layer) {
    const int n = blockIdx.x * 256 + threadIdx.x, r0 = blockIdx.y * 4;
    const bf16* A = (const bf16*)(a.ws + WS_YB) + (size_t)r0 * DM; const bf16* B = (const bf16*)(a.ws + WS_WB + layer * WB_L) + (size_t)n * DM;
    float s[4] = {0.f, 0.f, 0.f, 0.f}, f[4] = {0.f, 0.f, 0.f, 0.f};
    dot4(A, A + DM, A + 2 * DM, A + 3 * DM, B, 1024, s);
    dot4(A + 1024, A + DM + 1024, A + 2 * DM + 1024, A + 3 * DM + 1024, B + 1024, 1024, f);
    const bf16* G = (const bf16*)(a.ws + WS_GB);
    for (int i = 0; i < 4; ++i) { const size_t r = r0 + i; const float gs = bf2f(G[r * G_N + n]), gf = bf2f(G[r * G_N + DM + n]);
        ((bf16*)(a.ws + WS_MG))[r * DM + n] = (bf16)f2bf(gs * s[i] + gf * f[i]); }
}
__global__ void __launch_bounds__(256) naive_outproj(Args a, int layer) {
    const int n = blockIdx.x * 256 + threadIdx.x, r0 = blockIdx.y * 4;
    const bf16* A = (const bf16*)(a.ws + WS_MG) + (size_t)r0 * DM; const bf16* B = (const bf16*)(a.ws + WS_WOUT + layer * WOUT_L) + (size_t)n * DM;
    float acc[4] = {0.f, 0.f, 0.f, 0.f};
    dot4(A, A + DM, A + 2 * DM, A + 3 * DM, B, DM, acc);
    const float* HF = (const float*)(a.ws + WS_HF); float* R = (float*)(a.ws + WS_RB);
    for (int i = 0; i < 4; ++i) { const size_t o = (size_t)(r0 + i) * DM + n; R[o] = ALPHA * HF[o] + acc[i]; }
}
__global__ void __launch_bounds__(256) naive_moe_gu(Args a, int layer) {
    const int j = blockIdx.x * 256 + threadIdx.x, s0 = blockIdx.y * 4;
    int e, cnt, ps; if (!moe_find((const unsigned*)(a.ws + WS_CTL), layer, s0, e, cnt, ps)) return;
    const int* elist = (const int*)(a.ws + WS_ELIST) + (size_t)e * MROWS;
    const bf16* HB = (const bf16*)(a.ws + WS_HB);
    const int rank = s0 - ps;
    const bf16* ap0 = HB + (size_t)(rank + 0 < cnt ? elist[rank + 0] : 0) * DM; const bf16* ap1 = HB + (size_t)(rank + 1 < cnt ? elist[rank + 1] : 0) * DM;
    const bf16* ap2 = HB + (size_t)(rank + 2 < cnt ? elist[rank + 2] : 0) * DM; const bf16* ap3 = HB + (size_t)(rank + 3 < cnt ? elist[rank + 3] : 0) * DM;
    const bf16* W = (const bf16*)(a.ws + WS_WGU + layer * WGU_L + e * WGU_E);
    const int rg = 256 * (j >> 7) + (j & 127);
    float g[4] = {0.f, 0.f, 0.f, 0.f}, u[4] = {0.f, 0.f, 0.f, 0.f};
    dot4(ap0, ap1, ap2, ap3, W + (size_t)rg * DM, DM, g);
    dot4(ap0, ap1, ap2, ap3, W + (size_t)(rg + 128) * DM, DM, u);
    bf16* act = (bf16*)(a.ws + WS_ACT);
#pragma unroll
    for (int i = 0; i < 4; ++i) act[(size_t)(s0 + i) * FF + j] = (bf16)f2bf(g[i] * sigmoidf_(g[i]) * u[i]);
}
__global__ void __launch_bounds__(256) naive_moe_down(Args a, int layer) {
    const int n = blockIdx.x * 256 + threadIdx.x, s0 = blockIdx.y * 4;
    int e, cnt, ps; if (!moe_find((const unsigned*)(a.ws + WS_CTL), layer, s0, e, cnt, ps)) return;
    const bf16* A = (const bf16*)(a.ws + WS_ACT) + (size_t)s0 * FF; const bf16* B = (const bf16*)(a.ws + WS_WD + layer * WD_L + e * WD_E) + (size_t)n * FF;
    float acc[4] = {0.f, 0.f, 0.f, 0.f};
    dot4(A, A + FF, A + 2 * FF, A + 3 * FF, B, FF, acc);
    bf16* O = (bf16*)(a.ws + WS_OSL);
#pragma unroll
    for (int i = 0; i < 4; ++i) O[(size_t)(s0 + i) * DM + n] = (bf16)f2bf(acc[i]);
}
__global__ void __launch_bounds__(256) naive_attn(Args a, int nq) {
    const int lane = threadIdx.x & 63, widx = blockIdx.x * 4 + (threadIdx.x >> 6);
    const int th = widx / nq, pq = nq - 1 - (widx % nq);
    if (th >= 16) return;
    const int type = th >> 3, head = th & 7;
    const bf16* QKV = (const bf16*)(a.ws + WS_QKV);
    const int qcol = (type ? 3072 : 0) + head * HD, kcol = qcol + 1024, vcol = qcol + 2048;
    const int rowq = row_of_p(pq);
    u32x4 q[16];
#pragma unroll
    for (int i = 0; i < 16; ++i) q[i] = *(const u32x4*)(QKV + (size_t)rowq * QKV_N + qcol + 8 * i);
    const float* cum = (const float*)(a.ws + WS_CUM) + (size_t)head * MROWS;
    float o0 = 0.f, o1 = 0.f, carry = 0.f, m = -1e30f, l = 0.f;
    const float cq = type ? cum[pq] : 0.f;
    for (int phi = type ? pq : pq - 1; phi >= 0; phi -= 64) {
        const int p = phi - lane; const bool valid = p >= 0; const int pr = row_of_p(valid ? p : 0);
        float u = 0.f;
        const bf16* kp = QKV + (size_t)pr * QKV_N + kcol;
#pragma unroll
        for (int i = 0; i < 16; ++i) u = dot8(q[i], *(const u32x4*)(kp + 8 * i), u);
        float w;
        if (type == 0) {
            const float aa = exp2f(-fabsf(u)), b = log2f(1.0f + aa);
            float lk = fminf(-u, 0.f) - b; const float lb = lk + u;
            if (!valid) lk = 0.f;
            float inc = lk;
#pragma unroll
            for (int off = 1; off < 64; off <<= 1) { const float t = __shfl_up(inc, off); if (lane >= off) inc += t; }
            const float after = carry + inc - lk;
            w = valid ? exp2f(lb + after) : 0.f;
            carry += __shfl(inc, 63);
        } else {
            const float s = valid ? u + cq - cum[valid ? p : 0] : -__builtin_inff();
            const float cm = wave_max(s), mn = fmaxf(m, cm), alpha = exp2f(m - mn);
            w = valid ? exp2f(s - mn) : 0.f;
            l = l * alpha + wave_sum(w); o0 *= alpha; o1 *= alpha; m = mn;
        }
        for (int j = 0; j < 64; ++j) {
            const float wj = __shfl(w, j); const int prj = __shfl(pr, j);
            const unsigned vv = *(const unsigned*)(QKV + (size_t)prj * QKV_N + vcol + 2 * lane);
            o0 = fmaf(wj, bflo(vv), o0); o1 = fmaf(wj, bfhi(vv), o1);
        }
    }
    if (type) { const float rl = 1.0f / l; o0 *= rl; o1 *= rl; }
    *(unsigned*)((bf16*)(a.ws + WS_YB) + (size_t)rowq * DM + type * 1024 + head * HD + 2 * lane) = pk2(o0, o1);
}

#define XB_TMO      128
#define XB_XCNT(j)  (256  + 64 * (j))
#define XB_XSUB(j)  (1280 + 64 * (j))
#define XB_XGEN(j)  (2304 + 64 * (j))
#define XB_TOP      3328
#define XB_TOPGEN   3392
#define XB_SPIN_CAP (1u << 18)
__device__ __forceinline__ unsigned xb_ld(unsigned* p)              { return __hip_atomic_load(p, __ATOMIC_RELAXED, __HIP_MEMORY_SCOPE_AGENT); }
__device__ __forceinline__ unsigned xb_add(unsigned* p, unsigned v) { return __hip_atomic_fetch_add(p, v, __ATOMIC_RELAXED, __HIP_MEMORY_SCOPE_AGENT); }
__device__ __forceinline__ unsigned xb_xcc_id() { return (unsigned)__builtin_amdgcn_s_getreg((3 << 11) | 20) & 0xFu; }
#define XB_SPIN(cond, bar) do { unsigned _sp = 0; while (cond) { __builtin_amdgcn_s_sleep(1); \
    if ((++_sp & 255u) == 0u) { if (xb_ld(&(bar)[XB_TMO])) break; if (_sp > XB_SPIN_CAP) { atomicAdd(&(bar)[XB_TMO], 1u); break; } } } } while (0)
struct XcdBarrier { unsigned* bar; unsigned x; volatile LAS unsigned* st; };
__device__ __forceinline__ XcdBarrier xcd_barrier_post(unsigned* bar, volatile LAS unsigned* st) {
    XcdBarrier b; b.bar = bar; b.x = xb_xcc_id(); b.st = st;
    if (threadIdx.x == 0) (void)xb_add(&bar[XB_XCNT(b.x)], 1u);
    return b;
}
__device__ __forceinline__ void xcd_barrier_complete(unsigned* bar, unsigned x, unsigned& nloc, unsigned& nx) {
    const unsigned G = gridDim.x * gridDim.y * gridDim.z;
    unsigned sum, cnt, mine, sp = 0u;
    for (;;) {
        sum = 0u; cnt = 0u; mine = 0u;
#pragma unroll
        for (unsigned j = 0; j < 16; ++j) { const unsigned c = xb_ld(&bar[XB_XCNT(j)]); sum += c; cnt += (c > 0u) ? 1u : 0u; mine = (j == x) ? c : mine; }
        if (sum == G) break;
        __builtin_amdgcn_s_sleep(1);
        if ((++sp & 255u) == 0u) { if (xb_ld(&bar[XB_TMO])) break; if (sp > XB_SPIN_CAP) { atomicAdd(&bar[XB_TMO], 1u); break; } }
    }
    nloc = mine > 0u ? mine : 1u; nx = cnt > 0u ? cnt : 1u;
}
__device__ __forceinline__ void xcd_barrier(const XcdBarrier& b) {
    asm volatile("s_waitcnt vmcnt(0)" ::: "memory");
    __syncthreads();
    if (threadIdx.x == 0) {
        unsigned* bar = b.bar;
        __builtin_amdgcn_s_waitcnt(0);
        unsigned nloc = b.st[0], nx = b.st[1];
        if (nloc == 0u) { xcd_barrier_complete(bar, b.x, nloc, nx); b.st[0] = nloc; b.st[1] = nx; }
        const unsigned old = xb_add(&bar[XB_XSUB(b.x)], 1u);
        const unsigned gen = old / nloc;
        if (old + 1u == (gen + 1u) * nloc) {
            __builtin_amdgcn_fence(__ATOMIC_RELEASE, "agent");
            asm volatile("s_waitcnt vmcnt(0)" ::: "memory");
            const unsigned og = xb_add(&bar[XB_TOP], 1u);
            const unsigned tg = og / nx;
            if (og + 1u == (tg + 1u) * nx) xb_add(&bar[XB_TOPGEN], 1u);
            else XB_SPIN(xb_ld(&bar[XB_TOPGEN]) == tg, bar);
            __builtin_amdgcn_fence(__ATOMIC_ACQUIRE, "agent");
            xb_add(&bar[XB_XGEN(b.x)], 1u);
            asm volatile("s_waitcnt vmcnt(0)" ::: "memory");
        } else {
            XB_SPIN(xb_ld(&bar[XB_XGEN(b.x)]) == gen, bar);
            __builtin_amdgcn_fence(__ATOMIC_ACQUIRE, "agent");
            asm volatile("s_waitcnt vmcnt(0)" ::: "memory");
        }
    }
    __syncthreads();
}

struct Frame {
    LAS unsigned char* lds; unsigned char* ws; unsigned* ctl;
    int tid, lane, wave, G, gw, NGW;
    const float* in[18]; float* out;
};
#define LDS_WAIT() asm volatile("s_waitcnt lgkmcnt(0)" ::: "memory")

__device__ __forceinline__ void transpose_item(const float* W, size_t ldw, bf16* WT, size_t ldt, LAS float* scr, int lane) {
#pragma unroll 8
    for (int i = 0; i < 32; ++i) { const int kk = 2 * i + (lane >> 5); scr[kk * 33 + (lane & 31)] = W[(size_t)kk * ldw + (lane & 31)]; }
    LDS_WAIT(); asm volatile("" ::: "memory");
    const int c = lane & 7;
#pragma unroll
    for (int j = 0; j < 4; ++j) { const int n = (lane >> 3) + 8 * j; const LAS float* s = scr + (8 * c) * 33 + n;
        u32x4 o; o.x = pk2(s[0 * 33], s[1 * 33]); o.y = pk2(s[2 * 33], s[3 * 33]); o.z = pk2(s[4 * 33], s[5 * 33]); o.w = pk2(s[6 * 33], s[7 * 33]);
        *(u32x4*)(WT + (size_t)n * ldt + 8 * c) = o; }
    LDS_WAIT(); asm volatile("" ::: "memory");
}
__device__ __forceinline__ void convert_item(Frame& F, int it, LAS float* scr) {
    constexpr int I_IN = 32 * 320, I_BS = 16 * 64, I_OUT = 32 * 64, I_GE = 32 * 32, I_DE = 16 * 64;
    constexpr int PER_LAYER = I_IN + 2 * I_BS + I_OUT + NE * (2 * I_GE + I_DE);
    const int l = it / PER_LAYER; int r = it % PER_LAYER;
    if (r < I_IN) { const int kb = r / 320, nb = r % 320, nd = 32 * nb, ns = nd + (nd >= FCOL ? 8 : 0);
        transpose_item(F.in[I_WIN] + (size_t)l * DM * INP_SRC + (size_t)(64 * kb) * INP_SRC + ns, INP_SRC, (bf16*)(F.ws + WS_WIN + l * WIN_L) + (size_t)nd * DM + 64 * kb, DM, scr, F.lane); return; }
    r -= I_IN;
    if (r < 2 * I_BS) { const int which = r / I_BS; r %= I_BS; const int kb = r / 64, nb = r % 64;
        transpose_item((which ? F.in[I_WBFX] : F.in[I_WBSB]) + (size_t)l * 1024 * DM + (size_t)(64 * kb) * DM + 32 * nb, DM, (bf16*)(F.ws + WS_WB + l * WB_L) + (size_t)(32 * nb) * DM + which * 1024 + 64 * kb, DM, scr, F.lane); return; }
    r -= 2 * I_BS;
    if (r < I_OUT) { const int kb = r / 64, nb = r % 64;
        transpose_item(F.in[I_WOUT] + (size_t)l * DM * DM + (size_t)(64 * kb) * DM + 32 * nb, DM, (bf16*)(F.ws + WS_WOUT + l * WOUT_L) + (size_t)(32 * nb) * DM + 64 * kb, DM, scr, F.lane); return; }
    r -= I_OUT;
    const int e = r / (2 * I_GE + I_DE); r %= (2 * I_GE + I_DE);
    if (r < 2 * I_GE) { const int which = r / I_GE; r %= I_GE; const int kb = r / 32, nb = r % 32, n0 = 32 * nb, rho = 256 * (n0 >> 7) + (n0 & 127) + which * 128;
        transpose_item((which ? F.in[I_WU] : F.in[I_WG]) + ((size_t)(l * NE + e) * DM + 64 * kb) * FF + n0, FF, (bf16*)(F.ws + WS_WGU + l * WGU_L + e * WGU_E) + (size_t)rho * DM + 64 * kb, DM, scr, F.lane); return; }
    r -= 2 * I_GE;
    { const int kb = r / 64, nb = r % 64;
        transpose_item(F.in[I_WD] + ((size_t)(l * NE + e) * FF + 64 * kb) * DM + 32 * nb, DM, (bf16*)(F.ws + WS_WD + l * WD_L + e * WD_E) + (size_t)(32 * nb) * FF + 64 * kb, FF, scr, F.lane); }
}
constexpr int N_CONVERT_ITEMS = NLAYER * (32 * 320 + 2 * 16 * 64 + 32 * 64 + NE * (2 * 32 * 32 + 16 * 64));

__device__ __forceinline__ int tab_rowpos(int c) { return (c & 3) * 512 + (c >> 8) * 64 + ((c >> 2) & 63); }
template <int NC> __device__ __forceinline__ void stage_table(Frame& F, const float* src, size_t pitch) {
    constexpr int CH = NC / 4;
    for (int ci = F.tid; ci < DM * CH; ci += NTHREADS) { const int c = ci / CH, q = ci % CH;
        const f32x4 v = *(const f32x4*)(src + (size_t)c * pitch + 4 * q);
        const int sw = (NC == 16) ? ((c >> 4) & 3) : ((c >> 5) & 1);
        *(LAS f32x4*)(F.lds + tab_rowpos(c) * (NC * 4) + ((q ^ sw) << 4)) = v; }
    LDS_WAIT(); __syncthreads();
}
template <int NC> __device__ __forceinline__ void table_dot(Frame& F, const f32x4 (&y)[8], float (&acc)[NC]) {
    constexpr int CH = NC / 4; const int l = F.lane; const int sw = (NC == 16) ? ((l >> 2) & 3) : ((l >> 3) & 1);
#pragma unroll
    for (int e = 0; e < NC; ++e) acc[e] = 0.f;
#pragma unroll
    for (int j = 0; j < 8; ++j)
#pragma unroll
        for (int i = 0; i < 4; ++i) { const float yv = y[j][i]; const int rp = i * 512 + j * 64 + l; if (i == 0) asm volatile("" ::: "memory");
#pragma unroll
            for (int q = 0; q < CH; ++q) { const f32x4 w = *(const LAS f32x4*)(F.lds + rp * (NC * 4) + ((q ^ sw) << 4));
                acc[4 * q + 0] = fmaf(yv, w.x, acc[4 * q + 0]); acc[4 * q + 1] = fmaf(yv, w.y, acc[4 * q + 1]); acc[4 * q + 2] = fmaf(yv, w.z, acc[4 * q + 2]); acc[4 * q + 3] = fmaf(yv, w.w, acc[4 * q + 3]); } }
#pragma unroll
    for (int e = 0; e < NC; ++e) acc[e] = wave_sum(acc[e]);
}
__device__ __forceinline__ void ln_row(Frame& F, f32x4 (&v)[8], const float* g, const float* b) {
    float s = 0.f;
#pragma unroll
    for (int j = 0; j < 8; ++j) s += (v[j].x + v[j].y) + (v[j].z + v[j].w);
    const float mean = wave_sum(s) * (1.f / DM); float s2 = 0.f;
#pragma unroll
    for (int j = 0; j < 8; ++j) { v[j] = v[j] - mean; s2 += (v[j].x * v[j].x + v[j].y * v[j].y) + (v[j].z * v[j].z + v[j].w * v[j].w); }
    const float rstd = 1.0f / sqrtf(wave_sum(s2) * (1.f / DM) + LN_EPS);
#pragma unroll
    for (int j = 0; j < 8; ++j) { const f32x4 gv = *(const f32x4*)(g + 256 * j + 4 * F.lane), bv = *(const f32x4*)(b + 256 * j + 4 * F.lane); v[j] = v[j] * rstd * gv + bv; }
}
__device__ __forceinline__ void store_h(Frame& F, int row, const f32x4 (&y)[8]) {
    float* hf = (float*)(F.ws + WS_HF) + (size_t)row * DM; bf16* hb = (bf16*)(F.ws + WS_HB) + (size_t)row * DM;
#pragma unroll
    for (int j = 0; j < 8; ++j) { *(f32x4*)(hf + 256 * j + 4 * F.lane) = y[j]; u32x2 w; w.x = pk2(y[j].x, y[j].y); w.y = pk2(y[j].z, y[j].w); *(u32x2*)(hb + 256 * j + 4 * F.lane) = w; }
}
__device__ __forceinline__ void store_logf(Frame& F, int row, const f32x4 (&y)[8], const float* bfor) {
    float acc[8]; table_dot<8>(F, y, acc);
    if (F.lane < 8) { float a = acc[0];
#pragma unroll
        for (int h = 1; h < 8; ++h) a = (F.lane == h) ? acc[h] : a;
        const float x = a + bfor[F.lane];
        const float ls = fminf(x, 0.f) - log1pf(__expf(-fabsf(x)));
        ((float*)(F.ws + WS_LOGF))[(size_t)row * 8 + F.lane] = ls; }
}

__device__ __forceinline__ void phase_prologue(Frame& F) {
    LAS float* scr = (LAS float*)(F.lds + F.wave * 16384);
    for (int it = F.gw; it < N_CONVERT_ITEMS; it += F.NGW) convert_item(F, it, scr);
    __syncthreads();
    stage_table<8>(F, F.in[I_WIN] + FCOL, INP_SRC);
    for (int row = F.gw; row < NTOK; row += F.NGW) {
        const float* src = row < SEQ ? F.in[I_X] + (size_t)row * DM : F.in[I_META] + (size_t)(row - SEQ) * DM;
        f32x4 v[8];
#pragma unroll
        for (int j = 0; j < 8; ++j) v[j] = *(const f32x4*)(src + 256 * j + 4 * F.lane);
        ln_row(F, v, F.in[I_LNIN_G], F.in[I_LNIN_B]);
        store_h(F, row, v);
        store_logf(F, row, v, F.in[I_BF]);
    }
    for (int row = NTOK + F.gw; row < MROWS; row += F.NGW) { bf16* hb = (bf16*)(F.ws + WS_HB) + (size_t)row * DM;
#pragma unroll
        for (int j = 0; j < 4; ++j) *(u32x4*)(hb + 512 * j + 8 * F.lane) = (u32x4){0u, 0u, 0u, 0u}; }
    __syncthreads();
}
__device__ __forceinline__ void phase_cumsum(Frame& F) {
    if (blockIdx.x >= NHEAD) return;
    const int h = blockIdx.x; const float* logf = (const float*)(F.ws + WS_LOGF); float* cum = (float*)(F.ws + WS_CUM) + (size_t)h * MROWS;
    constexpr int PER = 17; const int p0 = F.tid * PER;
    float loc[PER]; float s = 0.f;
#pragma unroll
    for (int i = 0; i < PER; ++i) { const int p = p0 + i; const float v = p < NTOK ? logf[(size_t)row_of_p(p) * 8 + h] : 0.f; s += v; loc[i] = s; }
    float inc = s;
#pragma unroll
    for (int off = 1; off < 64; off <<= 1) { const float t = __shfl_up(inc, off); if (F.lane >= off) inc += t; }
    LAS float* wt = (LAS float*)(F.lds);
    if (F.lane == 63) wt[F.wave] = inc;
    LDS_WAIT(); __syncthreads();
    float base = inc - s;
    for (int w = 0; w < F.wave; ++w) base += wt[w];
#pragma unroll
    for (int i = 0; i < PER; ++i) { const int p = p0 + i; if (p < NTOK) cum[p] = (base + loc[i]) * LOG2E; }
    LDS_WAIT(); __syncthreads();
}
__device__ __forceinline__ void phase_ln_router(Frame& F, int layer) {
    stage_table<16>(F, F.in[I_WR], 16);
    const float* g = F.in[I_LNMIX_G] + layer * DM; const float* b = F.in[I_LNMIX_B] + layer * DM;
    const float* rbias = F.in[I_RB];
    for (int row = F.gw; row < NTOK; row += F.NGW) {
        const float* src = (const float*)(F.ws + WS_RB) + (size_t)row * DM;
        f32x4 v[8];
#pragma unroll
        for (int j = 0; j < 8; ++j) v[j] = *(const f32x4*)(src + 256 * j + 4 * F.lane);
        ln_row(F, v, g, b);
        store_h(F, row, v);
        float lg[16]; table_dot<16>(F, v, lg);
        float aff[16], sel[16];
#pragma unroll
        for (int e = 0; e < 16; ++e) { aff[e] = 1.0f / (1.0f + __expf(-lg[e])); sel[e] = aff[e] + rbias[e]; }
        int bg = 0; float bs = -__builtin_inff();
#pragma unroll
        for (int gi = 0; gi < 4; ++gi) { const float a0 = sel[4 * gi], a1 = sel[4 * gi + 1], a2 = sel[4 * gi + 2], a3 = sel[4 * gi + 3];
            const float h1 = fmaxf(a0, a1), l1 = fminf(a0, a1), h2 = fmaxf(a2, a3), l2 = fminf(a2, a3);
            const float top = fmaxf(h1, h2), sec = fmaxf(fminf(h1, h2), fmaxf(l1, l2)), sc = top + sec;
            if (sc > bs) { bs = sc; bg = gi; } }
        float s4[4], a4[4];
#pragma unroll
        for (int i = 0; i < 4; ++i) { s4[i] = sel[i]; a4[i] = aff[i]; }
#pragma unroll
        for (int gi = 1; gi < 4; ++gi) if (bg == gi) {
#pragma unroll
            for (int i = 0; i < 4; ++i) { s4[i] = sel[4 * gi + i]; a4[i] = aff[4 * gi + i]; } }
        int i1 = 0; float m1 = s4[0];
#pragma unroll
        for (int i = 1; i < 4; ++i) if (s4[i] > m1) { m1 = s4[i]; i1 = i; }
        int i2 = -1; float m2 = -__builtin_inff();
#pragma unroll
        for (int i = 0; i < 4; ++i) if (i != i1 && s4[i] > m2) { m2 = s4[i]; i2 = i; }
        float af1 = a4[0], af2 = a4[0];
#pragma unroll
        for (int i = 1; i < 4; ++i) { if (i1 == i) af1 = a4[i]; if (i2 == i) af2 = a4[i]; }
        const float wsum = af1 + af2, w1 = af1 / wsum, w2 = af2 / wsum;
        const int e1 = 4 * bg + i1, e2 = 4 * bg + i2;
        if (F.lane == 0) {
            const int r1 = (int)atomicAdd(F.ctl + CW_CNT + (layer * NE + e1) * 64, 1u), r2 = (int)atomicAdd(F.ctl + CW_CNT + (layer * NE + e2) * 64, 1u);
            int* el = (int*)(F.ws + WS_ELIST); el[(size_t)e1 * MROWS + r1] = row; el[(size_t)e2 * MROWS + r2] = row;
            int* ti = (int*)(F.ws + WS_TOKI) + (size_t)row * 8;
            ti[0] = e1; ti[1] = e2; ti[2] = r1; ti[3] = r2; ti[4] = __builtin_bit_cast(int, w1); ti[5] = __builtin_bit_cast(int, w2);
        }
    }
    __syncthreads();
}
__device__ __forceinline__ void phase_ln_final(Frame& F, int layer) {
    const bool last = layer == NLAYER - 1;
    if (!last) stage_table<8>(F, F.in[I_WIN] + (size_t)(layer + 1) * DM * INP_SRC + FCOL, INP_SRC);
    const float* g = F.in[I_LNFFN_G] + layer * DM; const float* b = F.in[I_LNFFN_B] + layer * DM;
    const int nrows = last ? SEQ : NTOK;
    for (int row = F.gw; row < nrows; row += F.NGW) {
        const int* ti = (const int*)(F.ws + WS_TOKI) + (size_t)row * 8;
        const int e1 = ti[0], e2 = ti[1], r1 = ti[2], r2 = ti[3]; const float w1 = __builtin_bit_cast(float, ti[4]), w2 = __builtin_bit_cast(float, ti[5]);
        const int ps1 = moe_pstart(F.ctl, layer, e1), ps2 = moe_pstart(F.ctl, layer, e2);
        const bf16* o1 = (const bf16*)(F.ws + WS_OSL) + (size_t)(ps1 + r1) * DM; const bf16* o2 = (const bf16*)(F.ws + WS_OSL) + (size_t)(ps2 + r2) * DM;
        const float* hf = (const float*)(F.ws + WS_HF) + (size_t)row * DM;
        f32x4 v[8];
#pragma unroll
        for (int j = 0; j < 8; ++j) { const f32x4 hv = *(const f32x4*)(hf + 256 * j + 4 * F.lane);
            const u32x2 a = *(const u32x2*)(o1 + 256 * j + 4 * F.lane), c = *(const u32x2*)(o2 + 256 * j + 4 * F.lane);
            v[j].x = ALPHA * hv.x + w1 * bflo(a.x) + w2 * bflo(c.x); v[j].y = ALPHA * hv.y + w1 * bfhi(a.x) + w2 * bfhi(c.x);
            v[j].z = ALPHA * hv.z + w1 * bflo(a.y) + w2 * bflo(c.y); v[j].w = ALPHA * hv.w + w1 * bfhi(a.y) + w2 * bfhi(c.y); }
        ln_row(F, v, g, b);
        if (last) { float* o = F.out + (size_t)row * DM;
#pragma unroll
            for (int j = 0; j < 8; ++j) *(f32x4*)(o + 256 * j + 4 * F.lane) = v[j]; }
        else { store_h(F, row, v); store_logf(F, row, v, F.in[I_BF] + (layer + 1) * NHEAD); }
    }
    __syncthreads();
}

namespace pg8 {
typedef short bf16x8 __attribute__((ext_vector_type(8)));
constexpr int BM = 256, BK = 64, HALF = 128, HTB = HALF * BK * 2, STAGE_BYTES = 8 * HTB, NXCD = 8, WGM = 8;
__host__ __device__ __forceinline__ int lds_byte(int r, int c) { const int st = (r >> 4) * 2 + (c >> 5), rr = r & 15, cc = c & 31, ob = rr * 64 + cc * 2; return st * 1024 + (ob ^ (((ob >> 9) & 1) << 5)); }
__host__ __device__ __forceinline__ void stage_rc(int b, int& R, int& C) { const int st = b / 1024, sb = b % 1024, swz = sb ^ (((sb >> 9) & 1) << 5); R = (st >> 1) * 16 + swz / 64; C = (st & 1) * 32 + (swz % 64) / 2; }
__host__ __device__ __forceinline__ int perm32(int rho) { const int n = rho >> 4, i = rho & 15; return 8 * (i >> 2) + 4 * n + (i & 3); }
struct Unit { int pm, pn, aux; };
__device__ __forceinline__ bool static_tile(int nM, int nN, int G, int c, int i, int& pm, int& pn) {
    const int nwg = nM * nN; const long L = (long)i * G + c; if (L >= nwg) return false;
    int wgid = (int)L; { const int q = nwg / NXCD, r = nwg % NXCD, xcd = wgid % NXCD, off = wgid / NXCD; wgid = (xcd < r ? xcd * (q + 1) : r * (q + 1) + (xcd - r) * q) + off; }
    const int nig = WGM * nN, gid = wgid / nig, fm = gid * WGM, gsz = (nM - fm) < WGM ? (nM - fm) : WGM;
    pm = fm + ((wgid % nig) % gsz); pn = (wgid % nig) / gsz; return true;
}
__device__ __forceinline__ unsigned cvt_pk_bf16(float lo, float hi) { unsigned r; asm volatile("v_cvt_pk_bf16_f32 %0, %1, %2" : "=v"(r) : "v"(lo), "v"(hi)); return r; }

template <class P>
__device__ __forceinline__ void gemm_phase(LAS unsigned char* lds, const P& prob) {
    const int tid = threadIdx.x, wid = __builtin_amdgcn_readfirstlane(tid >> 6), lane = tid & 63, wr = wid >> 2, wc = wid & 3, fr = lane & 15, fq = lane >> 4;
    const int nt = prob.K / BK;
    unsigned voffA[2], voffA1[2], voffB[2];
#pragma unroll
    for (int i = 0; i < 2; ++i) { int R, C; stage_rc(tid * 16 + i * 8192, R, C); const int Rb = P::PERM ? ((R & ~31) + perm32(R & 31)) : R;
        voffA[i] = (unsigned)(R * prob.lda + C) * 2u; voffA1[i] = voffA[i]; voffB[i] = (unsigned)(Rb * prob.ldb + C) * 2u; }
    const size_t kstep = (size_t)(BK * 2);
    const size_t hstepA = P::GATHER ? (size_t)0 : (size_t)HALF * prob.lda * 2, hstepB = (size_t)HALF * prob.ldb * 2;
    const unsigned ldsw = (unsigned)wid * 1024u;
    const int aoff = lds_byte(wr * 64 + fr, fq * 8), boff = lds_byte(wc * 32 + fr, fq * 8);
#define PG8_SA(b, h) (((b) * 2 + (h)) * HTB)
#define PG8_SB(b, h) ((4 + (b) * 2 + (h)) * HTB)
#define PG8_STAGE(bufoff, gbase, voff) do { _Pragma("unroll") for (int _i = 0; _i < 2; ++_i) \
        __builtin_amdgcn_global_load_lds((const unsigned*)((const char*)(gbase) + (voff)[_i]), (LAS unsigned*)(lds + (bufoff) + ldsw + _i * 8192), 16, 0, 0); } while (0)
#define PG8_LDA(dst, b, h) do { _Pragma("unroll") for (int m = 0; m < 4; ++m) _Pragma("unroll") for (int k = 0; k < 2; ++k) dst[m][k] = *(const LAS bf16x8*)(lds + PG8_SA(b, h) + aoff + m * 2048 + k * 1024); } while (0)
#define PG8_LDB(dst, b, h) do { _Pragma("unroll") for (int n = 0; n < 2; ++n) _Pragma("unroll") for (int k = 0; k < 2; ++k) dst[n][k] = *(const LAS bf16x8*)(lds + PG8_SB(b, h) + boff + n * 2048 + k * 1024); } while (0)
#define PG8_MMA(ai, bj, At, Bt) do { __builtin_amdgcn_s_setprio(1); _Pragma("unroll") for (int m = 0; m < 4; ++m) _Pragma("unroll") for (int n = 0; n < 2; ++n) _Pragma("unroll") for (int k = 0; k < 2; ++k) \
        acc[ai][bj][m][n] = __builtin_amdgcn_mfma_f32_16x16x32_bf16(Bt[n][k], At[m][k], acc[ai][bj][m][n], 0, 0, 0); __builtin_amdgcn_s_setprio(0); } while (0)
#define PG8_WAIT_V(n) asm volatile("s_waitcnt vmcnt(" #n ")" ::: "memory")
#define PG8_WAIT_L(n) asm volatile("s_waitcnt lgkmcnt(" #n ")" ::: "memory")
#define PG8_BAR __builtin_amdgcn_s_barrier()
#define PG8_SCHED __builtin_amdgcn_sched_barrier(0)
#define PG8_GATHER_OFFS(ui_, d0, d1) do { _Pragma("unroll") for (int _i = 0; _i < 2; ++_i) { int R_, C_; stage_rc(tid * 16 + _i * 8192, R_, C_); \
        d0[_i] = (unsigned)(prob.a_row(ui_, R_) * prob.lda + C_) * 2u; d1[_i] = (unsigned)(prob.a_row(ui_, HALF + R_) * prob.lda + C_) * 2u; } } while (0)
    Unit cur, nxt; int ui = 0;
    if (!prob.next(0, cur)) return;
    f32x4 acc[2][2][4][2];
#pragma unroll
    for (int a = 0; a < 2; ++a)
#pragma unroll
        for (int b = 0; b < 2; ++b)
#pragma unroll
            for (int m = 0; m < 4; ++m)
#pragma unroll
                for (int n = 0; n < 2; ++n) acc[a][b][m][n] = (f32x4){0.f, 0.f, 0.f, 0.f};
    bf16x8 At[4][2], B0[2][2], B1[2][2];
    const char* cA = prob.a_ptr(cur); const char* cB = prob.b_ptr(cur);
    if constexpr (P::GATHER) PG8_GATHER_OFFS(0, voffA, voffA1);
    PG8_STAGE(PG8_SB(0, 0), cB, voffB); PG8_STAGE(PG8_SB(0, 1), cB + hstepB, voffB); PG8_STAGE(PG8_SA(0, 0), cA, voffA); PG8_STAGE(PG8_SA(0, 1), cA + hstepA, voffA1);
    if (wr == 1) PG8_BAR;
    PG8_WAIT_V(2); PG8_BAR;
    PG8_STAGE(PG8_SB(1, 0), cB + kstep, voffB); PG8_STAGE(PG8_SA(1, 0), cA + kstep, voffA); PG8_STAGE(PG8_SB(1, 1), cB + hstepB + kstep, voffB);
    PG8_WAIT_V(6); PG8_BAR;
    for (;;) {
        const bool has_next = prob.next(ui + 1, nxt);
        const char* nA = has_next ? prob.a_ptr(nxt) : cA; const char* nB = has_next ? prob.b_ptr(nxt) : cB;
        for (int t = 0; t < nt; t += 2) {
            const bool last = (t == nt - 2);
            const char* a1 = cA + (size_t)(t + 1) * kstep;
            const char* a2 = last ? nA : cA + (size_t)(t + 2) * kstep; const char* b2 = last ? nB : cB + (size_t)(t + 2) * kstep;
            const char* a3 = a2 + kstep; const char* b3 = b2 + kstep;
            if constexpr (P::GATHER) {
                unsigned v0[2], v1[2];
#pragma unroll
                for (int i = 0; i < 2; ++i) { v0[i] = voffA[i]; v1[i] = voffA1[i]; }
                if (last && has_next) PG8_GATHER_OFFS(ui + 1, v0, v1);
                PG8_LDB(B0, 0, 0); PG8_LDB(B1, 0, 1); PG8_SCHED; PG8_LDA(At, 0, 0); PG8_STAGE(PG8_SA(1, 1), a1, voffA1);
                PG8_WAIT_V(8); PG8_WAIT_L(0); PG8_BAR; PG8_MMA(0, 0, At, B0); PG8_MMA(0, 1, At, B1); PG8_BAR; PG8_SCHED;
                PG8_LDA(At, 0, 1); PG8_STAGE(PG8_SB(0, 0), b2, voffB); PG8_STAGE(PG8_SB(0, 1), b2 + hstepB, voffB); PG8_STAGE(PG8_SA(0, 0), a2, v0);
                PG8_WAIT_V(8); PG8_WAIT_L(0); PG8_BAR; PG8_MMA(1, 0, At, B0); PG8_MMA(1, 1, At, B1); PG8_BAR; PG8_SCHED;
                PG8_LDB(B0, 1, 0); PG8_LDB(B1, 1, 1); PG8_SCHED; PG8_LDA(At, 1, 0); PG8_STAGE(PG8_SA(0, 1), a2, v1);
                PG8_WAIT_V(8); PG8_WAIT_L(0); PG8_BAR; PG8_MMA(0, 0, At, B0); PG8_MMA(0, 1, At, B1); PG8_BAR; PG8_SCHED;
                PG8_LDA(At, 1, 1); PG8_STAGE(PG8_SB(1, 0), b3, voffB); PG8_STAGE(PG8_SB(1, 1), b3 + hstepB, voffB); PG8_STAGE(PG8_SA(1, 0), a3, v0);
                PG8_WAIT_V(8); PG8_WAIT_L(0); PG8_BAR; PG8_MMA(1, 0, At, B0); PG8_MMA(1, 1, At, B1); PG8_BAR; PG8_SCHED;
#pragma unroll
                for (int i = 0; i < 2; ++i) { voffA[i] = v0[i]; voffA1[i] = v1[i]; }
            } else {
                PG8_LDB(B0, 0, 0); PG8_LDB(B1, 0, 1); PG8_SCHED; PG8_LDA(At, 0, 0); PG8_STAGE(PG8_SA(1, 1), a1 + hstepA, voffA);
                PG8_WAIT_V(8); PG8_WAIT_L(0); PG8_BAR; PG8_MMA(0, 0, At, B0); PG8_MMA(0, 1, At, B1); PG8_BAR; PG8_SCHED;
                PG8_LDA(At, 0, 1); PG8_STAGE(PG8_SB(0, 0), b2, voffB); PG8_STAGE(PG8_SB(0, 1), b2 + hstepB, voffB); PG8_STAGE(PG8_SA(0, 0), a2, voffA);
                PG8_WAIT_V(8); PG8_WAIT_L(0); PG8_BAR; PG8_MMA(1, 0, At, B0); PG8_MMA(1, 1, At, B1); PG8_BAR; PG8_SCHED;
                PG8_LDB(B0, 1, 0); PG8_LDB(B1, 1, 1); PG8_SCHED; PG8_LDA(At, 1, 0); PG8_STAGE(PG8_SA(0, 1), a2 + hstepA, voffA);
                PG8_WAIT_V(8); PG8_WAIT_L(0); PG8_BAR; PG8_MMA(0, 0, At, B0); PG8_MMA(0, 1, At, B1); PG8_BAR; PG8_SCHED;
                PG8_LDA(At, 1, 1); PG8_STAGE(PG8_SB(1, 0), b3, voffB); PG8_STAGE(PG8_SB(1, 1), b3 + hstepB, voffB); PG8_STAGE(PG8_SA(1, 0), a3, voffA);
                PG8_WAIT_V(8); PG8_WAIT_L(0); PG8_BAR; PG8_MMA(1, 0, At, B0); PG8_MMA(1, 1, At, B1); PG8_BAR; PG8_SCHED;
            }
        }
        if (wr == 0) PG8_BAR;
        const bool keep = prob.epi(acc, cur, wr, wc, fr, fq);
        if (!has_next) break;
        if (!P::KEEPS || !keep) {
#pragma unroll
            for (int a = 0; a < 2; ++a)
#pragma unroll
                for (int b = 0; b < 2; ++b)
#pragma unroll
                    for (int m = 0; m < 4; ++m)
#pragma unroll
                        for (int n = 0; n < 2; ++n) acc[a][b][m][n] = (f32x4){0.f, 0.f, 0.f, 0.f};
        }
        cur = nxt; cA = nA; cB = nB; ++ui;
        if (wr == 1) PG8_BAR;
    }
    PG8_WAIT_V(0);
    PG8_BAR;
#undef PG8_SA
#undef PG8_SB
#undef PG8_STAGE
#undef PG8_LDA
#undef PG8_LDB
#undef PG8_MMA
#undef PG8_WAIT_V
#undef PG8_WAIT_L
#undef PG8_BAR
#undef PG8_SCHED
#undef PG8_GATHER_OFFS
}
}

using pg8::Unit;
struct ProbInProj {
    static constexpr bool PERM = true, GATHER = false, KEEPS = false;
    int K, lda, ldb, G, c; const bf16* A; const bf16* B; unsigned char* ws;
    __device__ __forceinline__ bool next(int i, Unit& u) const { u.aux = 0; return pg8::static_tile(MROWS / 256, INP_N / 256, G, c, i, u.pm, u.pn); }
    __device__ __forceinline__ const char* a_ptr(const Unit& u) const { return (const char*)(A + (size_t)u.pm * 256 * lda); }
    __device__ __forceinline__ const char* b_ptr(const Unit& u) const { return (const char*)(B + (size_t)u.pn * 256 * ldb); }
    __device__ __forceinline__ bool epi(f32x4 (&acc)[2][2][4][2], const Unit& u, int wr, int wc, int fr, int fq) const {
        const int row0 = u.pm * 256 + wr * 64 + fr, ct = u.pn * 256 + wc * 32 + 8 * fq;
        const bool isg = u.pn >= 24, isq = (u.pn < 4) || (u.pn >= 12 && u.pn < 16);
        bf16* base = isg ? (bf16*)(ws + WS_GB) + (ct - QKV_N) : (bf16*)(ws + WS_QKV) + ct; const int ldc = isg ? G_N : QKV_N; const float sc = isq ? QSCALE : 1.0f;
#pragma unroll
        for (int ai = 0; ai < 2; ++ai)
#pragma unroll
            for (int m = 0; m < 4; ++m) { bf16* rowp = base + (size_t)(row0 + ai * 128 + m * 16) * ldc;
#pragma unroll
                for (int bj = 0; bj < 2; ++bj) { f32x4 v0 = acc[ai][bj][m][0], v1 = acc[ai][bj][m][1];
                    if (isg) {
#pragma unroll
                        for (int j = 0; j < 4; ++j) { v0[j] = __builtin_amdgcn_rcpf(1.0f + __builtin_amdgcn_exp2f(-LOG2E * v0[j])); v1[j] = __builtin_amdgcn_rcpf(1.0f + __builtin_amdgcn_exp2f(-LOG2E * v1[j])); } }
                    else { v0 = v0 * sc; v1 = v1 * sc; }
                    u32x4 w; w.x = pg8::cvt_pk_bf16(v0[0], v0[1]); w.y = pg8::cvt_pk_bf16(v0[2], v0[3]); w.z = pg8::cvt_pk_bf16(v1[0], v1[1]); w.w = pg8::cvt_pk_bf16(v1[2], v1[3]);
                    *(u32x4*)(rowp + bj * 128) = w; } }
        return false;
    }
};
struct ProbOutProj {
    static constexpr bool PERM = false, GATHER = false, KEEPS = false;
    int K, lda, ldb, G, c; const bf16* A; const bf16* B; unsigned char* ws;
    __device__ __forceinline__ bool next(int i, Unit& u) const { u.aux = 0; return pg8::static_tile(MROWS / 256, DM / 256, G, c, i, u.pm, u.pn); }
    __device__ __forceinline__ const char* a_ptr(const Unit& u) const { return (const char*)(A + (size_t)u.pm * 256 * lda); }
    __device__ __forceinline__ const char* b_ptr(const Unit& u) const { return (const char*)(B + (size_t)u.pn * 256 * ldb); }
    __device__ __forceinline__ bool epi(f32x4 (&acc)[2][2][4][2], const Unit& u, int wr, int wc, int fr, int fq) const {
        const int row0 = u.pm * 256 + wr * 64 + fr, col0 = u.pn * 256 + wc * 32 + 4 * fq;
        const float* HF = (const float*)(ws + WS_HF); float* R = (float*)(ws + WS_RB);
#pragma unroll
        for (int ai = 0; ai < 2; ++ai)
#pragma unroll
            for (int m = 0; m < 4; ++m) { const size_t off = (size_t)(row0 + ai * 128 + m * 16) * DM + col0;
#pragma unroll
                for (int bj = 0; bj < 2; ++bj)
#pragma unroll
                    for (int n = 0; n < 2; ++n) { const f32x4 hv = *(const f32x4*)(HF + off + bj * 128 + n * 16); *(f32x4*)(R + off + bj * 128 + n * 16) = hv * ALPHA + acc[ai][bj][m][n]; }
                asm volatile("" ::: "memory"); }
        return false;
    }
};

struct ProbBranch {
    static constexpr bool PERM = true, GATHER = false, KEEPS = true;
    int K, lda, ldb, G, c; const bf16* A; const bf16* B; unsigned char* ws;
    __device__ __forceinline__ bool next(int i, Unit& u) const { u.aux = i & 1; return pg8::static_tile(MROWS / 256, DM / 256, G, c, i >> 1, u.pm, u.pn); }
    __device__ __forceinline__ const char* a_ptr(const Unit& u) const { return (const char*)(A + (size_t)u.pm * 256 * lda + u.aux * 1024); }
    __device__ __forceinline__ const char* b_ptr(const Unit& u) const { return (const char*)(B + (size_t)u.pn * 256 * ldb + u.aux * 1024); }
    __device__ __forceinline__ bool epi(f32x4 (&acc)[2][2][4][2], const Unit& u, int wr, int wc, int fr, int fq) const {
        const int row0 = u.pm * 256 + wr * 64 + fr, ct = u.pn * 256 + wc * 32 + 8 * fq;
        const bf16* Gs = (const bf16*)(ws + WS_GB) + ct; const bf16* Gf = Gs + DM; bf16* MG = (bf16*)(ws + WS_MG) + ct;
        const bool first = u.aux == 0;
#pragma unroll
        for (int ai = 0; ai < 2; ++ai)
#pragma unroll
            for (int m = 0; m < 4; ++m) { const size_t r = (size_t)(row0 + ai * 128 + m * 16);
#pragma unroll
                for (int bj = 0; bj < 2; ++bj) { const u32x4 gf = *(const u32x4*)(Gf + r * G_N + bj * 128);
                    f32x4 f0 = {bflo(gf.x), bfhi(gf.x), bflo(gf.y), bfhi(gf.y)}, f1 = {bflo(gf.z), bfhi(gf.z), bflo(gf.w), bfhi(gf.w)};
                    if (first) { const u32x4 gs = *(const u32x4*)(Gs + r * G_N + bj * 128);
                        const f32x4 s0 = {bflo(gs.x), bfhi(gs.x), bflo(gs.y), bfhi(gs.y)}, s1 = {bflo(gs.z), bfhi(gs.z), bflo(gs.w), bfhi(gs.w)};
#pragma unroll
                        for (int j = 0; j < 4; ++j) { acc[ai][bj][m][0][j] *= s0[j] * __builtin_amdgcn_rcpf(fmaxf(f0[j], 1e-30f)); acc[ai][bj][m][1][j] *= s1[j] * __builtin_amdgcn_rcpf(fmaxf(f1[j], 1e-30f)); } }
                    else { const f32x4 v0 = acc[ai][bj][m][0] * f0, v1 = acc[ai][bj][m][1] * f1;
                        u32x4 w; w.x = pg8::cvt_pk_bf16(v0[0], v0[1]); w.y = pg8::cvt_pk_bf16(v0[2], v0[3]); w.z = pg8::cvt_pk_bf16(v1[0], v1[1]); w.w = pg8::cvt_pk_bf16(v1[2], v1[3]);
                        *(u32x4*)(MG + r * DM + bj * 128) = w; } }
                asm volatile("" ::: "memory"); }
        return first;
    }
};
constexpr int IDX_OFF = RING_BYTES + 1024, MOE_MAXU = 3;
struct ProbMoeGU {
    static constexpr bool PERM = true, GATHER = true, KEEPS = false;
    int K, lda, ldb, G, c, layer; const bf16* A; const bf16* B; unsigned char* ws; const unsigned* ctl; LAS unsigned char* lds;
    __device__ __forceinline__ bool next(int i, Unit& u) const { const int L = i * G + c; u.pm = L >> 3; u.pn = L & 7; int cnt, ps; return moe_find(ctl, layer, u.pm * 256, u.aux, cnt, ps); }
    __device__ __forceinline__ const char* a_ptr(const Unit&) const { return (const char*)A; }
    __device__ __forceinline__ const char* b_ptr(const Unit& u) const { return (const char*)(B + (size_t)u.aux * (WGU_E / 2) + (size_t)u.pn * 256 * ldb); }
    __device__ __forceinline__ int a_row(int ui, int r) const { return *(const LAS int*)(lds + IDX_OFF + (ui * 256 + r) * 4); }
    __device__ __forceinline__ void fill_idx(int tid) const {
        for (int ui = 0; ui < MOE_MAXU; ++ui) { const int L = ui * G + c; int e, cnt, ps; if (!moe_find(ctl, layer, (L >> 3) * 256, e, cnt, ps)) break;
            if (tid < 256) { const int rank = (L >> 3) * 256 - ps + tid; *(LAS int*)(lds + IDX_OFF + (ui * 256 + tid) * 4) = rank < cnt ? ((const int*)(ws + WS_ELIST))[(size_t)e * MROWS + rank] : 0; } }
        LDS_WAIT(); __syncthreads();
    }
    __device__ __forceinline__ bool epi(f32x4 (&acc)[2][2][4][2], const Unit& u, int wr, int wc, int fr, int fq) const {
        const int row0 = u.pm * 256 + wr * 64 + fr, ct = u.pn * 128 + wc * 32 + 8 * fq; bf16* act = (bf16*)(ws + WS_ACT) + ct;
#pragma unroll
        for (int ai = 0; ai < 2; ++ai)
#pragma unroll
            for (int m = 0; m < 4; ++m) { f32x4 v[2];
#pragma unroll
                for (int n = 0; n < 2; ++n)
#pragma unroll
                    for (int j = 0; j < 4; ++j) { const float g = acc[ai][0][m][n][j]; v[n][j] = g * __builtin_amdgcn_rcpf(1.0f + __builtin_amdgcn_exp2f(-LOG2E * g)) * acc[ai][1][m][n][j]; }
                u32x4 w; w.x = pg8::cvt_pk_bf16(v[0][0], v[0][1]); w.y = pg8::cvt_pk_bf16(v[0][2], v[0][3]); w.z = pg8::cvt_pk_bf16(v[1][0], v[1][1]); w.w = pg8::cvt_pk_bf16(v[1][2], v[1][3]);
                *(u32x4*)(act + (size_t)(row0 + ai * 128 + m * 16) * FF) = w; }
        return false;
    }
};
struct ProbMoeDown {
    static constexpr bool PERM = true, GATHER = false, KEEPS = false;
    int K, lda, ldb, G, c, layer; const bf16* A; const bf16* B; unsigned char* ws; const unsigned* ctl;
    __device__ __forceinline__ bool next(int i, Unit& u) const { const int L = i * G + c; u.pm = L >> 3; u.pn = L & 7; int cnt, ps; return moe_find(ctl, layer, u.pm * 256, u.aux, cnt, ps); }
    __device__ __forceinline__ const char* a_ptr(const Unit& u) const { return (const char*)(A + (size_t)u.pm * 256 * lda); }
    __device__ __forceinline__ const char* b_ptr(const Unit& u) const { return (const char*)(B + (size_t)u.aux * (WD_E / 2) + (size_t)u.pn * 256 * ldb); }
    __device__ __forceinline__ bool epi(f32x4 (&acc)[2][2][4][2], const Unit& u, int wr, int wc, int fr, int fq) const {
        const int row0 = u.pm * 256 + wr * 64 + fr, ct = u.pn * 256 + wc * 32 + 8 * fq; bf16* O = (bf16*)(ws + WS_OSL) + ct;
#pragma unroll
        for (int ai = 0; ai < 2; ++ai)
#pragma unroll
            for (int m = 0; m < 4; ++m)
#pragma unroll
                for (int bj = 0; bj < 2; ++bj) { const f32x4 v0 = acc[ai][bj][m][0], v1 = acc[ai][bj][m][1];
                    u32x4 w; w.x = pg8::cvt_pk_bf16(v0[0], v0[1]); w.y = pg8::cvt_pk_bf16(v0[2], v0[3]); w.z = pg8::cvt_pk_bf16(v1[0], v1[1]); w.w = pg8::cvt_pk_bf16(v1[2], v1[3]);
                    *(u32x4*)(O + (size_t)(row0 + ai * 128 + m * 16) * DM + bj * 128) = w; }
        return false;
    }
};

namespace att {
typedef short bf16x8 __attribute__((ext_vector_type(8)));
typedef short s16x4 __attribute__((ext_vector_type(4)));
typedef float f32x16 __attribute__((ext_vector_type(16)));
constexpr int TILE_B = 16384;
constexpr int L_V = 0, L_K = 2 * TILE_B, L_C2 = 4 * TILE_B, L_WS = L_C2 + 512, L_ITEM = L_WS + 8 * 256, L_END = L_ITEM + 16;
#define KSWZ(row, colB) ((row) * 256 + ((colB) ^ (((row) & 7) << 4)))
#define SBAR() __builtin_amdgcn_sched_barrier(0)
__device__ __forceinline__ int v_st(int k, int c) { const int kk = (k & ~0xC) | ((k & 4) << 1) | ((k & 8) >> 1); return ((kk >> 3) * 4 + (c >> 5)) * 512 + ((kk & 7) * 32 + (c & 31)) * 2; }
__device__ __forceinline__ int v_rd_base(int lane) { return ((lane & 3) << 3) | (((lane >> 2) & 3) << 6) | (((lane >> 4) & 1) << 5) | (((lane >> 5) & 1) << 8); }
constexpr int v_rd_off(int d0, int ks, int half) { return d0 * 512 + ks * 4096 + half * 2048; }
__device__ __forceinline__ int crow(int r, int hi) { return (r & 3) + 8 * (r >> 2) + 4 * hi; }
__device__ __forceinline__ unsigned cvtpk(float lo, float hi) { unsigned r; asm volatile("v_cvt_pk_bf16_f32 %0, %1, %2" : "=v"(r) : "v"(lo), "v"(hi)); return r; }
__device__ __forceinline__ float xchg_sum(float v) { auto rr = __builtin_amdgcn_permlane32_swap(__float_as_uint(v), __float_as_uint(v), false, false); return __uint_as_float(rr[0]) + __uint_as_float(rr[1]); }
__device__ __forceinline__ float xchg_max(float v) { auto rr = __builtin_amdgcn_permlane32_swap(__float_as_uint(v), __float_as_uint(v), false, false); return fmaxf(__uint_as_float(rr[0]), __uint_as_float(rr[1])); }
#define PK4(P, B_, OUT) do { unsigned a0 = cvtpk(P[B_+0], P[B_+1]), a1 = cvtpk(P[B_+2], P[B_+3]); unsigned b0 = cvtpk(P[B_+4], P[B_+5]), b1 = cvtpk(P[B_+6], P[B_+7]); \
        auto r0 = __builtin_amdgcn_permlane32_swap(a0, b0, false, false); auto r1 = __builtin_amdgcn_permlane32_swap(a1, b1, false, false); \
        u32x4 w = {r0[0], r1[0], r0[1], r1[1]}; OUT = *reinterpret_cast<bf16x8*>(&w); } while (0)
__device__ __forceinline__ void qkt(f32x16& p0, f32x16& p1, const LAS unsigned char* kt, int r32, int hi, const bf16x8* qr) {
    p0 = f32x16{}; p1 = f32x16{};
    const LAS unsigned char* kb[4];
#pragma unroll
    for (int dd = 0; dd < 4; ++dd) kb[dd] = kt + KSWZ(r32, (dd * 16 + hi * 8) * 2);
#pragma unroll
    for (int d0 = 0; d0 < 8; ++d0) { const LAS unsigned char* a = kb[d0 & 3] + (d0 >> 2) * 128;
        const bf16x8 b0 = *(const LAS bf16x8*)(a); const bf16x8 b1 = *(const LAS bf16x8*)(a + 32 * 256);
        p0 = __builtin_amdgcn_mfma_f32_32x32x16_bf16(b0, qr[d0], p0, 0, 0, 0);
        p1 = __builtin_amdgcn_mfma_f32_32x32x16_bf16(b1, qr[d0], p1, 0, 0, 0); }
}
__device__ __forceinline__ void pv_tile(f32x16* o, unsigned vb0, bf16x8 pa0, bf16x8 pa1, bf16x8 pa2, bf16x8 pa3) {
#define TRRD(dst, off) asm volatile("ds_read_b64_tr_b16 %0, %1 offset:%2" : "=&v"(dst) : "v"(vb0), "i"(off) : "memory")
#define PV_D0(d0) do { s16x4 l0, l1, l2, l3, h0, h1, h2, h3; constexpr int b_ = v_rd_off(d0, 0, 0); \
        TRRD(l0, b_); TRRD(h0, b_ + 2048); TRRD(l1, b_ + 4096); TRRD(h1, b_ + 6144); TRRD(l2, b_ + 8192); TRRD(h2, b_ + 10240); TRRD(l3, b_ + 12288); TRRD(h3, b_ + 14336); \
        asm volatile("s_waitcnt lgkmcnt(0)" ::: "memory"); SBAR(); \
        o[d0] = __builtin_amdgcn_mfma_f32_32x32x16_bf16(pa0, (bf16x8){l0[0], l0[1], l0[2], l0[3], h0[0], h0[1], h0[2], h0[3]}, o[d0], 0, 0, 0); \
        o[d0] = __builtin_amdgcn_mfma_f32_32x32x16_bf16(pa1, (bf16x8){l1[0], l1[1], l1[2], l1[3], h1[0], h1[1], h1[2], h1[3]}, o[d0], 0, 0, 0); \
        o[d0] = __builtin_amdgcn_mfma_f32_32x32x16_bf16(pa2, (bf16x8){l2[0], l2[1], l2[2], l2[3], h2[0], h2[1], h2[2], h2[3]}, o[d0], 0, 0, 0); \
        o[d0] = __builtin_amdgcn_mfma_f32_32x32x16_bf16(pa3, (bf16x8){l3[0], l3[1], l3[2], l3[3], h3[0], h3[1], h3[2], h3[3]}, o[d0], 0, 0, 0); } while (0)
    PV_D0(0); PV_D0(1); PV_D0(2); PV_D0(3);
#undef PV_D0
#undef TRRD
}
#define VIS(cc) (((dqh) - (cc)) >= NEED && (cc) < (nvh))
__device__ __forceinline__ void sb_tile(f32x16& p0, f32x16& p1, float& carry, bool domask, int dqh, int nvh, int hi, bf16x8& pa0, bf16x8& pa1, bf16x8& pa2, bf16x8& pa3) {
    constexpr int NEED = 1;
    f32x16 x0, x1;
#pragma unroll
    for (int r = 0; r < 16; ++r) {
        { const float u = p0[r], a = __builtin_amdgcn_exp2f(-__builtin_fabsf(u)), b = __builtin_amdgcn_logf(1.0f + a), lk = fminf(-u, 0.f) - b; x0[r] = lk + u; p0[r] = lk; }
        { const float u = p1[r], a = __builtin_amdgcn_exp2f(-__builtin_fabsf(u)), b = __builtin_amdgcn_logf(1.0f + a), lk = fminf(-u, 0.f) - b; x1[r] = lk + u; p1[r] = lk; } }
    if (domask) { const float NEG = -__builtin_inff();
#pragma unroll
        for (int r = 0; r < 16; ++r) { const int cc = (r & 3) + 8 * (r >> 2);
            if (!VIS(cc)) { p0[r] = 0.f; x0[r] = NEG; }
            if (!VIS(cc + 32)) { p1[r] = 0.f; x1[r] = NEG; } } }
    float A[9]; A[8] = 0.f;
#pragma unroll
    for (int g = 3; g >= 0; --g) A[4 + g] = A[5 + g] + ((p1[4 * g] + p1[4 * g + 1]) + (p1[4 * g + 2] + p1[4 * g + 3]));
#pragma unroll
    for (int g = 3; g >= 0; --g) A[g] = A[1 + g] + ((p0[4 * g] + p0[4 * g + 1]) + (p0[4 * g + 2] + p0[4 * g + 3]));
    float off[8];
#pragma unroll
    for (int i = 0; i < 8; ++i) { auto rr = __builtin_amdgcn_permlane32_swap(__float_as_uint(A[i]), __float_as_uint(A[i + 1]), false, false);
        const float recv = hi ? __uint_as_float(rr[0]) : __uint_as_float(rr[1]); off[i] = carry + A[i + 1] + recv; }
    carry += xchg_sum(A[0]);
#pragma unroll
    for (int g = 0; g < 4; ++g) {
        { float af = off[g]; const float l3 = p0[4 * g + 3], l2 = p0[4 * g + 2], l1 = p0[4 * g + 1];
          x0[4 * g + 3] = __builtin_amdgcn_exp2f(x0[4 * g + 3] + af); af += l3; x0[4 * g + 2] = __builtin_amdgcn_exp2f(x0[4 * g + 2] + af); af += l2;
          x0[4 * g + 1] = __builtin_amdgcn_exp2f(x0[4 * g + 1] + af); af += l1; x0[4 * g] = __builtin_amdgcn_exp2f(x0[4 * g] + af); }
        { float af = off[4 + g]; const float l3 = p1[4 * g + 3], l2 = p1[4 * g + 2], l1 = p1[4 * g + 1];
          x1[4 * g + 3] = __builtin_amdgcn_exp2f(x1[4 * g + 3] + af); af += l3; x1[4 * g + 2] = __builtin_amdgcn_exp2f(x1[4 * g + 2] + af); af += l2;
          x1[4 * g + 1] = __builtin_amdgcn_exp2f(x1[4 * g + 1] + af); af += l1; x1[4 * g] = __builtin_amdgcn_exp2f(x1[4 * g] + af); } }
    PK4(x0, 0, pa0); PK4(x0, 8, pa1); PK4(x1, 0, pa2); PK4(x1, 8, pa3);
}
__device__ __forceinline__ float fox_tile(f32x16& p0, f32x16& p1, const LAS float* c2t, float& m_reg, float& l_reg, bool domask, int dqh, int nvh, int hi, bf16x8& pa0, bf16x8& pa1, bf16x8& pa2, bf16x8& pa3) {
    constexpr int NEED = 0;
#pragma unroll
    for (int g = 0; g < 4; ++g) { const f32x4 c0 = *(const LAS f32x4*)(c2t + 8 * g + 4 * hi), c1 = *(const LAS f32x4*)(c2t + 32 + 8 * g + 4 * hi);
#pragma unroll
        for (int j = 0; j < 4; ++j) { p0[4 * g + j] -= c0[j]; p1[4 * g + j] -= c1[j]; } }
    if (domask) { const float NEG = -__builtin_inff();
#pragma unroll
        for (int r = 0; r < 16; ++r) { const int cc = (r & 3) + 8 * (r >> 2);
            if (!VIS(cc)) p0[r] = NEG;
            if (!VIS(cc + 32)) p1[r] = NEG; } }
    float pmax = p0[0];
#pragma unroll
    for (int r = 1; r < 16; ++r) pmax = fmaxf(pmax, p0[r]);
#pragma unroll
    for (int r = 0; r < 16; ++r) pmax = fmaxf(pmax, p1[r]);
    pmax = xchg_max(pmax);
    const float mn = fmaxf(m_reg, pmax), alpha = __builtin_amdgcn_exp2f(m_reg - mn); m_reg = mn;
    float ps = 0.f;
#pragma unroll
    for (int r = 0; r < 16; ++r) { p0[r] = __builtin_amdgcn_exp2f(p0[r] - mn); p1[r] = __builtin_amdgcn_exp2f(p1[r] - mn); ps += p0[r] + p1[r]; }
    l_reg = l_reg * alpha + xchg_sum(ps);
    PK4(p0, 0, pa0); PK4(p0, 8, pa1); PK4(p1, 0, pa2); PK4(p1, 8, pa3);
    return alpha;
}
#undef VIS
template <int TYPE>
__device__ __forceinline__ void attn_unit(LAS unsigned char* lds, unsigned char* ws, int head, int qb) {
    const int tid = threadIdx.x, wid = __builtin_amdgcn_readfirstlane(tid >> 6), lane = tid & 63, r32 = lane & 31, hi = lane >> 5;
    const bf16* QKV = (const bf16*)(ws + WS_QKV);
    const int qcol = (TYPE ? 3072 : 0) + head * HD, kcol = qcol + 1024, vcol = qcol + 2048;
    const float* cum = (const float*)(ws + WS_CUM) + (size_t)head * MROWS;
    const int qrow0 = qb * 256, NT = qb < 32 ? 4 * qb + 5 : 1;
    const int qbase = qb < 32 ? qrow0 : -NMETA;
    const int qlo = qbase + wid * 32, qpos = qlo + r32;
    LAS unsigned char* V_lds = lds + L_V; LAS unsigned char* K_lds = lds + L_K; LAS float* c2_lds = (LAS float*)(lds + L_C2);
    LAS float* wsl = (LAS float*)(lds + L_WS) + wid * 64;
    bf16x8 qr[8];
#pragma unroll
    for (int d0 = 0; d0 < 8; ++d0) qr[d0] = *(const bf16x8*)(QKV + (size_t)(qrow0 + wid * 32 + r32) * QKV_N + qcol + d0 * 16 + hi * 8);
    const int sr = tid >> 4, sc = (tid & 15) * 8, vst0 = v_st(sr, sc), vst1 = v_st(32 + sr, sc), kws = KSWZ(sr, sc * 2);
    const unsigned vrd = (unsigned)(size_t)V_lds + (unsigned)v_rd_base(lane);
    bf16x8 st_k0, st_k1, st_v0, st_v1; float st_c = 0.f;
#define TROW(t) ((t) < NT - 1 || qb == 32 ? ((qb == 32) ? SEQ : 64 * (4 * qb + 3 - (t))) : SEQ)
#define TISMETA(t) ((t) == NT - 1)
#define SLOAD(t) do { const int row_ = TISMETA(t) ? SEQ : 64 * (4 * qb + 3 - (t)); const bf16* kp_ = QKV + (size_t)(row_ + sr) * QKV_N + sc; \
        st_k0 = *(const bf16x8*)(kp_ + kcol); st_k1 = *(const bf16x8*)(kp_ + (size_t)32 * QKV_N + kcol); st_v0 = *(const bf16x8*)(kp_ + vcol); st_v1 = *(const bf16x8*)(kp_ + (size_t)32 * QKV_N + vcol); \
        if (TYPE == 1 && tid < 64) st_c = TISMETA(t) ? (tid < NMETA ? cum[tid] : 0.f) : cum[NMETA + row_ + tid]; } while (0)
#define SWRITE(bf) do { *(LAS bf16x8*)(K_lds + (bf) * TILE_B + kws) = st_k0; *(LAS bf16x8*)(K_lds + (bf) * TILE_B + kws + 32 * 256) = st_k1; \
        *(LAS bf16x8*)(V_lds + (bf) * TILE_B + vst0) = st_v0; *(LAS bf16x8*)(V_lds + (bf) * TILE_B + vst1) = st_v1; if (TYPE == 1 && tid < 64) c2_lds[(bf) * 64 + tid] = st_c; } while (0)
    SLOAD(0); SWRITE(0);
    asm volatile("s_waitcnt lgkmcnt(0)" ::: "memory"); __syncthreads();
    f32x16 o[4] = {}; float carry = 0.f, m_reg = -1e30f, l_reg = 0.f;
    for (int t = 0; t < NT; ++t) {
        const int cb = t & 1;
        if (t + 1 < NT) SLOAD(t + 1);
        const int kbase = TISMETA(t) ? -NMETA : 64 * (4 * qb + 3 - t), nvalid = TISMETA(t) ? NMETA : 64;
        constexpr int NEEDW = TYPE == 0 ? 1 : 0;
        const bool actw = (qlo + 31 - kbase) >= NEEDW;
        const bool domask = (qlo - (kbase + 63) < NEEDW) || nvalid < 64;
        if (actw) {
            f32x16 p0, p1; bf16x8 pa0, pa1, pa2, pa3;
            qkt(p0, p1, K_lds + cb * TILE_B, r32, hi, qr);
            const int dqh = qpos - kbase - 4 * hi, nvh = nvalid - 4 * hi;
            if (TYPE == 0) sb_tile(p0, p1, carry, domask, dqh, nvh, hi, pa0, pa1, pa2, pa3);
            else { const float alpha = fox_tile(p0, p1, c2_lds + cb * 64, m_reg, l_reg, domask, dqh, nvh, hi, pa0, pa1, pa2, pa3);
                if (__any(alpha < 1.f)) { if (hi == 0) wsl[r32] = alpha; asm volatile("s_waitcnt lgkmcnt(0)" ::: "memory");
#pragma unroll
                    for (int r = 0; r < 16; ++r) { const float al = wsl[crow(r, hi)];
#pragma unroll
                        for (int d = 0; d < 4; ++d) o[d][r] *= al; } } }
            SBAR();
            pv_tile(o, vrd + cb * TILE_B, pa0, pa1, pa2, pa3);
        }
        if (t + 1 < NT) SWRITE(cb ^ 1);
        asm volatile("s_waitcnt lgkmcnt(0)" ::: "memory"); __syncthreads();
    }
    float rli[16];
    if (TYPE == 1) { if (hi == 0) wsl[32 + r32] = l_reg; asm volatile("s_waitcnt lgkmcnt(0)" ::: "memory");
#pragma unroll
        for (int r = 0; r < 16; ++r) rli[r] = __builtin_amdgcn_rcpf(wsl[32 + crow(r, hi)]); }
    bf16* Yw = (bf16*)(ws + WS_YB) + (size_t)(qrow0 + wid * 32) * DM + TYPE * 1024 + head * HD;
#pragma unroll
    for (int r = 0; r < 16; ++r) { const int orow = crow(r, hi);
#pragma unroll
        for (int d0 = 0; d0 < 4; ++d0) { const float v = TYPE == 1 ? o[d0][r] * rli[r] : o[d0][r]; const float vn = __shfl_xor(v, 1);
            if ((r32 & 1) == 0) *(unsigned*)(Yw + (size_t)orow * DM + d0 * 32 + r32) = cvtpk(v, vn); } }
#undef TROW
#undef TISMETA
#undef SLOAD
#undef SWRITE
}
constexpr int CW_ATTNQ = 3072;
__device__ __forceinline__ void attn_phase(LAS unsigned char* lds, unsigned char* ws, unsigned* ctl, int layer, int G) {
    const int NI = 512 + (layer == 0 ? 16 : 0);
    LAS int* itemw = (LAS int*)(lds + L_ITEM);
    int it = blockIdx.x;
    while (it < NI) {
        int qb, th; if (it < 512) { qb = 31 - (it >> 4); th = it & 15; } else { qb = 32; th = it - 512; }
        if (th < 8) attn_unit<0>(lds, ws, th, qb); else attn_unit<1>(lds, ws, th - 8, qb);
        __syncthreads();
        if (threadIdx.x == 0) *itemw = G + (int)atomicAdd(ctl + CW_ATTNQ + layer * 64, 1u);
        asm volatile("s_waitcnt lgkmcnt(0)" ::: "memory"); __syncthreads();
        it = __builtin_amdgcn_readfirstlane(*itemw);
    }
}
#undef KSWZ
#undef SBAR
#undef PK4
}

__global__ void __launch_bounds__(NTHREADS, 2) mk_fwd(Args args) {
    extern __shared__ __attribute__((aligned(16))) unsigned char lds_raw[];
    Frame F;
    F.lds = (LAS unsigned char*)lds_raw; F.ws = args.ws; F.ctl = (unsigned*)(args.ws + WS_CTL);
    F.tid = threadIdx.x; F.lane = F.tid & 63; F.wave = __builtin_amdgcn_readfirstlane(F.tid >> 6);
    F.G = gridDim.x; F.gw = blockIdx.x * NWAVES + F.wave; F.NGW = F.G * NWAVES;
#pragma unroll
    for (int i = 0; i < 18; ++i) F.in[i] = args.in[i];
    F.out = args.out;
    volatile LAS unsigned* MISC = (volatile LAS unsigned*)(F.lds + MISC_OFF);
    for (int u = F.tid; u < (LDS_BYTES - RING_BYTES) / 4; u += NTHREADS) ((LAS unsigned*)(F.lds + RING_BYTES))[u] = 0u;
    __syncthreads();
    XcdBarrier bar = xcd_barrier_post(F.ctl + CW_BAR + args.li * XCD_BAR_WORDS, MISC + 8);
    const int lo = args.ph_lo, hi = args.ph_hi; const unsigned naive = args.naive;
#define IN(k) (lo <= (k) && (k) < hi)
#define SEAM(k) do { if (IN(k) && IN((k) + 1)) xcd_barrier(bar); } while (0)
#define NAIVE(t) ((naive >> (t)) & 1u)
    if (IN(0)) { phase_prologue(F); SEAM(0); }
#define LAYER_PHASES(l, pb) do { \
        if (IN(pb + PH_A)) { phase_cumsum(F); \
            if (!NAIVE(PH_A)) { ProbInProj P{DM, DM, DM, F.G, (int)blockIdx.x, (const bf16*)(F.ws + WS_HB), (const bf16*)(F.ws + WS_WIN + l * WIN_L), F.ws}; pg8::gemm_phase(F.lds, P); } \
            SEAM(pb + PH_A); } \
        if (IN(pb + PH_B)) { \
            if (!NAIVE(PH_B)) att::attn_phase(F.lds, F.ws, F.ctl, l, F.G); \
            SEAM(pb + PH_B); } \
        if (IN(pb + PH_C)) { \
            if (!NAIVE(PH_C)) { ProbBranch P{1024, DM, DM, F.G, (int)blockIdx.x, (const bf16*)(F.ws + WS_YB), (const bf16*)(F.ws + WS_WB + l * WB_L), F.ws}; pg8::gemm_phase(F.lds, P); } \
            SEAM(pb + PH_C); } \
        if (IN(pb + PH_D)) { \
            if (!NAIVE(PH_D)) { ProbOutProj P{DM, DM, DM, F.G, (int)blockIdx.x, (const bf16*)(F.ws + WS_MG), (const bf16*)(F.ws + WS_WOUT + l * WOUT_L), F.ws}; pg8::gemm_phase(F.lds, P); } \
            SEAM(pb + PH_D); } \
        if (IN(pb + PH_E)) { phase_ln_router(F, l); SEAM(pb + PH_E); } \
        if (IN(pb + PH_F)) { \
            if (!NAIVE(PH_F)) { ProbMoeGU P{DM, DM, DM, F.G, (int)blockIdx.x, l, (const bf16*)(F.ws + WS_HB), (const bf16*)(F.ws + WS_WGU + l * WGU_L), F.ws, F.ctl, F.lds}; P.fill_idx(F.tid); pg8::gemm_phase(F.lds, P); } \
            SEAM(pb + PH_F); } \
        if (IN(pb + PH_G)) { \
            if (!NAIVE(PH_G)) { ProbMoeDown P{FF, FF, FF, F.G, (int)blockIdx.x, l, (const bf16*)(F.ws + WS_ACT), (const bf16*)(F.ws + WS_WD + l * WD_L), F.ws, F.ctl}; pg8::gemm_phase(F.lds, P); } \
            SEAM(pb + PH_G); } \
        if (IN(pb + PH_H)) { phase_ln_final(F, l); SEAM(pb + PH_H); } \
    } while (0)
    LAYER_PHASES(0, 1);
    LAYER_PHASES(1, 9);
#undef LAYER_PHASES
#undef IN
#undef SEAM
#undef NAIVE
}

#ifndef NAIVE_MASK
#define NAIVE_MASK 0x00u
#endif
static void launch_naive(int type, int layer, const Args& a, hipStream_t stream) {
    switch (type) {
    case PH_A: hipLaunchKernelGGL(naive_inproj, dim3(INP_N / 256, MROWS / 4), dim3(256), 0, stream, a, layer); break;
    case PH_B: { const int nq = NTOK; hipLaunchKernelGGL(naive_attn, dim3((16 * nq + 3) / 4), dim3(256), 0, stream, a, nq); } break;
    case PH_C: hipLaunchKernelGGL(naive_branch, dim3(DM / 256, MROWS / 4), dim3(256), 0, stream, a, layer); break;
    case PH_D: hipLaunchKernelGGL(naive_outproj, dim3(DM / 256, MROWS / 4), dim3(256), 0, stream, a, layer); break;
    case PH_F: hipLaunchKernelGGL(naive_moe_gu, dim3(FF / 256, NSLOT_MAX / 4), dim3(256), 0, stream, a, layer); break;
    case PH_G: hipLaunchKernelGGL(naive_moe_down, dim3(DM / 256, NSLOT_MAX / 4), dim3(256), 0, stream, a, layer); break;
    default: break;
    }
}
extern "C" void kernel_launch(void* const* d_in, const int* in_sizes, int n_in, void* d_out, int out_size, void* d_ws, size_t ws_size, hipStream_t stream) {
    static int grid = 0;
    if (grid == 0) {
        if (n_in != 18 || out_size != SEQ * DM || ws_size < WS_END) { fprintf(stderr, "kernel_launch: unexpected shapes (n_in %d out %d ws %zu)\n", n_in, out_size, ws_size); grid = -1; return; }
        int dev = 0, cus = 0;
        if (hipGetDevice(&dev) != hipSuccess || hipDeviceGetAttribute(&cus, hipDeviceAttributeMultiprocessorCount, dev) != hipSuccess) { grid = -1; return; }
        if (hipFuncSetAttribute((const void*)mk_fwd, hipFuncAttributeMaxDynamicSharedMemorySize, LDS_BYTES) != hipSuccess) { fprintf(stderr, "kernel_launch: hipFuncSetAttribute failed\n"); grid = -1; return; }
        int per_cu = 0;
        if (hipOccupancyMaxActiveBlocksPerMultiprocessor(&per_cu, (const void*)mk_fwd, NTHREADS, LDS_BYTES) != hipSuccess || per_cu < 1) fprintf(stderr, "kernel_launch: occupancy query says %d\n", per_cu);
        (void)hipGetLastError();
        grid = cus;
    }
    if (grid < 0) return;
    (void)hipMemsetAsync((char*)d_ws + WS_CTL, 0, CTL_ZERO_BYTES, stream);
    Args a{};
    for (int i = 0; i < 18; ++i) a.in[i] = (const float*)d_in[i];
    a.out = (float*)d_out; a.ws = (unsigned char*)d_ws; a.naive = NAIVE_MASK;
    int li = 0, lo = 0;
    auto flush = [&](int hi) { if (hi > lo) { a.ph_lo = lo; a.ph_hi = hi; a.li = li++; hipLaunchKernelGGL(mk_fwd, dim3(grid), dim3(NTHREADS), LDS_BYTES, stream, a); } lo = hi; };
    for (int ph = 1; ph < NPHASE; ++ph) {
        const int type = (ph - 1) & 7, layer = (ph - 1) >> 3;
        if ((NAIVE_MASK >> type) & 1u) {
            if (type == PH_A) flush(ph + 1); else { flush(ph); lo = ph + 1; }
            launch_naive(type, layer, a, stream); }
    }
    flush(NPHASE);
}
```

```cpp
#include <hip/hip_runtime.h>
#include <cstdio>
#include <cstdint>

#define GAS __attribute__((address_space(1)))
#define LAS __attribute__((address_space(3)))
typedef unsigned short bf16;
typedef float f32x4 __attribute__((ext_vector_type(4)));
typedef float f32x2 __attribute__((ext_vector_type(2)));
typedef unsigned u32x4 __attribute__((ext_vector_type(4)));
typedef unsigned u32x2 __attribute__((ext_vector_type(2)));
typedef GAS unsigned gu32;

constexpr int DM = 2048, SEQ = 8192, NMETA = 16, NTOK = SEQ + NMETA, MROWS = 8448;
constexpr int HD = 128, NHEAD = 8;
constexpr int QKV_N = 6144, G_N = 4096, INP_N = 10240, INP_SRC = 10248, FCOL = 6144;
constexpr int NE = 16, FF = 1024, NSLOT_MAX = 20480;
constexpr float ALPHA = 1.4142135623730951f, LN_EPS = 1e-5f;
constexpr float LOG2E = 1.4426950408889634f;
constexpr float QSCALE = 0.08838834764831845f * 1.4426950408889634f;
constexpr int NLAYER = 2, NPHASE = 1 + 8 * NLAYER;
enum { PH_A = 0, PH_B = 1, PH_C = 2, PH_D = 3, PH_E = 4, PH_F = 5, PH_G = 6, PH_H = 7 };

constexpr size_t MiB = 1u << 20;
constexpr size_t WS_CTL = 0, CTL_ZERO_BYTES = 1 * MiB;
constexpr size_t WS_WIN = 2 * MiB, WIN_L = 40 * MiB;
constexpr size_t WS_WB = 82 * MiB, WB_L = 8 * MiB;
constexpr size_t WS_WOUT = 98 * MiB, WOUT_L = 8 * MiB;
constexpr size_t WS_WGU = 114 * MiB, WGU_L = 128 * MiB, WGU_E = 8 * MiB;
constexpr size_t WS_WD = 370 * MiB, WD_L = 64 * MiB, WD_E = 4 * MiB;
constexpr size_t WS_HF = 498 * MiB;
constexpr size_t WS_HB = 564 * MiB;
constexpr size_t WS_RB = 597 * MiB;
constexpr size_t WS_QKV = 663 * MiB;
constexpr size_t WS_GB = 762 * MiB;
constexpr size_t WS_YB = 828 * MiB;
constexpr size_t WS_MG = 861 * MiB;
constexpr size_t WS_ACT = 663 * MiB;
constexpr size_t WS_OSL = 703 * MiB;
constexpr size_t WS_LOGF = 894 * MiB;
constexpr size_t WS_CUM = 895 * MiB;
constexpr size_t WS_ELIST = 896 * MiB;
constexpr size_t WS_TOKI = 897 * MiB;
constexpr size_t WS_END = 898 * MiB;
constexpr int CW_CNT = 1024;
constexpr int CW_BAR = 8192;
#define XCD_BAR_WORDS 3456
constexpr int MAX_LAUNCH = 20;
static_assert((CW_BAR + MAX_LAUNCH * XCD_BAR_WORDS) * 4 <= (int)CTL_ZERO_BYTES, "ctl");

constexpr int NWAVES = 8, NTHREADS = 512;
constexpr int RING_BYTES = 131072, MISC_OFF = RING_BYTES + 320, LDS_BYTES = 147456;

__device__ __forceinline__ unsigned f2bf(float f) { unsigned u = __builtin_bit_cast(unsigned, f); return (u + 0x7fffu + ((u >> 16) & 1u)) >> 16; }
__device__ __forceinline__ unsigned pk2(float lo, float hi) { return f2bf(lo) | (f2bf(hi) << 16); }
__device__ __forceinline__ float bflo(unsigned w) { return __builtin_bit_cast(float, w << 16); }
__device__ __forceinline__ float bfhi(unsigned w) { return __builtin_bit_cast(float, w & 0xffff0000u); }
__device__ __forceinline__ float bf2f(bf16 b) { return __builtin_bit_cast(float, ((unsigned)b) << 16); }
__device__ __forceinline__ float wave_sum(float v) {
#pragma unroll
    for (int o = 1; o < 64; o <<= 1) v += __shfl_xor(v, o);
    return v;
}
__device__ __forceinline__ float wave_max(float v) {
#pragma unroll
    for (int o = 1; o < 64; o <<= 1) v = fmaxf(v, __shfl_xor(v, o));
    return v;
}
__device__ __forceinline__ int row_of_p(int p) { return p < NMETA ? SEQ + p : p - NMETA; }
__device__ __forceinline__ float sigmoidf_(float x) { return 1.0f / (1.0f + __expf(-x)); }
__device__ __forceinline__ float dot8(u32x4 a, u32x4 b, float acc) {
    acc = fmaf(bflo(a.x), bflo(b.x), acc); acc = fmaf(bfhi(a.x), bfhi(b.x), acc);
    acc = fmaf(bflo(a.y), bflo(b.y), acc); acc = fmaf(bfhi(a.y), bfhi(b.y), acc);
    acc = fmaf(bflo(a.z), bflo(b.z), acc); acc = fmaf(bfhi(a.z), bfhi(b.z), acc);
    acc = fmaf(bflo(a.w), bflo(b.w), acc); acc = fmaf(bfhi(a.w), bfhi(b.w), acc);
    return acc;
}

struct Args { const float* in[18]; float* out; unsigned char* ws; int ph_lo, ph_hi; unsigned naive; int li; };
enum { I_X = 0, I_META, I_LNIN_G, I_LNIN_B, I_WIN, I_BF, I_WBSB, I_WBFX, I_WOUT, I_LNMIX_G, I_LNMIX_B, I_WR, I_RB, I_WG, I_WU, I_WD, I_LNFFN_G, I_LNFFN_B };

__device__ __forceinline__ int moe_cnt(const unsigned* ctl, int layer, int e) { return (int)ctl[CW_CNT + (layer * NE + e) * 64]; }
__device__ __forceinline__ bool moe_find(const unsigned* ctl, int layer, int s0, int& e_out, int& cnt_out, int& ps_out) {
    int acc = 0; e_out = -1; cnt_out = 0; ps_out = 0;
#pragma unroll
    for (int e = 0; e < NE; ++e) { const int c = moe_cnt(ctl, layer, e), nb = (c + 255) >> 8;
        if (e_out < 0 && s0 < (acc + nb) * 256) { e_out = e; cnt_out = c; ps_out = acc * 256; }
        acc += nb; }
    return e_out >= 0;
}
__device__ __forceinline__ int moe_pstart(const unsigned* ctl, int layer, int ex) {
    int acc = 0, r = 0;
#pragma unroll
    for (int e = 0; e < NE; ++e) { const int c = moe_cnt(ctl, layer, e); if (e == ex) r = acc * 256; acc += (c + 255) >> 8; }
    return r;
}

__device__ __forceinline__ void inproj_store(unsigned char* ws, int row, int n, float v) {
    if (n < QKV_N) { const bool isq = (n < 1024) || (n >= 3072 && n < 4096); ((bf16*)(ws + WS_QKV))[(size_t)row * QKV_N + n] = (bf16)f2bf(isq ? v * QSCALE : v); }
    else ((bf16*)(ws + WS_GB))[(size_t)row * G_N + (n - QKV_N)] = (bf16)f2bf(sigmoidf_(v));
}

__device__ __forceinline__ void dot4(const bf16* a0, const bf16* a1, const bf16* a2, const bf16* a3, const bf16* b, int K, float (&acc)[4]) {
    for (int k = 0; k < K; k += 8) {
        const u32x4 bv = *(const u32x4*)(b + k);
        acc[0] = dot8(*(const u32x4*)(a0 + k), bv, acc[0]); acc[1] = dot8(*(const u32x4*)(a1 + k), bv, acc[1]);
        acc[2] = dot8(*(const u32x4*)(a2 + k), bv, acc[2]); acc[3] = dot8(*(const u32x4*)(a3 + k), bv, acc[3]);
    }
}
__global__ void __launch_bounds__(256) naive_inproj(Args a, int layer) {
    const int n = blockIdx.x * 256 + threadIdx.x, r0 = blockIdx.y * 4;
    const bf16* A = (const bf16*)(a.ws + WS_HB) + (size_t)r0 * DM; const bf16* B = (const bf16*)(a.ws + WS_WIN + layer * WIN_L) + (size_t)n * DM;
    float acc[4] = {0.f, 0.f, 0.f, 0.f};
    dot4(A, A + DM, A + 2 * DM, A + 3 * DM, B, DM, acc);
    for (int i = 0; i < 4; ++i) inproj_store(a.ws, r0 + i, n, acc[i]);
}
__global__ void __launch_bounds__(256) naive_branch(Args a, int layer) {
    const int n = blockIdx.x * 256 + threadIdx.x, r0 = blockIdx.y * 4;
    const bf16* A = (const bf16*)(a.ws + WS_YB) + (size_t)r0 * DM; const bf16* B = (const bf16*)(a.ws + WS_WB + layer * WB_L) + (size_t)n * DM;
    float s[4] = {0.f, 0.f, 0.f, 0.f}, f[4] = {0.f, 0.f, 0.f, 0.f};
    dot4(A, A + DM, A + 2 * DM, A + 3 * DM, B, 1024, s);
    dot4(A + 1024, A + DM + 1024, A + 2 * DM + 1024, A + 3 * DM + 1024, B + 1024, 1024, f);
    const bf16* G = (const bf16*)(a.ws + WS_GB);
    for (int i = 0; i < 4; ++i) { const size_t r = r0 + i; const float gs = bf2f(G[r * G_N + n]), gf = bf2f(G[r * G_N + DM + n]);
        ((bf16*)(a.ws + WS_MG))[r * DM + n] = (bf16)f2bf(gs * s[i] + gf * f[i]); }
}
__global__ void __launch_bounds__(256) naive_outproj(Args a, int layer) {
    const int n = blockIdx.x * 256 + threadIdx.x, r0 = blockIdx.y * 4;
    const bf16* A = (const bf16*)(a.ws + WS_MG) + (size_t)r0 * DM; const bf16* B = (const bf16*)(a.ws + WS_WOUT + layer * WOUT_L) + (size_t)n * DM;
    float acc[4] = {0.f, 0.f, 0.f, 0.f};
    dot4(A, A + DM, A + 2 * DM, A + 3 * DM, B, DM, acc);
    const float* HF = (const float*)(a.ws + WS_HF); float* R = (float*)(a.ws + WS_RB);
    for (int i = 0; i < 4; ++i) { const size_t o = (size_t)(r0 + i) * DM + n; R[o] = ALPHA * HF[o] + acc[i]; }
}
__global__ void __launch_bounds__(256) naive_moe_gu(Args a, int layer) {
    const int j = blockIdx.x * 256 + threadIdx.x, s0 = blockIdx.y * 4;
    int e, cnt, ps; if (!moe_find((const unsigned*)(a.ws + WS_CTL), layer, s0, e, cnt, ps)) return;
    const int* elist = (const int*)(a.ws + WS_ELIST) + (size_t)e * MROWS;
    const bf16* HB = (const bf16*)(a.ws + WS_HB);
    const int rank = s0 - ps;
    const bf16* ap0 = HB + (size_t)(rank + 0 < cnt ? elist[rank + 0] : 0) * DM; const bf16* ap1 = HB + (size_t)(rank + 1 < cnt ? elist[rank + 1] : 0) * DM;
    const bf16* ap2 = HB + (size_t)(rank + 2 < cnt ? elist[rank + 2] : 0) * DM; const bf16* ap3 = HB + (size_t)(rank + 3 < cnt ? elist[rank + 3] : 0) * DM;
    const bf16* W = (const bf16*)(a.ws + WS_WGU + layer * WGU_L + e * WGU_E);
    const int rg = 256 * (j >> 7) + (j & 127);
    float g[4] = {0.f, 0.f, 0.f, 0.f}, u[4] = {0.f, 0.f, 0.f, 0.f};
    dot4(ap0, ap1, ap2, ap3, W + (size_t)rg * DM, DM, g);
    dot4(ap0, ap1, ap2, ap3, W + (size_t)(rg + 128) * DM, DM, u);
    bf16* act = (bf16*)(a.ws + WS_ACT);
#pragma unroll
    for (int i = 0; i < 4; ++i) act[(size_t)(s0 + i) * FF + j] = (bf16)f2bf(g[i] * sigmoidf_(g[i]) * u[i]);
}
__global__ void __launch_bounds__(256) naive_moe_down(Args a, int layer) {
    const int n = blockIdx.x * 256 + threadIdx.x, s0 = blockIdx.y * 4;
    int e, cnt, ps; if (!moe_find((const unsigned*)(a.ws + WS_CTL), layer, s0, e, cnt, ps)) return;
    const bf16* A = (const bf16*)(a.ws + WS_ACT) + (size_t)s0 * FF; const bf16* B = (const bf16*)(a.ws + WS_WD + layer * WD_L + e * WD_E) + (size_t)n * FF;
    float acc[4] = {0.f, 0.f, 0.f, 0.f};
    dot4(A, A + FF, A + 2 * FF, A + 3 * FF, B, FF, acc);
    bf16* O = (bf16*)(a.ws + WS_OSL);
#pragma unroll
    for (int i = 0; i < 4; ++i) O[(size_t)(s0 + i) * DM + n] = (bf16)f2bf(acc[i]);
}
__global__ void __launch_bounds__(256) naive_attn(Args a, int nq) {
    const int lane = threadIdx.x & 63, widx = blockIdx.x * 4 + (threadIdx.x >> 6);
    const int th = widx / nq, pq = nq - 1 - (widx % nq);
    if (th >= 16) return;
    const int type = th >> 3, head = th & 7;
    const bf16* QKV = (const bf16*)(a.ws + WS_QKV);
    const int qcol = (type ? 3072 : 0) + head * HD, kcol = qcol + 1024, vcol = qcol + 2048;
    const int rowq = row_of_p(pq);
    u32x4 q[16];
#pragma unroll
    for (int i = 0; i < 16; ++i) q[i] = *(const u32x4*)(QKV + (size_t)rowq * QKV_N + qcol + 8 * i);
    const float* cum = (const float*)(a.ws + WS_CUM) + (size_t)head * MROWS;
    float o0 = 0.f, o1 = 0.f, carry = 0.f, m = -1e30f, l = 0.f;
    const float cq = type ? cum[pq] : 0.f;
    for (int phi = type ? pq : pq - 1; phi >= 0; phi -= 64) {
        const int p = phi - lane; const bool valid = p >= 0; const int pr = row_of_p(valid ? p : 0);
        float u = 0.f;
        const bf16* kp = QKV + (size_t)pr * QKV_N + kcol;
#pragma unroll
        for (int i = 0; i < 16; ++i) u = dot8(q[i], *(const u32x4*)(kp + 8 * i), u);
        float w;
        if (type == 0) {
            const float aa = exp2f(-fabsf(u)), b = log2f(1.0f + aa);
            float lk = fminf(-u, 0.f) - b; const float lb = lk + u;
            if (!valid) lk = 0.f;
            float inc = lk;
#pragma unroll
            for (int off = 1; off < 64; off <<= 1) { const float t = __shfl_up(inc, off); if (lane >= off) inc += t; }
            const float after = carry + inc - lk;
            w = valid ? exp2f(lb + after) : 0.f;
            carry += __shfl(inc, 63);
        } else {
            const float s = valid ? u + cq - cum[valid ? p : 0] : -__builtin_inff();
            const float cm = wave_max(s), mn = fmaxf(m, cm), alpha = exp2f(m - mn);
            w = valid ? exp2f(s - mn) : 0.f;
            l = l * alpha + wave_sum(w); o0 *= alpha; o1 *= alpha; m = mn;
        }
        for (int j = 0; j < 64; ++j) {
            const float wj = __shfl(w, j); const int prj = __shfl(pr, j);
            const unsigned vv = *(const unsigned*)(QKV + (size_t)prj * QKV_N + vcol + 2 * lane);
            o0 = fmaf(wj, bflo(vv), o0); o1 = fmaf(wj, bfhi(vv), o1);
        }
    }
    if (type) { const float rl = 1.0f / l; o0 *= rl; o1 *= rl; }
    *(unsigned*)((bf16*)(a.ws + WS_YB) + (size_t)rowq * DM + type * 1024 + head * HD + 2 * lane) = pk2(o0, o1);
}

#define XB_TMO      128
#define XB_XCNT(j)  (256  + 64 * (j))
#define XB_XSUB(j)  (1280 + 64 * (j))
#define XB_XGEN(j)  (2304 + 64 * (j))
#define XB_TOP      3328
#define XB_TOPGEN   3392
#define XB_SPIN_CAP (1u << 18)
__device__ __forceinline__ unsigned xb_ld(unsigned* p)              { return __hip_atomic_load(p, __ATOMIC_RELAXED, __HIP_MEMORY_SCOPE_AGENT); }
__device__ __forceinline__ unsigned xb_add(unsigned* p, unsigned v) { return __hip_atomic_fetch_add(p, v, __ATOMIC_RELAXED, __HIP_MEMORY_SCOPE_AGENT); }
__device__ __forceinline__ unsigned xb_xcc_id() { return (unsigned)__builtin_amdgcn_s_getreg((3 << 11) | 20) & 0xFu; }
#define XB_SPIN(cond, bar) do { unsigned _sp = 0; while (cond) { __builtin_amdgcn_s_sleep(1); \
    if ((++_sp & 255u) == 0u) { if (xb_ld(&(bar)[XB_TMO])) break; if (_sp > XB_SPIN_CAP) { atomicAdd(&(bar)[XB_TMO], 1u); break; } } } } while (0)
struct XcdBarrier { unsigned* bar; unsigned x; volatile LAS unsigned* st; };
__device__ __forceinline__ XcdBarrier xcd_barrier_post(unsigned* bar, volatile LAS unsigned* st) {
    XcdBarrier b; b.bar = bar; b.x = xb_xcc_id(); b.st = st;
    if (threadIdx.x == 0) (void)xb_add(&bar[XB_XCNT(b.x)], 1u);
    return b;
}
__device__ __forceinline__ void xcd_barrier_complete(unsigned* bar, unsigned x, unsigned& nloc, unsigned& nx) {
    const unsigned G = gridDim.x * gridDim.y * gridDim.z;
    unsigned sum, cnt, mine, sp = 0u;
    for (;;) {
        sum = 0u; cnt = 0u; mine = 0u;
#pragma unroll
        for (unsigned j = 0; j < 16; ++j) { const unsigned c = xb_ld(&bar[XB_XCNT(j)]); sum += c; cnt += (c > 0u) ? 1u : 0u; mine = (j == x) ? c : mine; }
        if (sum == G) break;
        __builtin_amdgcn_s_sleep(1);
        if ((++sp & 255u) == 0u) { if (xb_ld(&bar[XB_TMO])) break; if (sp > XB_SPIN_CAP) { atomicAdd(&bar[XB_TMO], 1u); break; } }
    }
    nloc = mine > 0u ? mine : 1u; nx = cnt > 0u ? cnt : 1u;
}
__device__ __forceinline__ void xcd_barrier(const XcdBarrier& b) {
    asm volatile("s_waitcnt vmcnt(0)" ::: "memory");
    __syncthreads();
    if (threadIdx.x == 0) {
        unsigned* bar = b.bar;
        __builtin_amdgcn_s_waitcnt(0);
        unsigned nloc = b.st[0], nx = b.st[1];
        if (nloc == 0u) { xcd_barrier_complete(bar, b.x, nloc, nx); b.st[0] = nloc; b.st[1] = nx; }
        const unsigned old = xb_add(&bar[XB_XSUB(b.x)], 1u);
        const unsigned gen = old / nloc;
        if (old + 1u == (gen + 1u) * nloc) {
            __builtin_amdgcn_fence(__ATOMIC_RELEASE, "agent");
            asm volatile("s_waitcnt vmcnt(0)" ::: "memory");
            const unsigned og = xb_add(&bar[XB_TOP], 1u);
            const unsigned tg = og / nx;
            if (og + 1u == (tg + 1u) * nx) xb_add(&bar[XB_TOPGEN], 1u);
            else XB_SPIN(xb_ld(&bar[XB_TOPGEN]) == tg, bar);
            __builtin_amdgcn_fence(__ATOMIC_ACQUIRE, "agent");
            xb_add(&bar[XB_XGEN(b.x)], 1u);
            asm volatile("s_waitcnt vmcnt(0)" ::: "memory");
        } else {
            XB_SPIN(xb_ld(&bar[XB_XGEN(b.x)]) == gen, bar);
            __builtin_amdgcn_fence(__ATOMIC_ACQUIRE, "agent");
            asm volatile("s_waitcnt vmcnt(0)" ::: "memory");
        }
    }
    __syncthreads();
}

#ifndef DBL_MASK
#define DBL_MASK 0u
#endif
struct Frame {
    LAS unsigned char* lds; unsigned char* ws; unsigned* ctl;
    int tid, lane, wave, G, gw, NGW;
    const float* in[18]; float* out;
};
#define LDS_WAIT() asm volatile("s_waitcnt lgkmcnt(0)" ::: "memory")

__device__ __forceinline__ void transpose_item(const float* W, size_t ldw, bf16* WT, size_t ldt, LAS float* scr, int lane) {
#pragma unroll 8
    for (int i = 0; i < 32; ++i) { const int kk = 2 * i + (lane >> 5); scr[kk * 33 + (lane & 31)] = W[(size_t)kk * ldw + (lane & 31)]; }
    LDS_WAIT(); asm volatile("" ::: "memory");
    const int c = lane & 7;
#pragma unroll
    for (int j = 0; j < 4; ++j) { const int n = (lane >> 3) + 8 * j; const LAS float* s = scr + (8 * c) * 33 + n;
        u32x4 o; o.x = pk2(s[0 * 33], s[1 * 33]); o.y = pk2(s[2 * 33], s[3 * 33]); o.z = pk2(s[4 * 33], s[5 * 33]); o.w = pk2(s[6 * 33], s[7 * 33]);
        *(u32x4*)(WT + (size_t)n * ldt + 8 * c) = o; }
    LDS_WAIT(); asm volatile("" ::: "memory");
}
__device__ __forceinline__ void convert_item(Frame& F, int it, LAS float* scr) {
    constexpr int I_IN = 32 * 320, I_BS = 16 * 64, I_OUT = 32 * 64, I_GE = 32 * 32, I_DE = 16 * 64;
    constexpr int PER_LAYER = I_IN + 2 * I_BS + I_OUT + NE * (2 * I_GE + I_DE);
    const int l = it / PER_LAYER; int r = it % PER_LAYER;
    if (r < I_IN) { const int kb = r / 320, nb = r % 320, nd = 32 * nb, ns = nd + (nd >= FCOL ? 8 : 0);
        transpose_item(F.in[I_WIN] + (size_t)l * DM * INP_SRC + (size_t)(64 * kb) * INP_SRC + ns, INP_SRC, (bf16*)(F.ws + WS_WIN + l * WIN_L) + (size_t)nd * DM + 64 * kb, DM, scr, F.lane); return; }
    r -= I_IN;
    if (r < 2 * I_BS) { const int which = r / I_BS; r %= I_BS; const int kb = r / 64, nb = r % 64;
        transpose_item((which ? F.in[I_WBFX] : F.in[I_WBSB]) + (size_t)l * 1024 * DM + (size_t)(64 * kb) * DM + 32 * nb, DM, (bf16*)(F.ws + WS_WB + l * WB_L) + (size_t)(32 * nb) * DM + which * 1024 + 64 * kb, DM, scr, F.lane); return; }
    r -= 2 * I_BS;
    if (r < I_OUT) { const int kb = r / 64, nb = r % 64;
        transpose_item(F.in[I_WOUT] + (size_t)l * DM * DM + (size_t)(64 * kb) * DM + 32 * nb, DM, (bf16*)(F.ws + WS_WOUT + l * WOUT_L) + (size_t)(32 * nb) * DM + 64 * kb, DM, scr, F.lane); return; }
    r -= I_OUT;
    const int e = r / (2 * I_GE + I_DE); r %= (2 * I_GE + I_DE);
    if (r < 2 * I_GE) { const int which = r / I_GE; r %= I_GE; const int kb = r / 32, nb = r % 32, n0 = 32 * nb, rho = 256 * (n0 >> 7) + (n0 & 127) + which * 128;
        transpose_item((which ? F.in[I_WU] : F.in[I_WG]) + ((size_t)(l * NE + e) * DM + 64 * kb) * FF + n0, FF, (bf16*)(F.ws + WS_WGU + l * WGU_L + e * WGU_E) + (size_t)rho * DM + 64 * kb, DM, scr, F.lane); return; }
    r -= 2 * I_GE;
    { const int kb = r / 64, nb = r % 64;
        transpose_item(F.in[I_WD] + ((size_t)(l * NE + e) * FF + 64 * kb) * DM + 32 * nb, DM, (bf16*)(F.ws + WS_WD + l * WD_L + e * WD_E) + (size_t)(32 * nb) * FF + 64 * kb, FF, scr, F.lane); }
}
constexpr int N_CONVERT_ITEMS = NLAYER * (32 * 320 + 2 * 16 * 64 + 32 * 64 + NE * (2 * 32 * 32 + 16 * 64));

__device__ __forceinline__ int tab_rowpos(int c) { return (c & 3) * 512 + (c >> 8) * 64 + ((c >> 2) & 63); }
template <int NC> __device__ __forceinline__ void stage_table(Frame& F, const float* src, size_t pitch) {
    constexpr int CH = NC / 4;
    for (int ci = F.tid; ci < DM * CH; ci += NTHREADS) { const int c = ci / CH, q = ci % CH;
        const f32x4 v = *(const f32x4*)(src + (size_t)c * pitch + 4 * q);
        const int sw = (NC == 16) ? ((c >> 4) & 3) : ((c >> 5) & 1);
        *(LAS f32x4*)(F.lds + tab_rowpos(c) * (NC * 4) + ((q ^ sw) << 4)) = v; }
    LDS_WAIT(); __syncthreads();
}
template <int NC> __device__ __forceinline__ void table_dot(Frame& F, const f32x4 (&y)[8], float (&acc)[NC]) {
    constexpr int CH = NC / 4; const int l = F.lane; const int sw = (NC == 16) ? ((l >> 2) & 3) : ((l >> 3) & 1);
#pragma unroll
    for (int e = 0; e < NC; ++e) acc[e] = 0.f;
#pragma unroll
    for (int j = 0; j < 8; ++j)
#pragma unroll
        for (int i = 0; i < 4; ++i) { const float yv = y[j][i]; const int rp = i * 512 + j * 64 + l; if (i == 0) asm volatile("" ::: "memory");
#pragma unroll
            for (int q = 0; q < CH; ++q) { const f32x4 w = *(const LAS f32x4*)(F.lds + rp * (NC * 4) + ((q ^ sw) << 4));
                acc[4 * q + 0] = fmaf(yv, w.x, acc[4 * q + 0]); acc[4 * q + 1] = fmaf(yv, w.y, acc[4 * q + 1]); acc[4 * q + 2] = fmaf(yv, w.z, acc[4 * q + 2]); acc[4 * q + 3] = fmaf(yv, w.w, acc[4 * q + 3]); } }
#pragma unroll
    for (int e = 0; e < NC; ++e) acc[e] = wave_sum(acc[e]);
}
__device__ __forceinline__ void ln_row(Frame& F, f32x4 (&v)[8], const float* g, const float* b) {
    float s = 0.f;
#pragma unroll
    for (int j = 0; j < 8; ++j) s += (v[j].x + v[j].y) + (v[j].z + v[j].w);
    const float mean = wave_sum(s) * (1.f / DM); float s2 = 0.f;
#pragma unroll
    for (int j = 0; j < 8; ++j) { v[j] = v[j] - mean; s2 += (v[j].x * v[j].x + v[j].y * v[j].y) + (v[j].z * v[j].z + v[j].w * v[j].w); }
    const float rstd = 1.0f / sqrtf(wave_sum(s2) * (1.f / DM) + LN_EPS);
#pragma unroll
    for (int j = 0; j < 8; ++j) { const f32x4 gv = *(const f32x4*)(g + 256 * j + 4 * F.lane), bv = *(const f32x4*)(b + 256 * j + 4 * F.lane); v[j] = v[j] * rstd * gv + bv; }
}
__device__ __forceinline__ void store_h(Frame& F, int row, const f32x4 (&y)[8], bool dry = false) {
    float* hf = (float*)(F.ws + (dry ? WS_YB : WS_HF)) + (size_t)row * DM; bf16* hb = (bf16*)(F.ws + (dry ? WS_GB + 21 * MiB : WS_HB)) + (size_t)row * DM;
#pragma unroll
    for (int j = 0; j < 8; ++j) { *(f32x4*)(hf + 256 * j + 4 * F.lane) = y[j]; u32x2 w; w.x = pk2(y[j].x, y[j].y); w.y = pk2(y[j].z, y[j].w); *(u32x2*)(hb + 256 * j + 4 * F.lane) = w; }
}
__device__ __forceinline__ void store_logf(Frame& F, int row, const f32x4 (&y)[8], const float* bfor) {
    float acc[8]; table_dot<8>(F, y, acc);
    if (F.lane < 8) { float a = acc[0];
#pragma unroll
        for (int h = 1; h < 8; ++h) a = (F.lane == h) ? acc[h] : a;
        const float x = a + bfor[F.lane];
        const float ls = fminf(x, 0.f) - log1pf(__expf(-fabsf(x)));
        ((float*)(F.ws + WS_LOGF))[(size_t)row * 8 + F.lane] = ls; }
}

__device__ __forceinline__ void phase_prologue(Frame& F) {
    LAS float* scr = (LAS float*)(F.lds + F.wave * 16384);
    for (int rep = 0; rep < 1 + (int)((DBL_MASK >> 8) & 1u); ++rep)
    for (int it = F.gw; it < N_CONVERT_ITEMS; it += F.NGW) convert_item(F, it, scr);
    __syncthreads();
    stage_table<8>(F, F.in[I_WIN] + FCOL, INP_SRC);
    for (int row = F.gw; row < NTOK; row += F.NGW) {
        const float* src = row < SEQ ? F.in[I_X] + (size_t)row * DM : F.in[I_META] + (size_t)(row - SEQ) * DM;
        f32x4 v[8];
#pragma unroll
        for (int j = 0; j < 8; ++j) v[j] = *(const f32x4*)(src + 256 * j + 4 * F.lane);
        ln_row(F, v, F.in[I_LNIN_G], F.in[I_LNIN_B]);
        store_h(F, row, v);
        store_logf(F, row, v, F.in[I_BF]);
    }
    for (int row = NTOK + F.gw; row < MROWS; row += F.NGW) { bf16* hb = (bf16*)(F.ws + WS_HB) + (size_t)row * DM;
#pragma unroll
        for (int j = 0; j < 4; ++j) *(u32x4*)(hb + 512 * j + 8 * F.lane) = (u32x4){0u, 0u, 0u, 0u}; }
    __syncthreads();
}
__device__ __forceinline__ void phase_cumsum(Frame& F) {
    if (blockIdx.x >= NHEAD) {
        if (blockIdx.x < NHEAD + 48) { bf16* q = (bf16*)(F.ws + WS_QKV) + (size_t)(NTOK + blockIdx.x - NHEAD) * QKV_N;
            for (int i = F.tid; i < QKV_N / 8; i += NTHREADS) *(u32x4*)(q + 8 * i) = (u32x4){0u, 0u, 0u, 0u}; }
        return; }
    const int h = blockIdx.x; const float* logf = (const float*)(F.ws + WS_LOGF); float* cum = (float*)(F.ws + WS_CUM) + (size_t)h * MROWS;
    constexpr int PER = 17; const int p0 = F.tid * PER;
    float loc[PER]; float s = 0.f;
#pragma unroll
    for (int i = 0; i < PER; ++i) { const int p = p0 + i; const float v = p < NTOK ? logf[(size_t)row_of_p(p) * 8 + h] : 0.f; s += v; loc[i] = s; }
    float inc = s;
#pragma unroll
    for (int off = 1; off < 64; off <<= 1) { const float t = __shfl_up(inc, off); if (F.lane >= off) inc += t; }
    LAS float* wt = (LAS float*)(F.lds);
    if (F.lane == 63) wt[F.wave] = inc;
    LDS_WAIT(); __syncthreads();
    float base = inc - s;
    for (int w = 0; w < F.wave; ++w) base += wt[w];
#pragma unroll
    for (int i = 0; i < PER; ++i) { const int p = p0 + i; if (p < NTOK) cum[p] = (base + loc[i]) * LOG2E; }
    LDS_WAIT(); __syncthreads();
}
__device__ __forceinline__ void phase_ln_router(Frame& F, int layer, bool dry = false) {
    stage_table<16>(F, F.in[I_WR], 16);
    const float* g = F.in[I_LNMIX_G] + layer * DM; const float* b = F.in[I_LNMIX_B] + layer * DM;
    const float* rbias = F.in[I_RB];
    const int nrows_e = layer == NLAYER - 1 ? SEQ : NTOK;
    for (int row = F.gw; row < nrows_e; row += F.NGW) {
        const float* src = (const float*)(F.ws + WS_RB) + (size_t)row * DM;
        f32x4 v[8];
#pragma unroll
        for (int j = 0; j < 8; ++j) v[j] = *(const f32x4*)(src + 256 * j + 4 * F.lane);
        ln_row(F, v, g, b);
        store_h(F, row, v, dry);
        float lg[16]; table_dot<16>(F, v, lg);
        float aff[16], sel[16];
#pragma unroll
        for (int e = 0; e < 16; ++e) { aff[e] = 1.0f / (1.0f + __expf(-lg[e])); sel[e] = aff[e] + rbias[e]; }
        int bg = 0; float bs = -__builtin_inff();
#pragma unroll
        for (int gi = 0; gi < 4; ++gi) { const float a0 = sel[4 * gi], a1 = sel[4 * gi + 1], a2 = sel[4 * gi + 2], a3 = sel[4 * gi + 3];
            const float h1 = fmaxf(a0, a1), l1 = fminf(a0, a1), h2 = fmaxf(a2, a3), l2 = fminf(a2, a3);
            const float top = fmaxf(h1, h2), sec = fmaxf(fminf(h1, h2), fmaxf(l1, l2)), sc = top + sec;
            if (sc > bs) { bs = sc; bg = gi; } }
        float s4[4], a4[4];
#pragma unroll
        for (int i = 0; i < 4; ++i) { s4[i] = sel[i]; a4[i] = aff[i]; }
#pragma unroll
        for (int gi = 1; gi < 4; ++gi) if (bg == gi) {
#pragma unroll
            for (int i = 0; i < 4; ++i) { s4[i] = sel[4 * gi + i]; a4[i] = aff[4 * gi + i]; } }
        int i1 = 0; float m1 = s4[0];
#pragma unroll
        for (int i = 1; i < 4; ++i) if (s4[i] > m1) { m1 = s4[i]; i1 = i; }
        int i2 = -1; float m2 = -__builtin_inff();
#pragma unroll
        for (int i = 0; i < 4; ++i) if (i != i1 && s4[i] > m2) { m2 = s4[i]; i2 = i; }
        float af1 = a4[0], af2 = a4[0];
#pragma unroll
        for (int i = 1; i < 4; ++i) { if (i1 == i) af1 = a4[i]; if (i2 == i) af2 = a4[i]; }
        const float wsum = af1 + af2, w1 = af1 / wsum, w2 = af2 / wsum;
        const int e1 = 4 * bg + i1, e2 = 4 * bg + i2;
        if (dry) { if (F.lane == 0) ((float*)(F.ws + WS_GB + 60 * MiB))[row] = w1 + w2 + (float)(e1 + e2); }
        if (F.lane == 0 && !dry) {
            const int r1 = (int)atomicAdd(F.ctl + CW_CNT + (layer * NE + e1) * 64, 1u), r2 = (int)atomicAdd(F.ctl + CW_CNT + (layer * NE + e2) * 64, 1u);
            int* el = (int*)(F.ws + WS_ELIST); el[(size_t)e1 * MROWS + r1] = row; el[(size_t)e2 * MROWS + r2] = row;
            int* ti = (int*)(F.ws + WS_TOKI) + (size_t)row * 8;
            ti[0] = e1; ti[1] = e2; ti[2] = r1; ti[3] = r2; ti[4] = __builtin_bit_cast(int, w1); ti[5] = __builtin_bit_cast(int, w2);
        }
    }
    __syncthreads();
}
__device__ __forceinline__ void phase_ln_final(Frame& F, int layer, bool dry = false) {
    const bool last = layer == NLAYER - 1;
    if (!last) stage_table<8>(F, F.in[I_WIN] + (size_t)(layer + 1) * DM * INP_SRC + FCOL, INP_SRC);
    const float* g = F.in[I_LNFFN_G] + layer * DM; const float* b = F.in[I_LNFFN_B] + layer * DM;
    const int nrows = last ? SEQ : NTOK;
    for (int row = F.gw; row < nrows; row += F.NGW) {
        const int* ti = (const int*)(F.ws + WS_TOKI) + (size_t)row * 8;
        const int e1 = ti[0], e2 = ti[1], r1 = ti[2], r2 = ti[3]; const float w1 = __builtin_bit_cast(float, ti[4]), w2 = __builtin_bit_cast(float, ti[5]);
        const int ps1 = moe_pstart(F.ctl, layer, e1), ps2 = moe_pstart(F.ctl, layer, e2);
        const bf16* o1 = (const bf16*)(F.ws + WS_OSL) + (size_t)(ps1 + r1) * DM; const bf16* o2 = (const bf16*)(F.ws + WS_OSL) + (size_t)(ps2 + r2) * DM;
        const float* hf = (const float*)(F.ws + WS_HF) + (size_t)row * DM;
        f32x4 v[8];
#pragma unroll
        for (int j = 0; j < 8; ++j) { const f32x4 hv = *(const f32x4*)(hf + 256 * j + 4 * F.lane);
            const u32x2 a = *(const u32x2*)(o1 + 256 * j + 4 * F.lane), c = *(const u32x2*)(o2 + 256 * j + 4 * F.lane);
            v[j].x = ALPHA * hv.x + w1 * bflo(a.x) + w2 * bflo(c.x); v[j].y = ALPHA * hv.y + w1 * bfhi(a.x) + w2 * bfhi(c.x);
            v[j].z = ALPHA * hv.z + w1 * bflo(a.y) + w2 * bflo(c.y); v[j].w = ALPHA * hv.w + w1 * bfhi(a.y) + w2 * bfhi(c.y); }
        ln_row(F, v, g, b);
        if (dry) { store_h(F, row, v, true); if (!last) { float acc8[8]; table_dot<8>(F, v, acc8); if (F.lane == 0) ((float*)(F.ws + WS_GB + 60 * MiB))[row] = acc8[0] + acc8[7]; } }
        else if (last) { float* o = F.out + (size_t)row * DM;
#pragma unroll
            for (int j = 0; j < 8; ++j) *(f32x4*)(o + 256 * j + 4 * F.lane) = v[j]; }
        else { store_h(F, row, v); store_logf(F, row, v, F.in[I_BF] + (layer + 1) * NHEAD); }
    }
    __syncthreads();
}

namespace pg8 {
typedef short bf16x8 __attribute__((ext_vector_type(8)));
constexpr int BM = 256, BK = 64, HALF = 128, HTB = HALF * BK * 2, STAGE_BYTES = 8 * HTB, NXCD = 8, WGM = 8;
__host__ __device__ __forceinline__ int lds_byte(int r, int c) { const int st = (r >> 4) * 2 + (c >> 5), rr = r & 15, cc = c & 31, ob = rr * 64 + cc * 2; return st * 1024 + (ob ^ (((ob >> 9) & 1) << 5)); }
__host__ __device__ __forceinline__ void stage_rc(int b, int& R, int& C) { const int st = b / 1024, sb = b % 1024, swz = sb ^ (((sb >> 9) & 1) << 5); R = (st >> 1) * 16 + swz / 64; C = (st & 1) * 32 + (swz % 64) / 2; }
__host__ __device__ __forceinline__ int perm32(int rho) { const int n = rho >> 4, i = rho & 15; return 8 * (i >> 2) + 4 * n + (i & 3); }
struct Unit { int pm, pn, aux; };
__device__ __forceinline__ bool static_tile(int nM, int nN, int G, int c, int i, int& pm, int& pn) {
    const int nwg = nM * nN; const long L = (long)i * G + c; if (L >= nwg) return false;
    int wgid = (int)L; { const int q = nwg / NXCD, r = nwg % NXCD, xcd = wgid % NXCD, off = wgid / NXCD; wgid = (xcd < r ? xcd * (q + 1) : r * (q + 1) + (xcd - r) * q) + off; }
    const int nig = WGM * nN, gid = wgid / nig, fm = gid * WGM, gsz = (nM - fm) < WGM ? (nM - fm) : WGM;
    pm = fm + ((wgid % nig) % gsz); pn = (wgid % nig) / gsz; return true;
}
__device__ __forceinline__ unsigned cvt_pk_bf16(float lo, float hi) { unsigned r; asm volatile("v_cvt_pk_bf16_f32 %0, %1, %2" : "=v"(r) : "v"(lo), "v"(hi)); return r; }

template <class P>
__device__ __forceinline__ void gemm_phase(LAS unsigned char* lds, const P& prob) {
    const int tid = threadIdx.x, wid = __builtin_amdgcn_readfirstlane(tid >> 6), lane = tid & 63, wr = wid >> 2, wc = wid & 3, fr = lane & 15, fq = lane >> 4;
    const int nt = prob.K / BK;
    unsigned voffA[2], voffA1[2], voffB[2];
#pragma unroll
    for (int i = 0; i < 2; ++i) { int R, C; stage_rc(tid * 16 + i * 8192, R, C); const int Rb = P::PERM ? ((R & ~31) + perm32(R & 31)) : R;
        voffA[i] = (unsigned)(R * prob.lda + C) * 2u; voffA1[i] = voffA[i]; voffB[i] = (unsigned)(Rb * prob.ldb + C) * 2u; }
    const size_t kstep = (size_t)(BK * 2);
    const size_t hstepA = P::GATHER ? (size_t)0 : (size_t)HALF * prob.lda * 2, hstepB = (size_t)HALF * prob.ldb * 2;
    const unsigned ldsw = (unsigned)wid * 1024u;
    const int aoff = lds_byte(wr * 64 + fr, fq * 8), boff = lds_byte(wc * 32 + fr, fq * 8);
#define PG8_SA(b, h) (((b) * 2 + (h)) * HTB)
#define PG8_SB(b, h) ((4 + (b) * 2 + (h)) * HTB)
#define PG8_STAGE(bufoff, gbase, voff) do { _Pragma("unroll") for (int _i = 0; _i < 2; ++_i) \
        __builtin_amdgcn_global_load_lds((const unsigned*)((const char*)(gbase) + (voff)[_i]), (LAS unsigned*)(lds + (bufoff) + ldsw + _i * 8192), 16, 0, 0); } while (0)
#define PG8_LDA(dst, b, h) do { _Pragma("unroll") for (int m = 0; m < 4; ++m) _Pragma("unroll") for (int k = 0; k < 2; ++k) dst[m][k] = *(const LAS bf16x8*)(lds + PG8_SA(b, h) + aoff + m * 2048 + k * 1024); } while (0)
#define PG8_LDB(dst, b, h) do { _Pragma("unroll") for (int n = 0; n < 2; ++n) _Pragma("unroll") for (int k = 0; k < 2; ++k) dst[n][k] = *(const LAS bf16x8*)(lds + PG8_SB(b, h) + boff + n * 2048 + k * 1024); } while (0)
#define PG8_MMA(ai, bj, At, Bt) do { __builtin_amdgcn_s_setprio(1); _Pragma("unroll") for (int m = 0; m < 4; ++m) _Pragma("unroll") for (int n = 0; n < 2; ++n) _Pragma("unroll") for (int k = 0; k < 2; ++k) \
        acc[ai][bj][m][n] = __builtin_amdgcn_mfma_f32_16x16x32_bf16(Bt[n][k], At[m][k], acc[ai][bj][m][n], 0, 0, 0); __builtin_amdgcn_s_setprio(0); } while (0)
#define PG8_WAIT_V(n) asm volatile("s_waitcnt vmcnt(" #n ")" ::: "memory")
#define PG8_WAIT_L(n) asm volatile("s_waitcnt lgkmcnt(" #n ")" ::: "memory")
#define PG8_BAR __builtin_amdgcn_s_barrier()
#define PG8_SCHED __builtin_amdgcn_sched_barrier(0)
#define PG8_GATHER_OFFS(ui_, d0, d1) do { _Pragma("unroll") for (int _i = 0; _i < 2; ++_i) { int R_, C_; stage_rc(tid * 16 + _i * 8192, R_, C_); \
        d0[_i] = (unsigned)(prob.a_row(ui_, R_) * prob.lda + C_) * 2u; d1[_i] = (unsigned)(prob.a_row(ui_, HALF + R_) * prob.lda + C_) * 2u; } } while (0)
    Unit cur, nxt; int ui = 0;
    if (!prob.next(0, cur)) return;
    f32x4 acc[2][2][4][2];
#pragma unroll
    for (int a = 0; a < 2; ++a)
#pragma unroll
        for (int b = 0; b < 2; ++b)
#pragma unroll
            for (int m = 0; m < 4; ++m)
#pragma unroll
                for (int n = 0; n < 2; ++n) acc[a][b][m][n] = (f32x4){0.f, 0.f, 0.f, 0.f};
    bf16x8 At[4][2], B0[2][2], B1[2][2];
    const char* cA = prob.a_ptr(cur); const char* cB = prob.b_ptr(cur);
    if constexpr (P::GATHER) PG8_GATHER_OFFS(0, voffA, voffA1);
    PG8_STAGE(PG8_SB(0, 0), cB, voffB); PG8_STAGE(PG8_SB(0, 1), cB + hstepB, voffB); PG8_STAGE(PG8_SA(0, 0), cA, voffA); PG8_STAGE(PG8_SA(0, 1), cA + hstepA, voffA1);
    if (wr == 1) PG8_BAR;
    PG8_WAIT_V(2); PG8_BAR;
    PG8_STAGE(PG8_SB(1, 0), cB + kstep, voffB); PG8_STAGE(PG8_SA(1, 0), cA + kstep, voffA); PG8_STAGE(PG8_SB(1, 1), cB + hstepB + kstep, voffB);
    PG8_WAIT_V(6); PG8_BAR;
    for (;;) {
        const bool has_next = prob.next(ui + 1, nxt);
        const char* nA = has_next ? prob.a_ptr(nxt) : cA; const char* nB = has_next ? prob.b_ptr(nxt) : cB;
        for (int t = 0; t < nt; t += 2) {
            const bool last = (t == nt - 2);
            const char* a1 = cA + (size_t)(t + 1) * kstep;
            const char* a2 = last ? nA : cA + (size_t)(t + 2) * kstep; const char* b2 = last ? nB : cB + (size_t)(t + 2) * kstep;
            const char* a3 = a2 + kstep; const char* b3 = b2 + kstep;
            if constexpr (P::GATHER) {
                unsigned v0[2], v1[2];
#pragma unroll
                for (int i = 0; i < 2; ++i) { v0[i] = voffA[i]; v1[i] = voffA1[i]; }
                if (last && has_next) PG8_GATHER_OFFS(ui + 1, v0, v1);
                PG8_LDB(B0, 0, 0); PG8_LDB(B1, 0, 1); PG8_SCHED; PG8_LDA(At, 0, 0); PG8_STAGE(PG8_SA(1, 1), a1, voffA1);
                PG8_WAIT_V(8); PG8_WAIT_L(0); PG8_BAR; PG8_MMA(0, 0, At, B0); PG8_MMA(0, 1, At, B1); PG8_BAR; PG8_SCHED;
                PG8_LDA(At, 0, 1); PG8_STAGE(PG8_SB(0, 0), b2, voffB); PG8_STAGE(PG8_SB(0, 1), b2 + hstepB, voffB); PG8_STAGE(PG8_SA(0, 0), a2, v0);
                PG8_WAIT_V(8); PG8_WAIT_L(0); PG8_BAR; PG8_MMA(1, 0, At, B0); PG8_MMA(1, 1, At, B1); PG8_BAR; PG8_SCHED;
                PG8_LDB(B0, 1, 0); PG8_LDB(B1, 1, 1); PG8_SCHED; PG8_LDA(At, 1, 0); PG8_STAGE(PG8_SA(0, 1), a2, v1);
                PG8_WAIT_V(8); PG8_WAIT_L(0); PG8_BAR; PG8_MMA(0, 0, At, B0); PG8_MMA(0, 1, At, B1); PG8_BAR; PG8_SCHED;
                PG8_LDA(At, 1, 1); PG8_STAGE(PG8_SB(1, 0), b3, voffB); PG8_STAGE(PG8_SB(1, 1), b3 + hstepB, voffB); PG8_STAGE(PG8_SA(1, 0), a3, v0);
                PG8_WAIT_V(8); PG8_WAIT_L(0); PG8_BAR; PG8_MMA(1, 0, At, B0); PG8_MMA(1, 1, At, B1); PG8_BAR; PG8_SCHED;
#pragma unroll
                for (int i = 0; i < 2; ++i) { voffA[i] = v0[i]; voffA1[i] = v1[i]; }
            } else {
                PG8_LDB(B0, 0, 0); PG8_LDB(B1, 0, 1); PG8_SCHED; PG8_LDA(At, 0, 0); PG8_STAGE(PG8_SA(1, 1), a1 + hstepA, voffA);
                PG8_WAIT_V(8); PG8_WAIT_L(0); PG8_BAR; PG8_MMA(0, 0, At, B0); PG8_MMA(0, 1, At, B1); PG8_BAR; PG8_SCHED;
                PG8_LDA(At, 0, 1); PG8_STAGE(PG8_SB(0, 0), b2, voffB); PG8_STAGE(PG8_SB(0, 1), b2 + hstepB, voffB); PG8_STAGE(PG8_SA(0, 0), a2, voffA);
                PG8_WAIT_V(8); PG8_WAIT_L(0); PG8_BAR; PG8_MMA(1, 0, At, B0); PG8_MMA(1, 1, At, B1); PG8_BAR; PG8_SCHED;
                PG8_LDB(B0, 1, 0); PG8_LDB(B1, 1, 1); PG8_SCHED; PG8_LDA(At, 1, 0); PG8_STAGE(PG8_SA(0, 1), a2 + hstepA, voffA);
                PG8_WAIT_V(8); PG8_WAIT_L(0); PG8_BAR; PG8_MMA(0, 0, At, B0); PG8_MMA(0, 1, At, B1); PG8_BAR; PG8_SCHED;
                PG8_LDA(At, 1, 1); PG8_STAGE(PG8_SB(1, 0), b3, voffB); PG8_STAGE(PG8_SB(1, 1), b3 + hstepB, voffB); PG8_STAGE(PG8_SA(1, 0), a3, voffA);
                PG8_WAIT_V(8); PG8_WAIT_L(0); PG8_BAR; PG8_MMA(1, 0, At, B0); PG8_MMA(1, 1, At, B1); PG8_BAR; PG8_SCHED;
            }
        }
        if (wr == 0) PG8_BAR;
        const bool keep = prob.epi(acc, cur, wr, wc, fr, fq);
        if (!has_next) break;
        if (!P::KEEPS || !keep) {
#pragma unroll
            for (int a = 0; a < 2; ++a)
#pragma unroll
                for (int b = 0; b < 2; ++b)
#pragma unroll
                    for (int m = 0; m < 4; ++m)
#pragma unroll
                        for (int n = 0; n < 2; ++n) acc[a][b][m][n] = (f32x4){0.f, 0.f, 0.f, 0.f};
        }
        cur = nxt; cA = nA; cB = nB; ++ui;
        if (wr == 1) PG8_BAR;
    }
    PG8_WAIT_V(0);
    PG8_BAR;
#undef PG8_SA
#undef PG8_SB
#undef PG8_STAGE
#undef PG8_LDA
#undef PG8_LDB
#undef PG8_MMA
#undef PG8_WAIT_V
#undef PG8_WAIT_L
#undef PG8_BAR
#undef PG8_SCHED
#undef PG8_GATHER_OFFS
}
}

template <class Epi>
__device__ __forceinline__ void skinny16(LAS unsigned char* lds, const bf16* A, int lda, const bf16* Bt, int ldb, int K, int N, const Epi& epi) {
    const int tid = threadIdx.x, wid = __builtin_amdgcn_readfirstlane(tid >> 6), lane = tid & 63, r = lane & 15, kg = lane >> 4;
    const int kw = K / 8, k0 = wid * kw;
    LAS float* part = (LAS float*)lds;
    for (int ct = blockIdx.x; ct < N / 16; ct += gridDim.x) {
        const bf16* ap = A + (size_t)r * lda + k0 + 8 * kg; const bf16* bp = Bt + (size_t)(16 * ct + r) * ldb + k0 + 8 * kg;
        f32x4 acc = {0.f, 0.f, 0.f, 0.f};
#pragma unroll 8
        for (int ks = 0; ks < kw; ks += 32) acc = __builtin_amdgcn_mfma_f32_16x16x32_bf16(*(const pg8::bf16x8*)(ap + ks), *(const pg8::bf16x8*)(bp + ks), acc, 0, 0, 0);
#pragma unroll
        for (int i = 0; i < 4; ++i) part[wid * 256 + (4 * kg + i) * 16 + r] = acc[i];
        LDS_WAIT(); __syncthreads();
        if (tid < 256) { const float s0 = (part[tid] + part[256 + tid]) + (part[512 + tid] + part[768 + tid]), s1 = (part[1024 + tid] + part[1280 + tid]) + (part[1536 + tid] + part[1792 + tid]);
            epi(tid >> 4, 16 * ct + (tid & 15), s0, s1); }
        LDS_WAIT(); __syncthreads();
    }
}
struct SkinnyInProj { unsigned char* ws; __device__ __forceinline__ void operator()(int j, int n, float s0, float s1) const { inproj_store(ws, SEQ + j, n, s0 + s1); } };
struct SkinnyBranch { unsigned char* ws; __device__ __forceinline__ void operator()(int j, int n, float s0, float s1) const {
    const size_t r = SEQ + j; const bf16* G = (const bf16*)(ws + WS_GB); ((bf16*)(ws + WS_MG))[r * DM + n] = (bf16)f2bf(bf2f(G[r * G_N + n]) * s0 + bf2f(G[r * G_N + DM + n]) * s1); } };
struct SkinnyOut { unsigned char* ws; __device__ __forceinline__ void operator()(int j, int n, float s0, float s1) const {
    const size_t o = (size_t)(SEQ + j) * DM + n; ((float*)(ws + WS_RB))[o] = ALPHA * ((const float*)(ws + WS_HF))[o] + (s0 + s1); } };

using pg8::Unit;
struct ProbInProj {
    static constexpr bool PERM = true, GATHER = false, KEEPS = false;
    int K, lda, ldb, G, c; const bf16* A; const bf16* B; unsigned char* ws;
    __device__ __forceinline__ bool next(int i, Unit& u) const { u.aux = 0; return pg8::static_tile(SEQ / 256, INP_N / 256, G, c, i, u.pm, u.pn); }
    __device__ __forceinline__ const char* a_ptr(const Unit& u) const { return (const char*)(A + (size_t)u.pm * 256 * lda); }
    __device__ __forceinline__ const char* b_ptr(const Unit& u) const { return (const char*)(B + (size_t)u.pn * 256 * ldb); }
    __device__ __forceinline__ bool epi(f32x4 (&acc)[2][2][4][2], const Unit& u, int wr, int wc, int fr, int fq) const {
        const int row0 = u.pm * 256 + wr * 64 + fr, ct = u.pn * 256 + wc * 32 + 8 * fq;
        const bool isg = u.pn >= 24, isq = (u.pn < 4) || (u.pn >= 12 && u.pn < 16);
        bf16* base = isg ? (bf16*)(ws + WS_GB) + (ct - QKV_N) : (bf16*)(ws + WS_QKV) + ct; const int ldc = isg ? G_N : QKV_N; const float sc = isq ? QSCALE : 1.0f;
#pragma unroll
        for (int ai = 0; ai < 2; ++ai)
#pragma unroll
            for (int m = 0; m < 4; ++m) { bf16* rowp = base + (size_t)(row0 + ai * 128 + m * 16) * ldc;
#pragma unroll
                for (int bj = 0; bj < 2; ++bj) { f32x4 v0 = acc[ai][bj][m][0], v1 = acc[ai][bj][m][1];
                    if (isg) {
#pragma unroll
                        for (int j = 0; j < 4; ++j) { v0[j] = __builtin_amdgcn_rcpf(1.0f + __builtin_amdgcn_exp2f(-LOG2E * v0[j])); v1[j] = __builtin_amdgcn_rcpf(1.0f + __builtin_amdgcn_exp2f(-LOG2E * v1[j])); } }
                    else { v0 = v0 * sc; v1 = v1 * sc; }
                    u32x4 w; w.x = pg8::cvt_pk_bf16(v0[0], v0[1]); w.y = pg8::cvt_pk_bf16(v0[2], v0[3]); w.z = pg8::cvt_pk_bf16(v1[0], v1[1]); w.w = pg8::cvt_pk_bf16(v1[2], v1[3]);
                    *(u32x4*)(rowp + bj * 128) = w; } }
        return false;
    }
};
struct ProbOutProj {
    static constexpr bool PERM = false, GATHER = false, KEEPS = false;
    int K, lda, ldb, G, c; const bf16* A; const bf16* B; unsigned char* ws;
    __device__ __forceinline__ bool next(int i, Unit& u) const { u.aux = 0; return pg8::static_tile(SEQ / 256, DM / 256, G, c, i, u.pm, u.pn); }
    __device__ __forceinline__ const char* a_ptr(const Unit& u) const { return (const char*)(A + (size_t)u.pm * 256 * lda); }
    __device__ __forceinline__ const char* b_ptr(const Unit& u) const { return (const char*)(B + (size_t)u.pn * 256 * ldb); }
    __device__ __forceinline__ bool epi(f32x4 (&acc)[2][2][4][2], const Unit& u, int wr, int wc, int fr, int fq) const {
        const int row0 = u.pm * 256 + wr * 64 + fr, col0 = u.pn * 256 + wc * 32 + 4 * fq;
        const float* HF = (const float*)(ws + WS_HF); float* R = (float*)(ws + WS_RB);
#pragma unroll
        for (int ai = 0; ai < 2; ++ai)
#pragma unroll
            for (int m = 0; m < 4; ++m) { const size_t off = (size_t)(row0 + ai * 128 + m * 16) * DM + col0;
#pragma unroll
                for (int bj = 0; bj < 2; ++bj)
#pragma unroll
                    for (int n = 0; n < 2; ++n) { const f32x4 hv = *(const f32x4*)(HF + off + bj * 128 + n * 16); *(f32x4*)(R + off + bj * 128 + n * 16) = hv * ALPHA + acc[ai][bj][m][n]; }
                asm volatile("" ::: "memory"); }
        return false;
    }
};

struct ProbBranch {
    static constexpr bool PERM = true, GATHER = false, KEEPS = true;
    int K, lda, ldb, G, c; const bf16* A; const bf16* B; unsigned char* ws;
    __device__ __forceinline__ bool next(int i, Unit& u) const { u.aux = i & 1; return pg8::static_tile(SEQ / 256, DM / 256, G, c, i >> 1, u.pm, u.pn); }
    __device__ __forceinline__ const char* a_ptr(const Unit& u) const { return (const char*)(A + (size_t)u.pm * 256 * lda + u.aux * 1024); }
    __device__ __forceinline__ const char* b_ptr(const Unit& u) const { return (const char*)(B + (size_t)u.pn * 256 * ldb + u.aux * 1024); }
    __device__ __forceinline__ bool epi(f32x4 (&acc)[2][2][4][2], const Unit& u, int wr, int wc, int fr, int fq) const {
        const int row0 = u.pm * 256 + wr * 64 + fr, ct = u.pn * 256 + wc * 32 + 8 * fq;
        const bf16* Gs = (const bf16*)(ws + WS_GB) + ct; const bf16* Gf = Gs + DM; bf16* MG = (bf16*)(ws + WS_MG) + ct;
        const bool first = u.aux == 0;
#pragma unroll
        for (int ai = 0; ai < 2; ++ai)
#pragma unroll
            for (int m = 0; m < 4; ++m) { const size_t r = (size_t)(row0 + ai * 128 + m * 16);
#pragma unroll
                for (int bj = 0; bj < 2; ++bj) { const u32x4 gf = *(const u32x4*)(Gf + r * G_N + bj * 128);
                    f32x4 f0 = {bflo(gf.x), bfhi(gf.x), bflo(gf.y), bfhi(gf.y)}, f1 = {bflo(gf.z), bfhi(gf.z), bflo(gf.w), bfhi(gf.w)};
                    if (first) { const u32x4 gs = *(const u32x4*)(Gs + r * G_N + bj * 128);
                        const f32x4 s0 = {bflo(gs.x), bfhi(gs.x), bflo(gs.y), bfhi(gs.y)}, s1 = {bflo(gs.z), bfhi(gs.z), bflo(gs.w), bfhi(gs.w)};
#pragma unroll
                        for (int j = 0; j < 4; ++j) { acc[ai][bj][m][0][j] *= s0[j] * __builtin_amdgcn_rcpf(fmaxf(f0[j], 1e-30f)); acc[ai][bj][m][1][j] *= s1[j] * __builtin_amdgcn_rcpf(fmaxf(f1[j], 1e-30f)); } }
                    else { const f32x4 v0 = acc[ai][bj][m][0] * f0, v1 = acc[ai][bj][m][1] * f1;
                        u32x4 w; w.x = pg8::cvt_pk_bf16(v0[0], v0[1]); w.y = pg8::cvt_pk_bf16(v0[2], v0[3]); w.z = pg8::cvt_pk_bf16(v1[0], v1[1]); w.w = pg8::cvt_pk_bf16(v1[2], v1[3]);
                        *(u32x4*)(MG + r * DM + bj * 128) = w; } }
                asm volatile("" ::: "memory"); }
        return first;
    }
};
constexpr int IDX_OFF = RING_BYTES + 1024, MOE_MAXU = 3;
struct ProbMoeGU {
    static constexpr bool PERM = true, GATHER = true, KEEPS = false;
    int K, lda, ldb, G, c, layer; const bf16* A; const bf16* B; unsigned char* ws; const unsigned* ctl; LAS unsigned char* lds;
    __device__ __forceinline__ bool next(int i, Unit& u) const { const int L = i * G + c; u.pm = L >> 3; u.pn = L & 7; int cnt, ps; return moe_find(ctl, layer, u.pm * 256, u.aux, cnt, ps); }
    __device__ __forceinline__ const char* a_ptr(const Unit&) const { return (const char*)A; }
    __device__ __forceinline__ const char* b_ptr(const Unit& u) const { return (const char*)(B + (size_t)u.aux * (WGU_E / 2) + (size_t)u.pn * 256 * ldb); }
    __device__ __forceinline__ int a_row(int ui, int r) const { return *(const LAS int*)(lds + IDX_OFF + (ui * 256 + r) * 4); }
    __device__ __forceinline__ void fill_idx(int tid) const {
        for (int ui = 0; ui < MOE_MAXU; ++ui) { const int L = ui * G + c; int e, cnt, ps; if (!moe_find(ctl, layer, (L >> 3) * 256, e, cnt, ps)) break;
            if (tid < 256) { const int rank = (L >> 3) * 256 - ps + tid; *(LAS int*)(lds + IDX_OFF + (ui * 256 + tid) * 4) = rank < cnt ? ((const int*)(ws + WS_ELIST))[(size_t)e * MROWS + rank] : 0; } }
        LDS_WAIT(); __syncthreads();
    }
    __device__ __forceinline__ bool epi(f32x4 (&acc)[2][2][4][2], const Unit& u, int wr, int wc, int fr, int fq) const {
        const int row0 = u.pm * 256 + wr * 64 + fr, ct = u.pn * 128 + wc * 32 + 8 * fq; bf16* act = (bf16*)(ws + WS_ACT) + ct;
#pragma unroll
        for (int ai = 0; ai < 2; ++ai)
#pragma unroll
            for (int m = 0; m < 4; ++m) { f32x4 v[2];
#pragma unroll
                for (int n = 0; n < 2; ++n)
#pragma unroll
                    for (int j = 0; j < 4; ++j) { const float g = acc[ai][0][m][n][j]; v[n][j] = g * __builtin_amdgcn_rcpf(1.0f + __builtin_amdgcn_exp2f(-LOG2E * g)) * acc[ai][1][m][n][j]; }
                u32x4 w; w.x = pg8::cvt_pk_bf16(v[0][0], v[0][1]); w.y = pg8::cvt_pk_bf16(v[0][2], v[0][3]); w.z = pg8::cvt_pk_bf16(v[1][0], v[1][1]); w.w = pg8::cvt_pk_bf16(v[1][2], v[1][3]);
                *(u32x4*)(act + (size_t)(row0 + ai * 128 + m * 16) * FF) = w; }
        return false;
    }
};
struct ProbMoeDown {
    static constexpr bool PERM = true, GATHER = false, KEEPS = false;
    int K, lda, ldb, G, c, layer; const bf16* A; const bf16* B; unsigned char* ws; const unsigned* ctl;
    __device__ __forceinline__ bool next(int i, Unit& u) const { const int L = i * G + c; u.pm = L >> 3; u.pn = L & 7; int cnt, ps; return moe_find(ctl, layer, u.pm * 256, u.aux, cnt, ps); }
    __device__ __forceinline__ const char* a_ptr(const Unit& u) const { return (const char*)(A + (size_t)u.pm * 256 * lda); }
    __device__ __forceinline__ const char* b_ptr(const Unit& u) const { return (const char*)(B + (size_t)u.aux * (WD_E / 2) + (size_t)u.pn * 256 * ldb); }
    __device__ __forceinline__ bool epi(f32x4 (&acc)[2][2][4][2], const Unit& u, int wr, int wc, int fr, int fq) const {
        const int row0 = u.pm * 256 + wr * 64 + fr, ct = u.pn * 256 + wc * 32 + 8 * fq; bf16* O = (bf16*)(ws + WS_OSL) + ct;
#pragma unroll
        for (int ai = 0; ai < 2; ++ai)
#pragma unroll
            for (int m = 0; m < 4; ++m)
#pragma unroll
                for (int bj = 0; bj < 2; ++bj) { const f32x4 v0 = acc[ai][bj][m][0], v1 = acc[ai][bj][m][1];
                    u32x4 w; w.x = pg8::cvt_pk_bf16(v0[0], v0[1]); w.y = pg8::cvt_pk_bf16(v0[2], v0[3]); w.z = pg8::cvt_pk_bf16(v1[0], v1[1]); w.w = pg8::cvt_pk_bf16(v1[2], v1[3]);
                    *(u32x4*)(O + (size_t)(row0 + ai * 128 + m * 16) * DM + bj * 128) = w; }
        return false;
    }
};

#ifndef ATT_DBL
#define ATT_DBL 0
#endif
namespace att {
typedef short bf16x8 __attribute__((ext_vector_type(8)));
typedef short s16x4 __attribute__((ext_vector_type(4)));
typedef float f32x16 __attribute__((ext_vector_type(16)));
constexpr int TILE_B = 16384;
constexpr int L_V = 0, L_K = 3 * TILE_B, L_C2 = 6 * TILE_B, L_WS = L_C2 + 1024, L_ITEM = L_WS + 8 * 256, L_END = L_ITEM + 16;
#define KSWZ(row, colB) ((row) * 256 + ((colB) ^ (((row) & 7) << 4)))
#define SBAR() __builtin_amdgcn_sched_barrier(0)
__device__ __forceinline__ int v_st(int k, int c) { const int kk = (k & ~0xC) | ((k & 4) << 1) | ((k & 8) >> 1); return ((kk >> 3) * 4 + (c >> 5)) * 512 + ((kk & 7) * 32 + (c & 31)) * 2; }
__device__ __forceinline__ int v_rd_base(int lane) { return ((lane & 3) << 3) | (((lane >> 2) & 3) << 6) | (((lane >> 4) & 1) << 5) | (((lane >> 5) & 1) << 8); }
constexpr int v_rd_off(int d0, int ks, int half) { return d0 * 512 + ks * 4096 + half * 2048; }
__device__ __forceinline__ int crow(int r, int hi) { return (r & 3) + 8 * (r >> 2) + 4 * hi; }
__device__ __forceinline__ unsigned cvtpk(float lo, float hi) { unsigned r; asm volatile("v_cvt_pk_bf16_f32 %0, %1, %2" : "=v"(r) : "v"(lo), "v"(hi)); return r; }
__device__ __forceinline__ float xchg_sum(float v) { auto rr = __builtin_amdgcn_permlane32_swap(__float_as_uint(v), __float_as_uint(v), false, false); return __uint_as_float(rr[0]) + __uint_as_float(rr[1]); }
__device__ __forceinline__ float xchg_max(float v) { auto rr = __builtin_amdgcn_permlane32_swap(__float_as_uint(v), __float_as_uint(v), false, false); return fmaxf(__uint_as_float(rr[0]), __uint_as_float(rr[1])); }
#define PK4(P, B_, OUT) do { unsigned a0 = cvtpk(P[B_+0], P[B_+1]), a1 = cvtpk(P[B_+2], P[B_+3]); unsigned b0 = cvtpk(P[B_+4], P[B_+5]), b1 = cvtpk(P[B_+6], P[B_+7]); \
        auto r0 = __builtin_amdgcn_permlane32_swap(a0, b0, false, false); auto r1 = __builtin_amdgcn_permlane32_swap(a1, b1, false, false); \
        u32x4 w = {r0[0], r1[0], r0[1], r1[1]}; OUT = *reinterpret_cast<bf16x8*>(&w); } while (0)
__device__ __forceinline__ void qkt(f32x16& p0, f32x16& p1, const LAS unsigned char* kt, int r32, int hi, const bf16x8* qr) {
    p0 = f32x16{}; p1 = f32x16{};
    const LAS unsigned char* kb[4];
#pragma unroll
    for (int dd = 0; dd < 4; ++dd) kb[dd] = kt + KSWZ(r32, (dd * 16 + hi * 8) * 2);
#pragma unroll
    for (int d0 = 0; d0 < 8; ++d0) { const LAS unsigned char* a = kb[d0 & 3] + (d0 >> 2) * 128;
        const bf16x8 b0 = *(const LAS bf16x8*)(a); const bf16x8 b1 = *(const LAS bf16x8*)(a + 32 * 256);
        p0 = __builtin_amdgcn_mfma_f32_32x32x16_bf16(b0, qr[d0], p0, 0, 0, 0);
        p1 = __builtin_amdgcn_mfma_f32_32x32x16_bf16(b1, qr[d0], p1, 0, 0, 0); }
}
__device__ __forceinline__ void pv_tile(f32x16* o, unsigned vb0, bf16x8 pa0, bf16x8 pa1, bf16x8 pa2, bf16x8 pa3) {
#define TRRD(dst, off) asm volatile("ds_read_b64_tr_b16 %0, %1 offset:%2" : "=&v"(dst) : "v"(vb0), "i"(off) : "memory")
#define PV_D0(d0) do { s16x4 l0, l1, l2, l3, h0, h1, h2, h3; constexpr int b_ = v_rd_off(d0, 0, 0); \
        TRRD(l0, b_); TRRD(h0, b_ + 2048); TRRD(l1, b_ + 4096); TRRD(h1, b_ + 6144); TRRD(l2, b_ + 8192); TRRD(h2, b_ + 10240); TRRD(l3, b_ + 12288); TRRD(h3, b_ + 14336); \
        asm volatile("s_waitcnt lgkmcnt(0)" ::: "memory"); SBAR(); \
        o[d0] = __builtin_amdgcn_mfma_f32_32x32x16_bf16(pa0, (bf16x8){l0[0], l0[1], l0[2], l0[3], h0[0], h0[1], h0[2], h0[3]}, o[d0], 0, 0, 0); \
        o[d0] = __builtin_amdgcn_mfma_f32_32x32x16_bf16(pa1, (bf16x8){l1[0], l1[1], l1[2], l1[3], h1[0], h1[1], h1[2], h1[3]}, o[d0], 0, 0, 0); \
        o[d0] = __builtin_amdgcn_mfma_f32_32x32x16_bf16(pa2, (bf16x8){l2[0], l2[1], l2[2], l2[3], h2[0], h2[1], h2[2], h2[3]}, o[d0], 0, 0, 0); \
        o[d0] = __builtin_amdgcn_mfma_f32_32x32x16_bf16(pa3, (bf16x8){l3[0], l3[1], l3[2], l3[3], h3[0], h3[1], h3[2], h3[3]}, o[d0], 0, 0, 0); } while (0)
    PV_D0(0); PV_D0(1); PV_D0(2); PV_D0(3);
#undef PV_D0
#undef TRRD
}
#define VIS(cc) (((dqh) - (cc)) >= NEED && (cc) < (nvh))
__device__ __forceinline__ void sb_tile(f32x16& p0, f32x16& p1, float& carry, bool domask, int dqh, int nvh, int hi, bf16x8& pa0, bf16x8& pa1, bf16x8& pa2, bf16x8& pa3) {
    constexpr int NEED = 1;
    f32x16 x0, x1;
#pragma unroll
    for (int r = 0; r < 16; ++r) {
        { const float u = __builtin_amdgcn_fmed3f(p0[r], -126.f, 126.f), b = __builtin_amdgcn_logf(1.0f + __builtin_amdgcn_exp2f(-u)); x0[r] = -b; p0[r] = -u - b; }
        { const float u = __builtin_amdgcn_fmed3f(p1[r], -126.f, 126.f), b = __builtin_amdgcn_logf(1.0f + __builtin_amdgcn_exp2f(-u)); x1[r] = -b; p1[r] = -u - b; } }
    if (domask) { const float NEG = -__builtin_inff();
#pragma unroll
        for (int r = 0; r < 16; ++r) { const int cc = (r & 3) + 8 * (r >> 2);
            if (!VIS(cc)) { p0[r] = 0.f; x0[r] = NEG; }
            if (!VIS(cc + 32)) { p1[r] = 0.f; x1[r] = NEG; } } }
    float A[9]; A[8] = 0.f;
#pragma unroll
    for (int g = 3; g >= 0; --g) A[4 + g] = A[5 + g] + ((p1[4 * g] + p1[4 * g + 1]) + (p1[4 * g + 2] + p1[4 * g + 3]));
#pragma unroll
    for (int g = 3; g >= 0; --g) A[g] = A[1 + g] + ((p0[4 * g] + p0[4 * g + 1]) + (p0[4 * g + 2] + p0[4 * g + 3]));
    float off[8];
#pragma unroll
    for (int i = 0; i < 8; ++i) { auto rr = __builtin_amdgcn_permlane32_swap(__float_as_uint(A[i]), __float_as_uint(A[i + 1]), false, false);
        const float recv = hi ? __uint_as_float(rr[0]) : __uint_as_float(rr[1]); off[i] = carry + A[i + 1] + recv; }
    carry += xchg_sum(A[0]);
#pragma unroll
    for (int g = 0; g < 4; ++g) {
        { float af = off[g]; const float l3 = p0[4 * g + 3], l2 = p0[4 * g + 2], l1 = p0[4 * g + 1];
          x0[4 * g + 3] = __builtin_amdgcn_exp2f(x0[4 * g + 3] + af); af += l3; x0[4 * g + 2] = __builtin_amdgcn_exp2f(x0[4 * g + 2] + af); af += l2;
          x0[4 * g + 1] = __builtin_amdgcn_exp2f(x0[4 * g + 1] + af); af += l1; x0[4 * g] = __builtin_amdgcn_exp2f(x0[4 * g] + af); }
        { float af = off[4 + g]; const float l3 = p1[4 * g + 3], l2 = p1[4 * g + 2], l1 = p1[4 * g + 1];
          x1[4 * g + 3] = __builtin_amdgcn_exp2f(x1[4 * g + 3] + af); af += l3; x1[4 * g + 2] = __builtin_amdgcn_exp2f(x1[4 * g + 2] + af); af += l2;
          x1[4 * g + 1] = __builtin_amdgcn_exp2f(x1[4 * g + 1] + af); af += l1; x1[4 * g] = __builtin_amdgcn_exp2f(x1[4 * g] + af); } }
    PK4(x0, 0, pa0); PK4(x0, 8, pa1); PK4(x1, 0, pa2); PK4(x1, 8, pa3);
}
__device__ __forceinline__ float fox_tile(f32x16& p0, f32x16& p1, const LAS float* c2t, float& m_reg, float& l_reg, bool domask, int dqh, int nvh, int hi, bf16x8& pa0, bf16x8& pa1, bf16x8& pa2, bf16x8& pa3) {
    constexpr int NEED = 0;
#pragma unroll
    for (int g = 0; g < 4; ++g) { const f32x4 c0 = *(const LAS f32x4*)(c2t + 8 * g + 4 * hi), c1 = *(const LAS f32x4*)(c2t + 32 + 8 * g + 4 * hi);
#pragma unroll
        for (int j = 0; j < 4; ++j) { p0[4 * g + j] -= c0[j]; p1[4 * g + j] -= c1[j]; } }
    if (domask) { const float NEG = -__builtin_inff();
#pragma unroll
        for (int r = 0; r < 16; ++r) { const int cc = (r & 3) + 8 * (r >> 2);
            if (!VIS(cc)) p0[r] = NEG;
            if (!VIS(cc + 32)) p1[r] = NEG; } }
    float pmax = p0[0];
#pragma unroll
    for (int r = 1; r < 16; ++r) pmax = fmaxf(pmax, p0[r]);
#pragma unroll
    for (int r = 0; r < 16; ++r) pmax = fmaxf(pmax, p1[r]);
    pmax = xchg_max(pmax);
    const float mn = fmaxf(m_reg, pmax), alpha = __builtin_amdgcn_exp2f(m_reg - mn); m_reg = mn;
    float ps = 0.f;
#pragma unroll
    for (int r = 0; r < 16; ++r) { p0[r] = __builtin_amdgcn_exp2f(p0[r] - mn); p1[r] = __builtin_amdgcn_exp2f(p1[r] - mn); ps += p0[r] + p1[r]; }
    l_reg = l_reg * alpha + xchg_sum(ps);
    PK4(p0, 0, pa0); PK4(p0, 8, pa1); PK4(p1, 0, pa2); PK4(p1, 8, pa3);
    return alpha;
}
#undef VIS
template <int TYPE>
__device__ __forceinline__ void attn_unit(LAS unsigned char* lds, unsigned char* ws, int head, int qb) {
    const int tid = threadIdx.x, wid = __builtin_amdgcn_readfirstlane(tid >> 6), lane = tid & 63, r32 = lane & 31, hi = lane >> 5;
    const bool grpY = wid >= 4;
    const bf16* QKV = (const bf16*)(ws + WS_QKV);
    const int qcol = (TYPE ? 3072 : 0) + head * HD, kcol = qcol + 1024, vcol = qcol + 2048;
    const float* cum = (const float*)(ws + WS_CUM) + (size_t)head * MROWS;
    const int qrow0 = qb * 256, NT = qb < 32 ? 4 * qb + 5 : 1;
    const int qbase = qb < 32 ? qrow0 : -NMETA;
    const int qlo = qbase + wid * 32, qpos = qlo + r32;
    LAS unsigned char* V_lds = lds + L_V; LAS unsigned char* K_lds = lds + L_K; LAS float* c2_lds = (LAS float*)(lds + L_C2);
    LAS float* wsl = (LAS float*)(lds + L_WS) + wid * 64;
    bf16x8 qr[8];
#pragma unroll
    for (int d0 = 0; d0 < 8; ++d0) qr[d0] = *(const bf16x8*)(QKV + (size_t)(qrow0 + wid * 32 + r32) * QKV_N + qcol + d0 * 16 + hi * 8);
    const int sr = tid >> 4, sc = (tid & 15) * 8, vst0 = v_st(sr, sc), vst1 = v_st(32 + sr, sc), kws = KSWZ(sr, sc * 2);
    const unsigned vrd = (unsigned)(size_t)V_lds + (unsigned)v_rd_base(lane);
    bf16x8 st_k0, st_k1, st_v0, st_v1; float st_c = 0.f;
#define TISMETA(t) ((t) == NT - 1)
#define SLOAD(t) do { const int row_ = TISMETA(t) ? SEQ : 64 * (4 * qb + 3 - (t)); const bf16* kp_ = QKV + (size_t)(row_ + sr) * QKV_N + sc; \
        st_k0 = *(const bf16x8*)(kp_ + kcol); st_k1 = *(const bf16x8*)(kp_ + (size_t)32 * QKV_N + kcol); st_v0 = *(const bf16x8*)(kp_ + vcol); st_v1 = *(const bf16x8*)(kp_ + (size_t)32 * QKV_N + vcol); \
        if (TYPE == 1 && tid < 64) st_c = TISMETA(t) ? (tid < NMETA ? cum[tid] : 0.f) : cum[NMETA + row_ + tid]; } while (0)
#define SWRITE(bo) do { *(LAS bf16x8*)(K_lds + (bo) + kws) = st_k0; *(LAS bf16x8*)(K_lds + (bo) + kws + 32 * 256) = st_k1; \
        *(LAS bf16x8*)(V_lds + (bo) + vst0) = st_v0; *(LAS bf16x8*)(V_lds + (bo) + vst1) = st_v1; if (TYPE == 1 && tid < 64) c2_lds[((bo) >> 8) + tid] = st_c; } while (0)
#define BAR() asm volatile("s_waitcnt lgkmcnt(0)\n\ts_barrier" ::: "memory")
    SLOAD(0); SWRITE(0);
    if (NT > 1) { SLOAD(1); SWRITE(TILE_B); }
    __builtin_amdgcn_s_waitcnt(0x0F70);
    if (NT > 2) SLOAD(2);
    BAR();
    if (grpY) BAR();
    f32x16 o[4] = {}; float carry = 0.f, m_reg = -1e30f, l_reg = 0.f;
    constexpr int NEEDW = TYPE == 0 ? 1 : 0;
#define KBASE(t) (TISMETA(t) ? -NMETA : 64 * (4 * qb + 3 - (t)))
#define ACTW(t) ((qlo + 31 - KBASE(t)) >= NEEDW && (qb < 32 || wid == 0))
    f32x16 p0, p1;
    if (ACTW(0)) qkt(p0, p1, K_lds, r32, hi, qr);
    int bo = 0, bo1 = TILE_B, bo2 = 2 * TILE_B;
    for (int t = 0; t < NT; ++t) {
        BAR();
        const int kbase = KBASE(t), nvalid = TISMETA(t) ? NMETA : 64;
        const bool actw = ACTW(t);
        const bool domask = (qlo - (kbase + 63) < NEEDW) || nvalid < 64;
        bf16x8 pa0, pa1, pa2, pa3;
        if (actw) {
            const int dqh = qpos - kbase - 4 * hi, nvh = nvalid - 4 * hi;
            if (TYPE == 0) sb_tile(p0, p1, carry, domask, dqh, nvh, hi, pa0, pa1, pa2, pa3);
            else { const float alpha = fox_tile(p0, p1, c2_lds + (bo >> 8), m_reg, l_reg, domask, dqh, nvh, hi, pa0, pa1, pa2, pa3);
                if (__any(alpha < 1.f)) { if (hi == 0) wsl[r32] = alpha; asm volatile("s_waitcnt lgkmcnt(0)" ::: "memory");
#pragma unroll
                    for (int r = 0; r < 16; ++r) { const float al = wsl[crow(r, hi)];
#pragma unroll
                        for (int d = 0; d < 4; ++d) o[d][r] *= al; } } }
        }
        BAR();
        if (t + 2 < NT) SWRITE(bo2);
        if (t + 3 < NT) SLOAD(t + 3);
        if (actw) pv_tile(o, vrd + bo, pa0, pa1, pa2, pa3);
        if (t + 1 < NT) { if (ACTW(t + 1)) qkt(p0, p1, K_lds + bo1, r32, hi, qr); }
        { const int tmp = bo; bo = bo1; bo1 = bo2; bo2 = tmp; }
    }
    if (!grpY) BAR();
    float rli[16];
    if (TYPE == 1) { if (hi == 0) wsl[32 + r32] = l_reg; asm volatile("s_waitcnt lgkmcnt(0)" ::: "memory");
#pragma unroll
        for (int r = 0; r < 16; ++r) rli[r] = __builtin_amdgcn_rcpf(wsl[32 + crow(r, hi)]); }
    bf16* Yw = (bf16*)(ws + WS_YB) + (size_t)(qrow0 + wid * 32) * DM + TYPE * 1024 + head * HD;
    if (qb < 32 || wid == 0)
#pragma unroll
    for (int r = 0; r < 16; ++r) { const int orow = crow(r, hi);
#pragma unroll
        for (int d0 = 0; d0 < 4; ++d0) { const float v = TYPE == 1 ? o[d0][r] * rli[r] : o[d0][r]; const float vn = __shfl_xor(v, 1);
            if ((r32 & 1) == 0) *(unsigned*)(Yw + (size_t)orow * DM + d0 * 32 + r32) = cvtpk(v, vn); } }
#undef TISMETA
#undef SLOAD
#undef SWRITE
#undef BAR
#undef KBASE
#undef ACTW
}
constexpr int CW_ATTNQ = 3072;
__device__ __forceinline__ void attn_phase(LAS unsigned char* lds, unsigned char* ws, unsigned* ctl, int layer, int G, int qoff) {
    const int NI = 512 + (layer == 0 ? 16 : 0);
    LAS int* itemw = (LAS int*)(lds + L_ITEM);
    int it = blockIdx.x;
    while (it < NI) {
        int qb, th; if (it < 512) { qb = 31 - (it >> 4); th = it & 15; } else { qb = 32; th = it - 512; }
        if (th < 8) attn_unit<0>(lds, ws, th, qb); else attn_unit<1>(lds, ws, th - 8, qb);
        __syncthreads();
        if (threadIdx.x == 0) *itemw = G + (int)atomicAdd(ctl + CW_ATTNQ + layer * 64 + qoff, 1u);
        asm volatile("s_waitcnt lgkmcnt(0)" ::: "memory"); __syncthreads();
        it = __builtin_amdgcn_readfirstlane(*itemw);
    }
}
#undef KSWZ
#undef SBAR
#undef PK4
}

__global__ void __launch_bounds__(NTHREADS, 2) mk_fwd(Args args) {
    extern __shared__ __attribute__((aligned(16))) unsigned char lds_raw[];
    Frame F;
    F.lds = (LAS unsigned char*)lds_raw; F.ws = args.ws; F.ctl = (unsigned*)(args.ws + WS_CTL);
    F.tid = threadIdx.x; F.lane = F.tid & 63; F.wave = __builtin_amdgcn_readfirstlane(F.tid >> 6);
    F.G = gridDim.x; F.gw = blockIdx.x * NWAVES + F.wave; F.NGW = F.G * NWAVES;
#pragma unroll
    for (int i = 0; i < 18; ++i) F.in[i] = args.in[i];
    F.out = args.out;
    volatile LAS unsigned* MISC = (volatile LAS unsigned*)(F.lds + MISC_OFF);
    for (int u = F.tid; u < (LDS_BYTES - RING_BYTES) / 4; u += NTHREADS) ((LAS unsigned*)(F.lds + RING_BYTES))[u] = 0u;
    __syncthreads();
    XcdBarrier bar = xcd_barrier_post(F.ctl + CW_BAR + args.li * XCD_BAR_WORDS, MISC + 8);
    const int lo = args.ph_lo, hi = args.ph_hi; const unsigned naive = args.naive;
#define IN(k) (lo <= (k) && (k) < hi)
#define SEAM(k) do { if (IN(k) && IN((k) + 1)) { xcd_barrier(bar); if ((DBL_MASK >> 9) & 1u) xcd_barrier(bar); } } while (0)
#define NAIVE(t) ((naive >> (t)) & 1u)
    if (IN(0)) { phase_prologue(F); SEAM(0); }
#define LAYER_PHASES(l, pb) do { \
        if (IN(pb + PH_A)) { phase_cumsum(F); \
            if (!NAIVE(PH_A)) { skinny16(F.lds, (const bf16*)(F.ws + WS_HB) + (size_t)SEQ * DM, DM, (const bf16*)(F.ws + WS_WIN + l * WIN_L), DM, DM, INP_N, SkinnyInProj{F.ws}); \
              ProbInProj P{DM, DM, DM, F.G, (int)blockIdx.x, (const bf16*)(F.ws + WS_HB), (const bf16*)(F.ws + WS_WIN + l * WIN_L), F.ws}; pg8::gemm_phase(F.lds, P); if ((DBL_MASK >> PH_A) & 1u) pg8::gemm_phase(F.lds, P); } \
            SEAM(pb + PH_A); } \
        if (IN(pb + PH_B)) { \
            if (!NAIVE(PH_B)) { att::attn_phase(F.lds, F.ws, F.ctl, l, F.G, 0); if ((DBL_MASK >> PH_B) & 1u) att::attn_phase(F.lds, F.ws, F.ctl, l, F.G, 32); } \
            SEAM(pb + PH_B); } \
        if (IN(pb + PH_C)) { \
            if (!NAIVE(PH_C)) { if (l == 0) skinny16(F.lds, (const bf16*)(F.ws + WS_YB) + (size_t)SEQ * DM, DM, (const bf16*)(F.ws + WS_WB + l * WB_L), DM, DM, DM, SkinnyBranch{F.ws}); \
              ProbBranch P{1024, DM, DM, F.G, (int)blockIdx.x, (const bf16*)(F.ws + WS_YB), (const bf16*)(F.ws + WS_WB + l * WB_L), F.ws}; pg8::gemm_phase(F.lds, P); if ((DBL_MASK >> PH_C) & 1u) pg8::gemm_phase(F.lds, P); } \
            SEAM(pb + PH_C); } \
        if (IN(pb + PH_D)) { \
            if (!NAIVE(PH_D)) { if (l == 0) skinny16(F.lds, (const bf16*)(F.ws + WS_MG) + (size_t)SEQ * DM, DM, (const bf16*)(F.ws + WS_WOUT + l * WOUT_L), DM, DM, DM, SkinnyOut{F.ws}); \
              ProbOutProj P{DM, DM, DM, F.G, (int)blockIdx.x, (const bf16*)(F.ws + WS_MG), (const bf16*)(F.ws + WS_WOUT + l * WOUT_L), F.ws}; pg8::gemm_phase(F.lds, P); if ((DBL_MASK >> PH_D) & 1u) pg8::gemm_phase(F.lds, P); } \
            SEAM(pb + PH_D); } \
        if (IN(pb + PH_E)) { if ((DBL_MASK >> PH_E) & 1u) phase_ln_router(F, l, true); phase_ln_router(F, l); SEAM(pb + PH_E); } \
        if (IN(pb + PH_F)) { \
            if (!NAIVE(PH_F)) { ProbMoeGU P{DM, DM, DM, F.G, (int)blockIdx.x, l, (const bf16*)(F.ws + WS_HB), (const bf16*)(F.ws + WS_WGU + l * WGU_L), F.ws, F.ctl, F.lds}; P.fill_idx(F.tid); pg8::gemm_phase(F.lds, P); if ((DBL_MASK >> PH_F) & 1u) pg8::gemm_phase(F.lds, P); } \
            SEAM(pb + PH_F); } \
        if (IN(pb + PH_G)) { \
            if (!NAIVE(PH_G)) { ProbMoeDown P{FF, FF, FF, F.G, (int)blockIdx.x, l, (const bf16*)(F.ws + WS_ACT), (const bf16*)(F.ws + WS_WD + l * WD_L), F.ws, F.ctl}; pg8::gemm_phase(F.lds, P); if ((DBL_MASK >> PH_G) & 1u) pg8::gemm_phase(F.lds, P); } \
            SEAM(pb + PH_G); } \
        if (IN(pb + PH_H)) { if ((DBL_MASK >> PH_H) & 1u) phase_ln_final(F, l, true); phase_ln_final(F, l); SEAM(pb + PH_H); } \
    } while (0)
    LAYER_PHASES(0, 1);
    LAYER_PHASES(1, 9);
#undef LAYER_PHASES
#undef IN
#undef SEAM
#undef NAIVE
}

#ifndef NAIVE_MASK
#define NAIVE_MASK 0x00u
#endif
static void launch_naive(int type, int layer, const Args& a, hipStream_t stream) {
    switch (type) {
    case PH_A: hipLaunchKernelGGL(naive_inproj, dim3(INP_N / 256, MROWS / 4), dim3(256), 0, stream, a, layer); break;
    case PH_B: { const int nq = NTOK; hipLaunchKernelGGL(naive_attn, dim3((16 * nq + 3) / 4), dim3(256), 0, stream, a, nq); } break;
    case PH_C: hipLaunchKernelGGL(naive_branch, dim3(DM / 256, MROWS / 4), dim3(256), 0, stream, a, layer); break;
    case PH_D: hipLaunchKernelGGL(naive_outproj, dim3(DM / 256, MROWS / 4), dim3(256), 0, stream, a, layer); break;
    case PH_F: hipLaunchKernelGGL(naive_moe_gu, dim3(FF / 256, NSLOT_MAX / 4), dim3(256), 0, stream, a, layer); break;
    case PH_G: hipLaunchKernelGGL(naive_moe_down, dim3(DM / 256, NSLOT_MAX / 4), dim3(256), 0, stream, a, layer); break;
    default: break;
    }
}
extern "C" void kernel_launch(void* const* d_in, const int* in_sizes, int n_in, void* d_out, int out_size, void* d_ws, size_t ws_size, hipStream_t stream) {
    static int grid = 0;
    if (grid == 0) {
        if (n_in != 18 || out_size != SEQ * DM || ws_size < WS_END) { fprintf(stderr, "kernel_launch: unexpected shapes (n_in %d out %d ws %zu)\n", n_in, out_size, ws_size); grid = -1; return; }
        int dev = 0, cus = 0;
        if (hipGetDevice(&dev) != hipSuccess || hipDeviceGetAttribute(&cus, hipDeviceAttributeMultiprocessorCount, dev) != hipSuccess) { grid = -1; return; }
        if (hipFuncSetAttribute((const void*)mk_fwd, hipFuncAttributeMaxDynamicSharedMemorySize, LDS_BYTES) != hipSuccess) { fprintf(stderr, "kernel_launch: hipFuncSetAttribute failed\n"); grid = -1; return; }
        int per_cu = 0;
        if (hipOccupancyMaxActiveBlocksPerMultiprocessor(&per_cu, (const void*)mk_fwd, NTHREADS, LDS_BYTES) != hipSuccess || per_cu < 1) fprintf(stderr, "kernel_launch: occupancy query says %d\n", per_cu);
        (void)hipGetLastError();
        grid = cus;
    }
    if (grid < 0) return;
    (void)hipMemsetAsync((char*)d_ws + WS_CTL, 0, CTL_ZERO_BYTES, stream);
    Args a{};
    for (int i = 0; i < 18; ++i) a.in[i] = (const float*)d_in[i];
    a.out = (float*)d_out; a.ws = (unsigned char*)d_ws; a.naive = NAIVE_MASK;
    int li = 0, lo = 0;
    auto flush = [&](int hi) { if (hi > lo) { a.ph_lo = lo; a.ph_hi = hi; a.li = li++; hipLaunchKernelGGL(mk_fwd, dim3(grid), dim3(NTHREADS), LDS_BYTES, stream, a); } lo = hi; };
    for (int ph = 1; ph < NPHASE; ++ph) {
        const int type = (ph - 1) & 7, layer = (ph - 1) >> 3;
        if ((NAIVE_MASK >> type) & 1u) {
            if (type == PH_A) flush(ph + 1); else { flush(ph); lo = ph + 1; }
            launch_naive(type, layer, a, stream); }
    }
    flush(NPHASE);
}
```

```cpp
#include <hip/hip_runtime.h>
#include <cstdio>
#include <cstdint>

#define GAS __attribute__((address_space(1)))
#define LAS __attribute__((address_space(3)))
typedef unsigned short bf16;
typedef float f32x4 __attribute__((ext_vector_type(4)));
typedef float f32x2 __attribute__((ext_vector_type(2)));
typedef unsigned u32x4 __attribute__((ext_vector_type(4)));
typedef unsigned u32x2 __attribute__((ext_vector_type(2)));
typedef GAS unsigned gu32;

constexpr int DM = 2048, SEQ = 8192, NMETA = 16, NTOK = SEQ + NMETA, MROWS = 8448;
constexpr int HD = 128, NHEAD = 8;
constexpr int QKV_N = 6144, G_N = 4096, INP_N = 10240, INP_SRC = 10248, FCOL = 6144;
constexpr int NE = 16, FF = 1024, NSLOT_MAX = 20480;
constexpr float ALPHA = 1.4142135623730951f, LN_EPS = 1e-5f;
constexpr float LOG2E = 1.4426950408889634f;
constexpr float QSCALE = 0.08838834764831845f * 1.4426950408889634f;
constexpr int NLAYER = 2, NPHASE = 1 + 8 * NLAYER;
enum { PH_A = 0, PH_B = 1, PH_C = 2, PH_D = 3, PH_E = 4, PH_F = 5, PH_G = 6, PH_H = 7 };

#ifndef DBL_MASK
#define DBL_MASK 0u
#endif
constexpr size_t MiB = 1u << 20;
constexpr size_t WS_CTL = 0, CTL_ZERO_BYTES = 1 * MiB;
constexpr size_t WS_WIN = 2 * MiB, WIN_L = 40 * MiB;
constexpr size_t WS_WB = 82 * MiB, WB_L = 8 * MiB;
constexpr size_t WS_WOUT = 98 * MiB, WOUT_L = 8 * MiB;
constexpr size_t WS_WGU = 114 * MiB, WGU_L = 128 * MiB, WGU_E = 8 * MiB;
constexpr size_t WS_WD = 370 * MiB, WD_L = 64 * MiB, WD_E = 4 * MiB;
constexpr size_t WS_HF = 498 * MiB;
constexpr size_t WS_HB = 564 * MiB;
constexpr size_t WS_RB = 597 * MiB;
constexpr size_t WS_QKV = 663 * MiB;
constexpr size_t WS_GB = 762 * MiB;
constexpr size_t WS_YB = 828 * MiB;
constexpr size_t WS_MG = 861 * MiB;
constexpr size_t WS_ACT = 663 * MiB;
constexpr size_t WS_OSL = 703 * MiB;
constexpr size_t WS_LOGF = 894 * MiB;
constexpr size_t WS_CUM = 895 * MiB;
constexpr size_t WS_ELIST = 896 * MiB;
constexpr size_t WS_TOKI = 897 * MiB;
constexpr size_t WS_H8 = 898 * MiB;
constexpr size_t WS_END = 916 * MiB;
constexpr int CW_CNT = 1024;
constexpr int CW_BAR = 8192;
#define XCD_BAR_WORDS 3456
constexpr int MAX_LAUNCH = 20;
static_assert((CW_BAR + MAX_LAUNCH * XCD_BAR_WORDS) * 4 <= (int)CTL_ZERO_BYTES, "ctl");

constexpr int NWAVES = 8, NTHREADS = 512;
constexpr int RING_BYTES = 131072, MISC_OFF = RING_BYTES + 320, LDS_BYTES = 147456;

constexpr float W8_SCALE = 64.f, H8_SCALE = 4.f, MG8_SCALE = 16.f, ACT8_SCALE = 4.f;
constexpr int SC_W = 0x79797979, SC_H = 0x7D7D7D7D, SC_MG = 0x7B7B7B7B, SC_ACT = 0x7D7D7D7D;
__device__ __forceinline__ unsigned f2bf(float f) { unsigned u = __builtin_bit_cast(unsigned, f); return (u + 0x7fffu + ((u >> 16) & 1u)) >> 16; }
__device__ __forceinline__ unsigned pk2(float lo, float hi) { return f2bf(lo) | (f2bf(hi) << 16); }
__device__ __forceinline__ unsigned pk4_fp8(float a, float b, float c, float d) {
    a = __builtin_amdgcn_fmed3f(a, -448.f, 448.f); b = __builtin_amdgcn_fmed3f(b, -448.f, 448.f); c = __builtin_amdgcn_fmed3f(c, -448.f, 448.f); d = __builtin_amdgcn_fmed3f(d, -448.f, 448.f);
    int w = 0; w = __builtin_amdgcn_cvt_pk_fp8_f32(a, b, w, false); w = __builtin_amdgcn_cvt_pk_fp8_f32(c, d, w, true); return (unsigned)w; }
__device__ __forceinline__ float bflo(unsigned w) { return __builtin_bit_cast(float, w << 16); }
__device__ __forceinline__ float bfhi(unsigned w) { return __builtin_bit_cast(float, w & 0xffff0000u); }
__device__ __forceinline__ float bf2f(bf16 b) { return __builtin_bit_cast(float, ((unsigned)b) << 16); }
__device__ __forceinline__ float wave_sum(float v) {
#pragma unroll
    for (int o = 1; o < 64; o <<= 1) v += __shfl_xor(v, o);
    return v;
}
__device__ __forceinline__ float wave_max(float v) {
#pragma unroll
    for (int o = 1; o < 64; o <<= 1) v = fmaxf(v, __shfl_xor(v, o));
    return v;
}
__device__ __forceinline__ int row_of_p(int p) { return p < NMETA ? SEQ + p : p - NMETA; }
__device__ __forceinline__ float sigmoidf_(float x) { return 1.0f / (1.0f + __expf(-x)); }
__device__ __forceinline__ float dot8(u32x4 a, u32x4 b, float acc) {
    acc = fmaf(bflo(a.x), bflo(b.x), acc); acc = fmaf(bfhi(a.x), bfhi(b.x), acc);
    acc = fmaf(bflo(a.y), bflo(b.y), acc); acc = fmaf(bfhi(a.y), bfhi(b.y), acc);
    acc = fmaf(bflo(a.z), bflo(b.z), acc); acc = fmaf(bfhi(a.z), bfhi(b.z), acc);
    acc = fmaf(bflo(a.w), bflo(b.w), acc); acc = fmaf(bfhi(a.w), bfhi(b.w), acc);
    return acc;
}

struct Args { const float* in[18]; float* out; unsigned char* ws; int ph_lo, ph_hi; unsigned naive; int li; };
enum { I_X = 0, I_META, I_LNIN_G, I_LNIN_B, I_WIN, I_BF, I_WBSB, I_WBFX, I_WOUT, I_LNMIX_G, I_LNMIX_B, I_WR, I_RB, I_WG, I_WU, I_WD, I_LNFFN_G, I_LNFFN_B };

__device__ __forceinline__ int moe_cnt(const unsigned* ctl, int layer, int e) { return (int)ctl[CW_CNT + (layer * NE + e) * 64]; }
__device__ __forceinline__ bool moe_find(const unsigned* ctl, int layer, int s0, int& e_out, int& cnt_out, int& ps_out) {
    int acc = 0; e_out = -1; cnt_out = 0; ps_out = 0;
#pragma unroll
    for (int e = 0; e < NE; ++e) { const int c = moe_cnt(ctl, layer, e), nb = (c + 255) >> 8;
        if (e_out < 0 && s0 < (acc + nb) * 256) { e_out = e; cnt_out = c; ps_out = acc * 256; }
        acc += nb; }
    return e_out >= 0;
}
__device__ __forceinline__ int moe_pstart(const unsigned* ctl, int layer, int ex) {
    int acc = 0, r = 0;
#pragma unroll
    for (int e = 0; e < NE; ++e) { const int c = moe_cnt(ctl, layer, e); if (e == ex) r = acc * 256; acc += (c + 255) >> 8; }
    return r;
}

__device__ __forceinline__ void inproj_store(unsigned char* ws, int row, int n, float v) {
    if (n < QKV_N) { const bool isq = (n < 1024) || (n >= 3072 && n < 4096); ((bf16*)(ws + WS_QKV))[(size_t)row * QKV_N + n] = (bf16)f2bf(isq ? v * QSCALE : v); }
    else ((bf16*)(ws + WS_GB))[(size_t)row * G_N + (n - QKV_N)] = (bf16)f2bf(sigmoidf_(v));
}

__device__ __forceinline__ void dot4(const bf16* a0, const bf16* a1, const bf16* a2, const bf16* a3, const bf16* b, int K, float (&acc)[4]) {
    for (int k = 0; k < K; k += 8) {
        const u32x4 bv = *(const u32x4*)(b + k);
        acc[0] = dot8(*(const u32x4*)(a0 + k), bv, acc[0]); acc[1] = dot8(*(const u32x4*)(a1 + k), bv, acc[1]);
        acc[2] = dot8(*(const u32x4*)(a2 + k), bv, acc[2]); acc[3] = dot8(*(const u32x4*)(a3 + k), bv, acc[3]);
    }
}
__global__ void __launch_bounds__(256) naive_inproj(Args a, int layer) {
    const int n = blockIdx.x * 256 + threadIdx.x, r0 = blockIdx.y * 4;
    const bf16* A = (const bf16*)(a.ws + WS_HB) + (size_t)r0 * DM; const bf16* B = (const bf16*)(a.ws + WS_WIN + layer * WIN_L) + (size_t)n * DM;
    float acc[4] = {0.f, 0.f, 0.f, 0.f};
    dot4(A, A + DM, A + 2 * DM, A + 3 * DM, B, DM, acc);
    for (int i = 0; i < 4; ++i) inproj_store(a.ws, r0 + i, n, acc[i]);
}
__global__ void __launch_bounds__(256) naive_branch(Args a, int layer) {
    const int n = blockIdx.x * 256 + threadIdx.x, r0 = blockIdx.y * 4;
    const bf16* A = (const bf16*)(a.ws + WS_YB) + (size_t)r0 * DM; const bf16* B = (const bf16*)(a.ws + WS_WB + layer * WB_L) + (size_t)n * DM;
    float s[4] = {0.f, 0.f, 0.f, 0.f}, f[4] = {0.f, 0.f, 0.f, 0.f};
    dot4(A, A + DM, A + 2 * DM, A + 3 * DM, B, 1024, s);
    dot4(A + 1024, A + DM + 1024, A + 2 * DM + 1024, A + 3 * DM + 1024, B + 1024, 1024, f);
    const bf16* G = (const bf16*)(a.ws + WS_GB);
    for (int i = 0; i < 4; ++i) { const size_t r = r0 + i; const float gs = bf2f(G[r * G_N + n]), gf = bf2f(G[r * G_N + DM + n]);
        ((bf16*)(a.ws + WS_MG))[r * DM + n] = (bf16)f2bf(gs * s[i] + gf * f[i]); }
}
__global__ void __launch_bounds__(256) naive_outproj(Args a, int layer) {
    const int n = blockIdx.x * 256 + threadIdx.x, r0 = blockIdx.y * 4;
    const bf16* A = (const bf16*)(a.ws + WS_MG) + (size_t)r0 * DM; const bf16* B = (const bf16*)(a.ws + WS_WOUT + layer * WOUT_L) + (size_t)n * DM;
    float acc[4] = {0.f, 0.f, 0.f, 0.f};
    dot4(A, A + DM, A + 2 * DM, A + 3 * DM, B, DM, acc);
    const float* HF = (const float*)(a.ws + WS_HF); float* R = (float*)(a.ws + WS_RB);
    for (int i = 0; i < 4; ++i) { const size_t o = (size_t)(r0 + i) * DM + n; R[o] = ALPHA * HF[o] + acc[i]; }
}
__global__ void __launch_bounds__(256) naive_moe_gu(Args a, int layer) {
    const int j = blockIdx.x * 256 + threadIdx.x, s0 = blockIdx.y * 4;
    int e, cnt, ps; if (!moe_find((const unsigned*)(a.ws + WS_CTL), layer, s0, e, cnt, ps)) return;
    const int* elist = (const int*)(a.ws + WS_ELIST) + (size_t)e * MROWS;
    const bf16* HB = (const bf16*)(a.ws + WS_HB);
    const int rank = s0 - ps;
    const bf16* ap0 = HB + (size_t)(rank + 0 < cnt ? elist[rank + 0] : 0) * DM; const bf16* ap1 = HB + (size_t)(rank + 1 < cnt ? elist[rank + 1] : 0) * DM;
    const bf16* ap2 = HB + (size_t)(rank + 2 < cnt ? elist[rank + 2] : 0) * DM; const bf16* ap3 = HB + (size_t)(rank + 3 < cnt ? elist[rank + 3] : 0) * DM;
    const bf16* W = (const bf16*)(a.ws + WS_WGU + layer * WGU_L + e * WGU_E);
    const int rg = 256 * (j >> 7) + (j & 127);
    float g[4] = {0.f, 0.f, 0.f, 0.f}, u[4] = {0.f, 0.f, 0.f, 0.f};
    dot4(ap0, ap1, ap2, ap3, W + (size_t)rg * DM, DM, g);
    dot4(ap0, ap1, ap2, ap3, W + (size_t)(rg + 128) * DM, DM, u);
    bf16* act = (bf16*)(a.ws + WS_ACT);
#pragma unroll
    for (int i = 0; i < 4; ++i) act[(size_t)(s0 + i) * FF + j] = (bf16)f2bf(g[i] * sigmoidf_(g[i]) * u[i]);
}
__global__ void __launch_bounds__(256) naive_moe_down(Args a, int layer) {
    const int n = blockIdx.x * 256 + threadIdx.x, s0 = blockIdx.y * 4;
    int e, cnt, ps; if (!moe_find((const unsigned*)(a.ws + WS_CTL), layer, s0, e, cnt, ps)) return;
    const bf16* A = (const bf16*)(a.ws + WS_ACT) + (size_t)s0 * FF; const bf16* B = (const bf16*)(a.ws + WS_WD + layer * WD_L + e * WD_E) + (size_t)n * FF;
    float acc[4] = {0.f, 0.f, 0.f, 0.f};
    dot4(A, A + FF, A + 2 * FF, A + 3 * FF, B, FF, acc);
    bf16* O = (bf16*)(a.ws + WS_OSL);
#pragma unroll
    for (int i = 0; i < 4; ++i) O[(size_t)(s0 + i) * DM + n] = (bf16)f2bf(acc[i]);
}
__global__ void __launch_bounds__(256) naive_attn(Args a, int nq) {
    const int lane = threadIdx.x & 63, widx = blockIdx.x * 4 + (threadIdx.x >> 6);
    const int th = widx / nq, pq = nq - 1 - (widx % nq);
    if (th >= 16) return;
    const int type = th >> 3, head = th & 7;
    const bf16* QKV = (const bf16*)(a.ws + WS_QKV);
    const int qcol = (type ? 3072 : 0) + head * HD, kcol = qcol + 1024, vcol = qcol + 2048;
    const int rowq = row_of_p(pq);
    u32x4 q[16];
#pragma unroll
    for (int i = 0; i < 16; ++i) q[i] = *(const u32x4*)(QKV + (size_t)rowq * QKV_N + qcol + 8 * i);
    const float* cum = (const float*)(a.ws + WS_CUM) + (size_t)head * MROWS;
    float o0 = 0.f, o1 = 0.f, carry = 0.f, m = -1e30f, l = 0.f;
    const float cq = type ? cum[pq] : 0.f;
    for (int phi = type ? pq : pq - 1; phi >= 0; phi -= 64) {
        const int p = phi - lane; const bool valid = p >= 0; const int pr = row_of_p(valid ? p : 0);
        float u = 0.f;
        const bf16* kp = QKV + (size_t)pr * QKV_N + kcol;
#pragma unroll
        for (int i = 0; i < 16; ++i) u = dot8(q[i], *(const u32x4*)(kp + 8 * i), u);
        float w;
        if (type == 0) {
            const float aa = exp2f(-fabsf(u)), b = log2f(1.0f + aa);
            float lk = fminf(-u, 0.f) - b; const float lb = lk + u;
            if (!valid) lk = 0.f;
            float inc = lk;
#pragma unroll
            for (int off = 1; off < 64; off <<= 1) { const float t = __shfl_up(inc, off); if (lane >= off) inc += t; }
            const float after = carry + inc - lk;
            w = valid ? exp2f(lb + after) : 0.f;
            carry += __shfl(inc, 63);
        } else {
            const float s = valid ? u + cq - cum[valid ? p : 0] : -__builtin_inff();
            const float cm = wave_max(s), mn = fmaxf(m, cm), alpha = exp2f(m - mn);
            w = valid ? exp2f(s - mn) : 0.f;
            l = l * alpha + wave_sum(w); o0 *= alpha; o1 *= alpha; m = mn;
        }
        for (int j = 0; j < 64; ++j) {
            const float wj = __shfl(w, j); const int prj = __shfl(pr, j);
            const unsigned vv = *(const unsigned*)(QKV + (size_t)prj * QKV_N + vcol + 2 * lane);
            o0 = fmaf(wj, bflo(vv), o0); o1 = fmaf(wj, bfhi(vv), o1);
        }
    }
    if (type) { const float rl = 1.0f / l; o0 *= rl; o1 *= rl; }
    *(unsigned*)((bf16*)(a.ws + WS_YB) + (size_t)rowq * DM + type * 1024 + head * HD + 2 * lane) = pk2(o0, o1);
}

#define XB_TMO      128
#define XB_XCNT(j)  (256  + 64 * (j))
#define XB_XSUB(j)  (1280 + 64 * (j))
#define XB_XGEN(j)  (2304 + 64 * (j))
#define XB_TOP      3328
#define XB_TOPGEN   3392
#define XB_SPIN_CAP (1u << 18)
__device__ __forceinline__ unsigned xb_ld(unsigned* p)              { return __hip_atomic_load(p, __ATOMIC_RELAXED, __HIP_MEMORY_SCOPE_AGENT); }
__device__ __forceinline__ unsigned xb_add(unsigned* p, unsigned v) { return __hip_atomic_fetch_add(p, v, __ATOMIC_RELAXED, __HIP_MEMORY_SCOPE_AGENT); }
__device__ __forceinline__ unsigned xb_xcc_id() { return (unsigned)__builtin_amdgcn_s_getreg((3 << 11) | 20) & 0xFu; }
#define XB_SPIN(cond, bar) do { unsigned _sp = 0; while (cond) { __builtin_amdgcn_s_sleep(1); \
    if ((++_sp & 255u) == 0u) { if (xb_ld(&(bar)[XB_TMO])) break; if (_sp > XB_SPIN_CAP) { atomicAdd(&(bar)[XB_TMO], 1u); break; } } } } while (0)
struct XcdBarrier { unsigned* bar; unsigned x; volatile LAS unsigned* st; };
__device__ __forceinline__ XcdBarrier xcd_barrier_post(unsigned* bar, volatile LAS unsigned* st) {
    XcdBarrier b; b.bar = bar; b.x = xb_xcc_id(); b.st = st;
    if (threadIdx.x == 0) (void)xb_add(&bar[XB_XCNT(b.x)], 1u);
    return b;
}
__device__ __forceinline__ void xcd_barrier_complete(unsigned* bar, unsigned x, unsigned& nloc, unsigned& nx) {
    const unsigned G = gridDim.x * gridDim.y * gridDim.z;
    unsigned sum, cnt, mine, sp = 0u;
    for (;;) {
        sum = 0u; cnt = 0u; mine = 0u;
#pragma unroll
        for (unsigned j = 0; j < 16; ++j) { const unsigned c = xb_ld(&bar[XB_XCNT(j)]); sum += c; cnt += (c > 0u) ? 1u : 0u; mine = (j == x) ? c : mine; }
        if (sum == G) break;
        __builtin_amdgcn_s_sleep(1);
        if ((++sp & 255u) == 0u) { if (xb_ld(&bar[XB_TMO])) break; if (sp > XB_SPIN_CAP) { atomicAdd(&bar[XB_TMO], 1u); break; } }
    }
    nloc = mine > 0u ? mine : 1u; nx = cnt > 0u ? cnt : 1u;
}
__device__ __forceinline__ void xcd_barrier(const XcdBarrier& b) {
    asm volatile("s_waitcnt vmcnt(0)" ::: "memory");
    __syncthreads();
    if (threadIdx.x == 0) {
        unsigned* bar = b.bar;
        __builtin_amdgcn_s_waitcnt(0);
        unsigned nloc = b.st[0], nx = b.st[1];
        if (nloc == 0u) { xcd_barrier_complete(bar, b.x, nloc, nx); b.st[0] = nloc; b.st[1] = nx; }
        const unsigned old = xb_add(&bar[XB_XSUB(b.x)], 1u);
        const unsigned gen = old / nloc;
        if (old + 1u == (gen + 1u) * nloc) {
            __builtin_amdgcn_fence(__ATOMIC_RELEASE, "agent");
            asm volatile("s_waitcnt vmcnt(0)" ::: "memory");
            const unsigned og = xb_add(&bar[XB_TOP], 1u);
            const unsigned tg = og / nx;
            if (og + 1u == (tg + 1u) * nx) xb_add(&bar[XB_TOPGEN], 1u);
            else XB_SPIN(xb_ld(&bar[XB_TOPGEN]) == tg, bar);
            __builtin_amdgcn_fence(__ATOMIC_ACQUIRE, "agent");
            xb_add(&bar[XB_XGEN(b.x)], 1u);
            asm volatile("s_waitcnt vmcnt(0)" ::: "memory");
        } else {
            XB_SPIN(xb_ld(&bar[XB_XGEN(b.x)]) == gen, bar);
            __builtin_amdgcn_fence(__ATOMIC_ACQUIRE, "agent");
            asm volatile("s_waitcnt vmcnt(0)" ::: "memory");
        }
    }
    __syncthreads();
}

struct Frame {
    LAS unsigned char* lds; unsigned char* ws; unsigned* ctl;
    int tid, lane, wave, G, gw, NGW;
    const float* in[18]; float* out;
};
#define LDS_WAIT() asm volatile("s_waitcnt lgkmcnt(0)" ::: "memory")

__device__ __forceinline__ void transpose_item(const float* W, size_t ldw, bf16* WT, size_t ldt, LAS float* scr, int lane) {
#pragma unroll 8
    for (int i = 0; i < 32; ++i) { const int kk = 2 * i + (lane >> 5); scr[kk * 33 + (lane & 31)] = W[(size_t)kk * ldw + (lane & 31)]; }
    LDS_WAIT(); asm volatile("" ::: "memory");
    const int c = lane & 7;
#pragma unroll
    for (int j = 0; j < 4; ++j) { const int n = (lane >> 3) + 8 * j; const LAS float* s = scr + (8 * c) * 33 + n;
        u32x4 o; o.x = pk2(s[0 * 33], s[1 * 33]); o.y = pk2(s[2 * 33], s[3 * 33]); o.z = pk2(s[4 * 33], s[5 * 33]); o.w = pk2(s[6 * 33], s[7 * 33]);
        *(u32x4*)(WT + (size_t)n * ldt + 8 * c) = o; }
    LDS_WAIT(); asm volatile("" ::: "memory");
}
__device__ __forceinline__ void transpose_item8(const float* W, size_t ldw, unsigned char* WT, size_t ldt, LAS float* scr, int lane) {
#pragma unroll 8
    for (int i = 0; i < 32; ++i) { const int kk = 2 * i + (lane >> 5); scr[kk * 33 + (lane & 31)] = W[(size_t)kk * ldw + (lane & 31)]; }
    LDS_WAIT(); asm volatile("" ::: "memory");
    const int c = lane & 3;
#pragma unroll
    for (int j = 0; j < 2; ++j) { const int n = (lane >> 2) + 16 * j; const LAS float* p = scr + (16 * c) * 33 + n;
        u32x4 o;
        o.x = pk4_fp8(p[0 * 33] * W8_SCALE, p[1 * 33] * W8_SCALE, p[2 * 33] * W8_SCALE, p[3 * 33] * W8_SCALE); o.y = pk4_fp8(p[4 * 33] * W8_SCALE, p[5 * 33] * W8_SCALE, p[6 * 33] * W8_SCALE, p[7 * 33] * W8_SCALE);
        o.z = pk4_fp8(p[8 * 33] * W8_SCALE, p[9 * 33] * W8_SCALE, p[10 * 33] * W8_SCALE, p[11 * 33] * W8_SCALE); o.w = pk4_fp8(p[12 * 33] * W8_SCALE, p[13 * 33] * W8_SCALE, p[14 * 33] * W8_SCALE, p[15 * 33] * W8_SCALE);
        *(u32x4*)(WT + (size_t)n * ldt + 16 * c) = o; }
    LDS_WAIT(); asm volatile("" ::: "memory");
}
__device__ __forceinline__ void convert_item(Frame& F, int it, LAS float* scr) {
    constexpr int I_IN = 32 * 320, I_BS = 16 * 64, I_OUT = 32 * 64, I_GE = 32 * 32, I_DE = 16 * 64;
    constexpr int PER_LAYER = I_IN + 2 * I_BS + I_OUT + NE * (2 * I_GE + I_DE);
    const int l = it / PER_LAYER; int r = it % PER_LAYER;
    if (r < I_IN) { const int kb = r / 320, nb = r % 320, nd = 32 * nb, ns = nd + (nd >= FCOL ? 8 : 0);
        transpose_item8(F.in[I_WIN] + (size_t)l * DM * INP_SRC + (size_t)(64 * kb) * INP_SRC + ns, INP_SRC, F.ws + WS_WIN + l * WIN_L + (size_t)nd * DM + 64 * kb, DM, scr, F.lane); return; }
    r -= I_IN;
    if (r < 2 * I_BS) { const int which = r / I_BS; r %= I_BS; const int kb = r / 64, nb = r % 64;
        transpose_item((which ? F.in[I_WBFX] : F.in[I_WBSB]) + (size_t)l * 1024 * DM + (size_t)(64 * kb) * DM + 32 * nb, DM, (bf16*)(F.ws + WS_WB + l * WB_L) + (size_t)(32 * nb) * DM + which * 1024 + 64 * kb, DM, scr, F.lane); return; }
    r -= 2 * I_BS;
    if (r < I_OUT) { const int kb = r / 64, nb = r % 64;
        transpose_item8(F.in[I_WOUT] + (size_t)l * DM * DM + (size_t)(64 * kb) * DM + 32 * nb, DM, F.ws + WS_WOUT + l * WOUT_L + (size_t)(32 * nb) * DM + 64 * kb, DM, scr, F.lane); return; }
    r -= I_OUT;
    const int e = r / (2 * I_GE + I_DE); r %= (2 * I_GE + I_DE);
    if (r < 2 * I_GE) { const int which = r / I_GE; r %= I_GE; const int kb = r / 32, nb = r % 32, n0 = 32 * nb, rho = 256 * (n0 >> 7) + (n0 & 127) + which * 128;
        transpose_item8((which ? F.in[I_WU] : F.in[I_WG]) + ((size_t)(l * NE + e) * DM + 64 * kb) * FF + n0, FF, F.ws + WS_WGU + l * WGU_L + e * WGU_E + (size_t)rho * DM + 64 * kb, DM, scr, F.lane); return; }
    r -= 2 * I_GE;
    { const int kb = r / 64, nb = r % 64;
        transpose_item8(F.in[I_WD] + ((size_t)(l * NE + e) * FF + 64 * kb) * DM + 32 * nb, DM, F.ws + WS_WD + l * WD_L + e * WD_E + (size_t)(32 * nb) * FF + 64 * kb, FF, scr, F.lane); }
}
constexpr int N_CONVERT_ITEMS = NLAYER * (32 * 320 + 2 * 16 * 64 + 32 * 64 + NE * (2 * 32 * 32 + 16 * 64));

__device__ __forceinline__ int tab_rowpos(int c) { return (c & 3) * 512 + (c >> 8) * 64 + ((c >> 2) & 63); }
template <int NC> __device__ __forceinline__ void stage_table(Frame& F, const float* src, size_t pitch) {
    constexpr int CH = NC / 4;
    for (int ci = F.tid; ci < DM * CH; ci += NTHREADS) { const int c = ci / CH, q = ci % CH;
        const f32x4 v = *(const f32x4*)(src + (size_t)c * pitch + 4 * q);
        const int sw = (NC == 16) ? ((c >> 4) & 3) : ((c >> 5) & 1);
        *(LAS f32x4*)(F.lds + tab_rowpos(c) * (NC * 4) + ((q ^ sw) << 4)) = v; }
    LDS_WAIT(); __syncthreads();
}
template <int NC> __device__ __forceinline__ void table_dot(Frame& F, const f32x4 (&y)[8], float (&acc)[NC]) {
    constexpr int CH = NC / 4; const int l = F.lane; const int sw = (NC == 16) ? ((l >> 2) & 3) : ((l >> 3) & 1);
#pragma unroll
    for (int e = 0; e < NC; ++e) acc[e] = 0.f;
#pragma unroll
    for (int j = 0; j < 8; ++j)
#pragma unroll
        for (int i = 0; i < 4; ++i) { const float yv = y[j][i]; const int rp = i * 512 + j * 64 + l; if (i == 0) asm volatile("" ::: "memory");
#pragma unroll
            for (int q = 0; q < CH; ++q) { const f32x4 w = *(const LAS f32x4*)(F.lds + rp * (NC * 4) + ((q ^ sw) << 4));
                acc[4 * q + 0] = fmaf(yv, w.x, acc[4 * q + 0]); acc[4 * q + 1] = fmaf(yv, w.y, acc[4 * q + 1]); acc[4 * q + 2] = fmaf(yv, w.z, acc[4 * q + 2]); acc[4 * q + 3] = fmaf(yv, w.w, acc[4 * q + 3]); } }
#pragma unroll
    for (int e = 0; e < NC; ++e) acc[e] = wave_sum(acc[e]);
}
__device__ __forceinline__ void ln_row(Frame& F, f32x4 (&v)[8], const float* g, const float* b) {
    float s = 0.f;
#pragma unroll
    for (int j = 0; j < 8; ++j) s += (v[j].x + v[j].y) + (v[j].z + v[j].w);
    const float mean = wave_sum(s) * (1.f / DM); float s2 = 0.f;
#pragma unroll
    for (int j = 0; j < 8; ++j) { v[j] = v[j] - mean; s2 += (v[j].x * v[j].x + v[j].y * v[j].y) + (v[j].z * v[j].z + v[j].w * v[j].w); }
    const float rstd = 1.0f / sqrtf(wave_sum(s2) * (1.f / DM) + LN_EPS);
#pragma unroll
    for (int j = 0; j < 8; ++j) { const f32x4 gv = *(const f32x4*)(g + 256 * j + 4 * F.lane), bv = *(const f32x4*)(b + 256 * j + 4 * F.lane); v[j] = v[j] * rstd * gv + bv; }
}
__device__ __forceinline__ void store_h(Frame& F, int row, const f32x4 (&y)[8], bool dry = false) {
    float* hf = (float*)(F.ws + (dry ? WS_YB : WS_HF)) + (size_t)row * DM; bf16* hb = (bf16*)(F.ws + (dry ? WS_GB + 21 * MiB : WS_HB)) + (size_t)row * DM;
    unsigned char* h8 = F.ws + (dry ? WS_GB + 21 * MiB : WS_H8) + (size_t)row * DM;
#pragma unroll
    for (int j = 0; j < 8; ++j) { *(f32x4*)(hf + 256 * j + 4 * F.lane) = y[j]; u32x2 w; w.x = pk2(y[j].x, y[j].y); w.y = pk2(y[j].z, y[j].w); *(u32x2*)(hb + 256 * j + 4 * F.lane) = w;
        *(unsigned*)(h8 + 256 * j + 4 * F.lane) = pk4_fp8(y[j].x * H8_SCALE, y[j].y * H8_SCALE, y[j].z * H8_SCALE, y[j].w * H8_SCALE); }
}
__device__ __forceinline__ void store_logf(Frame& F, int row, const f32x4 (&y)[8], const float* bfor) {
    float acc[8]; table_dot<8>(F, y, acc);
    if (F.lane < 8) { float a = acc[0];
#pragma unroll
        for (int h = 1; h < 8; ++h) a = (F.lane == h) ? acc[h] : a;
        const float x = a + bfor[F.lane];
        const float ls = fminf(x, 0.f) - log1pf(__expf(-fabsf(x)));
        ((float*)(F.ws + WS_LOGF))[(size_t)row * 8 + F.lane] = ls; }
}

__device__ __forceinline__ void phase_prologue(Frame& F) {
    LAS float* scr = (LAS float*)(F.lds + F.wave * 16384);
    for (int rep = 0; rep < 1 + (int)((DBL_MASK >> 8) & 1u); ++rep)
    for (int it = F.gw; it < N_CONVERT_ITEMS; it += F.NGW) convert_item(F, it, scr);
    __syncthreads();
    stage_table<8>(F, F.in[I_WIN] + FCOL, INP_SRC);
    for (int row = F.gw; row < NTOK; row += F.NGW) {
        const float* src = row < SEQ ? F.in[I_X] + (size_t)row * DM : F.in[I_META] + (size_t)(row - SEQ) * DM;
        f32x4 v[8];
#pragma unroll
        for (int j = 0; j < 8; ++j) v[j] = *(const f32x4*)(src + 256 * j + 4 * F.lane);
        ln_row(F, v, F.in[I_LNIN_G], F.in[I_LNIN_B]);
        store_h(F, row, v);
        store_logf(F, row, v, F.in[I_BF]);
    }
    for (int row = NTOK + F.gw; row < MROWS; row += F.NGW) { bf16* hb = (bf16*)(F.ws + WS_HB) + (size_t)row * DM;
#pragma unroll
        for (int j = 0; j < 4; ++j) *(u32x4*)(hb + 512 * j + 8 * F.lane) = (u32x4){0u, 0u, 0u, 0u}; }
    __syncthreads();
}
__device__ __forceinline__ void phase_tilesuf(Frame& F) {
    if (blockIdx.x > SEQ / 64) return;
    const int tile = blockIdx.x, h = F.wave, row = tile * 64 + F.lane;
    const float v = (row < NTOK) ? LOG2E * ((const float*)(F.ws + WS_LOGF))[(size_t)row * 8 + h] : 0.f;
    float inc = v;
#pragma unroll
    for (int off = 1; off < 64; off <<= 1) { const float t = __shfl_down(inc, off); if (F.lane + off < 64) inc += t; }
    float* base = (float*)(F.ws + WS_CUM);
    base[(size_t)h * MROWS + row] = inc - v;
    if (F.lane == 0) base[(size_t)NHEAD * MROWS + h * 256 + tile] = inc;
}
__device__ __forceinline__ void phase_cumsum(Frame& F, bool do_scan) {
    if (blockIdx.x >= NHEAD) {
        if (blockIdx.x < NHEAD + 48) { bf16* q = (bf16*)(F.ws + WS_QKV) + (size_t)(NTOK + blockIdx.x - NHEAD) * QKV_N;
            for (int i = F.tid; i < QKV_N / 8; i += NTHREADS) *(u32x4*)(q + 8 * i) = (u32x4){0u, 0u, 0u, 0u}; }
        return; }
    if (!do_scan) return;
    const int h = blockIdx.x; const float* logf = (const float*)(F.ws + WS_LOGF); float* cum = (float*)(F.ws + WS_CUM) + (size_t)h * MROWS;
    constexpr int PER = 17; const int p0 = F.tid * PER;
    float loc[PER]; float s = 0.f;
#pragma unroll
    for (int i = 0; i < PER; ++i) { const int p = p0 + i; const float v = p < NTOK ? logf[(size_t)row_of_p(p) * 8 + h] : 0.f; s += v; loc[i] = s; }
    float inc = s;
#pragma unroll
    for (int off = 1; off < 64; off <<= 1) { const float t = __shfl_up(inc, off); if (F.lane >= off) inc += t; }
    LAS float* wt = (LAS float*)(F.lds);
    if (F.lane == 63) wt[F.wave] = inc;
    LDS_WAIT(); __syncthreads();
    float base = inc - s;
    for (int w = 0; w < F.wave; ++w) base += wt[w];
#pragma unroll
    for (int i = 0; i < PER; ++i) { const int p = p0 + i; if (p < NTOK) cum[p] = (base + loc[i]) * LOG2E; }
    LDS_WAIT(); __syncthreads();
}
__device__ __forceinline__ void phase_ln_router(Frame& F, int layer, bool dry = false) {
    stage_table<16>(F, F.in[I_WR], 16);
    const float* g = F.in[I_LNMIX_G] + layer * DM; const float* b = F.in[I_LNMIX_B] + layer * DM;
    const float* rbias = F.in[I_RB];
    const int nrows_e = layer == NLAYER - 1 ? SEQ : NTOK;
    for (int row = F.gw; row < nrows_e; row += F.NGW) {
        const float* src = (const float*)(F.ws + WS_RB) + (size_t)row * DM;
        f32x4 v[8];
#pragma unroll
        for (int j = 0; j < 8; ++j) v[j] = *(const f32x4*)(src + 256 * j + 4 * F.lane);
        ln_row(F, v, g, b);
        store_h(F, row, v, dry);
        float lg[16]; table_dot<16>(F, v, lg);
        float aff[16], sel[16];
#pragma unroll
        for (int e = 0; e < 16; ++e) { aff[e] = 1.0f / (1.0f + __expf(-lg[e])); sel[e] = aff[e] + rbias[e]; }
        int bg = 0; float bs = -__builtin_inff();
#pragma unroll
        for (int gi = 0; gi < 4; ++gi) { const float a0 = sel[4 * gi], a1 = sel[4 * gi + 1], a2 = sel[4 * gi + 2], a3 = sel[4 * gi + 3];
            const float h1 = fmaxf(a0, a1), l1 = fminf(a0, a1), h2 = fmaxf(a2, a3), l2 = fminf(a2, a3);
            const float top = fmaxf(h1, h2), sec = fmaxf(fminf(h1, h2), fmaxf(l1, l2)), sc = top + sec;
            if (sc > bs) { bs = sc; bg = gi; } }
        float s4[4], a4[4];
#pragma unroll
        for (int i = 0; i < 4; ++i) { s4[i] = sel[i]; a4[i] = aff[i]; }
#pragma unroll
        for (int gi = 1; gi < 4; ++gi) if (bg == gi) {
#pragma unroll
            for (int i = 0; i < 4; ++i) { s4[i] = sel[4 * gi + i]; a4[i] = aff[4 * gi + i]; } }
        int i1 = 0; float m1 = s4[0];
#pragma unroll
        for (int i = 1; i < 4; ++i) if (s4[i] > m1) { m1 = s4[i]; i1 = i; }
        int i2 = -1; float m2 = -__builtin_inff();
#pragma unroll
        for (int i = 0; i < 4; ++i) if (i != i1 && s4[i] > m2) { m2 = s4[i]; i2 = i; }
        float af1 = a4[0], af2 = a4[0];
#pragma unroll
        for (int i = 1; i < 4; ++i) { if (i1 == i) af1 = a4[i]; if (i2 == i) af2 = a4[i]; }
        const float wsum = af1 + af2, w1 = af1 / wsum, w2 = af2 / wsum;
        const int e1 = 4 * bg + i1, e2 = 4 * bg + i2;
        if (dry) { if (F.lane == 0) ((float*)(F.ws + WS_GB + 60 * MiB))[row] = w1 + w2 + (float)(e1 + e2); }
        if (F.lane == 0 && !dry) {
            const int r1 = (int)atomicAdd(F.ctl + CW_CNT + (layer * NE + e1) * 64, 1u), r2 = (int)atomicAdd(F.ctl + CW_CNT + (layer * NE + e2) * 64, 1u);
            int* el = (int*)(F.ws + WS_ELIST); el[(size_t)e1 * MROWS + r1] = row; el[(size_t)e2 * MROWS + r2] = row;
            int* ti = (int*)(F.ws + WS_TOKI) + (size_t)row * 8;
            ti[0] = e1; ti[1] = e2; ti[2] = r1; ti[3] = r2; ti[4] = __builtin_bit_cast(int, w1); ti[5] = __builtin_bit_cast(int, w2);
        }
    }
    __syncthreads();
}
__device__ __forceinline__ void phase_ln_final(Frame& F, int layer, bool dry = false) {
    const bool last = layer == NLAYER - 1;
    if (!last) stage_table<8>(F, F.in[I_WIN] + (size_t)(layer + 1) * DM * INP_SRC + FCOL, INP_SRC);
    const float* g = F.in[I_LNFFN_G] + layer * DM; const float* b = F.in[I_LNFFN_B] + layer * DM;
    const int nrows = last ? SEQ : NTOK;
    for (int row = F.gw; row < nrows; row += F.NGW) {
        const int* ti = (const int*)(F.ws + WS_TOKI) + (size_t)row * 8;
        const int e1 = ti[0], e2 = ti[1], r1 = ti[2], r2 = ti[3]; const float w1 = __builtin_bit_cast(float, ti[4]), w2 = __builtin_bit_cast(float, ti[5]);
        const int ps1 = moe_pstart(F.ctl, layer, e1), ps2 = moe_pstart(F.ctl, layer, e2);
        const bf16* o1 = (const bf16*)(F.ws + WS_OSL) + (size_t)(ps1 + r1) * DM; const bf16* o2 = (const bf16*)(F.ws + WS_OSL) + (size_t)(ps2 + r2) * DM;
        const float* hf = (const float*)(F.ws + WS_HF) + (size_t)row * DM;
        f32x4 v[8];
#pragma unroll
        for (int j = 0; j < 8; ++j) { const f32x4 hv = *(const f32x4*)(hf + 256 * j + 4 * F.lane);
            const u32x2 a = *(const u32x2*)(o1 + 256 * j + 4 * F.lane), c = *(const u32x2*)(o2 + 256 * j + 4 * F.lane);
            v[j].x = ALPHA * hv.x + w1 * bflo(a.x) + w2 * bflo(c.x); v[j].y = ALPHA * hv.y + w1 * bfhi(a.x) + w2 * bfhi(c.x);
            v[j].z = ALPHA * hv.z + w1 * bflo(a.y) + w2 * bflo(c.y); v[j].w = ALPHA * hv.w + w1 * bfhi(a.y) + w2 * bfhi(c.y); }
        ln_row(F, v, g, b);
        if (dry) { store_h(F, row, v, true); if (!last) { float acc8[8]; table_dot<8>(F, v, acc8); if (F.lane == 0) ((float*)(F.ws + WS_GB + 60 * MiB))[row] = acc8[0] + acc8[7]; } }
        else if (last) { float* o = F.out + (size_t)row * DM;
#pragma unroll
            for (int j = 0; j < 8; ++j) *(f32x4*)(o + 256 * j + 4 * F.lane) = v[j]; }
        else { store_h(F, row, v); store_logf(F, row, v, F.in[I_BF] + (layer + 1) * NHEAD); }
    }
    __syncthreads();
}

namespace pg8 {
typedef short bf16x8 __attribute__((ext_vector_type(8)));
typedef int i32x4 __attribute__((ext_vector_type(4)));
typedef int i32x8 __attribute__((ext_vector_type(8)));
__device__ __forceinline__ i32x8 ld_frag(const LAS unsigned char* p) { const i32x4 x = *(const LAS i32x4*)p, y = *(const LAS i32x4*)(p + 1024); return __builtin_shufflevector(x, y, 0, 1, 2, 3, 4, 5, 6, 7); }
__device__ __forceinline__ bf16x8 frag_lo(i32x8 f) { return __builtin_bit_cast(bf16x8, (i32x4)__builtin_shufflevector(f, f, 0, 1, 2, 3)); }
__device__ __forceinline__ bf16x8 frag_hi(i32x8 f) { return __builtin_bit_cast(bf16x8, (i32x4)__builtin_shufflevector(f, f, 4, 5, 6, 7)); }
constexpr int BM = 256, BK = 64, HALF = 128, HTB = HALF * BK * 2, STAGE_BYTES = 8 * HTB, NXCD = 8, WGM = 8;
__host__ __device__ __forceinline__ int lds_byte(int r, int c) { const int st = (r >> 4) * 2 + (c >> 5), rr = r & 15, cc = c & 31, ob = rr * 64 + cc * 2; return st * 1024 + (ob ^ (((ob >> 9) & 1) << 5)); }
__host__ __device__ __forceinline__ void stage_rc(int b, int& R, int& C) { const int st = b / 1024, sb = b % 1024, swz = sb ^ (((sb >> 9) & 1) << 5); R = (st >> 1) * 16 + swz / 64; C = (st & 1) * 32 + (swz % 64) / 2; }
__host__ __device__ __forceinline__ int perm32(int rho) { const int n = rho >> 4, i = rho & 15; return 8 * (i >> 2) + 4 * n + (i & 3); }
struct Unit { int pm, pn, aux; };
__device__ __forceinline__ bool static_tile(int nM, int nN, int G, int c, int i, int& pm, int& pn) {
    const int nwg = nM * nN; const long L = (long)i * G + c; if (L >= nwg) return false;
    int wgid = (int)L; { const int q = nwg / NXCD, r = nwg % NXCD, xcd = wgid % NXCD, off = wgid / NXCD; wgid = (xcd < r ? xcd * (q + 1) : r * (q + 1) + (xcd - r) * q) + off; }
    const int nig = WGM * nN, gid = wgid / nig, fm = gid * WGM, gsz = (nM - fm) < WGM ? (nM - fm) : WGM;
    pm = fm + ((wgid % nig) % gsz); pn = (wgid % nig) / gsz; return true;
}
__device__ __forceinline__ unsigned cvt_pk_bf16(float lo, float hi) { unsigned r; asm volatile("v_cvt_pk_bf16_f32 %0, %1, %2" : "=v"(r) : "v"(lo), "v"(hi)); return r; }

template <class P>
__device__ __forceinline__ void gemm_phase(LAS unsigned char* lds, const P& prob) {
    const int tid = threadIdx.x, wid = __builtin_amdgcn_readfirstlane(tid >> 6), lane = tid & 63, wr = wid >> 2, wc = wid & 3, fr = lane & 15, fq = lane >> 4;
    constexpr int ES = P::FP8 ? 1 : 2;
    const int nt = prob.K * ES / (BK * 2);
    unsigned voffA[2], voffA1[2], voffB[2];
#pragma unroll
    for (int i = 0; i < 2; ++i) { int R, C; stage_rc(tid * 16 + i * 8192, R, C); const int Rb = P::PERM ? ((R & ~31) + perm32(R & 31)) : R;
        voffA[i] = (unsigned)(R * prob.lda * ES + C * 2); voffA1[i] = voffA[i]; voffB[i] = (unsigned)(Rb * prob.ldb * ES + C * 2); }
    const size_t kstep = (size_t)(BK * 2);
    const size_t hstepA = P::GATHER ? (size_t)0 : (size_t)HALF * prob.lda * ES, hstepB = (size_t)HALF * prob.ldb * ES;
    const unsigned ldsw = (unsigned)wid * 1024u;
    const int aoff = lds_byte(wr * 64 + fr, fq * 8), boff = lds_byte(wc * 32 + fr, fq * 8);
#define PG8_SA(b, h) (((b) * 2 + (h)) * HTB)
#define PG8_SB(b, h) ((4 + (b) * 2 + (h)) * HTB)
#define PG8_STAGE(bufoff, gbase, voff) do { _Pragma("unroll") for (int _i = 0; _i < 2; ++_i) \
        __builtin_amdgcn_global_load_lds((const unsigned*)((const char*)(gbase) + (voff)[_i]), (LAS unsigned*)(lds + (bufoff) + ldsw + _i * 8192), 16, 0, 0); } while (0)
#define PG8_LDA(dst, b, h) do { _Pragma("unroll") for (int m = 0; m < 4; ++m) dst[m] = ld_frag(lds + PG8_SA(b, h) + aoff + m * 2048); } while (0)
#define PG8_LDB(dst, b, h) do { _Pragma("unroll") for (int n = 0; n < 2; ++n) dst[n] = ld_frag(lds + PG8_SB(b, h) + boff + n * 2048); } while (0)
#define PG8_MMA(ai, bj, At, Bt) do { __builtin_amdgcn_s_setprio(1); _Pragma("unroll") for (int m = 0; m < 4; ++m) _Pragma("unroll") for (int n = 0; n < 2; ++n) { \
        if constexpr (P::FP8) asm volatile("v_mfma_scale_f32_16x16x128_f8f6f4 %0, %1, %2, %0, %3, %4 op_sel_hi:[0,0,0]" : "+v"(acc[ai][bj][m][n]) : "v"(Bt[n]), "v"(At[m]), "v"(scb), "v"(sca)); \
        else { acc[ai][bj][m][n] = __builtin_amdgcn_mfma_f32_16x16x32_bf16(frag_lo(Bt[n]), frag_lo(At[m]), acc[ai][bj][m][n], 0, 0, 0); \
               acc[ai][bj][m][n] = __builtin_amdgcn_mfma_f32_16x16x32_bf16(frag_hi(Bt[n]), frag_hi(At[m]), acc[ai][bj][m][n], 0, 0, 0); } } __builtin_amdgcn_s_setprio(0); } while (0)
#define PG8_WAIT_V(n) asm volatile("s_waitcnt vmcnt(" #n ")" ::: "memory")
#define PG8_WAIT_L(n) asm volatile("s_waitcnt lgkmcnt(" #n ")" ::: "memory")
#define PG8_BAR __builtin_amdgcn_s_barrier()
#define PG8_SCHED __builtin_amdgcn_sched_barrier(0)
#define PG8_GATHER_OFFS(ui_, d0, d1) do { _Pragma("unroll") for (int _i = 0; _i < 2; ++_i) { int R_, C_; stage_rc(tid * 16 + _i * 8192, R_, C_); \
        d0[_i] = (unsigned)(prob.a_row(ui_, R_) * prob.lda * ES + C_ * 2); d1[_i] = (unsigned)(prob.a_row(ui_, HALF + R_) * prob.lda * ES + C_ * 2); } } while (0)
    Unit cur, nxt; int ui = 0;
    if (!prob.next(0, cur)) return;
    f32x4 acc[2][2][4][2];
#pragma unroll
    for (int a = 0; a < 2; ++a)
#pragma unroll
        for (int b = 0; b < 2; ++b)
#pragma unroll
            for (int m = 0; m < 4; ++m)
#pragma unroll
                for (int n = 0; n < 2; ++n) acc[a][b][m][n] = (f32x4){0.f, 0.f, 0.f, 0.f};
    const int sca = prob.sc_a, scb = prob.sc_b;
    i32x8 At[4], B0[2], B1[2];
    const char* cA = prob.a_ptr(cur); const char* cB = prob.b_ptr(cur);
    if constexpr (P::GATHER) PG8_GATHER_OFFS(0, voffA, voffA1);
    PG8_STAGE(PG8_SB(0, 0), cB, voffB); PG8_STAGE(PG8_SB(0, 1), cB + hstepB, voffB); PG8_STAGE(PG8_SA(0, 0), cA, voffA); PG8_STAGE(PG8_SA(0, 1), cA + hstepA, voffA1);
    if (wr == 1) PG8_BAR;
    PG8_WAIT_V(2); PG8_BAR;
    PG8_STAGE(PG8_SB(1, 0), cB + kstep, voffB); PG8_STAGE(PG8_SA(1, 0), cA + kstep, voffA); PG8_STAGE(PG8_SB(1, 1), cB + hstepB + kstep, voffB);
    PG8_WAIT_V(6); PG8_BAR;
    for (;;) {
        const bool has_next = prob.next(ui + 1, nxt);
        const char* nA = has_next ? prob.a_ptr(nxt) : cA; const char* nB = has_next ? prob.b_ptr(nxt) : cB;
        for (int t = 0; t < nt; t += 2) {
            const bool last = (t == nt - 2);
            const char* a1 = cA + (size_t)(t + 1) * kstep;
            const char* a2 = last ? nA : cA + (size_t)(t + 2) * kstep; const char* b2 = last ? nB : cB + (size_t)(t + 2) * kstep;
            const char* a3 = a2 + kstep; const char* b3 = b2 + kstep;
            if constexpr (P::GATHER) {
                unsigned v0[2], v1[2];
#pragma unroll
                for (int i = 0; i < 2; ++i) { v0[i] = voffA[i]; v1[i] = voffA1[i]; }
                if (last && has_next) PG8_GATHER_OFFS(ui + 1, v0, v1);
                PG8_LDB(B0, 0, 0); PG8_LDB(B1, 0, 1); PG8_SCHED; PG8_LDA(At, 0, 0); PG8_STAGE(PG8_SA(1, 1), a1, voffA1);
                PG8_WAIT_V(8); PG8_WAIT_L(0); PG8_BAR; PG8_MMA(0, 0, At, B0); PG8_MMA(0, 1, At, B1); PG8_BAR; PG8_SCHED;
                PG8_LDA(At, 0, 1); PG8_STAGE(PG8_SB(0, 0), b2, voffB); PG8_STAGE(PG8_SB(0, 1), b2 + hstepB, voffB); PG8_STAGE(PG8_SA(0, 0), a2, v0);
                PG8_WAIT_V(8); PG8_WAIT_L(0); PG8_BAR; PG8_MMA(1, 0, At, B0); PG8_MMA(1, 1, At, B1); PG8_BAR; PG8_SCHED;
                PG8_LDB(B0, 1, 0); PG8_LDB(B1, 1, 1); PG8_SCHED; PG8_LDA(At, 1, 0); PG8_STAGE(PG8_SA(0, 1), a2, v1);
                PG8_WAIT_V(8); PG8_WAIT_L(0); PG8_BAR; PG8_MMA(0, 0, At, B0); PG8_MMA(0, 1, At, B1); PG8_BAR; PG8_SCHED;
                PG8_LDA(At, 1, 1); PG8_STAGE(PG8_SB(1, 0), b3, voffB); PG8_STAGE(PG8_SB(1, 1), b3 + hstepB, voffB); PG8_STAGE(PG8_SA(1, 0), a3, v0);
                PG8_WAIT_V(8); PG8_WAIT_L(0); PG8_BAR; PG8_MMA(1, 0, At, B0); PG8_MMA(1, 1, At, B1); PG8_BAR; PG8_SCHED;
#pragma unroll
                for (int i = 0; i < 2; ++i) { voffA[i] = v0[i]; voffA1[i] = v1[i]; }
            } else {
                PG8_LDB(B0, 0, 0); PG8_LDB(B1, 0, 1); PG8_SCHED; PG8_LDA(At, 0, 0); PG8_STAGE(PG8_SA(1, 1), a1 + hstepA, voffA);
                PG8_WAIT_V(8); PG8_WAIT_L(0); PG8_BAR; PG8_MMA(0, 0, At, B0); PG8_MMA(0, 1, At, B1); PG8_BAR; PG8_SCHED;
                PG8_LDA(At, 0, 1); PG8_STAGE(PG8_SB(0, 0), b2, voffB); PG8_STAGE(PG8_SB(0, 1), b2 + hstepB, voffB); PG8_STAGE(PG8_SA(0, 0), a2, voffA);
                PG8_WAIT_V(8); PG8_WAIT_L(0); PG8_BAR; PG8_MMA(1, 0, At, B0); PG8_MMA(1, 1, At, B1); PG8_BAR; PG8_SCHED;
                PG8_LDB(B0, 1, 0); PG8_LDB(B1, 1, 1); PG8_SCHED; PG8_LDA(At, 1, 0); PG8_STAGE(PG8_SA(0, 1), a2 + hstepA, voffA);
                PG8_WAIT_V(8); PG8_WAIT_L(0); PG8_BAR; PG8_MMA(0, 0, At, B0); PG8_MMA(0, 1, At, B1); PG8_BAR; PG8_SCHED;
                PG8_LDA(At, 1, 1); PG8_STAGE(PG8_SB(1, 0), b3, voffB); PG8_STAGE(PG8_SB(1, 1), b3 + hstepB, voffB); PG8_STAGE(PG8_SA(1, 0), a3, voffA);
                PG8_WAIT_V(8); PG8_WAIT_L(0); PG8_BAR; PG8_MMA(1, 0, At, B0); PG8_MMA(1, 1, At, B1); PG8_BAR; PG8_SCHED;
            }
        }
        if (wr == 0) PG8_BAR;
        if constexpr (P::FP8) asm volatile("s_nop 15\n\ts_nop 15" ::: "memory");
        const bool keep = prob.epi(acc, cur, wr, wc, fr, fq);
        if (!has_next) break;
        if (!P::KEEPS || !keep) {
#pragma unroll
            for (int a = 0; a < 2; ++a)
#pragma unroll
                for (int b = 0; b < 2; ++b)
#pragma unroll
                    for (int m = 0; m < 4; ++m)
#pragma unroll
                        for (int n = 0; n < 2; ++n) acc[a][b][m][n] = (f32x4){0.f, 0.f, 0.f, 0.f};
        }
        cur = nxt; cA = nA; cB = nB; ++ui;
        if (wr == 1) PG8_BAR;
    }
    PG8_WAIT_V(0);
    PG8_BAR;
#undef PG8_SA
#undef PG8_SB
#undef PG8_STAGE
#undef PG8_LDA
#undef PG8_LDB
#undef PG8_MMA
#undef PG8_WAIT_V
#undef PG8_WAIT_L
#undef PG8_BAR
#undef PG8_SCHED
#undef PG8_GATHER_OFFS
}
}

template <class Epi>
__device__ __forceinline__ void skinny16_once(LAS unsigned char* lds, const bf16* A, int lda, const bf16* Bt, int ldb, int K, int N, const Epi& epi) {
    const int tid = threadIdx.x, wid = __builtin_amdgcn_readfirstlane(tid >> 6), lane = tid & 63, r = lane & 15, kg = lane >> 4;
    const int kw = K / 8, k0 = wid * kw;
    LAS float* part = (LAS float*)lds;
    for (int ct = blockIdx.x; ct < N / 16; ct += gridDim.x) {
        const bf16* ap = A + (size_t)r * lda + k0 + 8 * kg; const bf16* bp = Bt + (size_t)(16 * ct + r) * ldb + k0 + 8 * kg;
        f32x4 acc = {0.f, 0.f, 0.f, 0.f};
#pragma unroll 8
        for (int ks = 0; ks < kw; ks += 32) acc = __builtin_amdgcn_mfma_f32_16x16x32_bf16(*(const pg8::bf16x8*)(ap + ks), *(const pg8::bf16x8*)(bp + ks), acc, 0, 0, 0);
#pragma unroll
        for (int i = 0; i < 4; ++i) part[wid * 256 + (4 * kg + i) * 16 + r] = acc[i];
        LDS_WAIT(); __syncthreads();
        if (tid < 256) { const float s0 = (part[tid] + part[256 + tid]) + (part[512 + tid] + part[768 + tid]), s1 = (part[1024 + tid] + part[1280 + tid]) + (part[1536 + tid] + part[1792 + tid]);
            epi(tid >> 4, 16 * ct + (tid & 15), s0, s1); }
        LDS_WAIT(); __syncthreads();
    }
}
template <class Epi>
__device__ __forceinline__ void skinny16_f8(LAS unsigned char* lds, const unsigned char* A, int lda, const unsigned char* Bt, int ldb, int K, int N, int sc_a, int sc_b, const Epi& epi) {
    const int tid = threadIdx.x, wid = __builtin_amdgcn_readfirstlane(tid >> 6), lane = tid & 63, r = lane & 15, kg = lane >> 4;
    const int kw = K / 8, k0 = wid * kw;
    LAS float* part = (LAS float*)lds;
    for (int ct = blockIdx.x; ct < N / 16; ct += gridDim.x) {
        const unsigned char* ap = A + (size_t)r * lda + k0 + 32 * kg; const unsigned char* bp = Bt + (size_t)(16 * ct + r) * ldb + k0 + 32 * kg;
        f32x4 acc = {0.f, 0.f, 0.f, 0.f};
#pragma unroll 2
        for (int ks = 0; ks < kw; ks += 128) { const pg8::i32x8 av = *(const pg8::i32x8*)(ap + ks), bv = *(const pg8::i32x8*)(bp + ks);
            acc = __builtin_amdgcn_mfma_scale_f32_16x16x128_f8f6f4(av, bv, acc, 0, 0, 0, sc_a, 0, sc_b); }
#pragma unroll
        for (int i = 0; i < 4; ++i) part[wid * 256 + (4 * kg + i) * 16 + r] = acc[i];
        LDS_WAIT(); __syncthreads();
        if (tid < 256) { const float s0 = (part[tid] + part[256 + tid]) + (part[512 + tid] + part[768 + tid]), s1 = (part[1024 + tid] + part[1280 + tid]) + (part[1536 + tid] + part[1792 + tid]);
            epi(tid >> 4, 16 * ct + (tid & 15), s0, s1); }
        LDS_WAIT(); __syncthreads();
    }
}
template <class Epi>
__device__ __forceinline__ void skinny16(LAS unsigned char* lds, const bf16* A, int lda, const bf16* Bt, int ldb, int K, int N, const Epi& epi) {
    skinny16_once(lds, A, lda, Bt, ldb, K, N, epi); if ((DBL_MASK >> 10) & 1u) skinny16_once(lds, A, lda, Bt, ldb, K, N, epi);
}
struct SkinnyInProj { unsigned char* ws; __device__ __forceinline__ void operator()(int j, int n, float s0, float s1) const { inproj_store(ws, SEQ + j, n, s0 + s1); } };
struct SkinnyBranch { unsigned char* ws; __device__ __forceinline__ void operator()(int j, int n, float s0, float s1) const {
    const size_t r = SEQ + j; const bf16* G = (const bf16*)(ws + WS_GB); const float v = __builtin_amdgcn_fmed3f((bf2f(G[r * G_N + n]) * s0 + bf2f(G[r * G_N + DM + n]) * s1) * MG8_SCALE, -448.f, 448.f);
    (ws + WS_MG)[r * DM + n] = (unsigned char)(__builtin_amdgcn_cvt_pk_fp8_f32(v, 0.f, 0, false) & 0xff); } };
struct SkinnyOut { unsigned char* ws; __device__ __forceinline__ void operator()(int j, int n, float s0, float s1) const {
    const size_t o = (size_t)(SEQ + j) * DM + n; ((float*)(ws + WS_RB))[o] = ALPHA * ((const float*)(ws + WS_HF))[o] + (s0 + s1); } };

using pg8::Unit;
struct ProbInProj {
    static constexpr bool PERM = true, GATHER = false, KEEPS = false, FP8 = true;
    int K, lda, ldb, G, c; const unsigned char* A; const unsigned char* B; unsigned char* ws; int sc_a, sc_b;
    __device__ __forceinline__ bool next(int i, Unit& u) const { u.aux = 0; return pg8::static_tile(SEQ / 256, INP_N / 256, G, c, i, u.pm, u.pn); }
    __device__ __forceinline__ const char* a_ptr(const Unit& u) const { return (const char*)(A + (size_t)u.pm * 256 * lda); }
    __device__ __forceinline__ const char* b_ptr(const Unit& u) const { return (const char*)(B + (size_t)u.pn * 256 * ldb); }
    __device__ __forceinline__ bool epi(f32x4 (&acc)[2][2][4][2], const Unit& u, int wr, int wc, int fr, int fq) const {
        const int row0 = u.pm * 256 + wr * 64 + fr, ct = u.pn * 256 + wc * 32 + 8 * fq;
        const bool isg = u.pn >= 24, isq = (u.pn < 4) || (u.pn >= 12 && u.pn < 16);
        bf16* base = isg ? (bf16*)(ws + WS_GB) + (ct - QKV_N) : (bf16*)(ws + WS_QKV) + ct; const int ldc = isg ? G_N : QKV_N; const float sc = isq ? QSCALE : 1.0f;
#pragma unroll
        for (int ai = 0; ai < 2; ++ai)
#pragma unroll
            for (int m = 0; m < 4; ++m) { bf16* rowp = base + (size_t)(row0 + ai * 128 + m * 16) * ldc;
#pragma unroll
                for (int bj = 0; bj < 2; ++bj) { f32x4 v0 = acc[ai][bj][m][0], v1 = acc[ai][bj][m][1];
                    if (isg) {
#pragma unroll
                        for (int j = 0; j < 4; ++j) { v0[j] = __builtin_amdgcn_rcpf(1.0f + __builtin_amdgcn_exp2f(-LOG2E * v0[j])); v1[j] = __builtin_amdgcn_rcpf(1.0f + __builtin_amdgcn_exp2f(-LOG2E * v1[j])); } }
                    else { v0 = v0 * sc; v1 = v1 * sc; }
                    u32x4 w; w.x = pg8::cvt_pk_bf16(v0[0], v0[1]); w.y = pg8::cvt_pk_bf16(v0[2], v0[3]); w.z = pg8::cvt_pk_bf16(v1[0], v1[1]); w.w = pg8::cvt_pk_bf16(v1[2], v1[3]);
                    *(u32x4*)(rowp + bj * 128) = w; } }
        return false;
    }
};
struct ProbOutProj {
    static constexpr bool PERM = false, GATHER = false, KEEPS = false, FP8 = true;
    int K, lda, ldb, G, c; const unsigned char* A; const unsigned char* B; unsigned char* ws; int sc_a, sc_b;
    __device__ __forceinline__ bool next(int i, Unit& u) const { u.aux = 0; return pg8::static_tile(SEQ / 256, DM / 256, G, c, i, u.pm, u.pn); }
    __device__ __forceinline__ const char* a_ptr(const Unit& u) const { return (const char*)(A + (size_t)u.pm * 256 * lda); }
    __device__ __forceinline__ const char* b_ptr(const Unit& u) const { return (const char*)(B + (size_t)u.pn * 256 * ldb); }
    __device__ __forceinline__ bool epi(f32x4 (&acc)[2][2][4][2], const Unit& u, int wr, int wc, int fr, int fq) const {
        const int row0 = u.pm * 256 + wr * 64 + fr, col0 = u.pn * 256 + wc * 32 + 4 * fq;
        const float* HF = (const float*)(ws + WS_HF); float* R = (float*)(ws + WS_RB);
#pragma unroll
        for (int ai = 0; ai < 2; ++ai)
#pragma unroll
            for (int m = 0; m < 4; ++m) { const size_t off = (size_t)(row0 + ai * 128 + m * 16) * DM + col0;
#pragma unroll
                for (int bj = 0; bj < 2; ++bj)
#pragma unroll
                    for (int n = 0; n < 2; ++n) { const f32x4 hv = *(const f32x4*)(HF + off + bj * 128 + n * 16); *(f32x4*)(R + off + bj * 128 + n * 16) = hv * ALPHA + acc[ai][bj][m][n]; }
                asm volatile("" ::: "memory"); }
        return false;
    }
};

struct ProbBranch {
    static constexpr bool PERM = true, GATHER = false, KEEPS = true, FP8 = false;
    int K, lda, ldb, G, c; const bf16* A; const bf16* B; unsigned char* ws; int sc_a, sc_b;
    __device__ __forceinline__ bool next(int i, Unit& u) const { u.aux = i & 1; return pg8::static_tile(SEQ / 256, DM / 256, G, c, i >> 1, u.pm, u.pn); }
    __device__ __forceinline__ const char* a_ptr(const Unit& u) const { return (const char*)(A + (size_t)u.pm * 256 * lda + u.aux * 1024); }
    __device__ __forceinline__ const char* b_ptr(const Unit& u) const { return (const char*)(B + (size_t)u.pn * 256 * ldb + u.aux * 1024); }
    __device__ __forceinline__ bool epi(f32x4 (&acc)[2][2][4][2], const Unit& u, int wr, int wc, int fr, int fq) const {
        const int row0 = u.pm * 256 + wr * 64 + fr, ct = u.pn * 256 + wc * 32 + 8 * fq;
        const bf16* Gs = (const bf16*)(ws + WS_GB) + ct; const bf16* Gf = Gs + DM; unsigned char* MG = ws + WS_MG + ct;
        const bool first = u.aux == 0;
#pragma unroll
        for (int ai = 0; ai < 2; ++ai)
#pragma unroll
            for (int m = 0; m < 4; ++m) { const size_t r = (size_t)(row0 + ai * 128 + m * 16);
#pragma unroll
                for (int bj = 0; bj < 2; ++bj) { const u32x4 gf = *(const u32x4*)(Gf + r * G_N + bj * 128);
                    f32x4 f0 = {bflo(gf.x), bfhi(gf.x), bflo(gf.y), bfhi(gf.y)}, f1 = {bflo(gf.z), bfhi(gf.z), bflo(gf.w), bfhi(gf.w)};
                    if (first) { const u32x4 gs = *(const u32x4*)(Gs + r * G_N + bj * 128);
                        const f32x4 s0 = {bflo(gs.x), bfhi(gs.x), bflo(gs.y), bfhi(gs.y)}, s1 = {bflo(gs.z), bfhi(gs.z), bflo(gs.w), bfhi(gs.w)};
#pragma unroll
                        for (int j = 0; j < 4; ++j) { acc[ai][bj][m][0][j] *= s0[j] * __builtin_amdgcn_rcpf(fmaxf(f0[j], 1e-30f)); acc[ai][bj][m][1][j] *= s1[j] * __builtin_amdgcn_rcpf(fmaxf(f1[j], 1e-30f)); } }
                    else { const f32x4 v0 = acc[ai][bj][m][0] * f0 * MG8_SCALE, v1 = acc[ai][bj][m][1] * f1 * MG8_SCALE;
                        u32x2 w; w.x = pk4_fp8(v0[0], v0[1], v0[2], v0[3]); w.y = pk4_fp8(v1[0], v1[1], v1[2], v1[3]);
                        *(u32x2*)(MG + r * DM + bj * 128) = w; } }
                asm volatile("" ::: "memory"); }
        return first;
    }
};
constexpr int IDX_OFF = RING_BYTES + 1024, MOE_MAXU = 3;
struct ProbMoeGU {
    static constexpr bool PERM = true, GATHER = true, KEEPS = false, FP8 = true;
    int K, lda, ldb, G, c, layer; const unsigned char* A; const unsigned char* B; unsigned char* ws; const unsigned* ctl; LAS unsigned char* lds; int sc_a, sc_b;
    __device__ __forceinline__ bool next(int i, Unit& u) const { const int L = i * G + c; u.pm = L >> 3; u.pn = L & 7; int cnt, ps; return moe_find(ctl, layer, u.pm * 256, u.aux, cnt, ps); }
    __device__ __forceinline__ const char* a_ptr(const Unit&) const { return (const char*)A; }
    __device__ __forceinline__ const char* b_ptr(const Unit& u) const { return (const char*)(B + (size_t)u.aux * WGU_E + (size_t)u.pn * 256 * ldb); }
    __device__ __forceinline__ int a_row(int ui, int r) const { return *(const LAS int*)(lds + IDX_OFF + (ui * 256 + r) * 4); }
    __device__ __forceinline__ void fill_idx(int tid) const {
        for (int ui = 0; ui < MOE_MAXU; ++ui) { const int L = ui * G + c; int e, cnt, ps; if (!moe_find(ctl, layer, (L >> 3) * 256, e, cnt, ps)) break;
            if (tid < 256) { const int rank = (L >> 3) * 256 - ps + tid; *(LAS int*)(lds + IDX_OFF + (ui * 256 + tid) * 4) = rank < cnt ? ((const int*)(ws + WS_ELIST))[(size_t)e * MROWS + rank] : 0; } }
        LDS_WAIT(); __syncthreads();
    }
    __device__ __forceinline__ bool epi(f32x4 (&acc)[2][2][4][2], const Unit& u, int wr, int wc, int fr, int fq) const {
        const int row0 = u.pm * 256 + wr * 64 + fr, ct = u.pn * 128 + wc * 32 + 8 * fq; unsigned char* act = ws + WS_ACT + ct;
#pragma unroll
        for (int ai = 0; ai < 2; ++ai)
#pragma unroll
            for (int m = 0; m < 4; ++m) { f32x4 v[2];
#pragma unroll
                for (int n = 0; n < 2; ++n)
#pragma unroll
                    for (int j = 0; j < 4; ++j) { const float g = acc[ai][0][m][n][j]; v[n][j] = g * __builtin_amdgcn_rcpf(1.0f + __builtin_amdgcn_exp2f(-LOG2E * g)) * acc[ai][1][m][n][j]; }
                u32x2 w; w.x = pk4_fp8(v[0][0] * ACT8_SCALE, v[0][1] * ACT8_SCALE, v[0][2] * ACT8_SCALE, v[0][3] * ACT8_SCALE); w.y = pk4_fp8(v[1][0] * ACT8_SCALE, v[1][1] * ACT8_SCALE, v[1][2] * ACT8_SCALE, v[1][3] * ACT8_SCALE);
                *(u32x2*)(act + (size_t)(row0 + ai * 128 + m * 16) * FF) = w; }
        return false;
    }
};
struct ProbMoeDown {
    static constexpr bool PERM = true, GATHER = false, KEEPS = false, FP8 = true;
    int K, lda, ldb, G, c, layer; const unsigned char* A; const unsigned char* B; unsigned char* ws; const unsigned* ctl; int sc_a, sc_b;
    __device__ __forceinline__ bool next(int i, Unit& u) const { const int L = i * G + c; u.pm = L >> 3; u.pn = L & 7; int cnt, ps; return moe_find(ctl, layer, u.pm * 256, u.aux, cnt, ps); }
    __device__ __forceinline__ const char* a_ptr(const Unit& u) const { return (const char*)(A + (size_t)u.pm * 256 * lda); }
    __device__ __forceinline__ const char* b_ptr(const Unit& u) const { return (const char*)(B + (size_t)u.aux * WD_E + (size_t)u.pn * 256 * ldb); }
    __device__ __forceinline__ bool epi(f32x4 (&acc)[2][2][4][2], const Unit& u, int wr, int wc, int fr, int fq) const {
        const int row0 = u.pm * 256 + wr * 64 + fr, ct = u.pn * 256 + wc * 32 + 8 * fq; bf16* O = (bf16*)(ws + WS_OSL) + ct;
#pragma unroll
        for (int ai = 0; ai < 2; ++ai)
#pragma unroll
            for (int m = 0; m < 4; ++m)
#pragma unroll
                for (int bj = 0; bj < 2; ++bj) { const f32x4 v0 = acc[ai][bj][m][0], v1 = acc[ai][bj][m][1];
                    u32x4 w; w.x = pg8::cvt_pk_bf16(v0[0], v0[1]); w.y = pg8::cvt_pk_bf16(v0[2], v0[3]); w.z = pg8::cvt_pk_bf16(v1[0], v1[1]); w.w = pg8::cvt_pk_bf16(v1[2], v1[3]);
                    *(u32x4*)(O + (size_t)(row0 + ai * 128 + m * 16) * DM + bj * 128) = w; }
        return false;
    }
};

#ifndef ATT_DBL
#define ATT_DBL 0
#endif
namespace att {
typedef short bf16x8 __attribute__((ext_vector_type(8)));
typedef short s16x4 __attribute__((ext_vector_type(4)));
typedef float f32x16 __attribute__((ext_vector_type(16)));
constexpr int TILE_B = 16384;
constexpr int L_V = 0, L_K = 3 * TILE_B, L_C2 = 6 * TILE_B, L_WS = L_C2 + 1024, L_ITEM = L_WS + 8 * 256, L_END = L_ITEM + 16;
#define KSWZ(row, colB) ((row) * 256 + ((colB) ^ (((row) & 7) << 4)))
#define SBAR() __builtin_amdgcn_sched_barrier(0)
__device__ __forceinline__ int v_st(int k, int c) { const int kk = (k & ~0xC) | ((k & 4) << 1) | ((k & 8) >> 1); return ((kk >> 3) * 4 + (c >> 5)) * 512 + ((kk & 7) * 32 + (c & 31)) * 2; }
__device__ __forceinline__ int v_rd_base(int lane) { return ((lane & 3) << 3) | (((lane >> 2) & 3) << 6) | (((lane >> 4) & 1) << 5) | (((lane >> 5) & 1) << 8); }
constexpr int v_rd_off(int d0, int ks, int half) { return d0 * 512 + ks * 4096 + half * 2048; }
__device__ __forceinline__ int crow(int r, int hi) { return (r & 3) + 8 * (r >> 2) + 4 * hi; }
__device__ __forceinline__ unsigned cvtpk(float lo, float hi) { unsigned r; asm volatile("v_cvt_pk_bf16_f32 %0, %1, %2" : "=v"(r) : "v"(lo), "v"(hi)); return r; }
__device__ __forceinline__ float xchg_sum(float v) { auto rr = __builtin_amdgcn_permlane32_swap(__float_as_uint(v), __float_as_uint(v), false, false); return __uint_as_float(rr[0]) + __uint_as_float(rr[1]); }
__device__ __forceinline__ float xchg_max(float v) { auto rr = __builtin_amdgcn_permlane32_swap(__float_as_uint(v), __float_as_uint(v), false, false); return fmaxf(__uint_as_float(rr[0]), __uint_as_float(rr[1])); }
#define PK4(P, B_, OUT) do { unsigned a0 = cvtpk(P[B_+0], P[B_+1]), a1 = cvtpk(P[B_+2], P[B_+3]); unsigned b0 = cvtpk(P[B_+4], P[B_+5]), b1 = cvtpk(P[B_+6], P[B_+7]); \
        auto r0 = __builtin_amdgcn_permlane32_swap(a0, b0, false, false); auto r1 = __builtin_amdgcn_permlane32_swap(a1, b1, false, false); \
        u32x4 w = {r0[0], r1[0], r0[1], r1[1]}; OUT = *reinterpret_cast<bf16x8*>(&w); } while (0)
__device__ __forceinline__ void qkt(f32x16& p0, f32x16& p1, const LAS unsigned char* kt, int r32, int hi, const bf16x8* qr) {
    p0 = f32x16{}; p1 = f32x16{};
    const LAS unsigned char* kb[4];
#pragma unroll
    for (int dd = 0; dd < 4; ++dd) kb[dd] = kt + KSWZ(r32, (dd * 16 + hi * 8) * 2);
#pragma unroll
    for (int d0 = 0; d0 < 8; ++d0) { const LAS unsigned char* a = kb[d0 & 3] + (d0 >> 2) * 128;
        const bf16x8 b0 = *(const LAS bf16x8*)(a); const bf16x8 b1 = *(const LAS bf16x8*)(a + 32 * 256);
        p0 = __builtin_amdgcn_mfma_f32_32x32x16_bf16(b0, qr[d0], p0, 0, 0, 0);
        p1 = __builtin_amdgcn_mfma_f32_32x32x16_bf16(b1, qr[d0], p1, 0, 0, 0); }
}
__device__ __forceinline__ void pv_tile(f32x16* o, unsigned vb0, bf16x8 pa0, bf16x8 pa1, bf16x8 pa2, bf16x8 pa3) {
#define TRRD(dst, off) asm volatile("ds_read_b64_tr_b16 %0, %1 offset:%2" : "=&v"(dst) : "v"(vb0), "i"(off) : "memory")
#define PV_D0(d0) do { s16x4 l0, l1, l2, l3, h0, h1, h2, h3; constexpr int b_ = v_rd_off(d0, 0, 0); \
        TRRD(l0, b_); TRRD(h0, b_ + 2048); TRRD(l1, b_ + 4096); TRRD(h1, b_ + 6144); TRRD(l2, b_ + 8192); TRRD(h2, b_ + 10240); TRRD(l3, b_ + 12288); TRRD(h3, b_ + 14336); \
        asm volatile("s_waitcnt lgkmcnt(0)" ::: "memory"); SBAR(); \
        o[d0] = __builtin_amdgcn_mfma_f32_32x32x16_bf16(pa0, (bf16x8){l0[0], l0[1], l0[2], l0[3], h0[0], h0[1], h0[2], h0[3]}, o[d0], 0, 0, 0); \
        o[d0] = __builtin_amdgcn_mfma_f32_32x32x16_bf16(pa1, (bf16x8){l1[0], l1[1], l1[2], l1[3], h1[0], h1[1], h1[2], h1[3]}, o[d0], 0, 0, 0); \
        o[d0] = __builtin_amdgcn_mfma_f32_32x32x16_bf16(pa2, (bf16x8){l2[0], l2[1], l2[2], l2[3], h2[0], h2[1], h2[2], h2[3]}, o[d0], 0, 0, 0); \
        o[d0] = __builtin_amdgcn_mfma_f32_32x32x16_bf16(pa3, (bf16x8){l3[0], l3[1], l3[2], l3[3], h3[0], h3[1], h3[2], h3[3]}, o[d0], 0, 0, 0); } while (0)
    PV_D0(0); PV_D0(1); PV_D0(2); PV_D0(3);
#undef PV_D0
#undef TRRD
}
#define VIS(cc) (((dqh) - (cc)) >= NEED && (cc) < (nvh))
__device__ __forceinline__ void sb_tile(f32x16& p0, f32x16& p1, float& carry, bool domask, int dqh, int nvh, int hi, bf16x8& pa0, bf16x8& pa1, bf16x8& pa2, bf16x8& pa3) {
    constexpr int NEED = 1;
    f32x16 x0, x1;
#pragma unroll
    for (int r = 0; r < 16; ++r) {
        { const float u = __builtin_amdgcn_fmed3f(p0[r], -126.f, 126.f), b = __builtin_amdgcn_logf(1.0f + __builtin_amdgcn_exp2f(-u)); x0[r] = -b; p0[r] = -u - b; }
        { const float u = __builtin_amdgcn_fmed3f(p1[r], -126.f, 126.f), b = __builtin_amdgcn_logf(1.0f + __builtin_amdgcn_exp2f(-u)); x1[r] = -b; p1[r] = -u - b; } }
    if (domask) { const float NEG = -__builtin_inff();
#pragma unroll
        for (int r = 0; r < 16; ++r) { const int cc = (r & 3) + 8 * (r >> 2);
            if (!VIS(cc)) { p0[r] = 0.f; x0[r] = NEG; }
            if (!VIS(cc + 32)) { p1[r] = 0.f; x1[r] = NEG; } } }
    float A[9]; A[8] = 0.f;
#pragma unroll
    for (int g = 3; g >= 0; --g) A[4 + g] = A[5 + g] + ((p1[4 * g] + p1[4 * g + 1]) + (p1[4 * g + 2] + p1[4 * g + 3]));
#pragma unroll
    for (int g = 3; g >= 0; --g) A[g] = A[1 + g] + ((p0[4 * g] + p0[4 * g + 1]) + (p0[4 * g + 2] + p0[4 * g + 3]));
    float off[8];
#pragma unroll
    for (int i = 0; i < 8; ++i) { auto rr = __builtin_amdgcn_permlane32_swap(__float_as_uint(A[i]), __float_as_uint(A[i + 1]), false, false);
        const float recv = hi ? __uint_as_float(rr[0]) : __uint_as_float(rr[1]); off[i] = carry + A[i + 1] + recv; }
    carry += xchg_sum(A[0]);
#pragma unroll
    for (int g = 0; g < 4; ++g) {
        { float af = off[g]; const float l3 = p0[4 * g + 3], l2 = p0[4 * g + 2], l1 = p0[4 * g + 1];
          x0[4 * g + 3] = __builtin_amdgcn_exp2f(x0[4 * g + 3] + af); af += l3; x0[4 * g + 2] = __builtin_amdgcn_exp2f(x0[4 * g + 2] + af); af += l2;
          x0[4 * g + 1] = __builtin_amdgcn_exp2f(x0[4 * g + 1] + af); af += l1; x0[4 * g] = __builtin_amdgcn_exp2f(x0[4 * g] + af); }
        { float af = off[4 + g]; const float l3 = p1[4 * g + 3], l2 = p1[4 * g + 2], l1 = p1[4 * g + 1];
          x1[4 * g + 3] = __builtin_amdgcn_exp2f(x1[4 * g + 3] + af); af += l3; x1[4 * g + 2] = __builtin_amdgcn_exp2f(x1[4 * g + 2] + af); af += l2;
          x1[4 * g + 1] = __builtin_amdgcn_exp2f(x1[4 * g + 1] + af); af += l1; x1[4 * g] = __builtin_amdgcn_exp2f(x1[4 * g] + af); } }
    PK4(x0, 0, pa0); PK4(x0, 8, pa1); PK4(x1, 0, pa2); PK4(x1, 8, pa3);
}
__device__ __forceinline__ float fox_tile(f32x16& p0, f32x16& p1, const LAS float* c2t, float& m_reg, float& l_reg, bool domask, int dqh, int nvh, int hi, bf16x8& pa0, bf16x8& pa1, bf16x8& pa2, bf16x8& pa3) {
    constexpr int NEED = 0;
#pragma unroll
    for (int g = 0; g < 4; ++g) { const f32x4 c0 = *(const LAS f32x4*)(c2t + 8 * g + 4 * hi), c1 = *(const LAS f32x4*)(c2t + 32 + 8 * g + 4 * hi);
#pragma unroll
        for (int j = 0; j < 4; ++j) { p0[4 * g + j] -= c0[j]; p1[4 * g + j] -= c1[j]; } }
    if (domask) { const float NEG = -__builtin_inff();
#pragma unroll
        for (int r = 0; r < 16; ++r) { const int cc = (r & 3) + 8 * (r >> 2);
            if (!VIS(cc)) p0[r] = NEG;
            if (!VIS(cc + 32)) p1[r] = NEG; } }
    float pmax = p0[0];
#pragma unroll
    for (int r = 1; r < 16; ++r) pmax = fmaxf(pmax, p0[r]);
#pragma unroll
    for (int r = 0; r < 16; ++r) pmax = fmaxf(pmax, p1[r]);
    pmax = xchg_max(pmax);
    const float mn = fmaxf(m_reg, pmax), alpha = __builtin_amdgcn_exp2f(m_reg - mn); m_reg = mn;
    float ps = 0.f;
#pragma unroll
    for (int r = 0; r < 16; ++r) { p0[r] = __builtin_amdgcn_exp2f(p0[r] - mn); p1[r] = __builtin_amdgcn_exp2f(p1[r] - mn); ps += p0[r] + p1[r]; }
    l_reg = l_reg * alpha + xchg_sum(ps);
    PK4(p0, 0, pa0); PK4(p0, 8, pa1); PK4(p1, 0, pa2); PK4(p1, 8, pa3);
    return alpha;
}
#undef VIS
template <int TYPE>
__device__ __forceinline__ void attn_unit(LAS unsigned char* lds, unsigned char* ws, int head, int qb) {
    const int tid = threadIdx.x, wid = __builtin_amdgcn_readfirstlane(tid >> 6), lane = tid & 63, r32 = lane & 31, hi = lane >> 5;
    const bool grpY = wid >= 4;
    const bf16* QKV = (const bf16*)(ws + WS_QKV);
    const int qcol = (TYPE ? 3072 : 0) + head * HD, kcol = qcol + 1024, vcol = qcol + 2048;
    const float* fsuf = (const float*)(ws + WS_CUM) + (size_t)head * MROWS; const float* ftot = (const float*)(ws + WS_CUM) + (size_t)NHEAD * MROWS + head * 256;
    float fcarry = 0.f, st_tot = 0.f;
    const int qrow0 = qb * 256, NT = qb < 32 ? 4 * qb + 5 : 1;
    const int qbase = qb < 32 ? qrow0 : -NMETA;
    const int qlo = qbase + wid * 32, qpos = qlo + r32;
    LAS unsigned char* V_lds = lds + L_V; LAS unsigned char* K_lds = lds + L_K; LAS float* c2_lds = (LAS float*)(lds + L_C2);
    LAS float* wsl = (LAS float*)(lds + L_WS) + wid * 64;
    bf16x8 qr[8];
#pragma unroll
    for (int d0 = 0; d0 < 8; ++d0) qr[d0] = *(const bf16x8*)(QKV + (size_t)(qrow0 + wid * 32 + r32) * QKV_N + qcol + d0 * 16 + hi * 8);
    const int sr = tid >> 4, sc = (tid & 15) * 8, vst0 = v_st(sr, sc), vst1 = v_st(32 + sr, sc), kws = KSWZ(sr, sc * 2);
    const unsigned vrd = (unsigned)(size_t)V_lds + (unsigned)v_rd_base(lane);
    bf16x8 st_k0, st_k1, st_v0, st_v1; float st_c = 0.f;
#define TISMETA(t) ((t) == NT - 1)
#define SLOAD(t) do { const int row_ = TISMETA(t) ? SEQ : 64 * (4 * qb + 3 - (t)); const bf16* kp_ = QKV + (size_t)(row_ + sr) * QKV_N + sc; \
        st_k0 = *(const bf16x8*)(kp_ + kcol); st_k1 = *(const bf16x8*)(kp_ + (size_t)32 * QKV_N + kcol); st_v0 = *(const bf16x8*)(kp_ + vcol); st_v1 = *(const bf16x8*)(kp_ + (size_t)32 * QKV_N + vcol); \
        if (TYPE == 1 && tid < 64) { st_c = fsuf[row_ + tid]; st_tot = ftot[row_ >> 6]; } } while (0)
#define SWRITE(bo) do { *(LAS bf16x8*)(K_lds + (bo) + kws) = st_k0; *(LAS bf16x8*)(K_lds + (bo) + kws + 32 * 256) = st_k1; \
        *(LAS bf16x8*)(V_lds + (bo) + vst0) = st_v0; *(LAS bf16x8*)(V_lds + (bo) + vst1) = st_v1; if (TYPE == 1 && tid < 64) { c2_lds[((bo) >> 8) + tid] = -(fcarry + st_c); fcarry += st_tot; } } while (0)
#define BAR() asm volatile("s_waitcnt lgkmcnt(0)\n\ts_barrier" ::: "memory")
    SLOAD(0); SWRITE(0);
    if (NT > 1) { SLOAD(1); SWRITE(TILE_B); }
    __builtin_amdgcn_s_waitcnt(0x0F70);
    if (NT > 2) SLOAD(2);
    BAR();
    if (grpY) BAR();
    f32x16 o[4] = {}; float carry = 0.f, m_reg = -1e30f, l_reg = 0.f;
    constexpr int NEEDW = TYPE == 0 ? 1 : 0;
#define KBASE(t) (TISMETA(t) ? -NMETA : 64 * (4 * qb + 3 - (t)))
#define ACTW(t) ((qlo + 31 - KBASE(t)) >= NEEDW && (qb < 32 || wid == 0))
    f32x16 p0, p1;
    if (ACTW(0)) qkt(p0, p1, K_lds, r32, hi, qr);
    int bo = 0, bo1 = TILE_B, bo2 = 2 * TILE_B;
    for (int t = 0; t < NT; ++t) {
        BAR();
        const int kbase = KBASE(t), nvalid = TISMETA(t) ? NMETA : 64;
        const bool actw = ACTW(t);
        const bool domask = (qlo - (kbase + 63) < NEEDW) || nvalid < 64;
        bf16x8 pa0, pa1, pa2, pa3;
        if (actw) {
            const int dqh = qpos - kbase - 4 * hi, nvh = nvalid - 4 * hi;
            if (TYPE == 0) sb_tile(p0, p1, carry, domask, dqh, nvh, hi, pa0, pa1, pa2, pa3);
            else { const float alpha = fox_tile(p0, p1, c2_lds + (bo >> 8), m_reg, l_reg, domask, dqh, nvh, hi, pa0, pa1, pa2, pa3);
                if (__any(alpha < 1.f)) { if (hi == 0) wsl[r32] = alpha; asm volatile("s_waitcnt lgkmcnt(0)" ::: "memory");
#pragma unroll
                    for (int r = 0; r < 16; ++r) { const float al = wsl[crow(r, hi)];
#pragma unroll
                        for (int d = 0; d < 4; ++d) o[d][r] *= al; } } }
        }
        BAR();
        if (t + 2 < NT) SWRITE(bo2);
        if (t + 3 < NT) SLOAD(t + 3);
        if (actw) pv_tile(o, vrd + bo, pa0, pa1, pa2, pa3);
        if (t + 1 < NT) { if (ACTW(t + 1)) qkt(p0, p1, K_lds + bo1, r32, hi, qr); }
        { const int tmp = bo; bo = bo1; bo1 = bo2; bo2 = tmp; }
    }
    if (!grpY) BAR();
    float rli[16];
    if (TYPE == 1) { if (hi == 0) wsl[32 + r32] = l_reg; asm volatile("s_waitcnt lgkmcnt(0)" ::: "memory");
#pragma unroll
        for (int r = 0; r < 16; ++r) rli[r] = __builtin_amdgcn_rcpf(wsl[32 + crow(r, hi)]); }
    bf16* Yw = (bf16*)(ws + WS_YB) + (size_t)(qrow0 + wid * 32) * DM + TYPE * 1024 + head * HD;
    if (qb < 32 || wid == 0)
#pragma unroll
    for (int r = 0; r < 16; ++r) { const int orow = crow(r, hi);
#pragma unroll
        for (int d0 = 0; d0 < 4; ++d0) { const float v = TYPE == 1 ? o[d0][r] * rli[r] : o[d0][r]; const float vn = __shfl_xor(v, 1);
            if ((r32 & 1) == 0) *(unsigned*)(Yw + (size_t)orow * DM + d0 * 32 + r32) = cvtpk(v, vn); } }
#undef TISMETA
#undef SLOAD
#undef SWRITE
#undef BAR
#undef KBASE
#undef ACTW
}
constexpr int CW_ATTNQ = 3072;
__device__ __forceinline__ void attn_phase(LAS unsigned char* lds, unsigned char* ws, unsigned* ctl, int layer, int G, int qoff) {
    const int NI = 512 + (layer == 0 ? 16 : 0);
    LAS int* itemw = (LAS int*)(lds + L_ITEM);
    int it = blockIdx.x;
    while (it < NI) {
        int qb, th; if (it < 512) { qb = 31 - (it >> 4); th = it & 15; } else { qb = 32; th = it - 512; }
        if (th < 8) attn_unit<0>(lds, ws, th, qb); else attn_unit<1>(lds, ws, th - 8, qb);
        __syncthreads();
        if (threadIdx.x == 0) *itemw = G + (int)atomicAdd(ctl + CW_ATTNQ + layer * 64 + qoff, 1u);
        asm volatile("s_waitcnt lgkmcnt(0)" ::: "memory"); __syncthreads();
        it = __builtin_amdgcn_readfirstlane(*itemw);
    }
}
#undef KSWZ
#undef SBAR
#undef PK4
}

__global__ void __launch_bounds__(NTHREADS, 2) mk_fwd(Args args) {
    extern __shared__ __attribute__((aligned(16))) unsigned char lds_raw[];
    Frame F;
    F.lds = (LAS unsigned char*)lds_raw; F.ws = args.ws; F.ctl = (unsigned*)(args.ws + WS_CTL);
    F.tid = threadIdx.x; F.lane = F.tid & 63; F.wave = __builtin_amdgcn_readfirstlane(F.tid >> 6);
    F.G = gridDim.x; F.gw = blockIdx.x * NWAVES + F.wave; F.NGW = F.G * NWAVES;
#pragma unroll
    for (int i = 0; i < 18; ++i) F.in[i] = args.in[i];
    F.out = args.out;
    volatile LAS unsigned* MISC = (volatile LAS unsigned*)(F.lds + MISC_OFF);
    for (int u = F.tid; u < (LDS_BYTES - RING_BYTES) / 4; u += NTHREADS) ((LAS unsigned*)(F.lds + RING_BYTES))[u] = 0u;
    __syncthreads();
    XcdBarrier bar = xcd_barrier_post(F.ctl + CW_BAR + args.li * XCD_BAR_WORDS, MISC + 8);
    const int lo = args.ph_lo, hi = args.ph_hi; const unsigned naive = args.naive;
#define IN(k) (lo <= (k) && (k) < hi)
#define SEAM(k) do { if (IN(k) && IN((k) + 1)) { xcd_barrier(bar); if ((DBL_MASK >> 9) & 1u) xcd_barrier(bar); } } while (0)
#define NAIVE(t) ((naive >> (t)) & 1u)
    if (IN(0)) { phase_prologue(F); SEAM(0); }
#define LAYER_PHASES(l, pb) do { \
        if (IN(pb + PH_A)) { phase_cumsum(F, NAIVE(PH_B)); if (!NAIVE(PH_B)) phase_tilesuf(F); \
            if (!NAIVE(PH_A)) { skinny16_f8(F.lds, F.ws + WS_H8 + (size_t)SEQ * DM, DM, F.ws + WS_WIN + l * WIN_L, DM, DM, INP_N, SC_H, SC_W, SkinnyInProj{F.ws}); \
              ProbInProj P{DM, DM, DM, F.G, (int)blockIdx.x, F.ws + WS_H8, F.ws + WS_WIN + l * WIN_L, F.ws, SC_H, SC_W}; pg8::gemm_phase(F.lds, P); if ((DBL_MASK >> PH_A) & 1u) pg8::gemm_phase(F.lds, P); } \
            SEAM(pb + PH_A); } \
        if (IN(pb + PH_B)) { \
            if (!NAIVE(PH_B)) { att::attn_phase(F.lds, F.ws, F.ctl, l, F.G, 0); if ((DBL_MASK >> PH_B) & 1u) att::attn_phase(F.lds, F.ws, F.ctl, l, F.G, 32); } \
            SEAM(pb + PH_B); } \
        if (IN(pb + PH_C)) { \
            if (!NAIVE(PH_C)) { if (l == 0) skinny16(F.lds, (const bf16*)(F.ws + WS_YB) + (size_t)SEQ * DM, DM, (const bf16*)(F.ws + WS_WB + l * WB_L), DM, DM, DM, SkinnyBranch{F.ws}); \
              ProbBranch P{1024, DM, DM, F.G, (int)blockIdx.x, (const bf16*)(F.ws + WS_YB), (const bf16*)(F.ws + WS_WB + l * WB_L), F.ws, 0, 0}; pg8::gemm_phase(F.lds, P); if ((DBL_MASK >> PH_C) & 1u) pg8::gemm_phase(F.lds, P); } \
            SEAM(pb + PH_C); } \
        if (IN(pb + PH_D)) { \
            if (!NAIVE(PH_D)) { if (l == 0) skinny16_f8(F.lds, F.ws + WS_MG + (size_t)SEQ * DM, DM, F.ws + WS_WOUT + l * WOUT_L, DM, DM, DM, SC_MG, SC_W, SkinnyOut{F.ws}); \
              ProbOutProj P{DM, DM, DM, F.G, (int)blockIdx.x, F.ws + WS_MG, F.ws + WS_WOUT + l * WOUT_L, F.ws, SC_MG, SC_W}; pg8::gemm_phase(F.lds, P); if ((DBL_MASK >> PH_D) & 1u) pg8::gemm_phase(F.lds, P); } \
            SEAM(pb + PH_D); } \
        if (IN(pb + PH_E)) { if ((DBL_MASK >> PH_E) & 1u) phase_ln_router(F, l, true); phase_ln_router(F, l); SEAM(pb + PH_E); } \
        if (IN(pb + PH_F)) { \
            if (!NAIVE(PH_F)) { ProbMoeGU P{DM, DM, DM, F.G, (int)blockIdx.x, l, F.ws + WS_H8, F.ws + WS_WGU + l * WGU_L, F.ws, F.ctl, F.lds, SC_H, SC_W}; P.fill_idx(F.tid); pg8::gemm_phase(F.lds, P); if ((DBL_MASK >> PH_F) & 1u) pg8::gemm_phase(F.lds, P); } \
            SEAM(pb + PH_F); } \
        if (IN(pb + PH_G)) { \
            if (!NAIVE(PH_G)) { ProbMoeDown P{FF, FF, FF, F.G, (int)blockIdx.x, l, F.ws + WS_ACT, F.ws + WS_WD + l * WD_L, F.ws, F.ctl, SC_ACT, SC_W}; pg8::gemm_phase(F.lds, P); if ((DBL_MASK >> PH_G) & 1u) pg8::gemm_phase(F.lds, P); } \
            SEAM(pb + PH_G); } \
        if (IN(pb + PH_H)) { if ((DBL_MASK >> PH_H) & 1u) phase_ln_final(F, l, true); phase_ln_final(F, l); SEAM(pb + PH_H); } \
    } while (0)
    LAYER_PHASES(0, 1);
    LAYER_PHASES(1, 9);
#undef LAYER_PHASES
#undef IN
#undef SEAM
#undef NAIVE
}

#ifndef NAIVE_MASK
#define NAIVE_MASK 0x00u
#endif
static void launch_naive(int type, int layer, const Args& a, hipStream_t stream) {
    switch (type) {
    case PH_A: hipLaunchKernelGGL(naive_inproj, dim3(INP_N / 256, MROWS / 4), dim3(256), 0, stream, a, layer); break;
    case PH_B: { const int nq = NTOK; hipLaunchKernelGGL(naive_attn, dim3((16 * nq + 3) / 4), dim3(256), 0, stream, a, nq); } break;
    case PH_C: hipLaunchKernelGGL(naive_branch, dim3(DM / 256, MROWS / 4), dim3(256), 0, stream, a, layer); break;
    case PH_D: hipLaunchKernelGGL(naive_outproj, dim3(DM / 256, MROWS / 4), dim3(256), 0, stream, a, layer); break;
    case PH_F: hipLaunchKernelGGL(naive_moe_gu, dim3(FF / 256, NSLOT_MAX / 4), dim3(256), 0, stream, a, layer); break;
    case PH_G: hipLaunchKernelGGL(naive_moe_down, dim3(DM / 256, NSLOT_MAX / 4), dim3(256), 0, stream, a, layer); break;
    default: break;
    }
}
extern "C" void kernel_launch(void* const* d_in, const int* in_sizes, int n_in, void* d_out, int out_size, void* d_ws, size_t ws_size, hipStream_t stream) {
    static int grid = 0;
    if (grid == 0) {
        if (n_in != 18 || out_size != SEQ * DM || ws_size < WS_END) { fprintf(stderr, "kernel_launch: unexpected shapes (n_in %d out %d ws %zu)\n", n_in, out_size, ws_size); grid = -1; return; }
        int dev = 0, cus = 0;
        if (hipGetDevice(&dev) != hipSuccess || hipDeviceGetAttribute(&cus, hipDeviceAttributeMultiprocessorCount, dev) != hipSuccess) { grid = -1; return; }
        if (hipFuncSetAttribute((const void*)mk_fwd, hipFuncAttributeMaxDynamicSharedMemorySize, LDS_BYTES) != hipSuccess) { fprintf(stderr, "kernel_launch: hipFuncSetAttribute failed\n"); grid = -1; return; }
        int per_cu = 0;
        if (hipOccupancyMaxActiveBlocksPerMultiprocessor(&per_cu, (const void*)mk_fwd, NTHREADS, LDS_BYTES) != hipSuccess || per_cu < 1) fprintf(stderr, "kernel_launch: occupancy query says %d\n", per_cu);
        (void)hipGetLastError();
        grid = cus;
    }
    if (grid < 0) return;
    (void)hipMemsetAsync((char*)d_ws + WS_CTL, 0, CTL_ZERO_BYTES, stream);
    Args a{};
    for (int i = 0; i < 18; ++i) a.in[i] = (const float*)d_in[i];
    a.out = (float*)d_out; a.ws = (unsigned char*)d_ws; a.naive = NAIVE_MASK;
    int li = 0, lo = 0;
    auto flush = [&](int hi) { if (hi > lo) { a.ph_lo = lo; a.ph_hi = hi; a.li = li++; hipLaunchKernelGGL(mk_fwd, dim3(grid), dim3(NTHREADS), LDS_BYTES, stream, a); } lo = hi; };
    for (int ph = 1; ph < NPHASE; ++ph) {
        const int type = (ph - 1) & 7, layer = (ph - 1) >> 3;
        if ((NAIVE_MASK >> type) & 1u) {
            if (type == PH_A) flush(ph + 1); else { flush(ph); lo = ph + 1; }
            launch_naive(type, layer, a, stream); }
    }
    flush(NPHASE);
}
```

```cpp
#include <hip/hip_runtime.h>
#include <cstdio>
#include <cstdint>

#define GAS __attribute__((address_space(1)))
#define LAS __attribute__((address_space(3)))
typedef unsigned short bf16;
typedef float f32x4 __attribute__((ext_vector_type(4)));
typedef float f32x2 __attribute__((ext_vector_type(2)));
typedef unsigned u32x4 __attribute__((ext_vector_type(4)));
typedef unsigned u32x2 __attribute__((ext_vector_type(2)));
typedef GAS unsigned gu32;

constexpr int DM = 2048, SEQ = 8192, NMETA = 16, NTOK = SEQ + NMETA, MROWS = 8448;
constexpr int HD = 128, NHEAD = 8;
constexpr int QKV_N = 6144, G_N = 4096, INP_N = 10240, INP_SRC = 10248, FCOL = 6144;
constexpr int NE = 16, FF = 1024, NSLOT_MAX = 20480;
constexpr float ALPHA = 1.4142135623730951f, LN_EPS = 1e-5f;
constexpr float LOG2E = 1.4426950408889634f;
constexpr float QSCALE = 0.08838834764831845f * 1.4426950408889634f;
constexpr int NLAYER = 2, NPHASE = 1 + 8 * NLAYER;
enum { PH_A = 0, PH_B = 1, PH_C = 2, PH_D = 3, PH_E = 4, PH_F = 5, PH_G = 6, PH_H = 7 };

#ifndef NAIVE_MASK
#define NAIVE_MASK 0x00u
#endif
#ifndef DBL_MASK
#define DBL_MASK 0u
#endif
constexpr size_t MiB = 1u << 20;
constexpr size_t WS_CTL = 0, CTL_ZERO_BYTES = 1 * MiB;
constexpr size_t WS_WIN = 2 * MiB, WIN_L = 40 * MiB;
constexpr size_t WS_WB = 82 * MiB, WB_L = 8 * MiB;
constexpr size_t WS_WOUT = 98 * MiB, WOUT_L = 8 * MiB;
constexpr size_t WS_WGU = 114 * MiB, WGU_L = 128 * MiB, WGU_E = 8 * MiB;
constexpr size_t WS_WD = 370 * MiB, WD_L = 64 * MiB, WD_E = 4 * MiB;
constexpr size_t WS_HF = 498 * MiB;
constexpr size_t WS_HB = 564 * MiB;
constexpr size_t WS_RB = 597 * MiB;
constexpr size_t WS_QKV = 663 * MiB;
constexpr size_t WS_GB = 762 * MiB;
constexpr size_t WS_YB = 828 * MiB;
constexpr size_t WS_MG = 861 * MiB;
constexpr size_t WS_ACT = 663 * MiB;
constexpr size_t WS_OSL = 703 * MiB;
constexpr size_t WS_LOGF = 894 * MiB;
constexpr size_t WS_CUM = 895 * MiB;
constexpr size_t WS_ELIST = 896 * MiB;
constexpr size_t WS_TOKI = 897 * MiB;
constexpr size_t WS_H8 = 898 * MiB;
constexpr size_t WS_END = 916 * MiB;
constexpr int CW_CNT = 1024;
constexpr int CW_BAR = 8192;
#define XCD_BAR_WORDS 3456
constexpr int MAX_LAUNCH = 20;
static_assert((CW_BAR + MAX_LAUNCH * XCD_BAR_WORDS) * 4 <= (int)CTL_ZERO_BYTES, "ctl");

constexpr int NWAVES = 8, NTHREADS = 512;
constexpr int RING_BYTES = 131072, MISC_OFF = RING_BYTES + 320, LDS_BYTES = 147456;

constexpr float W8_SCALE = 64.f, H8_SCALE = 4.f, MG8_SCALE = 16.f, ACT8_SCALE = 4.f;
constexpr int SC_W = 0x79797979, SC_H = 0x7D7D7D7D, SC_MG = 0x7B7B7B7B, SC_ACT = 0x7D7D7D7D;
__device__ __forceinline__ unsigned f2bf(float f) { unsigned u = __builtin_bit_cast(unsigned, f); return (u + 0x7fffu + ((u >> 16) & 1u)) >> 16; }
__device__ __forceinline__ unsigned pk2(float lo, float hi) { return f2bf(lo) | (f2bf(hi) << 16); }
__device__ __forceinline__ unsigned pk4_fp8(float a, float b, float c, float d) {
    a = __builtin_amdgcn_fmed3f(a, -448.f, 448.f); b = __builtin_amdgcn_fmed3f(b, -448.f, 448.f); c = __builtin_amdgcn_fmed3f(c, -448.f, 448.f); d = __builtin_amdgcn_fmed3f(d, -448.f, 448.f);
    int w = 0; w = __builtin_amdgcn_cvt_pk_fp8_f32(a, b, w, false); w = __builtin_amdgcn_cvt_pk_fp8_f32(c, d, w, true); return (unsigned)w; }
__device__ __forceinline__ float bflo(unsigned w) { return __builtin_bit_cast(float, w << 16); }
__device__ __forceinline__ float bfhi(unsigned w) { return __builtin_bit_cast(float, w & 0xffff0000u); }
__device__ __forceinline__ float bf2f(bf16 b) { return __builtin_bit_cast(float, ((unsigned)b) << 16); }
__device__ __forceinline__ float wave_sum(float v) {
#pragma unroll
    for (int o = 1; o < 64; o <<= 1) v += __shfl_xor(v, o);
    return v;
}
__device__ __forceinline__ float wave_max(float v) {
#pragma unroll
    for (int o = 1; o < 64; o <<= 1) v = fmaxf(v, __shfl_xor(v, o));
    return v;
}
__device__ __forceinline__ int row_of_p(int p) { return p < NMETA ? SEQ + p : p - NMETA; }
__device__ __forceinline__ float sigmoidf_(float x) { return 1.0f / (1.0f + __expf(-x)); }
__device__ __forceinline__ float dot8(u32x4 a, u32x4 b, float acc) {
    acc = fmaf(bflo(a.x), bflo(b.x), acc); acc = fmaf(bfhi(a.x), bfhi(b.x), acc);
    acc = fmaf(bflo(a.y), bflo(b.y), acc); acc = fmaf(bfhi(a.y), bfhi(b.y), acc);
    acc = fmaf(bflo(a.z), bflo(b.z), acc); acc = fmaf(bfhi(a.z), bfhi(b.z), acc);
    acc = fmaf(bflo(a.w), bflo(b.w), acc); acc = fmaf(bfhi(a.w), bfhi(b.w), acc);
    return acc;
}

struct Args { const float* in[18]; float* out; unsigned char* ws; int ph_lo, ph_hi; unsigned naive; int li; };
enum { I_X = 0, I_META, I_LNIN_G, I_LNIN_B, I_WIN, I_BF, I_WBSB, I_WBFX, I_WOUT, I_LNMIX_G, I_LNMIX_B, I_WR, I_RB, I_WG, I_WU, I_WD, I_LNFFN_G, I_LNFFN_B };

__device__ __forceinline__ int moe_cnt(const unsigned* ctl, int layer, int e) { return (int)ctl[CW_CNT + (layer * NE + e) * 64]; }
__device__ __forceinline__ bool moe_find(const unsigned* ctl, int layer, int s0, int& e_out, int& cnt_out, int& ps_out) {
    int acc = 0; e_out = -1; cnt_out = 0; ps_out = 0;
#pragma unroll
    for (int e = 0; e < NE; ++e) { const int c = moe_cnt(ctl, layer, e), nb = (c + 255) >> 8;
        if (e_out < 0 && s0 < (acc + nb) * 256) { e_out = e; cnt_out = c; ps_out = acc * 256; }
        acc += nb; }
    return e_out >= 0;
}
__device__ __forceinline__ int moe_pstart(const unsigned* ctl, int layer, int ex) {
    int acc = 0, r = 0;
#pragma unroll
    for (int e = 0; e < NE; ++e) { const int c = moe_cnt(ctl, layer, e); if (e == ex) r = acc * 256; acc += (c + 255) >> 8; }
    return r;
}

__device__ __forceinline__ void inproj_store(unsigned char* ws, int row, int n, float v) {
    if (n < QKV_N) { const bool isq = (n < 1024) || (n >= 3072 && n < 4096); ((bf16*)(ws + WS_QKV))[(size_t)row * QKV_N + n] = (bf16)f2bf(isq ? v * QSCALE : v); }
    else ((bf16*)(ws + WS_GB))[(size_t)row * G_N + (n - QKV_N)] = (bf16)f2bf(sigmoidf_(v));
}

__device__ __forceinline__ void dot4(const bf16* a0, const bf16* a1, const bf16* a2, const bf16* a3, const bf16* b, int K, float (&acc)[4]) {
    for (int k = 0; k < K; k += 8) {
        const u32x4 bv = *(const u32x4*)(b + k);
        acc[0] = dot8(*(const u32x4*)(a0 + k), bv, acc[0]); acc[1] = dot8(*(const u32x4*)(a1 + k), bv, acc[1]);
        acc[2] = dot8(*(const u32x4*)(a2 + k), bv, acc[2]); acc[3] = dot8(*(const u32x4*)(a3 + k), bv, acc[3]);
    }
}
__global__ void __launch_bounds__(256) naive_inproj(Args a, int layer) {
    const int n = blockIdx.x * 256 + threadIdx.x, r0 = blockIdx.y * 4;
    const bf16* A = (const bf16*)(a.ws + WS_HB) + (size_t)r0 * DM; const bf16* B = (const bf16*)(a.ws + WS_WIN + layer * WIN_L) + (size_t)n * DM;
    float acc[4] = {0.f, 0.f, 0.f, 0.f};
    dot4(A, A + DM, A + 2 * DM, A + 3 * DM, B, DM, acc);
    for (int i = 0; i < 4; ++i) inproj_store(a.ws, r0 + i, n, acc[i]);
}
__global__ void __launch_bounds__(256) naive_branch(Args a, int layer) {
    const int n = blockIdx.x * 256 + threadIdx.x, r0 = blockIdx.y * 4;
    const bf16* A = (const bf16*)(a.ws + WS_YB) + (size_t)r0 * DM; const bf16* B = (const bf16*)(a.ws + WS_WB + layer * WB_L) + (size_t)n * DM;
    float s[4] = {0.f, 0.f, 0.f, 0.f}, f[4] = {0.f, 0.f, 0.f, 0.f};
    dot4(A, A + DM, A + 2 * DM, A + 3 * DM, B, 1024, s);
    dot4(A + 1024, A + DM + 1024, A + 2 * DM + 1024, A + 3 * DM + 1024, B + 1024, 1024, f);
    const bf16* G = (const bf16*)(a.ws + WS_GB);
    for (int i = 0; i < 4; ++i) { const size_t r = r0 + i; const float gs = bf2f(G[r * G_N + n]), gf = bf2f(G[r * G_N + DM + n]);
        ((bf16*)(a.ws + WS_MG))[r * DM + n] = (bf16)f2bf(gs * s[i] + gf * f[i]); }
}
__global__ void __launch_bounds__(256) naive_outproj(Args a, int layer) {
    const int n = blockIdx.x * 256 + threadIdx.x, r0 = blockIdx.y * 4;
    const bf16* A = (const bf16*)(a.ws + WS_MG) + (size_t)r0 * DM; const bf16* B = (const bf16*)(a.ws + WS_WOUT + layer * WOUT_L) + (size_t)n * DM;
    float acc[4] = {0.f, 0.f, 0.f, 0.f};
    dot4(A, A + DM, A + 2 * DM, A + 3 * DM, B, DM, acc);
    const float* HF = (const float*)(a.ws + WS_HF); float* R = (float*)(a.ws + WS_RB);
    for (int i = 0; i < 4; ++i) { const size_t o = (size_t)(r0 + i) * DM + n; R[o] = ALPHA * HF[o] + acc[i]; }
}
__global__ void __launch_bounds__(256) naive_moe_gu(Args a, int layer) {
    const int j = blockIdx.x * 256 + threadIdx.x, s0 = blockIdx.y * 4;
    int e, cnt, ps; if (!moe_find((const unsigned*)(a.ws + WS_CTL), layer, s0, e, cnt, ps)) return;
    const int* elist = (const int*)(a.ws + WS_ELIST) + (size_t)e * MROWS;
    const bf16* HB = (const bf16*)(a.ws + WS_HB);
    const int rank = s0 - ps;
    const bf16* ap0 = HB + (size_t)(rank + 0 < cnt ? elist[rank + 0] : 0) * DM; const bf16* ap1 = HB + (size_t)(rank + 1 < cnt ? elist[rank + 1] : 0) * DM;
    const bf16* ap2 = HB + (size_t)(rank + 2 < cnt ? elist[rank + 2] : 0) * DM; const bf16* ap3 = HB + (size_t)(rank + 3 < cnt ? elist[rank + 3] : 0) * DM;
    const bf16* W = (const bf16*)(a.ws + WS_WGU + layer * WGU_L + e * WGU_E);
    const int rg = 256 * (j >> 7) + (j & 127);
    float g[4] = {0.f, 0.f, 0.f, 0.f}, u[4] = {0.f, 0.f, 0.f, 0.f};
    dot4(ap0, ap1, ap2, ap3, W + (size_t)rg * DM, DM, g);
    dot4(ap0, ap1, ap2, ap3, W + (size_t)(rg + 128) * DM, DM, u);
    bf16* act = (bf16*)(a.ws + WS_ACT);
#pragma unroll
    for (int i = 0; i < 4; ++i) act[(size_t)(s0 + i) * FF + j] = (bf16)f2bf(g[i] * sigmoidf_(g[i]) * u[i]);
}
__global__ void __launch_bounds__(256) naive_moe_down(Args a, int layer) {
    const int n = blockIdx.x * 256 + threadIdx.x, s0 = blockIdx.y * 4;
    int e, cnt, ps; if (!moe_find((const unsigned*)(a.ws + WS_CTL), layer, s0, e, cnt, ps)) return;
    const bf16* A = (const bf16*)(a.ws + WS_ACT) + (size_t)s0 * FF; const bf16* B = (const bf16*)(a.ws + WS_WD + layer * WD_L + e * WD_E) + (size_t)n * FF;
    float acc[4] = {0.f, 0.f, 0.f, 0.f};
    dot4(A, A + FF, A + 2 * FF, A + 3 * FF, B, FF, acc);
    bf16* O = (bf16*)(a.ws + WS_OSL);
#pragma unroll
    for (int i = 0; i < 4; ++i) O[(size_t)(s0 + i) * DM + n] = (bf16)f2bf(acc[i]);
}
__global__ void __launch_bounds__(256) naive_attn(Args a, int nq) {
    const int lane = threadIdx.x & 63, widx = blockIdx.x * 4 + (threadIdx.x >> 6);
    const int th = widx / nq, pq = nq - 1 - (widx % nq);
    if (th >= 16) return;
    const int type = th >> 3, head = th & 7;
    const bf16* QKV = (const bf16*)(a.ws + WS_QKV);
    const int qcol = (type ? 3072 : 0) + head * HD, kcol = qcol + 1024, vcol = qcol + 2048;
    const int rowq = row_of_p(pq);
    u32x4 q[16];
#pragma unroll
    for (int i = 0; i < 16; ++i) q[i] = *(const u32x4*)(QKV + (size_t)rowq * QKV_N + qcol + 8 * i);
    const float* cum = (const float*)(a.ws + WS_CUM) + (size_t)head * MROWS;
    float o0 = 0.f, o1 = 0.f, carry = 0.f, m = -1e30f, l = 0.f;
    const float cq = type ? cum[pq] : 0.f;
    for (int phi = type ? pq : pq - 1; phi >= 0; phi -= 64) {
        const int p = phi - lane; const bool valid = p >= 0; const int pr = row_of_p(valid ? p : 0);
        float u = 0.f;
        const bf16* kp = QKV + (size_t)pr * QKV_N + kcol;
#pragma unroll
        for (int i = 0; i < 16; ++i) u = dot8(q[i], *(const u32x4*)(kp + 8 * i), u);
        float w;
        if (type == 0) {
            const float aa = exp2f(-fabsf(u)), b = log2f(1.0f + aa);
            float lk = fminf(-u, 0.f) - b; const float lb = lk + u;
            if (!valid) lk = 0.f;
            float inc = lk;
#pragma unroll
            for (int off = 1; off < 64; off <<= 1) { const float t = __shfl_up(inc, off); if (lane >= off) inc += t; }
            const float after = carry + inc - lk;
            w = valid ? exp2f(lb + after) : 0.f;
            carry += __shfl(inc, 63);
        } else {
            const float s = valid ? u + cq - cum[valid ? p : 0] : -__builtin_inff();
            const float cm = wave_max(s), mn = fmaxf(m, cm), alpha = exp2f(m - mn);
            w = valid ? exp2f(s - mn) : 0.f;
            l = l * alpha + wave_sum(w); o0 *= alpha; o1 *= alpha; m = mn;
        }
        for (int j = 0; j < 64; ++j) {
            const float wj = __shfl(w, j); const int prj = __shfl(pr, j);
            const unsigned vv = *(const unsigned*)(QKV + (size_t)prj * QKV_N + vcol + 2 * lane);
            o0 = fmaf(wj, bflo(vv), o0); o1 = fmaf(wj, bfhi(vv), o1);
        }
    }
    if (type) { const float rl = 1.0f / l; o0 *= rl; o1 *= rl; }
    *(unsigned*)((bf16*)(a.ws + WS_YB) + (size_t)rowq * DM + type * 1024 + head * HD + 2 * lane) = pk2(o0, o1);
}

#define XB_TMO      128
#define XB_XCNT(j)  (256  + 64 * (j))
#define XB_XSUB(j)  (1280 + 64 * (j))
#define XB_XGEN(j)  (2304 + 64 * (j))
#define XB_TOP      3328
#define XB_TOPGEN   3392
#define XB_SPIN_CAP (1u << 18)
__device__ __forceinline__ unsigned xb_ld(unsigned* p)              { return __hip_atomic_load(p, __ATOMIC_RELAXED, __HIP_MEMORY_SCOPE_AGENT); }
__device__ __forceinline__ unsigned xb_add(unsigned* p, unsigned v) { return __hip_atomic_fetch_add(p, v, __ATOMIC_RELAXED, __HIP_MEMORY_SCOPE_AGENT); }
__device__ __forceinline__ unsigned xb_xcc_id() { return (unsigned)__builtin_amdgcn_s_getreg((3 << 11) | 20) & 0xFu; }
#define XB_SPIN(cond, bar) do { unsigned _sp = 0; while (cond) { __builtin_amdgcn_s_sleep(1); \
    if ((++_sp & 255u) == 0u) { if (xb_ld(&(bar)[XB_TMO])) break; if (_sp > XB_SPIN_CAP) { atomicAdd(&(bar)[XB_TMO], 1u); break; } } } } while (0)
struct XcdBarrier { unsigned* bar; unsigned x; volatile LAS unsigned* st; };
__device__ __forceinline__ XcdBarrier xcd_barrier_post(unsigned* bar, volatile LAS unsigned* st) {
    XcdBarrier b; b.bar = bar; b.x = xb_xcc_id(); b.st = st;
    if (threadIdx.x == 0) (void)xb_add(&bar[XB_XCNT(b.x)], 1u);
    return b;
}
__device__ __forceinline__ void xcd_barrier_complete(unsigned* bar, unsigned x, unsigned& nloc, unsigned& nx) {
    const unsigned G = gridDim.x * gridDim.y * gridDim.z;
    unsigned sum, cnt, mine, sp = 0u;
    for (;;) {
        sum = 0u; cnt = 0u; mine = 0u;
#pragma unroll
        for (unsigned j = 0; j < 16; ++j) { const unsigned c = xb_ld(&bar[XB_XCNT(j)]); sum += c; cnt += (c > 0u) ? 1u : 0u; mine = (j == x) ? c : mine; }
        if (sum == G) break;
        __builtin_amdgcn_s_sleep(1);
        if ((++sp & 255u) == 0u) { if (xb_ld(&bar[XB_TMO])) break; if (sp > XB_SPIN_CAP) { atomicAdd(&bar[XB_TMO], 1u); break; } }
    }
    nloc = mine > 0u ? mine : 1u; nx = cnt > 0u ? cnt : 1u;
}
__device__ __forceinline__ void xcd_barrier(const XcdBarrier& b) {
    asm volatile("s_waitcnt vmcnt(0)" ::: "memory");
    __syncthreads();
    if (threadIdx.x == 0) {
        unsigned* bar = b.bar;
        __builtin_amdgcn_s_waitcnt(0);
        unsigned nloc = b.st[0], nx = b.st[1];
        if (nloc == 0u) { xcd_barrier_complete(bar, b.x, nloc, nx); b.st[0] = nloc; b.st[1] = nx; }
        const unsigned old = xb_add(&bar[XB_XSUB(b.x)], 1u);
        const unsigned gen = old / nloc;
        if (old + 1u == (gen + 1u) * nloc) {
            __builtin_amdgcn_fence(__ATOMIC_RELEASE, "agent");
            asm volatile("s_waitcnt vmcnt(0)" ::: "memory");
            const unsigned og = xb_add(&bar[XB_TOP], 1u);
            const unsigned tg = og / nx;
            if (og + 1u == (tg + 1u) * nx) xb_add(&bar[XB_TOPGEN], 1u);
            else XB_SPIN(xb_ld(&bar[XB_TOPGEN]) == tg, bar);
            __builtin_amdgcn_fence(__ATOMIC_ACQUIRE, "agent");
            xb_add(&bar[XB_XGEN(b.x)], 1u);
            asm volatile("s_waitcnt vmcnt(0)" ::: "memory");
        } else {
            XB_SPIN(xb_ld(&bar[XB_XGEN(b.x)]) == gen, bar);
            __builtin_amdgcn_fence(__ATOMIC_ACQUIRE, "agent");
            asm volatile("s_waitcnt vmcnt(0)" ::: "memory");
        }
    }
    __syncthreads();
}

struct Frame {
    LAS unsigned char* lds; unsigned char* ws; unsigned* ctl;
    int tid, lane, wave, G, gw, NGW;
    const float* const* in; float* out;
};
#define LDS_WAIT() asm volatile("s_waitcnt lgkmcnt(0)" ::: "memory")

__device__ __forceinline__ void transpose_item(const float* W, size_t ldw, bf16* WT, size_t ldt, LAS float* scr, int lane) {
#pragma unroll 8
    for (int i = 0; i < 32; ++i) { const int kk = 2 * i + (lane >> 5); scr[kk * 33 + (lane & 31)] = W[(size_t)kk * ldw + (lane & 31)]; }
    LDS_WAIT(); asm volatile("" ::: "memory");
    const int c = lane & 7;
#pragma unroll
    for (int j = 0; j < 4; ++j) { const int n = (lane >> 3) + 8 * j; const LAS float* s = scr + (8 * c) * 33 + n;
        u32x4 o; o.x = pk2(s[0 * 33], s[1 * 33]); o.y = pk2(s[2 * 33], s[3 * 33]); o.z = pk2(s[4 * 33], s[5 * 33]); o.w = pk2(s[6 * 33], s[7 * 33]);
        *(u32x4*)(WT + (size_t)n * ldt + 8 * c) = o; }
    LDS_WAIT(); asm volatile("" ::: "memory");
}
__device__ __forceinline__ void transpose_item8(const float* W, size_t ldw, unsigned char* WT, size_t ldt, LAS float* scr, int lane) {
#pragma unroll 8
    for (int i = 0; i < 32; ++i) { const int kk = 2 * i + (lane >> 5); scr[kk * 33 + (lane & 31)] = W[(size_t)kk * ldw + (lane & 31)]; }
    LDS_WAIT(); asm volatile("" ::: "memory");
    const int c = lane & 3;
#pragma unroll
    for (int j = 0; j < 2; ++j) { const int n = (lane >> 2) + 16 * j; const LAS float* p = scr + (16 * c) * 33 + n;
        u32x4 o;
        o.x = pk4_fp8(p[0 * 33] * W8_SCALE, p[1 * 33] * W8_SCALE, p[2 * 33] * W8_SCALE, p[3 * 33] * W8_SCALE); o.y = pk4_fp8(p[4 * 33] * W8_SCALE, p[5 * 33] * W8_SCALE, p[6 * 33] * W8_SCALE, p[7 * 33] * W8_SCALE);
        o.z = pk4_fp8(p[8 * 33] * W8_SCALE, p[9 * 33] * W8_SCALE, p[10 * 33] * W8_SCALE, p[11 * 33] * W8_SCALE); o.w = pk4_fp8(p[12 * 33] * W8_SCALE, p[13 * 33] * W8_SCALE, p[14 * 33] * W8_SCALE, p[15 * 33] * W8_SCALE);
        *(u32x4*)(WT + (size_t)n * ldt + 16 * c) = o; }
    LDS_WAIT(); asm volatile("" ::: "memory");
}
__device__ __forceinline__ void convert_item(Frame& F, int it, LAS float* scr) {
    constexpr int I_IN = 32 * 320, I_BS = 16 * 64, I_OUT = 32 * 64, I_GE = 32 * 32, I_DE = 16 * 64;
    constexpr int PER_LAYER = I_IN + 2 * I_BS + I_OUT + NE * (2 * I_GE + I_DE);
    const int l = it / PER_LAYER; int r = it % PER_LAYER;
    if (r < I_IN) { const int kb = r / 320, nb = r % 320, nd = 32 * nb, ns = nd + (nd >= FCOL ? 8 : 0);
        transpose_item8(F.in[I_WIN] + (size_t)l * DM * INP_SRC + (size_t)(64 * kb) * INP_SRC + ns, INP_SRC, F.ws + WS_WIN + l * WIN_L + (size_t)nd * DM + 64 * kb, DM, scr, F.lane); return; }
    r -= I_IN;
    if (r < 2 * I_BS) { const int which = r / I_BS; r %= I_BS; const int kb = r / 64, nb = r % 64;
        transpose_item((which ? F.in[I_WBFX] : F.in[I_WBSB]) + (size_t)l * 1024 * DM + (size_t)(64 * kb) * DM + 32 * nb, DM, (bf16*)(F.ws + WS_WB + l * WB_L) + (size_t)(32 * nb) * DM + which * 1024 + 64 * kb, DM, scr, F.lane); return; }
    r -= 2 * I_BS;
    if (r < I_OUT) { const int kb = r / 64, nb = r % 64;
        transpose_item8(F.in[I_WOUT] + (size_t)l * DM * DM + (size_t)(64 * kb) * DM + 32 * nb, DM, F.ws + WS_WOUT + l * WOUT_L + (size_t)(32 * nb) * DM + 64 * kb, DM, scr, F.lane); return; }
    r -= I_OUT;
    const int e = r / (2 * I_GE + I_DE); r %= (2 * I_GE + I_DE);
    if (r < 2 * I_GE) { const int which = r / I_GE; r %= I_GE; const int kb = r / 32, nb = r % 32, n0 = 32 * nb, rho = 256 * (n0 >> 7) + (n0 & 127) + which * 128;
        transpose_item8((which ? F.in[I_WU] : F.in[I_WG]) + ((size_t)(l * NE + e) * DM + 64 * kb) * FF + n0, FF, F.ws + WS_WGU + l * WGU_L + e * WGU_E + (size_t)rho * DM + 64 * kb, DM, scr, F.lane); return; }
    r -= 2 * I_GE;
    { const int kb = r / 64, nb = r % 64;
        transpose_item8(F.in[I_WD] + ((size_t)(l * NE + e) * FF + 64 * kb) * DM + 32 * nb, DM, F.ws + WS_WD + l * WD_L + e * WD_E + (size_t)(32 * nb) * FF + 64 * kb, FF, scr, F.lane); }
}
constexpr int N_CONVERT_ITEMS = NLAYER * (32 * 320 + 2 * 16 * 64 + 32 * 64 + NE * (2 * 32 * 32 + 16 * 64));
constexpr int CV_PER_LAYER = N_CONVERT_ITEMS / NLAYER, CV_G0_END = 32 * 320, CV_G1_END = CV_PER_LAYER + 32 * 320, CV_BUNDLE = 256;
static_assert((CV_G1_END - CV_G0_END) % CV_BUNDLE == 0 && (N_CONVERT_ITEMS - CV_G1_END) % CV_BUNDLE == 0, "bundles");
__device__ __forceinline__ void convert_bundle(Frame& F, int first_item) {
    LAS float* scr = (LAS float*)(F.lds + F.wave * 16384);
    for (int i = 0; i < CV_BUNDLE / NWAVES; ++i) convert_item(F, first_item + F.wave + NWAVES * i, scr);
}

__device__ __forceinline__ int tab_rowpos(int c) { return (c & 3) * 512 + (c >> 8) * 64 + ((c >> 2) & 63); }
template <int NC> __device__ __forceinline__ void stage_table(Frame& F, const float* src, size_t pitch) {
    constexpr int CH = NC / 4;
    for (int ci = F.tid; ci < DM * CH; ci += NTHREADS) { const int c = ci / CH, q = ci % CH;
        const f32x4 v = *(const f32x4*)(src + (size_t)c * pitch + 4 * q);
        const int sw = (NC == 16) ? ((c >> 4) & 3) : ((c >> 5) & 1);
        *(LAS f32x4*)(F.lds + tab_rowpos(c) * (NC * 4) + ((q ^ sw) << 4)) = v; }
    LDS_WAIT(); __syncthreads();
}
template <int NC> __device__ __forceinline__ void table_dot(Frame& F, const f32x4 (&y)[8], float (&acc)[NC]) {
    constexpr int CH = NC / 4; const int l = F.lane; const int sw = (NC == 16) ? ((l >> 2) & 3) : ((l >> 3) & 1);
#pragma unroll
    for (int e = 0; e < NC; ++e) acc[e] = 0.f;
#pragma unroll
    for (int j = 0; j < 8; ++j)
#pragma unroll
        for (int i = 0; i < 4; ++i) { const float yv = y[j][i]; const int rp = i * 512 + j * 64 + l; if (i == 0) asm volatile("" ::: "memory");
#pragma unroll
            for (int q = 0; q < CH; ++q) { const f32x4 w = *(const LAS f32x4*)(F.lds + rp * (NC * 4) + ((q ^ sw) << 4));
                acc[4 * q + 0] = fmaf(yv, w.x, acc[4 * q + 0]); acc[4 * q + 1] = fmaf(yv, w.y, acc[4 * q + 1]); acc[4 * q + 2] = fmaf(yv, w.z, acc[4 * q + 2]); acc[4 * q + 3] = fmaf(yv, w.w, acc[4 * q + 3]); } }
#pragma unroll
    for (int e = 0; e < NC; ++e) acc[e] = wave_sum(acc[e]);
}
__device__ __forceinline__ void ln_row(Frame& F, f32x4 (&v)[8], const float* g, const float* b) {
    float s = 0.f;
#pragma unroll
    for (int j = 0; j < 8; ++j) s += (v[j].x + v[j].y) + (v[j].z + v[j].w);
    const float mean = wave_sum(s) * (1.f / DM); float s2 = 0.f;
#pragma unroll
    for (int j = 0; j < 8; ++j) { v[j] = v[j] - mean; s2 += (v[j].x * v[j].x + v[j].y * v[j].y) + (v[j].z * v[j].z + v[j].w * v[j].w); }
    const float rstd = 1.0f / sqrtf(wave_sum(s2) * (1.f / DM) + LN_EPS);
#pragma unroll
    for (int j = 0; j < 8; ++j) { const f32x4 gv = *(const f32x4*)(g + 256 * j + 4 * F.lane), bv = *(const f32x4*)(b + 256 * j + 4 * F.lane); v[j] = v[j] * rstd * gv + bv; }
}
__device__ __forceinline__ void store_h(Frame& F, int row, const f32x4 (&y)[8], bool dry = false) {
    float* hf = (float*)(F.ws + (dry ? WS_YB : WS_HF)) + (size_t)row * DM; bf16* hb = (bf16*)(F.ws + (dry ? WS_GB + 21 * MiB : WS_HB)) + (size_t)row * DM;
    unsigned char* h8 = F.ws + (dry ? WS_GB + 21 * MiB : WS_H8) + (size_t)row * DM;
#pragma unroll
    for (int j = 0; j < 8; ++j) { *(f32x4*)(hf + 256 * j + 4 * F.lane) = y[j]; if (NAIVE_MASK != 0u) { u32x2 w; w.x = pk2(y[j].x, y[j].y); w.y = pk2(y[j].z, y[j].w); *(u32x2*)(hb + 256 * j + 4 * F.lane) = w; }
        *(unsigned*)(h8 + 256 * j + 4 * F.lane) = pk4_fp8(y[j].x * H8_SCALE, y[j].y * H8_SCALE, y[j].z * H8_SCALE, y[j].w * H8_SCALE); }
}
__device__ __forceinline__ void store_logf(Frame& F, int row, const f32x4 (&y)[8], const float* bfor) {
    float acc[8]; table_dot<8>(F, y, acc);
    if (F.lane < 8) { float a = acc[0];
#pragma unroll
        for (int h = 1; h < 8; ++h) a = (F.lane == h) ? acc[h] : a;
        const float x = a + bfor[F.lane];
        const float ls = fminf(x, 0.f) - log1pf(__expf(-fabsf(x)));
        ((float*)(F.ws + WS_LOGF))[(size_t)row * 8 + F.lane] = ls; }
}

__device__ __forceinline__ void phase_prologue(Frame& F) {
    LAS float* scr = (LAS float*)(F.lds + F.wave * 16384);
    for (int it = F.gw; it < CV_G0_END; it += F.NGW) convert_item(F, it, scr);
    __syncthreads();
    stage_table<8>(F, F.in[I_WIN] + FCOL, INP_SRC);
    for (int row = F.gw; row < NTOK; row += F.NGW) {
        const float* src = row < SEQ ? F.in[I_X] + (size_t)row * DM : F.in[I_META] + (size_t)(row - SEQ) * DM;
        f32x4 v[8];
#pragma unroll
        for (int j = 0; j < 8; ++j) v[j] = *(const f32x4*)(src + 256 * j + 4 * F.lane);
        ln_row(F, v, F.in[I_LNIN_G], F.in[I_LNIN_B]);
        store_h(F, row, v);
        store_logf(F, row, v, F.in[I_BF]);
    }
    for (int row = NTOK + F.gw; row < MROWS; row += F.NGW) { bf16* hb = (bf16*)(F.ws + WS_HB) + (size_t)row * DM;
#pragma unroll
        for (int j = 0; j < 4; ++j) *(u32x4*)(hb + 512 * j + 8 * F.lane) = (u32x4){0u, 0u, 0u, 0u}; }
    __syncthreads();
}
__device__ __forceinline__ void phase_tilesuf(Frame& F) {
    if (blockIdx.x > SEQ / 64) return;
    const int tile = blockIdx.x, h = F.wave, row = tile * 64 + F.lane;
    const float v = (row < NTOK) ? LOG2E * ((const float*)(F.ws + WS_LOGF))[(size_t)row * 8 + h] : 0.f;
    float inc = v;
#pragma unroll
    for (int off = 1; off < 64; off <<= 1) { const float t = __shfl_down(inc, off); if (F.lane + off < 64) inc += t; }
    float* base = (float*)(F.ws + WS_CUM);
    base[(size_t)h * MROWS + row] = inc - v;
    if (F.lane == 0) base[(size_t)NHEAD * MROWS + h * 256 + tile] = inc;
}
__device__ __forceinline__ void phase_cumsum(Frame& F, bool do_scan) {
    if (blockIdx.x >= NHEAD) {
        if (blockIdx.x < NHEAD + 48) { bf16* q = (bf16*)(F.ws + WS_QKV) + (size_t)(NTOK + blockIdx.x - NHEAD) * QKV_N;
            for (int i = F.tid; i < QKV_N / 8; i += NTHREADS) *(u32x4*)(q + 8 * i) = (u32x4){0u, 0u, 0u, 0u}; }
        return; }
    if (!do_scan) return;
    const int h = blockIdx.x; const float* logf = (const float*)(F.ws + WS_LOGF); float* cum = (float*)(F.ws + WS_CUM) + (size_t)h * MROWS;
    constexpr int PER = 17; const int p0 = F.tid * PER;
    float loc[PER]; float s = 0.f;
#pragma unroll
    for (int i = 0; i < PER; ++i) { const int p = p0 + i; const float v = p < NTOK ? logf[(size_t)row_of_p(p) * 8 + h] : 0.f; s += v; loc[i] = s; }
    float inc = s;
#pragma unroll
    for (int off = 1; off < 64; off <<= 1) { const float t = __shfl_up(inc, off); if (F.lane >= off) inc += t; }
    LAS float* wt = (LAS float*)(F.lds);
    if (F.lane == 63) wt[F.wave] = inc;
    LDS_WAIT(); __syncthreads();
    float base = inc - s;
    for (int w = 0; w < F.wave; ++w) base += wt[w];
#pragma unroll
    for (int i = 0; i < PER; ++i) { const int p = p0 + i; if (p < NTOK) cum[p] = (base + loc[i]) * LOG2E; }
    LDS_WAIT(); __syncthreads();
}
__device__ __forceinline__ void phase_ln_router(Frame& F, int layer, bool dry = false) {
    stage_table<16>(F, F.in[I_WR], 16);
    const float* g = F.in[I_LNMIX_G] + layer * DM; const float* b = F.in[I_LNMIX_B] + layer * DM;
    const float* rbias = F.in[I_RB];
    const int nrows_e = layer == NLAYER - 1 ? SEQ : NTOK;
    for (int row = F.gw; row < nrows_e; row += F.NGW) {
        const float* src = (const float*)(F.ws + WS_RB) + (size_t)row * DM;
        f32x4 v[8];
#pragma unroll
        for (int j = 0; j < 8; ++j) v[j] = *(const f32x4*)(src + 256 * j + 4 * F.lane);
        ln_row(F, v, g, b);
        store_h(F, row, v, dry);
        float lg[16]; table_dot<16>(F, v, lg);
        float aff[16], sel[16];
#pragma unroll
        for (int e = 0; e < 16; ++e) { aff[e] = 1.0f / (1.0f + __expf(-lg[e])); sel[e] = aff[e] + rbias[e]; }
        int bg = 0; float bs = -__builtin_inff();
#pragma unroll
        for (int gi = 0; gi < 4; ++gi) { const float a0 = sel[4 * gi], a1 = sel[4 * gi + 1], a2 = sel[4 * gi + 2], a3 = sel[4 * gi + 3];
            const float h1 = fmaxf(a0, a1), l1 = fminf(a0, a1), h2 = fmaxf(a2, a3), l2 = fminf(a2, a3);
            const float top = fmaxf(h1, h2), sec = fmaxf(fminf(h1, h2), fmaxf(l1, l2)), sc = top + sec;
            if (sc > bs) { bs = sc; bg = gi; } }
        float s4[4], a4[4];
#pragma unroll
        for (int i = 0; i < 4; ++i) { s4[i] = sel[i]; a4[i] = aff[i]; }
#pragma unroll
        for (int gi = 1; gi < 4; ++gi) if (bg == gi) {
#pragma unroll
            for (int i = 0; i < 4; ++i) { s4[i] = sel[4 * gi + i]; a4[i] = aff[4 * gi + i]; } }
        int i1 = 0; float m1 = s4[0];
#pragma unroll
        for (int i = 1; i < 4; ++i) if (s4[i] > m1) { m1 = s4[i]; i1 = i; }
        int i2 = -1; float m2 = -__builtin_inff();
#pragma unroll
        for (int i = 0; i < 4; ++i) if (i != i1 && s4[i] > m2) { m2 = s4[i]; i2 = i; }
        float af1 = a4[0], af2 = a4[0];
#pragma unroll
        for (int i = 1; i < 4; ++i) { if (i1 == i) af1 = a4[i]; if (i2 == i) af2 = a4[i]; }
        const float wsum = af1 + af2, w1 = af1 / wsum, w2 = af2 / wsum;
        const int e1 = 4 * bg + i1, e2 = 4 * bg + i2;
        if (dry) { if (F.lane == 0) ((float*)(F.ws + WS_GB + 60 * MiB))[row] = w1 + w2 + (float)(e1 + e2); }
        if (F.lane == 0 && !dry) {
            const int r1 = (int)atomicAdd(F.ctl + CW_CNT + (layer * NE + e1) * 64, 1u), r2 = (int)atomicAdd(F.ctl + CW_CNT + (layer * NE + e2) * 64, 1u);
            int* el = (int*)(F.ws + WS_ELIST); el[(size_t)e1 * MROWS + r1] = row; el[(size_t)e2 * MROWS + r2] = row;
            int* ti = (int*)(F.ws + WS_TOKI) + (size_t)row * 8;
            ti[0] = e1; ti[1] = e2; ti[2] = r1; ti[3] = r2; ti[4] = __builtin_bit_cast(int, w1); ti[5] = __builtin_bit_cast(int, w2);
        }
    }
    __syncthreads();
}
__device__ __forceinline__ void phase_ln_final(Frame& F, int layer, bool dry = false) {
    const bool last = layer == NLAYER - 1;
    if (!last) stage_table<8>(F, F.in[I_WIN] + (size_t)(layer + 1) * DM * INP_SRC + FCOL, INP_SRC);
    const float* g = F.in[I_LNFFN_G] + layer * DM; const float* b = F.in[I_LNFFN_B] + layer * DM;
    const int nrows = last ? SEQ : NTOK;
    for (int row = F.gw; row < nrows; row += F.NGW) {
        const int* ti = (const int*)(F.ws + WS_TOKI) + (size_t)row * 8;
        const int e1 = ti[0], e2 = ti[1], r1 = ti[2], r2 = ti[3]; const float w1 = __builtin_bit_cast(float, ti[4]), w2 = __builtin_bit_cast(float, ti[5]);
        const int ps1 = moe_pstart(F.ctl, layer, e1), ps2 = moe_pstart(F.ctl, layer, e2);
        const bf16* o1 = (const bf16*)(F.ws + WS_OSL) + (size_t)(ps1 + r1) * DM; const bf16* o2 = (const bf16*)(F.ws + WS_OSL) + (size_t)(ps2 + r2) * DM;
        const float* hf = (const float*)(F.ws + WS_HF) + (size_t)row * DM;
        f32x4 v[8];
#pragma unroll
        for (int j = 0; j < 8; ++j) { const f32x4 hv = *(const f32x4*)(hf + 256 * j + 4 * F.lane);
            const u32x2 a = *(const u32x2*)(o1 + 256 * j + 4 * F.lane), c = *(const u32x2*)(o2 + 256 * j + 4 * F.lane);
            v[j].x = ALPHA * hv.x + w1 * bflo(a.x) + w2 * bflo(c.x); v[j].y = ALPHA * hv.y + w1 * bfhi(a.x) + w2 * bfhi(c.x);
            v[j].z = ALPHA * hv.z + w1 * bflo(a.y) + w2 * bflo(c.y); v[j].w = ALPHA * hv.w + w1 * bfhi(a.y) + w2 * bfhi(c.y); }
        ln_row(F, v, g, b);
        if (dry) { store_h(F, row, v, true); if (!last) { float acc8[8]; table_dot<8>(F, v, acc8); if (F.lane == 0) ((float*)(F.ws + WS_GB + 60 * MiB))[row] = acc8[0] + acc8[7]; } }
        else if (last) { float* o = F.out + (size_t)row * DM;
#pragma unroll
            for (int j = 0; j < 8; ++j) *(f32x4*)(o + 256 * j + 4 * F.lane) = v[j]; }
        else { store_h(F, row, v); store_logf(F, row, v, F.in[I_BF] + (layer + 1) * NHEAD); }
    }
    __syncthreads();
}

namespace pg8 {
typedef short bf16x8 __attribute__((ext_vector_type(8)));
typedef int i32x4 __attribute__((ext_vector_type(4)));
typedef int i32x8 __attribute__((ext_vector_type(8)));
__device__ __forceinline__ i32x8 ld_frag(const LAS unsigned char* p) { const i32x4 x = *(const LAS i32x4*)p, y = *(const LAS i32x4*)(p + 1024); return __builtin_shufflevector(x, y, 0, 1, 2, 3, 4, 5, 6, 7); }
__device__ __forceinline__ bf16x8 frag_lo(i32x8 f) { return __builtin_bit_cast(bf16x8, (i32x4)__builtin_shufflevector(f, f, 0, 1, 2, 3)); }
__device__ __forceinline__ bf16x8 frag_hi(i32x8 f) { return __builtin_bit_cast(bf16x8, (i32x4)__builtin_shufflevector(f, f, 4, 5, 6, 7)); }
constexpr int BM = 256, BK = 64, HALF = 128, HTB = HALF * BK * 2, STAGE_BYTES = 8 * HTB, NXCD = 8, WGM = 8;
__host__ __device__ __forceinline__ int lds_byte(int r, int c) { const int st = (r >> 4) * 2 + (c >> 5), rr = r & 15, cc = c & 31, ob = rr * 64 + cc * 2; return st * 1024 + (ob ^ (((ob >> 9) & 1) << 5)); }
__host__ __device__ __forceinline__ void stage_rc(int b, int& R, int& C) { const int st = b / 1024, sb = b % 1024, swz = sb ^ (((sb >> 9) & 1) << 5); R = (st >> 1) * 16 + swz / 64; C = (st & 1) * 32 + (swz % 64) / 2; }
__host__ __device__ __forceinline__ int perm32(int rho) { const int n = rho >> 4, i = rho & 15; return 8 * (i >> 2) + 4 * n + (i & 3); }
struct Unit { int pm, pn, aux; };
__device__ __forceinline__ bool static_tile(int nM, int nN, int G, int c, int i, int& pm, int& pn) {
    const int nwg = nM * nN; const long L = (long)i * G + c; if (L >= nwg) return false;
    int wgid = (int)L; { const int q = nwg / NXCD, r = nwg % NXCD, xcd = wgid % NXCD, off = wgid / NXCD; wgid = (xcd < r ? xcd * (q + 1) : r * (q + 1) + (xcd - r) * q) + off; }
    const int nig = WGM * nN, gid = wgid / nig, fm = gid * WGM, gsz = (nM - fm) < WGM ? (nM - fm) : WGM;
    pm = fm + ((wgid % nig) % gsz); pn = (wgid % nig) / gsz; return true;
}
__device__ __forceinline__ unsigned cvt_pk_bf16(float lo, float hi) { unsigned r; asm volatile("v_cvt_pk_bf16_f32 %0, %1, %2" : "=v"(r) : "v"(lo), "v"(hi)); return r; }

template <class P>
__device__ __forceinline__ void gemm_phase(LAS unsigned char* lds, const P& prob) {
    const int tid = threadIdx.x, wid = __builtin_amdgcn_readfirstlane(tid >> 6), lane = tid & 63, wr = wid >> 2, wc = wid & 3, fr = lane & 15, fq = lane >> 4;
    constexpr int ES = P::FP8 ? 1 : 2;
    const int nt = prob.K * ES / (BK * 2);
    unsigned voffA[2], voffA1[2], voffB[2];
#pragma unroll
    for (int i = 0; i < 2; ++i) { int R, C; stage_rc(tid * 16 + i * 8192, R, C); const int Rb = P::PERM ? ((R & ~31) + perm32(R & 31)) : R;
        voffA[i] = (unsigned)(R * prob.lda * ES + C * 2); voffA1[i] = voffA[i]; voffB[i] = (unsigned)(Rb * prob.ldb * ES + C * 2); }
    const size_t kstep = (size_t)(BK * 2);
    const size_t hstepA = P::GATHER ? (size_t)0 : (size_t)HALF * prob.lda * ES, hstepB = (size_t)HALF * prob.ldb * ES;
    const unsigned ldsw = (unsigned)wid * 1024u;
    const int aoff = lds_byte(wr * 64 + fr, fq * 8), boff = lds_byte(wc * 32 + fr, fq * 8);
#define PG8_SA(b, h) (((b) * 2 + (h)) * HTB)
#define PG8_SB(b, h) ((4 + (b) * 2 + (h)) * HTB)
#define PG8_STAGE(bufoff, gbase, voff) do { _Pragma("unroll") for (int _i = 0; _i < 2; ++_i) \
        __builtin_amdgcn_global_load_lds((const unsigned*)((const char*)(gbase) + (voff)[_i]), (LAS unsigned*)(lds + (bufoff) + ldsw + _i * 8192), 16, 0, 0); } while (0)
#define PG8_LDA(dst, b, h) do { _Pragma("unroll") for (int m = 0; m < 4; ++m) dst[m] = ld_frag(lds + PG8_SA(b, h) + aoff + m * 2048); } while (0)
#define PG8_LDB(dst, b, h) do { _Pragma("unroll") for (int n = 0; n < 2; ++n) dst[n] = ld_frag(lds + PG8_SB(b, h) + boff + n * 2048); } while (0)
#define PG8_MMA(ai, bj, At, Bt) do { __builtin_amdgcn_s_setprio(1); _Pragma("unroll") for (int m = 0; m < 4; ++m) _Pragma("unroll") for (int n = 0; n < 2; ++n) { \
        if constexpr (P::FP8) asm volatile("v_mfma_scale_f32_16x16x128_f8f6f4 %0, %1, %2, %0, %3, %4 op_sel_hi:[0,0,0]" : "+v"(acc[ai][bj][m][n]) : "v"(Bt[n]), "v"(At[m]), "v"(scb), "v"(sca)); \
        else { acc[ai][bj][m][n] = __builtin_amdgcn_mfma_f32_16x16x32_bf16(frag_lo(Bt[n]), frag_lo(At[m]), acc[ai][bj][m][n], 0, 0, 0); \
               acc[ai][bj][m][n] = __builtin_amdgcn_mfma_f32_16x16x32_bf16(frag_hi(Bt[n]), frag_hi(At[m]), acc[ai][bj][m][n], 0, 0, 0); } } __builtin_amdgcn_s_setprio(0); } while (0)
#define PG8_WAIT_V(n) asm volatile("s_waitcnt vmcnt(" #n ")" ::: "memory")
#define PG8_WAIT_L(n) asm volatile("s_waitcnt lgkmcnt(" #n ")" ::: "memory")
#define PG8_BAR __builtin_amdgcn_s_barrier()
#define PG8_SCHED __builtin_amdgcn_sched_barrier(0)
#define PG8_GATHER_OFFS(ui_, d0, d1) do { _Pragma("unroll") for (int _i = 0; _i < 2; ++_i) { int R_, C_; stage_rc(tid * 16 + _i * 8192, R_, C_); \
        d0[_i] = (unsigned)(prob.a_row(ui_, R_) * prob.lda * ES + C_ * 2); d1[_i] = (unsigned)(prob.a_row(ui_, HALF + R_) * prob.lda * ES + C_ * 2); } } while (0)
    Unit cur, nxt; int ui = 0;
    if (!prob.next(0, cur)) return;
    f32x4 acc[2][2][4][2];
#pragma unroll
    for (int a = 0; a < 2; ++a)
#pragma unroll
        for (int b = 0; b < 2; ++b)
#pragma unroll
            for (int m = 0; m < 4; ++m)
#pragma unroll
                for (int n = 0; n < 2; ++n) acc[a][b][m][n] = (f32x4){0.f, 0.f, 0.f, 0.f};
    const int sca = prob.sc_a, scb = prob.sc_b;
    i32x8 At[4], B0[2], B1[2];
    const char* cA = prob.a_ptr(cur); const char* cB = prob.b_ptr(cur);
    if constexpr (P::GATHER) PG8_GATHER_OFFS(0, voffA, voffA1);
    PG8_STAGE(PG8_SB(0, 0), cB, voffB); PG8_STAGE(PG8_SB(0, 1), cB + hstepB, voffB); PG8_STAGE(PG8_SA(0, 0), cA, voffA); PG8_STAGE(PG8_SA(0, 1), cA + hstepA, voffA1);
    if (wr == 1) PG8_BAR;
    PG8_WAIT_V(2); PG8_BAR;
    PG8_STAGE(PG8_SB(1, 0), cB + kstep, voffB); PG8_STAGE(PG8_SA(1, 0), cA + kstep, voffA); PG8_STAGE(PG8_SB(1, 1), cB + hstepB + kstep, voffB);
    PG8_WAIT_V(6); PG8_BAR;
    for (;;) {
        const bool has_next = prob.next(ui + 1, nxt);
        const char* nA = has_next ? prob.a_ptr(nxt) : cA; const char* nB = has_next ? prob.b_ptr(nxt) : cB;
        for (int t = 0; t < nt; t += 2) {
            const bool last = (t == nt - 2);
            const char* a1 = cA + (size_t)(t + 1) * kstep;
            const char* a2 = last ? nA : cA + (size_t)(t + 2) * kstep; const char* b2 = last ? nB : cB + (size_t)(t + 2) * kstep;
            const char* a3 = a2 + kstep; const char* b3 = b2 + kstep;
            if constexpr (P::GATHER) {
                unsigned v0[2], v1[2];
#pragma unroll
                for (int i = 0; i < 2; ++i) { v0[i] = voffA[i]; v1[i] = voffA1[i]; }
                if (last && has_next) PG8_GATHER_OFFS(ui + 1, v0, v1);
                PG8_LDB(B0, 0, 0); PG8_LDB(B1, 0, 1); PG8_SCHED; PG8_LDA(At, 0, 0); PG8_STAGE(PG8_SA(1, 1), a1, voffA1);
                PG8_WAIT_V(8); PG8_WAIT_L(0); PG8_BAR; PG8_MMA(0, 0, At, B0); PG8_MMA(0, 1, At, B1); PG8_BAR; PG8_SCHED;
                PG8_LDA(At, 0, 1); PG8_STAGE(PG8_SB(0, 0), b2, voffB); PG8_STAGE(PG8_SB(0, 1), b2 + hstepB, voffB); PG8_STAGE(PG8_SA(0, 0), a2, v0);
                PG8_WAIT_V(8); PG8_WAIT_L(0); PG8_BAR; PG8_MMA(1, 0, At, B0); PG8_MMA(1, 1, At, B1); PG8_BAR; PG8_SCHED;
                PG8_LDB(B0, 1, 0); PG8_LDB(B1, 1, 1); PG8_SCHED; PG8_LDA(At, 1, 0); PG8_STAGE(PG8_SA(0, 1), a2, v1);
                PG8_WAIT_V(8); PG8_WAIT_L(0); PG8_BAR; PG8_MMA(0, 0, At, B0); PG8_MMA(0, 1, At, B1); PG8_BAR; PG8_SCHED;
                PG8_LDA(At, 1, 1); PG8_STAGE(PG8_SB(1, 0), b3, voffB); PG8_STAGE(PG8_SB(1, 1), b3 + hstepB, voffB); PG8_STAGE(PG8_SA(1, 0), a3, v0);
                PG8_WAIT_V(8); PG8_WAIT_L(0); PG8_BAR; PG8_MMA(1, 0, At, B0); PG8_MMA(1, 1, At, B1); PG8_BAR; PG8_SCHED;
#pragma unroll
                for (int i = 0; i < 2; ++i) { voffA[i] = v0[i]; voffA1[i] = v1[i]; }
            } else {
                PG8_LDB(B0, 0, 0); PG8_LDB(B1, 0, 1); PG8_SCHED; PG8_LDA(At, 0, 0); PG8_STAGE(PG8_SA(1, 1), a1 + hstepA, voffA);
                PG8_WAIT_V(8); PG8_WAIT_L(0); PG8_BAR; PG8_MMA(0, 0, At, B0); PG8_MMA(0, 1, At, B1); PG8_BAR; PG8_SCHED;
                PG8_LDA(At, 0, 1); PG8_STAGE(PG8_SB(0, 0), b2, voffB); PG8_STAGE(PG8_SB(0, 1), b2 + hstepB, voffB); PG8_STAGE(PG8_SA(0, 0), a2, voffA);
                PG8_WAIT_V(8); PG8_WAIT_L(0); PG8_BAR; PG8_MMA(1, 0, At, B0); PG8_MMA(1, 1, At, B1); PG8_BAR; PG8_SCHED;
                PG8_LDB(B0, 1, 0); PG8_LDB(B1, 1, 1); PG8_SCHED; PG8_LDA(At, 1, 0); PG8_STAGE(PG8_SA(0, 1), a2 + hstepA, voffA);
                PG8_WAIT_V(8); PG8_WAIT_L(0); PG8_BAR; PG8_MMA(0, 0, At, B0); PG8_MMA(0, 1, At, B1); PG8_BAR; PG8_SCHED;
                PG8_LDA(At, 1, 1); PG8_STAGE(PG8_SB(1, 0), b3, voffB); PG8_STAGE(PG8_SB(1, 1), b3 + hstepB, voffB); PG8_STAGE(PG8_SA(1, 0), a3, voffA);
                PG8_WAIT_V(8); PG8_WAIT_L(0); PG8_BAR; PG8_MMA(1, 0, At, B0); PG8_MMA(1, 1, At, B1); PG8_BAR; PG8_SCHED;
            }
        }
        if (wr == 0) PG8_BAR;
        if constexpr (P::FP8) asm volatile("s_nop 15\n\ts_nop 15" ::: "memory");
        const bool keep = prob.epi(acc, cur, wr, wc, fr, fq);
        if (!has_next) break;
        if (!P::KEEPS || !keep) {
#pragma unroll
            for (int a = 0; a < 2; ++a)
#pragma unroll
                for (int b = 0; b < 2; ++b)
#pragma unroll
                    for (int m = 0; m < 4; ++m)
#pragma unroll
                        for (int n = 0; n < 2; ++n) acc[a][b][m][n] = (f32x4){0.f, 0.f, 0.f, 0.f};
        }
        cur = nxt; cA = nA; cB = nB; ++ui;
        if (wr == 1) PG8_BAR;
    }
    PG8_WAIT_V(0);
    PG8_BAR;
#undef PG8_SA
#undef PG8_SB
#undef PG8_STAGE
#undef PG8_LDA
#undef PG8_LDB
#undef PG8_MMA
#undef PG8_WAIT_V
#undef PG8_WAIT_L
#undef PG8_BAR
#undef PG8_SCHED
#undef PG8_GATHER_OFFS
}
}

template <class Epi>
__device__ __forceinline__ void skinny16_once(LAS unsigned char* lds, const bf16* A, int lda, const bf16* Bt, int ldb, int K, int N, const Epi& epi) {
    const int tid = threadIdx.x, wid = __builtin_amdgcn_readfirstlane(tid >> 6), lane = tid & 63, r = lane & 15, kg = lane >> 4;
    const int kw = K / 8, k0 = wid * kw;
    LAS float* part = (LAS float*)lds;
    for (int ct = blockIdx.x; ct < N / 16; ct += gridDim.x) {
        const bf16* ap = A + (size_t)r * lda + k0 + 8 * kg; const bf16* bp = Bt + (size_t)(16 * ct + r) * ldb + k0 + 8 * kg;
        f32x4 acc = {0.f, 0.f, 0.f, 0.f};
#pragma unroll 8
        for (int ks = 0; ks < kw; ks += 32) acc = __builtin_amdgcn_mfma_f32_16x16x32_bf16(*(const pg8::bf16x8*)(ap + ks), *(const pg8::bf16x8*)(bp + ks), acc, 0, 0, 0);
#pragma unroll
        for (int i = 0; i < 4; ++i) part[wid * 256 + (4 * kg + i) * 16 + r] = acc[i];
        LDS_WAIT(); __syncthreads();
        if (tid < 256) { const float s0 = (part[tid] + part[256 + tid]) + (part[512 + tid] + part[768 + tid]), s1 = (part[1024 + tid] + part[1280 + tid]) + (part[1536 + tid] + part[1792 + tid]);
            epi(tid >> 4, 16 * ct + (tid & 15), s0, s1); }
        LDS_WAIT(); __syncthreads();
    }
}
template <class Epi>
__device__ __forceinline__ void skinny16_f8(LAS unsigned char* lds, const unsigned char* A, int lda, const unsigned char* Bt, int ldb, int K, int N, int sc_a, int sc_b, const Epi& epi) {
    const int tid = threadIdx.x, wid = __builtin_amdgcn_readfirstlane(tid >> 6), lane = tid & 63, r = lane & 15, kg = lane >> 4;
    const int kw = K / 8, k0 = wid * kw;
    LAS float* part = (LAS float*)lds;
    for (int ct = blockIdx.x; ct < N / 16; ct += gridDim.x) {
        const unsigned char* ap = A + (size_t)r * lda + k0 + 32 * kg; const unsigned char* bp = Bt + (size_t)(16 * ct + r) * ldb + k0 + 32 * kg;
        f32x4 acc = {0.f, 0.f, 0.f, 0.f};
#pragma unroll 2
        for (int ks = 0; ks < kw; ks += 128) { const pg8::i32x8 av = *(const pg8::i32x8*)(ap + ks), bv = *(const pg8::i32x8*)(bp + ks);
            acc = __builtin_amdgcn_mfma_scale_f32_16x16x128_f8f6f4(av, bv, acc, 0, 0, 0, sc_a, 0, sc_b); }
#pragma unroll
        for (int i = 0; i < 4; ++i) part[wid * 256 + (4 * kg + i) * 16 + r] = acc[i];
        LDS_WAIT(); __syncthreads();
        if (tid < 256) { const float s0 = (part[tid] + part[256 + tid]) + (part[512 + tid] + part[768 + tid]), s1 = (part[1024 + tid] + part[1280 + tid]) + (part[1536 + tid] + part[1792 + tid]);
            epi(tid >> 4, 16 * ct + (tid & 15), s0, s1); }
        LDS_WAIT(); __syncthreads();
    }
}
template <class Epi>
__device__ __forceinline__ void skinny16(LAS unsigned char* lds, const bf16* A, int lda, const bf16* Bt, int ldb, int K, int N, const Epi& epi) {
    skinny16_once(lds, A, lda, Bt, ldb, K, N, epi); if ((DBL_MASK >> 10) & 1u) skinny16_once(lds, A, lda, Bt, ldb, K, N, epi);
}
struct SkinnyInProj { unsigned char* ws; __device__ __forceinline__ void operator()(int j, int n, float s0, float s1) const { inproj_store(ws, SEQ + j, n, s0 + s1); } };
struct SkinnyBranch { unsigned char* ws; __device__ __forceinline__ void operator()(int j, int n, float s0, float s1) const {
    const size_t r = SEQ + j; const bf16* G = (const bf16*)(ws + WS_GB); const float v = __builtin_amdgcn_fmed3f((bf2f(G[r * G_N + n]) * s0 + bf2f(G[r * G_N + DM + n]) * s1) * MG8_SCALE, -448.f, 448.f);
    (ws + WS_MG)[r * DM + n] = (unsigned char)(__builtin_amdgcn_cvt_pk_fp8_f32(v, 0.f, 0, false) & 0xff); } };
struct SkinnyOut { unsigned char* ws; __device__ __forceinline__ void operator()(int j, int n, float s0, float s1) const {
    const size_t o = (size_t)(SEQ + j) * DM + n; ((float*)(ws + WS_RB))[o] = ALPHA * ((const float*)(ws + WS_HF))[o] + (s0 + s1); } };

using pg8::Unit;
struct ProbInProj {
    static constexpr bool PERM = true, GATHER = false, KEEPS = false, FP8 = true;
    int K, lda, ldb, G, c; const unsigned char* A; const unsigned char* B; unsigned char* ws; int sc_a, sc_b;
    __device__ __forceinline__ bool next(int i, Unit& u) const { u.aux = 0; return pg8::static_tile(SEQ / 256, INP_N / 256, G, c, i, u.pm, u.pn); }
    __device__ __forceinline__ const char* a_ptr(const Unit& u) const { return (const char*)(A + (size_t)u.pm * 256 * lda); }
    __device__ __forceinline__ const char* b_ptr(const Unit& u) const { return (const char*)(B + (size_t)u.pn * 256 * ldb); }
    __device__ __forceinline__ bool epi(f32x4 (&acc)[2][2][4][2], const Unit& u, int wr, int wc, int fr, int fq) const {
        const int row0 = u.pm * 256 + wr * 64 + fr, ct = u.pn * 256 + wc * 32 + 8 * fq;
        const bool isg = u.pn >= 24, isq = (u.pn < 4) || (u.pn >= 12 && u.pn < 16);
        bf16* base = isg ? (bf16*)(ws + WS_GB) + (ct - QKV_N) : (bf16*)(ws + WS_QKV) + ct; const int ldc = isg ? G_N : QKV_N; const float sc = isq ? QSCALE : 1.0f;
#pragma unroll
        for (int ai = 0; ai < 2; ++ai)
#pragma unroll
            for (int m = 0; m < 4; ++m) { bf16* rowp = base + (size_t)(row0 + ai * 128 + m * 16) * ldc;
#pragma unroll
                for (int bj = 0; bj < 2; ++bj) { f32x4 v0 = acc[ai][bj][m][0], v1 = acc[ai][bj][m][1];
                    if (isg) {
#pragma unroll
                        for (int j = 0; j < 4; ++j) { v0[j] = __builtin_amdgcn_rcpf(1.0f + __builtin_amdgcn_exp2f(-LOG2E * v0[j])); v1[j] = __builtin_amdgcn_rcpf(1.0f + __builtin_amdgcn_exp2f(-LOG2E * v1[j])); } }
                    else { v0 = v0 * sc; v1 = v1 * sc; }
                    u32x4 w; w.x = pg8::cvt_pk_bf16(v0[0], v0[1]); w.y = pg8::cvt_pk_bf16(v0[2], v0[3]); w.z = pg8::cvt_pk_bf16(v1[0], v1[1]); w.w = pg8::cvt_pk_bf16(v1[2], v1[3]);
                    *(u32x4*)(rowp + bj * 128) = w; } }
        return false;
    }
};
struct ProbOutProj {
    static constexpr bool PERM = false, GATHER = false, KEEPS = false, FP8 = true;
    int K, lda, ldb, G, c; const unsigned char* A; const unsigned char* B; unsigned char* ws; int sc_a, sc_b;
    __device__ __forceinline__ bool next(int i, Unit& u) const { u.aux = 0; return pg8::static_tile(SEQ / 256, DM / 256, G, c, i, u.pm, u.pn); }
    __device__ __forceinline__ const char* a_ptr(const Unit& u) const { return (const char*)(A + (size_t)u.pm * 256 * lda); }
    __device__ __forceinline__ const char* b_ptr(const Unit& u) const { return (const char*)(B + (size_t)u.pn * 256 * ldb); }
    __device__ __forceinline__ bool epi(f32x4 (&acc)[2][2][4][2], const Unit& u, int wr, int wc, int fr, int fq) const {
        const int row0 = u.pm * 256 + wr * 64 + fr, col0 = u.pn * 256 + wc * 32 + 4 * fq;
        const float* HF = (const float*)(ws + WS_HF); float* R = (float*)(ws + WS_RB);
#pragma unroll
        for (int ai = 0; ai < 2; ++ai)
#pragma unroll
            for (int m = 0; m < 4; ++m) { const size_t off = (size_t)(row0 + ai * 128 + m * 16) * DM + col0;
#pragma unroll
                for (int bj = 0; bj < 2; ++bj)
#pragma unroll
                    for (int n = 0; n < 2; ++n) { const f32x4 hv = *(const f32x4*)(HF + off + bj * 128 + n * 16); *(f32x4*)(R + off + bj * 128 + n * 16) = hv * ALPHA + acc[ai][bj][m][n]; }
                asm volatile("" ::: "memory"); }
        return false;
    }
};

struct ProbBranch {
    static constexpr bool PERM = true, GATHER = false, KEEPS = true, FP8 = false;
    int K, lda, ldb, G, c; const bf16* A; const bf16* B; unsigned char* ws; int sc_a, sc_b;
    __device__ __forceinline__ bool next(int i, Unit& u) const { u.aux = i & 1; return pg8::static_tile(SEQ / 256, DM / 256, G, c, i >> 1, u.pm, u.pn); }
    __device__ __forceinline__ const char* a_ptr(const Unit& u) const { return (const char*)(A + (size_t)u.pm * 256 * lda + u.aux * 1024); }
    __device__ __forceinline__ const char* b_ptr(const Unit& u) const { return (const char*)(B + (size_t)u.pn * 256 * ldb + u.aux * 1024); }
    __device__ __forceinline__ bool epi(f32x4 (&acc)[2][2][4][2], const Unit& u, int wr, int wc, int fr, int fq) const {
        const int row0 = u.pm * 256 + wr * 64 + fr, ct = u.pn * 256 + wc * 32 + 8 * fq;
        const bf16* Gs = (const bf16*)(ws + WS_GB) + ct; const bf16* Gf = Gs + DM; unsigned char* MG = ws + WS_MG + ct;
        const bool first = u.aux == 0;
#pragma unroll
        for (int ai = 0; ai < 2; ++ai)
#pragma unroll
            for (int m = 0; m < 4; ++m) { const size_t r = (size_t)(row0 + ai * 128 + m * 16);
#pragma unroll
                for (int bj = 0; bj < 2; ++bj) { const u32x4 gf = *(const u32x4*)(Gf + r * G_N + bj * 128);
                    f32x4 f0 = {bflo(gf.x), bfhi(gf.x), bflo(gf.y), bfhi(gf.y)}, f1 = {bflo(gf.z), bfhi(gf.z), bflo(gf.w), bfhi(gf.w)};
                    if (first) { const u32x4 gs = *(const u32x4*)(Gs + r * G_N + bj * 128);
                        const f32x4 s0 = {bflo(gs.x), bfhi(gs.x), bflo(gs.y), bfhi(gs.y)}, s1 = {bflo(gs.z), bfhi(gs.z), bflo(gs.w), bfhi(gs.w)};
#pragma unroll
                        for (int j = 0; j < 4; ++j) { acc[ai][bj][m][0][j] *= s0[j] * __builtin_amdgcn_rcpf(fmaxf(f0[j], 1e-30f)); acc[ai][bj][m][1][j] *= s1[j] * __builtin_amdgcn_rcpf(fmaxf(f1[j], 1e-30f)); } }
                    else { const f32x4 v0 = acc[ai][bj][m][0] * f0 * MG8_SCALE, v1 = acc[ai][bj][m][1] * f1 * MG8_SCALE;
                        u32x2 w; w.x = pk4_fp8(v0[0], v0[1], v0[2], v0[3]); w.y = pk4_fp8(v1[0], v1[1], v1[2], v1[3]);
                        *(u32x2*)(MG + r * DM + bj * 128) = w; } }
                asm volatile("" ::: "memory"); }
        return first;
    }
};
constexpr int IDX_OFF = RING_BYTES + 1024, MOE_MAXU = 3;
struct ProbMoeGU {
    static constexpr bool PERM = true, GATHER = true, KEEPS = false, FP8 = true;
    int K, lda, ldb, G, c, layer; const unsigned char* A; const unsigned char* B; unsigned char* ws; const unsigned* ctl; LAS unsigned char* lds; int sc_a, sc_b;
    __device__ __forceinline__ bool next(int i, Unit& u) const { const int L = i * G + c; u.pm = L >> 3; u.pn = L & 7; int cnt, ps; return moe_find(ctl, layer, u.pm * 256, u.aux, cnt, ps); }
    __device__ __forceinline__ const char* a_ptr(const Unit&) const { return (const char*)A; }
    __device__ __forceinline__ const char* b_ptr(const Unit& u) const { return (const char*)(B + (size_t)u.aux * WGU_E + (size_t)u.pn * 256 * ldb); }
    __device__ __forceinline__ int a_row(int ui, int r) const { return *(const LAS int*)(lds + IDX_OFF + (ui * 256 + r) * 4); }
    __device__ __forceinline__ void fill_idx(int tid) const {
        for (int ui = 0; ui < MOE_MAXU; ++ui) { const int L = ui * G + c; int e, cnt, ps; if (!moe_find(ctl, layer, (L >> 3) * 256, e, cnt, ps)) break;
            if (tid < 256) { const int rank = (L >> 3) * 256 - ps + tid; *(LAS int*)(lds + IDX_OFF + (ui * 256 + tid) * 4) = rank < cnt ? ((const int*)(ws + WS_ELIST))[(size_t)e * MROWS + rank] : 0; } }
        LDS_WAIT(); __syncthreads();
    }
    __device__ __forceinline__ bool epi(f32x4 (&acc)[2][2][4][2], const Unit& u, int wr, int wc, int fr, int fq) const {
        const int row0 = u.pm * 256 + wr * 64 + fr, ct = u.pn * 128 + wc * 32 + 8 * fq; unsigned char* act = ws + WS_ACT + ct;
#pragma unroll
        for (int ai = 0; ai < 2; ++ai)
#pragma unroll
            for (int m = 0; m < 4; ++m) { f32x4 v[2];
#pragma unroll
                for (int n = 0; n < 2; ++n)
#pragma unroll
                    for (int j = 0; j < 4; ++j) { const float g = acc[ai][0][m][n][j]; v[n][j] = g * __builtin_amdgcn_rcpf(1.0f + __builtin_amdgcn_exp2f(-LOG2E * g)) * acc[ai][1][m][n][j]; }
                u32x2 w; w.x = pk4_fp8(v[0][0] * ACT8_SCALE, v[0][1] * ACT8_SCALE, v[0][2] * ACT8_SCALE, v[0][3] * ACT8_SCALE); w.y = pk4_fp8(v[1][0] * ACT8_SCALE, v[1][1] * ACT8_SCALE, v[1][2] * ACT8_SCALE, v[1][3] * ACT8_SCALE);
                *(u32x2*)(act + (size_t)(row0 + ai * 128 + m * 16) * FF) = w; }
        return false;
    }
};
struct ProbMoeDown {
    static constexpr bool PERM = true, GATHER = false, KEEPS = false, FP8 = true;
    int K, lda, ldb, G, c, layer; const unsigned char* A; const unsigned char* B; unsigned char* ws; const unsigned* ctl; int sc_a, sc_b;
    __device__ __forceinline__ bool next(int i, Unit& u) const { const int L = i * G + c; u.pm = L >> 3; u.pn = L & 7; int cnt, ps; return moe_find(ctl, layer, u.pm * 256, u.aux, cnt, ps); }
    __device__ __forceinline__ const char* a_ptr(const Unit& u) const { return (const char*)(A + (size_t)u.pm * 256 * lda); }
    __device__ __forceinline__ const char* b_ptr(const Unit& u) const { return (const char*)(B + (size_t)u.aux * WD_E + (size_t)u.pn * 256 * ldb); }
    __device__ __forceinline__ bool epi(f32x4 (&acc)[2][2][4][2], const Unit& u, int wr, int wc, int fr, int fq) const {
        const int row0 = u.pm * 256 + wr * 64 + fr, ct = u.pn * 256 + wc * 32 + 8 * fq; bf16* O = (bf16*)(ws + WS_OSL) + ct;
#pragma unroll
        for (int ai = 0; ai < 2; ++ai)
#pragma unroll
            for (int m = 0; m < 4; ++m)
#pragma unroll
                for (int bj = 0; bj < 2; ++bj) { const f32x4 v0 = acc[ai][bj][m][0], v1 = acc[ai][bj][m][1];
                    u32x4 w; w.x = pg8::cvt_pk_bf16(v0[0], v0[1]); w.y = pg8::cvt_pk_bf16(v0[2], v0[3]); w.z = pg8::cvt_pk_bf16(v1[0], v1[1]); w.w = pg8::cvt_pk_bf16(v1[2], v1[3]);
                    *(u32x4*)(O + (size_t)(row0 + ai * 128 + m * 16) * DM + bj * 128) = w; }
        return false;
    }
};

#ifndef ATT_DBL
#define ATT_DBL 0
#endif
namespace att {
typedef short bf16x8 __attribute__((ext_vector_type(8)));
typedef short s16x4 __attribute__((ext_vector_type(4)));
typedef float f32x16 __attribute__((ext_vector_type(16)));
constexpr int TILE_B = 16384;
constexpr int L_V = 0, L_K = 3 * TILE_B, L_C2 = 6 * TILE_B, L_WS = L_C2 + 1024, L_ITEM = L_WS + 8 * 256, L_END = L_ITEM + 16;
#define KSWZ(row, colB) ((row) * 256 + ((colB) ^ (((row) & 7) << 4)))
#define SBAR() __builtin_amdgcn_sched_barrier(0)
__device__ __forceinline__ int v_st(int k, int c) { const int kk = (k & ~0xC) | ((k & 4) << 1) | ((k & 8) >> 1); return ((kk >> 3) * 4 + (c >> 5)) * 512 + ((kk & 7) * 32 + (c & 31)) * 2; }
__device__ __forceinline__ int v_rd_base(int lane) { return ((lane & 3) << 3) | (((lane >> 2) & 3) << 6) | (((lane >> 4) & 1) << 5) | (((lane >> 5) & 1) << 8); }
constexpr int v_rd_off(int d0, int ks, int half) { return d0 * 512 + ks * 4096 + half * 2048; }
__device__ __forceinline__ int crow(int r, int hi) { return (r & 3) + 8 * (r >> 2) + 4 * hi; }
__device__ __forceinline__ unsigned cvtpk(float lo, float hi) { unsigned r; asm volatile("v_cvt_pk_bf16_f32 %0, %1, %2" : "=v"(r) : "v"(lo), "v"(hi)); return r; }
__device__ __forceinline__ float xchg_sum(float v) { auto rr = __builtin_amdgcn_permlane32_swap(__float_as_uint(v), __float_as_uint(v), false, false); return __uint_as_float(rr[0]) + __uint_as_float(rr[1]); }
__device__ __forceinline__ float xchg_max(float v) { auto rr = __builtin_amdgcn_permlane32_swap(__float_as_uint(v), __float_as_uint(v), false, false); return fmaxf(__uint_as_float(rr[0]), __uint_as_float(rr[1])); }
#define PK4(P, B_, OUT) do { unsigned a0 = cvtpk(P[B_+0], P[B_+1]), a1 = cvtpk(P[B_+2], P[B_+3]); unsigned b0 = cvtpk(P[B_+4], P[B_+5]), b1 = cvtpk(P[B_+6], P[B_+7]); \
        auto r0 = __builtin_amdgcn_permlane32_swap(a0, b0, false, false); auto r1 = __builtin_amdgcn_permlane32_swap(a1, b1, false, false); \
        u32x4 w = {r0[0], r1[0], r0[1], r1[1]}; OUT = *reinterpret_cast<bf16x8*>(&w); } while (0)
__device__ __forceinline__ void qkt(f32x16& p0, f32x16& p1, const LAS unsigned char* kt, int r32, int hi, const bf16x8* qr) {
    p0 = f32x16{}; p1 = f32x16{};
    const LAS unsigned char* kb[4];
#pragma unroll
    for (int dd = 0; dd < 4; ++dd) kb[dd] = kt + KSWZ(r32, (dd * 16 + hi * 8) * 2);
#pragma unroll
    for (int d0 = 0; d0 < 8; ++d0) { const LAS unsigned char* a = kb[d0 & 3] + (d0 >> 2) * 128;
        const bf16x8 b0 = *(const LAS bf16x8*)(a); const bf16x8 b1 = *(const LAS bf16x8*)(a + 32 * 256);
        p0 = __builtin_amdgcn_mfma_f32_32x32x16_bf16(b0, qr[d0], p0, 0, 0, 0);
        p1 = __builtin_amdgcn_mfma_f32_32x32x16_bf16(b1, qr[d0], p1, 0, 0, 0); }
}
__device__ __forceinline__ void pv_tile(f32x16* o, unsigned vb0, bf16x8 pa0, bf16x8 pa1, bf16x8 pa2, bf16x8 pa3) {
#define TRRD(dst, off) asm volatile("ds_read_b64_tr_b16 %0, %1 offset:%2" : "=&v"(dst) : "v"(vb0), "i"(off) : "memory")
#define PV_D0(d0) do { s16x4 l0, l1, l2, l3, h0, h1, h2, h3; constexpr int b_ = v_rd_off(d0, 0, 0); \
        TRRD(l0, b_); TRRD(h0, b_ + 2048); TRRD(l1, b_ + 4096); TRRD(h1, b_ + 6144); TRRD(l2, b_ + 8192); TRRD(h2, b_ + 10240); TRRD(l3, b_ + 12288); TRRD(h3, b_ + 14336); \
        asm volatile("s_waitcnt lgkmcnt(0)" ::: "memory"); SBAR(); \
        o[d0] = __builtin_amdgcn_mfma_f32_32x32x16_bf16(pa0, (bf16x8){l0[0], l0[1], l0[2], l0[3], h0[0], h0[1], h0[2], h0[3]}, o[d0], 0, 0, 0); \
        o[d0] = __builtin_amdgcn_mfma_f32_32x32x16_bf16(pa1, (bf16x8){l1[0], l1[1], l1[2], l1[3], h1[0], h1[1], h1[2], h1[3]}, o[d0], 0, 0, 0); \
        o[d0] = __builtin_amdgcn_mfma_f32_32x32x16_bf16(pa2, (bf16x8){l2[0], l2[1], l2[2], l2[3], h2[0], h2[1], h2[2], h2[3]}, o[d0], 0, 0, 0); \
        o[d0] = __builtin_amdgcn_mfma_f32_32x32x16_bf16(pa3, (bf16x8){l3[0], l3[1], l3[2], l3[3], h3[0], h3[1], h3[2], h3[3]}, o[d0], 0, 0, 0); } while (0)
    PV_D0(0); PV_D0(1); PV_D0(2); PV_D0(3);
#undef PV_D0
#undef TRRD
}
#define VIS(cc) (((dqh) - (cc)) >= NEED && (cc) < (nvh))
__device__ __forceinline__ void sb_tile(f32x16& p0, f32x16& p1, float& carry, bool domask, int dqh, int nvh, int hi, bf16x8& pa0, bf16x8& pa1, bf16x8& pa2, bf16x8& pa3) {
    constexpr int NEED = 1;
    f32x16 x0, x1;
#pragma unroll
    for (int r = 0; r < 16; ++r) {
        { const float u = __builtin_amdgcn_fmed3f(p0[r], -126.f, 126.f), b = __builtin_amdgcn_logf(1.0f + __builtin_amdgcn_exp2f(-u)); x0[r] = -b; p0[r] = -u - b; }
        { const float u = __builtin_amdgcn_fmed3f(p1[r], -126.f, 126.f), b = __builtin_amdgcn_logf(1.0f + __builtin_amdgcn_exp2f(-u)); x1[r] = -b; p1[r] = -u - b; } }
    if (domask) { const float NEG = -__builtin_inff();
#pragma unroll
        for (int r = 0; r < 16; ++r) { const int cc = (r & 3) + 8 * (r >> 2);
            if (!VIS(cc)) { p0[r] = 0.f; x0[r] = NEG; }
            if (!VIS(cc + 32)) { p1[r] = 0.f; x1[r] = NEG; } } }
    float A[9]; A[8] = 0.f;
#pragma unroll
    for (int g = 3; g >= 0; --g) A[4 + g] = A[5 + g] + ((p1[4 * g] + p1[4 * g + 1]) + (p1[4 * g + 2] + p1[4 * g + 3]));
#pragma unroll
    for (int g = 3; g >= 0; --g) A[g] = A[1 + g] + ((p0[4 * g] + p0[4 * g + 1]) + (p0[4 * g + 2] + p0[4 * g + 3]));
    float off[8];
#pragma unroll
    for (int i = 0; i < 8; ++i) { auto rr = __builtin_amdgcn_permlane32_swap(__float_as_uint(A[i]), __float_as_uint(A[i + 1]), false, false);
        const float recv = hi ? __uint_as_float(rr[0]) : __uint_as_float(rr[1]); off[i] = carry + A[i + 1] + recv; }
    carry += xchg_sum(A[0]);
#pragma unroll
    for (int g = 0; g < 4; ++g) {
        { float af = off[g]; const float l3 = p0[4 * g + 3], l2 = p0[4 * g + 2], l1 = p0[4 * g + 1];
          x0[4 * g + 3] = __builtin_amdgcn_exp2f(x0[4 * g + 3] + af); af += l3; x0[4 * g + 2] = __builtin_amdgcn_exp2f(x0[4 * g + 2] + af); af += l2;
          x0[4 * g + 1] = __builtin_amdgcn_exp2f(x0[4 * g + 1] + af); af += l1; x0[4 * g] = __builtin_amdgcn_exp2f(x0[4 * g] + af); }
        { float af = off[4 + g]; const float l3 = p1[4 * g + 3], l2 = p1[4 * g + 2], l1 = p1[4 * g + 1];
          x1[4 * g + 3] = __builtin_amdgcn_exp2f(x1[4 * g + 3] + af); af += l3; x1[4 * g + 2] = __builtin_amdgcn_exp2f(x1[4 * g + 2] + af); af += l2;
          x1[4 * g + 1] = __builtin_amdgcn_exp2f(x1[4 * g + 1] + af); af += l1; x1[4 * g] = __builtin_amdgcn_exp2f(x1[4 * g] + af); } }
    PK4(x0, 0, pa0); PK4(x0, 8, pa1); PK4(x1, 0, pa2); PK4(x1, 8, pa3);
}
__device__ __forceinline__ float fox_tile(f32x16& p0, f32x16& p1, const LAS float* c2t, float& m_reg, float& l_reg, bool domask, int dqh, int nvh, int hi, bf16x8& pa0, bf16x8& pa1, bf16x8& pa2, bf16x8& pa3) {
    constexpr int NEED = 0;
#pragma unroll
    for (int g = 0; g < 4; ++g) { const f32x4 c0 = *(const LAS f32x4*)(c2t + 8 * g + 4 * hi), c1 = *(const LAS f32x4*)(c2t + 32 + 8 * g + 4 * hi);
#pragma unroll
        for (int j = 0; j < 4; ++j) { p0[4 * g + j] -= c0[j]; p1[4 * g + j] -= c1[j]; } }
    if (domask) { const float NEG = -__builtin_inff();
#pragma unroll
        for (int r = 0; r < 16; ++r) { const int cc = (r & 3) + 8 * (r >> 2);
            if (!VIS(cc)) p0[r] = NEG;
            if (!VIS(cc + 32)) p1[r] = NEG; } }
    float pmax = p0[0];
#pragma unroll
    for (int r = 1; r < 16; ++r) pmax = fmaxf(pmax, p0[r]);
#pragma unroll
    for (int r = 0; r < 16; ++r) pmax = fmaxf(pmax, p1[r]);
    pmax = xchg_max(pmax);
    const float mn = fmaxf(m_reg, pmax), alpha = __builtin_amdgcn_exp2f(m_reg - mn); m_reg = mn;
    float ps = 0.f;
#pragma unroll
    for (int r = 0; r < 16; ++r) { p0[r] = __builtin_amdgcn_exp2f(p0[r] - mn); p1[r] = __builtin_amdgcn_exp2f(p1[r] - mn); ps += p0[r] + p1[r]; }
    l_reg = l_reg * alpha + xchg_sum(ps);
    PK4(p0, 0, pa0); PK4(p0, 8, pa1); PK4(p1, 0, pa2); PK4(p1, 8, pa3);
    return alpha;
}
#undef VIS
template <int TYPE>
__device__ __forceinline__ void attn_unit(LAS unsigned char* lds, unsigned char* ws, int head, int qb) {
    const int tid = threadIdx.x, wid = __builtin_amdgcn_readfirstlane(tid >> 6), lane = tid & 63, r32 = lane & 31, hi = lane >> 5;
    const bool grpY = wid >= 4;
    const bf16* QKV = (const bf16*)(ws + WS_QKV);
    const int qcol = (TYPE ? 3072 : 0) + head * HD, kcol = qcol + 1024, vcol = qcol + 2048;
    const float* fsuf = (const float*)(ws + WS_CUM) + (size_t)head * MROWS; const float* ftot = (const float*)(ws + WS_CUM) + (size_t)NHEAD * MROWS + head * 256;
    float fcarry = 0.f, st_tot = 0.f;
    const int qrow0 = qb * 256, NT = qb < 32 ? 4 * qb + 5 : 1;
    const int qbase = qb < 32 ? qrow0 : -NMETA;
    const int qlo = qbase + wid * 32, qpos = qlo + r32;
    LAS unsigned char* V_lds = lds + L_V; LAS unsigned char* K_lds = lds + L_K; LAS float* c2_lds = (LAS float*)(lds + L_C2);
    LAS float* wsl = (LAS float*)(lds + L_WS) + wid * 64;
    bf16x8 qr[8];
#pragma unroll
    for (int d0 = 0; d0 < 8; ++d0) qr[d0] = *(const bf16x8*)(QKV + (size_t)(qrow0 + wid * 32 + r32) * QKV_N + qcol + d0 * 16 + hi * 8);
    const int sr = tid >> 4, sc = (tid & 15) * 8, vst0 = v_st(sr, sc), vst1 = v_st(32 + sr, sc), kws = KSWZ(sr, sc * 2);
    const unsigned vrd = (unsigned)(size_t)V_lds + (unsigned)v_rd_base(lane);
    bf16x8 st_k0, st_k1, st_v0, st_v1; float st_c = 0.f;
#define TISMETA(t) ((t) == NT - 1)
#define SLOAD(t) do { const int row_ = TISMETA(t) ? SEQ : 64 * (4 * qb + 3 - (t)); const bf16* kp_ = QKV + (size_t)(row_ + sr) * QKV_N + sc; \
        st_k0 = *(const bf16x8*)(kp_ + kcol); st_k1 = *(const bf16x8*)(kp_ + (size_t)32 * QKV_N + kcol); st_v0 = *(const bf16x8*)(kp_ + vcol); st_v1 = *(const bf16x8*)(kp_ + (size_t)32 * QKV_N + vcol); \
        if (TYPE == 1 && tid < 64) { st_c = fsuf[row_ + tid]; st_tot = ftot[row_ >> 6]; } } while (0)
#define SWRITE(bo) do { *(LAS bf16x8*)(K_lds + (bo) + kws) = st_k0; *(LAS bf16x8*)(K_lds + (bo) + kws + 32 * 256) = st_k1; \
        *(LAS bf16x8*)(V_lds + (bo) + vst0) = st_v0; *(LAS bf16x8*)(V_lds + (bo) + vst1) = st_v1; if (TYPE == 1 && tid < 64) { c2_lds[((bo) >> 8) + tid] = -(fcarry + st_c); fcarry += st_tot; } } while (0)
#define BAR() asm volatile("s_waitcnt lgkmcnt(0)\n\ts_barrier" ::: "memory")
    SLOAD(0); SWRITE(0);
    if (NT > 1) { SLOAD(1); SWRITE(TILE_B); }
    __builtin_amdgcn_s_waitcnt(0x0F70);
    if (NT > 2) SLOAD(2);
    BAR();
    if (grpY) BAR();
    f32x16 o[4] = {}; float carry = 0.f, m_reg = -1e30f, l_reg = 0.f;
    constexpr int NEEDW = TYPE == 0 ? 1 : 0;
#define KBASE(t) (TISMETA(t) ? -NMETA : 64 * (4 * qb + 3 - (t)))
#define ACTW(t) ((qlo + 31 - KBASE(t)) >= NEEDW && (qb < 32 || wid == 0))
    f32x16 p0, p1;
    if (ACTW(0)) qkt(p0, p1, K_lds, r32, hi, qr);
    int bo = 0, bo1 = TILE_B, bo2 = 2 * TILE_B;
    for (int t = 0; t < NT; ++t) {
        BAR();
        const int kbase = KBASE(t), nvalid = TISMETA(t) ? NMETA : 64;
        const bool actw = ACTW(t);
        const bool domask = (qlo - (kbase + 63) < NEEDW) || nvalid < 64;
        bf16x8 pa0, pa1, pa2, pa3;
        if (actw) {
            const int dqh = qpos - kbase - 4 * hi, nvh = nvalid - 4 * hi;
            if (TYPE == 0) sb_tile(p0, p1, carry, domask, dqh, nvh, hi, pa0, pa1, pa2, pa3);
            else { const float alpha = fox_tile(p0, p1, c2_lds + (bo >> 8), m_reg, l_reg, domask, dqh, nvh, hi, pa0, pa1, pa2, pa3);
                if (__any(alpha < 1.f)) { if (hi == 0) wsl[r32] = alpha; asm volatile("s_waitcnt lgkmcnt(0)" ::: "memory");
#pragma unroll
                    for (int r = 0; r < 16; ++r) { const float al = wsl[crow(r, hi)];
#pragma unroll
                        for (int d = 0; d < 4; ++d) o[d][r] *= al; } } }
        }
        BAR();
        if (t + 2 < NT) SWRITE(bo2);
        if (t + 3 < NT) SLOAD(t + 3);
        if (actw) pv_tile(o, vrd + bo, pa0, pa1, pa2, pa3);
        if (t + 1 < NT) { if (ACTW(t + 1)) qkt(p0, p1, K_lds + bo1, r32, hi, qr); }
        { const int tmp = bo; bo = bo1; bo1 = bo2; bo2 = tmp; }
    }
    if (!grpY) BAR();
    float rli[16];
    if (TYPE == 1) { if (hi == 0) wsl[32 + r32] = l_reg; asm volatile("s_waitcnt lgkmcnt(0)" ::: "memory");
#pragma unroll
        for (int r = 0; r < 16; ++r) rli[r] = __builtin_amdgcn_rcpf(wsl[32 + crow(r, hi)]); }
    bf16* Yw = (bf16*)(ws + WS_YB) + (size_t)(qrow0 + wid * 32) * DM + TYPE * 1024 + head * HD;
    if (qb < 32 || wid == 0)
#pragma unroll
    for (int r = 0; r < 16; ++r) { const int orow = crow(r, hi);
#pragma unroll
        for (int d0 = 0; d0 < 4; ++d0) { const float v = TYPE == 1 ? o[d0][r] * rli[r] : o[d0][r]; const float vn = __shfl_xor(v, 1);
            if ((r32 & 1) == 0) *(unsigned*)(Yw + (size_t)orow * DM + d0 * 32 + r32) = cvtpk(v, vn); } }
#undef TISMETA
#undef SLOAD
#undef SWRITE
#undef BAR
#undef KBASE
#undef ACTW
}
constexpr int CW_ATTNQ = 3072;
__device__ __forceinline__ void attn_phase(Frame& F, int layer, int qoff) {
    LAS unsigned char* lds = F.lds; unsigned char* ws = F.ws; unsigned* ctl = F.ctl; const int G = F.G, b = blockIdx.x;
    const int NA = 512 + (layer == 0 ? 16 : 0);
    const int cv0 = layer == 0 ? CV_G0_END : CV_G1_END, NB_ = ((layer == 0 ? CV_G1_END : N_CONVERT_ITEMS) - cv0) / CV_BUNDLE;
    const bool copier = (b % 3) == 2; const int ncop = (G + 1) / 3, nfree = G - ncop;
    LAS int* itemw = (LAS int*)(lds + L_ITEM);
    int it;
    if (copier) {
        for (int j = b / 3; j < NB_; j += ncop) convert_bundle(F, cv0 + j * CV_BUNDLE);
        __syncthreads();
        if (threadIdx.x == 0) *itemw = nfree + (int)atomicAdd(ctl + CW_ATTNQ + layer * 64 + qoff, 1u);
        asm volatile("s_waitcnt lgkmcnt(0)" ::: "memory"); __syncthreads();
        it = __builtin_amdgcn_readfirstlane(*itemw);
    } else it = b - b / 3;
    while (it < NA) {
        int qb, th; if (it < 512) { qb = 31 - (it >> 4); th = it & 15; } else { qb = 32; th = it - 512; }
        if (th < 8) attn_unit<0>(lds, ws, th, qb); else attn_unit<1>(lds, ws, th - 8, qb);
        __syncthreads();
        if (threadIdx.x == 0) *itemw = nfree + (int)atomicAdd(ctl + CW_ATTNQ + layer * 64 + qoff, 1u);
        asm volatile("s_waitcnt lgkmcnt(0)" ::: "memory"); __syncthreads();
        it = __builtin_amdgcn_readfirstlane(*itemw);
    }
}
#undef KSWZ
#undef SBAR
#undef PK4
}

__global__ void __launch_bounds__(NTHREADS, 2) mk_fwd(Args args) {
    extern __shared__ __attribute__((aligned(16))) unsigned char lds_raw[];
    Frame F;
    F.lds = (LAS unsigned char*)lds_raw; F.ws = args.ws; F.ctl = (unsigned*)(args.ws + WS_CTL);
    F.tid = threadIdx.x; F.lane = F.tid & 63; F.wave = __builtin_amdgcn_readfirstlane(F.tid >> 6);
    F.G = gridDim.x; F.gw = blockIdx.x * NWAVES + F.wave; F.NGW = F.G * NWAVES;
    F.in = (const float* const*)__builtin_amdgcn_kernarg_segment_ptr();
    F.out = args.out;
    volatile LAS unsigned* MISC = (volatile LAS unsigned*)(F.lds + MISC_OFF);
    for (int u = F.tid; u < (LDS_BYTES - RING_BYTES) / 4; u += NTHREADS) ((LAS unsigned*)(F.lds + RING_BYTES))[u] = 0u;
    __syncthreads();
    XcdBarrier bar = xcd_barrier_post(F.ctl + CW_BAR + args.li * XCD_BAR_WORDS, MISC + 8);
    const int lo = args.ph_lo, hi = args.ph_hi; const unsigned naive = args.naive;
#define IN(k) (lo <= (k) && (k) < hi)
#define SEAM(k) do { if (IN(k) && IN((k) + 1)) { xcd_barrier(bar); if ((DBL_MASK >> 9) & 1u) xcd_barrier(bar); } } while (0)
#define NAIVE(t) ((naive >> (t)) & 1u)
    if (IN(0)) { phase_prologue(F); SEAM(0); }
#define LAYER_PHASES(l, pb) do { \
        if (IN(pb + PH_A)) { phase_cumsum(F, NAIVE(PH_B)); if (!NAIVE(PH_B)) phase_tilesuf(F); \
            if (!NAIVE(PH_A)) { skinny16_f8(F.lds, F.ws + WS_H8 + (size_t)SEQ * DM, DM, F.ws + WS_WIN + l * WIN_L, DM, DM, INP_N, SC_H, SC_W, SkinnyInProj{F.ws}); \
              ProbInProj P{DM, DM, DM, F.G, (int)blockIdx.x, F.ws + WS_H8, F.ws + WS_WIN + l * WIN_L, F.ws, SC_H, SC_W}; pg8::gemm_phase(F.lds, P); if ((DBL_MASK >> PH_A) & 1u) pg8::gemm_phase(F.lds, P); } \
            SEAM(pb + PH_A); } \
        if (IN(pb + PH_B)) { \
            if (!NAIVE(PH_B)) att::attn_phase(F, l, 0); \
            SEAM(pb + PH_B); } \
        if (IN(pb + PH_C)) { \
            if (!NAIVE(PH_C)) { if (l == 0) skinny16(F.lds, (const bf16*)(F.ws + WS_YB) + (size_t)SEQ * DM, DM, (const bf16*)(F.ws + WS_WB + l * WB_L), DM, DM, DM, SkinnyBranch{F.ws}); \
              ProbBranch P{1024, DM, DM, F.G, (int)blockIdx.x, (const bf16*)(F.ws + WS_YB), (const bf16*)(F.ws + WS_WB + l * WB_L), F.ws, 0, 0}; pg8::gemm_phase(F.lds, P); if ((DBL_MASK >> PH_C) & 1u) pg8::gemm_phase(F.lds, P); } \
            SEAM(pb + PH_C); } \
        if (IN(pb + PH_D)) { \
            if (!NAIVE(PH_D)) { if (l == 0) skinny16_f8(F.lds, F.ws + WS_MG + (size_t)SEQ * DM, DM, F.ws + WS_WOUT + l * WOUT_L, DM, DM, DM, SC_MG, SC_W, SkinnyOut{F.ws}); \
              ProbOutProj P{DM, DM, DM, F.G, (int)blockIdx.x, F.ws + WS_MG, F.ws + WS_WOUT + l * WOUT_L, F.ws, SC_MG, SC_W}; pg8::gemm_phase(F.lds, P); if ((DBL_MASK >> PH_D) & 1u) pg8::gemm_phase(F.lds, P); } \
            SEAM(pb + PH_D); } \
        if (IN(pb + PH_E)) { if ((DBL_MASK >> PH_E) & 1u) phase_ln_router(F, l, true); phase_ln_router(F, l); SEAM(pb + PH_E); } \
        if (IN(pb + PH_F)) { \
            if (!NAIVE(PH_F)) { ProbMoeGU P{DM, DM, DM, F.G, (int)blockIdx.x, l, F.ws + WS_H8, F.ws + WS_WGU + l * WGU_L, F.ws, F.ctl, F.lds, SC_H, SC_W}; P.fill_idx(F.tid); pg8::gemm_phase(F.lds, P); if ((DBL_MASK >> PH_F) & 1u) pg8::gemm_phase(F.lds, P); } \
            SEAM(pb + PH_F); } \
        if (IN(pb + PH_G)) { \
            if (!NAIVE(PH_G)) { ProbMoeDown P{FF, FF, FF, F.G, (int)blockIdx.x, l, F.ws + WS_ACT, F.ws + WS_WD + l * WD_L, F.ws, F.ctl, SC_ACT, SC_W}; pg8::gemm_phase(F.lds, P); if ((DBL_MASK >> PH_G) & 1u) pg8::gemm_phase(F.lds, P); } \
            SEAM(pb + PH_G); } \
        if (IN(pb + PH_H)) { if ((DBL_MASK >> PH_H) & 1u) phase_ln_final(F, l, true); phase_ln_final(F, l); SEAM(pb + PH_H); } \
    } while (0)
    LAYER_PHASES(0, 1);
    LAYER_PHASES(1, 9);
#undef LAYER_PHASES
#undef IN
#undef SEAM
#undef NAIVE
}

static void launch_naive(int type, int layer, const Args& a, hipStream_t stream) {
    switch (type) {
    case PH_A: hipLaunchKernelGGL(naive_inproj, dim3(INP_N / 256, MROWS / 4), dim3(256), 0, stream, a, layer); break;
    case PH_B: { const int nq = NTOK; hipLaunchKernelGGL(naive_attn, dim3((16 * nq + 3) / 4), dim3(256), 0, stream, a, nq); } break;
    case PH_C: hipLaunchKernelGGL(naive_branch, dim3(DM / 256, MROWS / 4), dim3(256), 0, stream, a, layer); break;
    case PH_D: hipLaunchKernelGGL(naive_outproj, dim3(DM / 256, MROWS / 4), dim3(256), 0, stream, a, layer); break;
    case PH_F: hipLaunchKernelGGL(naive_moe_gu, dim3(FF / 256, NSLOT_MAX / 4), dim3(256), 0, stream, a, layer); break;
    case PH_G: hipLaunchKernelGGL(naive_moe_down, dim3(DM / 256, NSLOT_MAX / 4), dim3(256), 0, stream, a, layer); break;
    default: break;
    }
}
extern "C" void kernel_launch(void* const* d_in, const int* in_sizes, int n_in, void* d_out, int out_size, void* d_ws, size_t ws_size, hipStream_t stream) {
    static int grid = 0;
    if (grid == 0) {
        if (n_in != 18 || out_size != SEQ * DM || ws_size < WS_END) { fprintf(stderr, "kernel_launch: unexpected shapes (n_in %d out %d ws %zu)\n", n_in, out_size, ws_size); grid = -1; return; }
        int dev = 0, cus = 0;
        if (hipGetDevice(&dev) != hipSuccess || hipDeviceGetAttribute(&cus, hipDeviceAttributeMultiprocessorCount, dev) != hipSuccess) { grid = -1; return; }
        if (hipFuncSetAttribute((const void*)mk_fwd, hipFuncAttributeMaxDynamicSharedMemorySize, LDS_BYTES) != hipSuccess) { fprintf(stderr, "kernel_launch: hipFuncSetAttribute failed\n"); grid = -1; return; }
        int per_cu = 0;
        if (hipOccupancyMaxActiveBlocksPerMultiprocessor(&per_cu, (const void*)mk_fwd, NTHREADS, LDS_BYTES) != hipSuccess || per_cu < 1) fprintf(stderr, "kernel_launch: occupancy query says %d\n", per_cu);
        (void)hipGetLastError();
        grid = cus;
    }
    if (grid < 0) return;
    (void)hipMemsetAsync((char*)d_ws + WS_CTL, 0, CTL_ZERO_BYTES, stream);
    Args a{};
    for (int i = 0; i < 18; ++i) a.in[i] = (const float*)d_in[i];
    a.out = (float*)d_out; a.ws = (unsigned char*)d_ws; a.naive = NAIVE_MASK;
    int li = 0, lo = 0;
    auto flush = [&](int hi) { if (hi > lo) { a.ph_lo = lo; a.ph_hi = hi; a.li = li++; hipLaunchKernelGGL(mk_fwd, dim3(grid), dim3(NTHREADS), LDS_BYTES, stream, a); } lo = hi; };
    for (int ph = 1; ph < NPHASE; ++ph) {
        const int type = (ph - 1) & 7, layer = (ph - 1) >> 3;
        if ((NAIVE_MASK >> type) & 1u) {
            if (type == PH_A) flush(ph + 1); else { flush(ph); lo = ph + 1; }
            launch_naive(type, layer, a, stream); }
    }
    flush(NPHASE);
}
```

```cpp
#include <hip/hip_runtime.h>
#include <cstdio>
#include <cstdint>

#define GAS __attribute__((address_space(1)))
#define LAS __attribute__((address_space(3)))
typedef unsigned short bf16;
typedef float f32x4 __attribute__((ext_vector_type(4)));
typedef float f32x2 __attribute__((ext_vector_type(2)));
typedef unsigned u32x4 __attribute__((ext_vector_type(4)));
typedef unsigned u32x2 __attribute__((ext_vector_type(2)));
typedef GAS unsigned gu32;

constexpr int DM = 2048, SEQ = 8192, NMETA = 16, NTOK = SEQ + NMETA, MROWS = 8448;
constexpr int HD = 128, NHEAD = 8;
constexpr int QKV_N = 6144, G_N = 4096, INP_N = 10240, INP_SRC = 10248, FCOL = 6144;
constexpr int NE = 16, FF = 1024, NSLOT_MAX = 20480;
constexpr float ALPHA = 1.4142135623730951f, LN_EPS = 1e-5f;
constexpr float LOG2E = 1.4426950408889634f;
constexpr float QSCALE = 0.08838834764831845f * 1.4426950408889634f;
constexpr int NLAYER = 2, NPHASE = 1 + 8 * NLAYER;
enum { PH_A = 0, PH_B = 1, PH_C = 2, PH_D = 3, PH_E = 4, PH_F = 5, PH_G = 6, PH_H = 7 };

#ifndef NAIVE_MASK
#define NAIVE_MASK 0x00u
#endif
#ifndef DBL_MASK
#define DBL_MASK 0u
#endif
constexpr size_t MiB = 1u << 20;
constexpr size_t WS_CTL = 0, CTL_ZERO_BYTES = 1 * MiB;
constexpr size_t WS_WIN = 2 * MiB, WIN_L = 40 * MiB;
constexpr size_t WS_WB = 82 * MiB, WB_L = 8 * MiB;
constexpr size_t WS_WOUT = 98 * MiB, WOUT_L = 8 * MiB;
constexpr size_t WS_WGU = 114 * MiB, WGU_L = 128 * MiB, WGU_E = 8 * MiB;
constexpr size_t WS_WD = 370 * MiB, WD_L = 64 * MiB, WD_E = 4 * MiB;
constexpr size_t WS_HF = 498 * MiB;
constexpr size_t WS_HB = 564 * MiB;
constexpr size_t WS_RB = 597 * MiB;
constexpr size_t WS_QKV = 663 * MiB;
constexpr size_t WS_GB = 762 * MiB;
constexpr size_t WS_YB = 828 * MiB;
constexpr size_t WS_MG = 861 * MiB;
constexpr size_t WS_ACT = 663 * MiB;
constexpr size_t WS_OSL = 703 * MiB;
constexpr size_t WS_LOGF = 894 * MiB;
constexpr size_t WS_CUM = 895 * MiB;
constexpr size_t WS_ELIST = 896 * MiB;
constexpr size_t WS_TOKI = 897 * MiB;
constexpr size_t WS_H8 = 898 * MiB;
constexpr size_t WS_END = 916 * MiB;
constexpr int CW_CNT = 1024;
constexpr int CW_KMAX = 4096;
constexpr int CW_BAR = 8192;
#define XCD_BAR_WORDS 3456
constexpr int MAX_LAUNCH = 20;
static_assert((CW_BAR + MAX_LAUNCH * XCD_BAR_WORDS) * 4 <= (int)CTL_ZERO_BYTES, "ctl");

constexpr int NWAVES = 8, NTHREADS = 512;
constexpr int RING_BYTES = 131072, MISC_OFF = RING_BYTES + 320, LDS_BYTES = 147456;

constexpr float W8_SCALE = 64.f, H8_SCALE = 4.f, MG8_SCALE = 16.f, ACT8_SCALE = 4.f;
constexpr int SC_W = 0x79797979, SC_H = 0x7D7D7D7D, SC_MG = 0x7B7B7B7B, SC_ACT = 0x7D7D7D7D;
__device__ __forceinline__ unsigned f2bf(float f) { unsigned u = __builtin_bit_cast(unsigned, f); return (u + 0x7fffu + ((u >> 16) & 1u)) >> 16; }
__device__ __forceinline__ unsigned pk2(float lo, float hi) { return f2bf(lo) | (f2bf(hi) << 16); }
__device__ __forceinline__ unsigned pk4_fp8(float a, float b, float c, float d) {
    a = __builtin_amdgcn_fmed3f(a, -448.f, 448.f); b = __builtin_amdgcn_fmed3f(b, -448.f, 448.f); c = __builtin_amdgcn_fmed3f(c, -448.f, 448.f); d = __builtin_amdgcn_fmed3f(d, -448.f, 448.f);
    int w = 0; w = __builtin_amdgcn_cvt_pk_fp8_f32(a, b, w, false); w = __builtin_amdgcn_cvt_pk_fp8_f32(c, d, w, true); return (unsigned)w; }
__device__ __forceinline__ float bflo(unsigned w) { return __builtin_bit_cast(float, w << 16); }
__device__ __forceinline__ float bfhi(unsigned w) { return __builtin_bit_cast(float, w & 0xffff0000u); }
__device__ __forceinline__ float bf2f(bf16 b) { return __builtin_bit_cast(float, ((unsigned)b) << 16); }
__device__ __forceinline__ float wave_sum(float v) {
#pragma unroll
    for (int o = 1; o < 64; o <<= 1) v += __shfl_xor(v, o);
    return v;
}
__device__ __forceinline__ float wave_max(float v) {
#pragma unroll
    for (int o = 1; o < 64; o <<= 1) v = fmaxf(v, __shfl_xor(v, o));
    return v;
}
__device__ __forceinline__ int row_of_p(int p) { return p < NMETA ? SEQ + p : p - NMETA; }
__device__ __forceinline__ float sigmoidf_(float x) { return 1.0f / (1.0f + __expf(-x)); }
__device__ __forceinline__ float dot8(u32x4 a, u32x4 b, float acc) {
    acc = fmaf(bflo(a.x), bflo(b.x), acc); acc = fmaf(bfhi(a.x), bfhi(b.x), acc);
    acc = fmaf(bflo(a.y), bflo(b.y), acc); acc = fmaf(bfhi(a.y), bfhi(b.y), acc);
    acc = fmaf(bflo(a.z), bflo(b.z), acc); acc = fmaf(bfhi(a.z), bfhi(b.z), acc);
    acc = fmaf(bflo(a.w), bflo(b.w), acc); acc = fmaf(bfhi(a.w), bfhi(b.w), acc);
    return acc;
}

struct Args { const float* in[18]; float* out; unsigned char* ws; int ph_lo, ph_hi; unsigned naive; int li; };
enum { I_X = 0, I_META, I_LNIN_G, I_LNIN_B, I_WIN, I_BF, I_WBSB, I_WBFX, I_WOUT, I_LNMIX_G, I_LNMIX_B, I_WR, I_RB, I_WG, I_WU, I_WD, I_LNFFN_G, I_LNFFN_B };

__device__ __forceinline__ int moe_cnt(const unsigned* ctl, int layer, int e) { return (int)ctl[CW_CNT + (layer * NE + e) * 64]; }
__device__ __forceinline__ bool moe_find(const unsigned* ctl, int layer, int s0, int& e_out, int& cnt_out, int& ps_out) {
    int acc = 0; e_out = -1; cnt_out = 0; ps_out = 0;
#pragma unroll
    for (int e = 0; e < NE; ++e) { const int c = moe_cnt(ctl, layer, e), nb = (c + 255) >> 8;
        if (e_out < 0 && s0 < (acc + nb) * 256) { e_out = e; cnt_out = c; ps_out = acc * 256; }
        acc += nb; }
    return e_out >= 0;
}
__device__ __forceinline__ int moe_pstart(const unsigned* ctl, int layer, int ex) {
    int acc = 0, r = 0;
#pragma unroll
    for (int e = 0; e < NE; ++e) { const int c = moe_cnt(ctl, layer, e); if (e == ex) r = acc * 256; acc += (c + 255) >> 8; }
    return r;
}

__device__ __forceinline__ void inproj_store(unsigned char* ws, int row, int n, float v, unsigned* kmax = nullptr) {
    if (kmax && n >= 4096 && n < 5120) atomicMax(kmax + ((n - 4096) >> 7) * 64, __builtin_bit_cast(unsigned, __builtin_fabsf(v)));
    if (n < QKV_N) { const bool isq = (n < 1024) || (n >= 3072 && n < 4096); ((bf16*)(ws + WS_QKV))[(size_t)row * QKV_N + n] = (bf16)f2bf(isq ? v * QSCALE : v); }
    else ((bf16*)(ws + WS_GB))[(size_t)row * G_N + (n - QKV_N)] = (bf16)f2bf(sigmoidf_(v));
}

__device__ __forceinline__ void dot4(const bf16* a0, const bf16* a1, const bf16* a2, const bf16* a3, const bf16* b, int K, float (&acc)[4]) {
    for (int k = 0; k < K; k += 8) {
        const u32x4 bv = *(const u32x4*)(b + k);
        acc[0] = dot8(*(const u32x4*)(a0 + k), bv, acc[0]); acc[1] = dot8(*(const u32x4*)(a1 + k), bv, acc[1]);
        acc[2] = dot8(*(const u32x4*)(a2 + k), bv, acc[2]); acc[3] = dot8(*(const u32x4*)(a3 + k), bv, acc[3]);
    }
}
__global__ void __launch_bounds__(256) naive_inproj(Args a, int layer) {
    const int n = blockIdx.x * 256 + threadIdx.x, r0 = blockIdx.y * 4;
    const bf16* A = (const bf16*)(a.ws + WS_HB) + (size_t)r0 * DM; const bf16* B = (const bf16*)(a.ws + WS_WIN + layer * WIN_L) + (size_t)n * DM;
    float acc[4] = {0.f, 0.f, 0.f, 0.f};
    dot4(A, A + DM, A + 2 * DM, A + 3 * DM, B, DM, acc);
    for (int i = 0; i < 4; ++i) inproj_store(a.ws, r0 + i, n, acc[i]);
}
__global__ void __launch_bounds__(256) naive_branch(Args a, int layer) {
    const int n = blockIdx.x * 256 + threadIdx.x, r0 = blockIdx.y * 4;
    const bf16* A = (const bf16*)(a.ws + WS_YB) + (size_t)r0 * DM; const bf16* B = (const bf16*)(a.ws + WS_WB + layer * WB_L) + (size_t)n * DM;
    float s[4] = {0.f, 0.f, 0.f, 0.f}, f[4] = {0.f, 0.f, 0.f, 0.f};
    dot4(A, A + DM, A + 2 * DM, A + 3 * DM, B, 1024, s);
    dot4(A + 1024, A + DM + 1024, A + 2 * DM + 1024, A + 3 * DM + 1024, B + 1024, 1024, f);
    const bf16* G = (const bf16*)(a.ws + WS_GB);
    for (int i = 0; i < 4; ++i) { const size_t r = r0 + i; const float gs = bf2f(G[r * G_N + n]), gf = bf2f(G[r * G_N + DM + n]);
        ((bf16*)(a.ws + WS_MG))[r * DM + n] = (bf16)f2bf(gs * s[i] + gf * f[i]); }
}
__global__ void __launch_bounds__(256) naive_outproj(Args a, int layer) {
    const int n = blockIdx.x * 256 + threadIdx.x, r0 = blockIdx.y * 4;
    const bf16* A = (const bf16*)(a.ws + WS_MG) + (size_t)r0 * DM; const bf16* B = (const bf16*)(a.ws + WS_WOUT + layer * WOUT_L) + (size_t)n * DM;
    float acc[4] = {0.f, 0.f, 0.f, 0.f};
    dot4(A, A + DM, A + 2 * DM, A + 3 * DM, B, DM, acc);
    const float* HF = (const float*)(a.ws + WS_HF); float* R = (float*)(a.ws + WS_RB);
    for (int i = 0; i < 4; ++i) { const size_t o = (size_t)(r0 + i) * DM + n; R[o] = ALPHA * HF[o] + acc[i]; }
}
__global__ void __launch_bounds__(256) naive_moe_gu(Args a, int layer) {
    const int j = blockIdx.x * 256 + threadIdx.x, s0 = blockIdx.y * 4;
    int e, cnt, ps; if (!moe_find((const unsigned*)(a.ws + WS_CTL), layer, s0, e, cnt, ps)) return;
    const int* elist = (const int*)(a.ws + WS_ELIST) + (size_t)e * MROWS;
    const bf16* HB = (const bf16*)(a.ws + WS_HB);
    const int rank = s0 - ps;
    const bf16* ap0 = HB + (size_t)(rank + 0 < cnt ? elist[rank + 0] : 0) * DM; const bf16* ap1 = HB + (size_t)(rank + 1 < cnt ? elist[rank + 1] : 0) * DM;
    const bf16* ap2 = HB + (size_t)(rank + 2 < cnt ? elist[rank + 2] : 0) * DM; const bf16* ap3 = HB + (size_t)(rank + 3 < cnt ? elist[rank + 3] : 0) * DM;
    const bf16* W = (const bf16*)(a.ws + WS_WGU + layer * WGU_L + e * WGU_E);
    const int rg = 256 * (j >> 7) + (j & 127);
    float g[4] = {0.f, 0.f, 0.f, 0.f}, u[4] = {0.f, 0.f, 0.f, 0.f};
    dot4(ap0, ap1, ap2, ap3, W + (size_t)rg * DM, DM, g);
    dot4(ap0, ap1, ap2, ap3, W + (size_t)(rg + 128) * DM, DM, u);
    bf16* act = (bf16*)(a.ws + WS_ACT);
#pragma unroll
    for (int i = 0; i < 4; ++i) act[(size_t)(s0 + i) * FF + j] = (bf16)f2bf(g[i] * sigmoidf_(g[i]) * u[i]);
}
__global__ void __launch_bounds__(256) naive_moe_down(Args a, int layer) {
    const int n = blockIdx.x * 256 + threadIdx.x, s0 = blockIdx.y * 4;
    int e, cnt, ps; if (!moe_find((const unsigned*)(a.ws + WS_CTL), layer, s0, e, cnt, ps)) return;
    const bf16* A = (const bf16*)(a.ws + WS_ACT) + (size_t)s0 * FF; const bf16* B = (const bf16*)(a.ws + WS_WD + layer * WD_L + e * WD_E) + (size_t)n * FF;
    float acc[4] = {0.f, 0.f, 0.f, 0.f};
    dot4(A, A + FF, A + 2 * FF, A + 3 * FF, B, FF, acc);
    bf16* O = (bf16*)(a.ws + WS_OSL);
#pragma unroll
    for (int i = 0; i < 4; ++i) O[(size_t)(s0 + i) * DM + n] = (bf16)f2bf(acc[i]);
}
__global__ void __launch_bounds__(256) naive_attn(Args a, int nq) {
    const int lane = threadIdx.x & 63, widx = blockIdx.x * 4 + (threadIdx.x >> 6);
    const int th = widx / nq, pq = nq - 1 - (widx % nq);
    if (th >= 16) return;
    const int type = th >> 3, head = th & 7;
    const bf16* QKV = (const bf16*)(a.ws + WS_QKV);
    const int qcol = (type ? 3072 : 0) + head * HD, kcol = qcol + 1024, vcol = qcol + 2048;
    const int rowq = row_of_p(pq);
    u32x4 q[16];
#pragma unroll
    for (int i = 0; i < 16; ++i) q[i] = *(const u32x4*)(QKV + (size_t)rowq * QKV_N + qcol + 8 * i);
    const float* cum = (const float*)(a.ws + WS_CUM) + (size_t)head * MROWS;
    float o0 = 0.f, o1 = 0.f, carry = 0.f, m = -1e30f, l = 0.f;
    const float cq = type ? cum[pq] : 0.f;
    for (int phi = type ? pq : pq - 1; phi >= 0; phi -= 64) {
        const int p = phi - lane; const bool valid = p >= 0; const int pr = row_of_p(valid ? p : 0);
        float u = 0.f;
        const bf16* kp = QKV + (size_t)pr * QKV_N + kcol;
#pragma unroll
        for (int i = 0; i < 16; ++i) u = dot8(q[i], *(const u32x4*)(kp + 8 * i), u);
        float w;
        if (type == 0) {
            const float aa = exp2f(-fabsf(u)), b = log2f(1.0f + aa);
            float lk = fminf(-u, 0.f) - b; const float lb = lk + u;
            if (!valid) lk = 0.f;
            float inc = lk;
#pragma unroll
            for (int off = 1; off < 64; off <<= 1) { const float t = __shfl_up(inc, off); if (lane >= off) inc += t; }
            const float after = carry + inc - lk;
            w = valid ? exp2f(lb + after) : 0.f;
            carry += __shfl(inc, 63);
        } else {
            const float s = valid ? u + cq - cum[valid ? p : 0] : -__builtin_inff();
            const float cm = wave_max(s), mn = fmaxf(m, cm), alpha = exp2f(m - mn);
            w = valid ? exp2f(s - mn) : 0.f;
            l = l * alpha + wave_sum(w); o0 *= alpha; o1 *= alpha; m = mn;
        }
        for (int j = 0; j < 64; ++j) {
            const float wj = __shfl(w, j); const int prj = __shfl(pr, j);
            const unsigned vv = *(const unsigned*)(QKV + (size_t)prj * QKV_N + vcol + 2 * lane);
            o0 = fmaf(wj, bflo(vv), o0); o1 = fmaf(wj, bfhi(vv), o1);
        }
    }
    if (type) { const float rl = 1.0f / l; o0 *= rl; o1 *= rl; }
    *(unsigned*)((bf16*)(a.ws + WS_YB) + (size_t)rowq * DM + type * 1024 + head * HD + 2 * lane) = pk2(o0, o1);
}

#define XB_TMO      128
#define XB_XCNT(j)  (256  + 64 * (j))
#define XB_XSUB(j)  (1280 + 64 * (j))
#define XB_XGEN(j)  (2304 + 64 * (j))
#define XB_TOP      3328
#define XB_TOPGEN   3392
#define XB_SPIN_CAP (1u << 18)
__device__ __forceinline__ unsigned xb_ld(unsigned* p)              { return __hip_atomic_load(p, __ATOMIC_RELAXED, __HIP_MEMORY_SCOPE_AGENT); }
__device__ __forceinline__ unsigned xb_add(unsigned* p, unsigned v) { return __hip_atomic_fetch_add(p, v, __ATOMIC_RELAXED, __HIP_MEMORY_SCOPE_AGENT); }
__device__ __forceinline__ unsigned xb_xcc_id() { return (unsigned)__builtin_amdgcn_s_getreg((3 << 11) | 20) & 0xFu; }
#define XB_SPIN(cond, bar) do { unsigned _sp = 0; while (cond) { __builtin_amdgcn_s_sleep(1); \
    if ((++_sp & 255u) == 0u) { if (xb_ld(&(bar)[XB_TMO])) break; if (_sp > XB_SPIN_CAP) { atomicAdd(&(bar)[XB_TMO], 1u); break; } } } } while (0)
struct XcdBarrier { unsigned* bar; unsigned x; volatile LAS unsigned* st; };
__device__ __forceinline__ XcdBarrier xcd_barrier_post(unsigned* bar, volatile LAS unsigned* st) {
    XcdBarrier b; b.bar = bar; b.x = xb_xcc_id(); b.st = st;
    if (threadIdx.x == 0) (void)xb_add(&bar[XB_XCNT(b.x)], 1u);
    return b;
}
__device__ __forceinline__ void xcd_barrier_complete(unsigned* bar, unsigned x, unsigned& nloc, unsigned& nx) {
    const unsigned G = gridDim.x * gridDim.y * gridDim.z;
    unsigned sum, cnt, mine, sp = 0u;
    for (;;) {
        sum = 0u; cnt = 0u; mine = 0u;
#pragma unroll
        for (unsigned j = 0; j < 16; ++j) { const unsigned c = xb_ld(&bar[XB_XCNT(j)]); sum += c; cnt += (c > 0u) ? 1u : 0u; mine = (j == x) ? c : mine; }
        if (sum == G) break;
        __builtin_amdgcn_s_sleep(1);
        if ((++sp & 255u) == 0u) { if (xb_ld(&bar[XB_TMO])) break; if (sp > XB_SPIN_CAP) { atomicAdd(&bar[XB_TMO], 1u); break; } }
    }
    nloc = mine > 0u ? mine : 1u; nx = cnt > 0u ? cnt : 1u;
}
__device__ __forceinline__ void xcd_barrier(const XcdBarrier& b) {
    asm volatile("s_waitcnt vmcnt(0)" ::: "memory");
    __syncthreads();
    if (threadIdx.x == 0) {
        unsigned* bar = b.bar;
        __builtin_amdgcn_s_waitcnt(0);
        unsigned nloc = b.st[0], nx = b.st[1];
        if (nloc == 0u) { xcd_barrier_complete(bar, b.x, nloc, nx); b.st[0] = nloc; b.st[1] = nx; }
        const unsigned old = xb_add(&bar[XB_XSUB(b.x)], 1u);
        const unsigned gen = old / nloc;
        if (old + 1u == (gen + 1u) * nloc) {
            __builtin_amdgcn_fence(__ATOMIC_RELEASE, "agent");
            asm volatile("s_waitcnt vmcnt(0)" ::: "memory");
            const unsigned og = xb_add(&bar[XB_TOP], 1u);
            const unsigned tg = og / nx;
            if (og + 1u == (tg + 1u) * nx) xb_add(&bar[XB_TOPGEN], 1u);
            else XB_SPIN(xb_ld(&bar[XB_TOPGEN]) == tg, bar);
            __builtin_amdgcn_fence(__ATOMIC_ACQUIRE, "agent");
            xb_add(&bar[XB_XGEN(b.x)], 1u);
            asm volatile("s_waitcnt vmcnt(0)" ::: "memory");
        } else {
            XB_SPIN(xb_ld(&bar[XB_XGEN(b.x)]) == gen, bar);
            __builtin_amdgcn_fence(__ATOMIC_ACQUIRE, "agent");
            asm volatile("s_waitcnt vmcnt(0)" ::: "memory");
        }
    }
    __syncthreads();
}

struct Frame {
    LAS unsigned char* lds; unsigned char* ws; unsigned* ctl;
    int tid, lane, wave, G, gw, NGW;
    const float* const* in; float* out;
};
#define LDS_WAIT() asm volatile("s_waitcnt lgkmcnt(0)" ::: "memory")

__device__ __forceinline__ void transpose_item(const float* W, size_t ldw, bf16* WT, size_t ldt, LAS float* scr, int lane) {
#pragma unroll 8
    for (int i = 0; i < 32; ++i) { const int kk = 2 * i + (lane >> 5); scr[kk * 33 + (lane & 31)] = W[(size_t)kk * ldw + (lane & 31)]; }
    LDS_WAIT(); asm volatile("" ::: "memory");
    const int c = lane & 7;
#pragma unroll
    for (int j = 0; j < 4; ++j) { const int n = (lane >> 3) + 8 * j; const LAS float* s = scr + (8 * c) * 33 + n;
        u32x4 o; o.x = pk2(s[0 * 33], s[1 * 33]); o.y = pk2(s[2 * 33], s[3 * 33]); o.z = pk2(s[4 * 33], s[5 * 33]); o.w = pk2(s[6 * 33], s[7 * 33]);
        *(u32x4*)(WT + (size_t)n * ldt + 8 * c) = o; }
    LDS_WAIT(); asm volatile("" ::: "memory");
}
__device__ __forceinline__ void transpose_item8(const float* W, size_t ldw, unsigned char* WT, size_t ldt, LAS float* scr, int lane) {
#pragma unroll 8
    for (int i = 0; i < 32; ++i) { const int kk = 2 * i + (lane >> 5); scr[kk * 33 + (lane & 31)] = W[(size_t)kk * ldw + (lane & 31)]; }
    LDS_WAIT(); asm volatile("" ::: "memory");
    const int c = lane & 3;
#pragma unroll
    for (int j = 0; j < 2; ++j) { const int n = (lane >> 2) + 16 * j; const LAS float* p = scr + (16 * c) * 33 + n;
        u32x4 o;
        o.x = pk4_fp8(p[0 * 33] * W8_SCALE, p[1 * 33] * W8_SCALE, p[2 * 33] * W8_SCALE, p[3 * 33] * W8_SCALE); o.y = pk4_fp8(p[4 * 33] * W8_SCALE, p[5 * 33] * W8_SCALE, p[6 * 33] * W8_SCALE, p[7 * 33] * W8_SCALE);
        o.z = pk4_fp8(p[8 * 33] * W8_SCALE, p[9 * 33] * W8_SCALE, p[10 * 33] * W8_SCALE, p[11 * 33] * W8_SCALE); o.w = pk4_fp8(p[12 * 33] * W8_SCALE, p[13 * 33] * W8_SCALE, p[14 * 33] * W8_SCALE, p[15 * 33] * W8_SCALE);
        *(u32x4*)(WT + (size_t)n * ldt + 16 * c) = o; }
    LDS_WAIT(); asm volatile("" ::: "memory");
}
__device__ __forceinline__ void convert_item(Frame& F, int it, LAS float* scr) {
    constexpr int I_IN = 32 * 320, I_BS = 16 * 64, I_OUT = 32 * 64, I_GE = 32 * 32, I_DE = 16 * 64;
    constexpr int PER_LAYER = I_IN + 2 * I_BS + I_OUT + NE * (2 * I_GE + I_DE);
    const int l = it / PER_LAYER; int r = it % PER_LAYER;
    if (r < I_IN) { const int kb = r / 320, nb = r % 320, nd = 32 * nb, ns = nd + (nd >= FCOL ? 8 : 0);
        transpose_item8(F.in[I_WIN] + (size_t)l * DM * INP_SRC + (size_t)(64 * kb) * INP_SRC + ns, INP_SRC, F.ws + WS_WIN + l * WIN_L + (size_t)nd * DM + 64 * kb, DM, scr, F.lane); return; }
    r -= I_IN;
    if (r < 2 * I_BS) { const int which = r / I_BS; r %= I_BS; const int kb = r / 64, nb = r % 64;
        transpose_item((which ? F.in[I_WBFX] : F.in[I_WBSB]) + (size_t)l * 1024 * DM + (size_t)(64 * kb) * DM + 32 * nb, DM, (bf16*)(F.ws + WS_WB + l * WB_L) + (size_t)(32 * nb) * DM + which * 1024 + 64 * kb, DM, scr, F.lane); return; }
    r -= 2 * I_BS;
    if (r < I_OUT) { const int kb = r / 64, nb = r % 64;
        transpose_item8(F.in[I_WOUT] + (size_t)l * DM * DM + (size_t)(64 * kb) * DM + 32 * nb, DM, F.ws + WS_WOUT + l * WOUT_L + (size_t)(32 * nb) * DM + 64 * kb, DM, scr, F.lane); return; }
    r -= I_OUT;
    const int e = r / (2 * I_GE + I_DE); r %= (2 * I_GE + I_DE);
    if (r < 2 * I_GE) { const int which = r / I_GE; r %= I_GE; const int kb = r / 32, nb = r % 32, n0 = 32 * nb, rho = 256 * (n0 >> 7) + (n0 & 127) + which * 128;
        transpose_item8((which ? F.in[I_WU] : F.in[I_WG]) + ((size_t)(l * NE + e) * DM + 64 * kb) * FF + n0, FF, F.ws + WS_WGU + l * WGU_L + e * WGU_E + (size_t)rho * DM + 64 * kb, DM, scr, F.lane); return; }
    r -= 2 * I_GE;
    { const int kb = r / 64, nb = r % 64;
        transpose_item8(F.in[I_WD] + ((size_t)(l * NE + e) * FF + 64 * kb) * DM + 32 * nb, DM, F.ws + WS_WD + l * WD_L + e * WD_E + (size_t)(32 * nb) * FF + 64 * kb, FF, scr, F.lane); }
}
constexpr int N_CONVERT_ITEMS = NLAYER * (32 * 320 + 2 * 16 * 64 + 32 * 64 + NE * (2 * 32 * 32 + 16 * 64));
constexpr int CV_PER_LAYER = N_CONVERT_ITEMS / NLAYER, CV_G0_END = 32 * 320, CV_G1_END = CV_PER_LAYER + 32 * 320, CV_BUNDLE = 256;
static_assert((CV_G1_END - CV_G0_END) % CV_BUNDLE == 0 && (N_CONVERT_ITEMS - CV_G1_END) % CV_BUNDLE == 0, "bundles");
__device__ __forceinline__ void convert_bundle(Frame& F, int first_item) {
    LAS float* scr = (LAS float*)(F.lds + F.wave * 16384);
    for (int i = 0; i < CV_BUNDLE / NWAVES; ++i) convert_item(F, first_item + F.wave + NWAVES * i, scr);
}

__device__ __forceinline__ int tab_rowpos(int c) { return (c & 3) * 512 + (c >> 8) * 64 + ((c >> 2) & 63); }
template <int NC> __device__ __forceinline__ void stage_table(Frame& F, const float* src, size_t pitch) {
    constexpr int CH = NC / 4;
    for (int ci = F.tid; ci < DM * CH; ci += NTHREADS) { const int c = ci / CH, q = ci % CH;
        const f32x4 v = *(const f32x4*)(src + (size_t)c * pitch + 4 * q);
        const int sw = (NC == 16) ? ((c >> 4) & 3) : ((c >> 5) & 1);
        *(LAS f32x4*)(F.lds + tab_rowpos(c) * (NC * 4) + ((q ^ sw) << 4)) = v; }
    LDS_WAIT(); __syncthreads();
}
template <int NC> __device__ __forceinline__ void table_dot(Frame& F, const f32x4 (&y)[8], float (&acc)[NC]) {
    constexpr int CH = NC / 4; const int l = F.lane; const int sw = (NC == 16) ? ((l >> 2) & 3) : ((l >> 3) & 1);
#pragma unroll
    for (int e = 0; e < NC; ++e) acc[e] = 0.f;
#pragma unroll
    for (int j = 0; j < 8; ++j)
#pragma unroll
        for (int i = 0; i < 4; ++i) { const float yv = y[j][i]; const int rp = i * 512 + j * 64 + l; if (i == 0) asm volatile("" ::: "memory");
#pragma unroll
            for (int q = 0; q < CH; ++q) { const f32x4 w = *(const LAS f32x4*)(F.lds + rp * (NC * 4) + ((q ^ sw) << 4));
                acc[4 * q + 0] = fmaf(yv, w.x, acc[4 * q + 0]); acc[4 * q + 1] = fmaf(yv, w.y, acc[4 * q + 1]); acc[4 * q + 2] = fmaf(yv, w.z, acc[4 * q + 2]); acc[4 * q + 3] = fmaf(yv, w.w, acc[4 * q + 3]); } }
#pragma unroll
    for (int e = 0; e < NC; ++e) acc[e] = wave_sum(acc[e]);
}
__device__ __forceinline__ void ln_row(Frame& F, f32x4 (&v)[8], const float* g, const float* b) {
    float s = 0.f;
#pragma unroll
    for (int j = 0; j < 8; ++j) s += (v[j].x + v[j].y) + (v[j].z + v[j].w);
    const float mean = wave_sum(s) * (1.f / DM); float s2 = 0.f;
#pragma unroll
    for (int j = 0; j < 8; ++j) { v[j] = v[j] - mean; s2 += (v[j].x * v[j].x + v[j].y * v[j].y) + (v[j].z * v[j].z + v[j].w * v[j].w); }
    const float rstd = 1.0f / sqrtf(wave_sum(s2) * (1.f / DM) + LN_EPS);
#pragma unroll
    for (int j = 0; j < 8; ++j) { const f32x4 gv = *(const f32x4*)(g + 256 * j + 4 * F.lane), bv = *(const f32x4*)(b + 256 * j + 4 * F.lane); v[j] = v[j] * rstd * gv + bv; }
}
__device__ __forceinline__ void store_h(Frame& F, int row, const f32x4 (&y)[8], bool dry = false) {
    float* hf = (float*)(F.ws + (dry ? WS_YB : WS_HF)) + (size_t)row * DM; bf16* hb = (bf16*)(F.ws + (dry ? WS_GB + 21 * MiB : WS_HB)) + (size_t)row * DM;
    unsigned char* h8 = F.ws + (dry ? WS_GB + 21 * MiB : WS_H8) + (size_t)row * DM;
#pragma unroll
    for (int j = 0; j < 8; ++j) { *(f32x4*)(hf + 256 * j + 4 * F.lane) = y[j]; if (NAIVE_MASK != 0u) { u32x2 w; w.x = pk2(y[j].x, y[j].y); w.y = pk2(y[j].z, y[j].w); *(u32x2*)(hb + 256 * j + 4 * F.lane) = w; }
        *(unsigned*)(h8 + 256 * j + 4 * F.lane) = pk4_fp8(y[j].x * H8_SCALE, y[j].y * H8_SCALE, y[j].z * H8_SCALE, y[j].w * H8_SCALE); }
}
__device__ __forceinline__ void store_logf(Frame& F, int row, const f32x4 (&y)[8], const float* bfor) {
    float acc[8]; table_dot<8>(F, y, acc);
    if (F.lane < 8) { float a = acc[0];
#pragma unroll
        for (int h = 1; h < 8; ++h) a = (F.lane == h) ? acc[h] : a;
        const float x = a + bfor[F.lane];
        const float ls = fminf(x, 0.f) - log1pf(__expf(-fabsf(x)));
        ((float*)(F.ws + WS_LOGF))[(size_t)row * 8 + F.lane] = ls; }
}

__device__ __forceinline__ void phase_prologue(Frame& F) {
    LAS float* scr = (LAS float*)(F.lds + F.wave * 16384);
    for (int it = F.gw; it < CV_G0_END; it += F.NGW) convert_item(F, it, scr);
    __syncthreads();
    stage_table<8>(F, F.in[I_WIN] + FCOL, INP_SRC);
    for (int row = F.gw; row < NTOK; row += F.NGW) {
        const float* src = row < SEQ ? F.in[I_X] + (size_t)row * DM : F.in[I_META] + (size_t)(row - SEQ) * DM;
        f32x4 v[8];
#pragma unroll
        for (int j = 0; j < 8; ++j) v[j] = *(const f32x4*)(src + 256 * j + 4 * F.lane);
        ln_row(F, v, F.in[I_LNIN_G], F.in[I_LNIN_B]);
        store_h(F, row, v);
        store_logf(F, row, v, F.in[I_BF]);
    }
    for (int row = NTOK + F.gw; row < MROWS; row += F.NGW) { bf16* hb = (bf16*)(F.ws + WS_HB) + (size_t)row * DM;
#pragma unroll
        for (int j = 0; j < 4; ++j) *(u32x4*)(hb + 512 * j + 8 * F.lane) = (u32x4){0u, 0u, 0u, 0u}; }
    __syncthreads();
}
__device__ __forceinline__ void phase_tilesuf(Frame& F) {
    if (blockIdx.x > SEQ / 64) return;
    const int tile = blockIdx.x, h = F.wave, row = tile * 64 + F.lane;
    const float v = (row < NTOK) ? LOG2E * ((const float*)(F.ws + WS_LOGF))[(size_t)row * 8 + h] : 0.f;
    float inc = v;
#pragma unroll
    for (int off = 1; off < 64; off <<= 1) { const float t = __shfl_down(inc, off); if (F.lane + off < 64) inc += t; }
    float* base = (float*)(F.ws + WS_CUM);
    base[(size_t)h * MROWS + row] = inc - v;
    if (F.lane == 0) base[(size_t)NHEAD * MROWS + h * 256 + tile] = inc;
}
__device__ __forceinline__ void phase_cumsum(Frame& F, bool do_scan) {
    if (blockIdx.x >= NHEAD) {
        if (blockIdx.x < NHEAD + 48) { bf16* q = (bf16*)(F.ws + WS_QKV) + (size_t)(NTOK + blockIdx.x - NHEAD) * QKV_N;
            for (int i = F.tid; i < QKV_N / 8; i += NTHREADS) *(u32x4*)(q + 8 * i) = (u32x4){0u, 0u, 0u, 0u}; }
        return; }
    if (!do_scan) return;
    const int h = blockIdx.x; const float* logf = (const float*)(F.ws + WS_LOGF); float* cum = (float*)(F.ws + WS_CUM) + (size_t)h * MROWS;
    constexpr int PER = 17; const int p0 = F.tid * PER;
    float loc[PER]; float s = 0.f;
#pragma unroll
    for (int i = 0; i < PER; ++i) { const int p = p0 + i; const float v = p < NTOK ? logf[(size_t)row_of_p(p) * 8 + h] : 0.f; s += v; loc[i] = s; }
    float inc = s;
#pragma unroll
    for (int off = 1; off < 64; off <<= 1) { const float t = __shfl_up(inc, off); if (F.lane >= off) inc += t; }
    LAS float* wt = (LAS float*)(F.lds);
    if (F.lane == 63) wt[F.wave] = inc;
    LDS_WAIT(); __syncthreads();
    float base = inc - s;
    for (int w = 0; w < F.wave; ++w) base += wt[w];
#pragma unroll
    for (int i = 0; i < PER; ++i) { const int p = p0 + i; if (p < NTOK) cum[p] = (base + loc[i]) * LOG2E; }
    LDS_WAIT(); __syncthreads();
}
__device__ __forceinline__ void phase_ln_router(Frame& F, int layer, bool dry = false) {
    stage_table<16>(F, F.in[I_WR], 16);
    const float* g = F.in[I_LNMIX_G] + layer * DM; const float* b = F.in[I_LNMIX_B] + layer * DM;
    const float* rbias = F.in[I_RB];
    const int nrows_e = layer == NLAYER - 1 ? SEQ : NTOK;
    for (int row = F.gw; row < nrows_e; row += F.NGW) {
        const float* src = (const float*)(F.ws + WS_RB) + (size_t)row * DM;
        f32x4 v[8];
#pragma unroll
        for (int j = 0; j < 8; ++j) v[j] = *(const f32x4*)(src + 256 * j + 4 * F.lane);
        ln_row(F, v, g, b);
        store_h(F, row, v, dry);
        float lg[16]; table_dot<16>(F, v, lg);
        float aff[16], sel[16];
#pragma unroll
        for (int e = 0; e < 16; ++e) { aff[e] = 1.0f / (1.0f + __expf(-lg[e])); sel[e] = aff[e] + rbias[e]; }
        int bg = 0; float bs = -__builtin_inff();
#pragma unroll
        for (int gi = 0; gi < 4; ++gi) { const float a0 = sel[4 * gi], a1 = sel[4 * gi + 1], a2 = sel[4 * gi + 2], a3 = sel[4 * gi + 3];
            const float h1 = fmaxf(a0, a1), l1 = fminf(a0, a1), h2 = fmaxf(a2, a3), l2 = fminf(a2, a3);
            const float top = fmaxf(h1, h2), sec = fmaxf(fminf(h1, h2), fmaxf(l1, l2)), sc = top + sec;
            if (sc > bs) { bs = sc; bg = gi; } }
        float s4[4], a4[4];
#pragma unroll
        for (int i = 0; i < 4; ++i) { s4[i] = sel[i]; a4[i] = aff[i]; }
#pragma unroll
        for (int gi = 1; gi < 4; ++gi) if (bg == gi) {
#pragma unroll
            for (int i = 0; i < 4; ++i) { s4[i] = sel[4 * gi + i]; a4[i] = aff[4 * gi + i]; } }
        int i1 = 0; float m1 = s4[0];
#pragma unroll
        for (int i = 1; i < 4; ++i) if (s4[i] > m1) { m1 = s4[i]; i1 = i; }
        int i2 = -1; float m2 = -__builtin_inff();
#pragma unroll
        for (int i = 0; i < 4; ++i) if (i != i1 && s4[i] > m2) { m2 = s4[i]; i2 = i; }
        float af1 = a4[0], af2 = a4[0];
#pragma unroll
        for (int i = 1; i < 4; ++i) { if (i1 == i) af1 = a4[i]; if (i2 == i) af2 = a4[i]; }
        const float wsum = af1 + af2, w1 = af1 / wsum, w2 = af2 / wsum;
        const int e1 = 4 * bg + i1, e2 = 4 * bg + i2;
        if (dry) { if (F.lane == 0) ((float*)(F.ws + WS_GB + 60 * MiB))[row] = w1 + w2 + (float)(e1 + e2); }
        if (F.lane == 0 && !dry) {
            const int r1 = (int)atomicAdd(F.ctl + CW_CNT + (layer * NE + e1) * 64, 1u), r2 = (int)atomicAdd(F.ctl + CW_CNT + (layer * NE + e2) * 64, 1u);
            int* el = (int*)(F.ws + WS_ELIST); el[(size_t)e1 * MROWS + r1] = row; el[(size_t)e2 * MROWS + r2] = row;
            int* ti = (int*)(F.ws + WS_TOKI) + (size_t)row * 8;
            ti[0] = e1; ti[1] = e2; ti[2] = r1; ti[3] = r2; ti[4] = __builtin_bit_cast(int, w1); ti[5] = __builtin_bit_cast(int, w2);
        }
    }
    __syncthreads();
}
__device__ __forceinline__ void phase_ln_final(Frame& F, int layer, bool dry = false) {
    const bool last = layer == NLAYER - 1;
    if (!last) stage_table<8>(F, F.in[I_WIN] + (size_t)(layer + 1) * DM * INP_SRC + FCOL, INP_SRC);
    const float* g = F.in[I_LNFFN_G] + layer * DM; const float* b = F.in[I_LNFFN_B] + layer * DM;
    const int nrows = last ? SEQ : NTOK;
    for (int row = F.gw; row < nrows; row += F.NGW) {
        const int* ti = (const int*)(F.ws + WS_TOKI) + (size_t)row * 8;
        const int e1 = ti[0], e2 = ti[1], r1 = ti[2], r2 = ti[3]; const float w1 = __builtin_bit_cast(float, ti[4]), w2 = __builtin_bit_cast(float, ti[5]);
        const int ps1 = moe_pstart(F.ctl, layer, e1), ps2 = moe_pstart(F.ctl, layer, e2);
        const bf16* o1 = (const bf16*)(F.ws + WS_OSL) + (size_t)(ps1 + r1) * DM; const bf16* o2 = (const bf16*)(F.ws + WS_OSL) + (size_t)(ps2 + r2) * DM;
        const float* hf = (const float*)(F.ws + WS_HF) + (size_t)row * DM;
        f32x4 v[8];
#pragma unroll
        for (int j = 0; j < 8; ++j) { const f32x4 hv = *(const f32x4*)(hf + 256 * j + 4 * F.lane);
            const u32x2 a = *(const u32x2*)(o1 + 256 * j + 4 * F.lane), c = *(const u32x2*)(o2 + 256 * j + 4 * F.lane);
            v[j].x = ALPHA * hv.x + w1 * bflo(a.x) + w2 * bflo(c.x); v[j].y = ALPHA * hv.y + w1 * bfhi(a.x) + w2 * bfhi(c.x);
            v[j].z = ALPHA * hv.z + w1 * bflo(a.y) + w2 * bflo(c.y); v[j].w = ALPHA * hv.w + w1 * bfhi(a.y) + w2 * bfhi(c.y); }
        ln_row(F, v, g, b);
        if (dry) { store_h(F, row, v, true); if (!last) { float acc8[8]; table_dot<8>(F, v, acc8); if (F.lane == 0) ((float*)(F.ws + WS_GB + 60 * MiB))[row] = acc8[0] + acc8[7]; } }
        else if (last) { float* o = F.out + (size_t)row * DM;
#pragma unroll
            for (int j = 0; j < 8; ++j) *(f32x4*)(o + 256 * j + 4 * F.lane) = v[j]; }
        else { store_h(F, row, v); store_logf(F, row, v, F.in[I_BF] + (layer + 1) * NHEAD); }
    }
    __syncthreads();
}

namespace pg8 {
typedef short bf16x8 __attribute__((ext_vector_type(8)));
typedef int i32x4 __attribute__((ext_vector_type(4)));
typedef int i32x8 __attribute__((ext_vector_type(8)));
__device__ __forceinline__ i32x8 ld_frag(const LAS unsigned char* p) { const i32x4 x = *(const LAS i32x4*)p, y = *(const LAS i32x4*)(p + 1024); return __builtin_shufflevector(x, y, 0, 1, 2, 3, 4, 5, 6, 7); }
__device__ __forceinline__ bf16x8 frag_lo(i32x8 f) { return __builtin_bit_cast(bf16x8, (i32x4)__builtin_shufflevector(f, f, 0, 1, 2, 3)); }
__device__ __forceinline__ bf16x8 frag_hi(i32x8 f) { return __builtin_bit_cast(bf16x8, (i32x4)__builtin_shufflevector(f, f, 4, 5, 6, 7)); }
constexpr int BM = 256, BK = 64, HALF = 128, HTB = HALF * BK * 2, STAGE_BYTES = 8 * HTB, NXCD = 8, WGM = 8;
__host__ __device__ __forceinline__ int lds_byte(int r, int c) { const int st = (r >> 4) * 2 + (c >> 5), rr = r & 15, cc = c & 31, ob = rr * 64 + cc * 2; return st * 1024 + (ob ^ (((ob >> 9) & 1) << 5)); }
__host__ __device__ __forceinline__ void stage_rc(int b, int& R, int& C) { const int st = b / 1024, sb = b % 1024, swz = sb ^ (((sb >> 9) & 1) << 5); R = (st >> 1) * 16 + swz / 64; C = (st & 1) * 32 + (swz % 64) / 2; }
__host__ __device__ __forceinline__ int perm32(int rho) { const int n = rho >> 4, i = rho & 15; return 8 * (i >> 2) + 4 * n + (i & 3); }
struct Unit { int pm, pn, aux; };
__device__ __forceinline__ bool static_tile(int nM, int nN, int G, int c, int i, int& pm, int& pn) {
    const int nwg = nM * nN; const long L = (long)i * G + c; if (L >= nwg) return false;
    int wgid = (int)L; { const int q = nwg / NXCD, r = nwg % NXCD, xcd = wgid % NXCD, off = wgid / NXCD; wgid = (xcd < r ? xcd * (q + 1) : r * (q + 1) + (xcd - r) * q) + off; }
    const int nig = WGM * nN, gid = wgid / nig, fm = gid * WGM, gsz = (nM - fm) < WGM ? (nM - fm) : WGM;
    pm = fm + ((wgid % nig) % gsz); pn = (wgid % nig) / gsz; return true;
}
__device__ __forceinline__ unsigned cvt_pk_bf16(float lo, float hi) { unsigned r; asm volatile("v_cvt_pk_bf16_f32 %0, %1, %2" : "=v"(r) : "v"(lo), "v"(hi)); return r; }

template <class P>
__device__ __forceinline__ void gemm_phase(LAS unsigned char* lds, const P& prob) {
    const int tid = threadIdx.x, wid = __builtin_amdgcn_readfirstlane(tid >> 6), lane = tid & 63, wr = wid >> 2, wc = wid & 3, fr = lane & 15, fq = lane >> 4;
    constexpr int ES = P::FP8 ? 1 : 2;
    const int nt = prob.K * ES / (BK * 2);
    unsigned voffA[2], voffA1[2], voffB[2];
#pragma unroll
    for (int i = 0; i < 2; ++i) { int R, C; stage_rc(tid * 16 + i * 8192, R, C); const int Rb = P::PERM ? ((R & ~31) + perm32(R & 31)) : R;
        voffA[i] = (unsigned)(R * prob.lda * ES + C * 2); voffA1[i] = voffA[i]; voffB[i] = (unsigned)(Rb * prob.ldb * ES + C * 2); }
    const size_t kstep = (size_t)(BK * 2);
    const size_t hstepA = P::GATHER ? (size_t)0 : (size_t)HALF * prob.lda * ES, hstepB = (size_t)HALF * prob.ldb * ES;
    const unsigned ldsw = (unsigned)wid * 1024u;
    const int aoff = lds_byte(wr * 64 + fr, fq * 8), boff = lds_byte(wc * 32 + fr, fq * 8);
#define PG8_SA(b, h) (((b) * 2 + (h)) * HTB)
#define PG8_SB(b, h) ((4 + (b) * 2 + (h)) * HTB)
#define PG8_STAGE(bufoff, gbase, voff) do { _Pragma("unroll") for (int _i = 0; _i < 2; ++_i) \
        __builtin_amdgcn_global_load_lds((const unsigned*)((const char*)(gbase) + (voff)[_i]), (LAS unsigned*)(lds + (bufoff) + ldsw + _i * 8192), 16, 0, 0); } while (0)
#define PG8_LDA(dst, b, h) do { _Pragma("unroll") for (int m = 0; m < 4; ++m) dst[m] = ld_frag(lds + PG8_SA(b, h) + aoff + m * 2048); } while (0)
#define PG8_LDB(dst, b, h) do { _Pragma("unroll") for (int n = 0; n < 2; ++n) dst[n] = ld_frag(lds + PG8_SB(b, h) + boff + n * 2048); } while (0)
#define PG8_MMA(ai, bj, At, Bt) do { __builtin_amdgcn_s_setprio(1); _Pragma("unroll") for (int m = 0; m < 4; ++m) _Pragma("unroll") for (int n = 0; n < 2; ++n) { \
        if constexpr (P::FP8) asm volatile("v_mfma_scale_f32_16x16x128_f8f6f4 %0, %1, %2, %0, %3, %4 op_sel_hi:[0,0,0]" : "+v"(acc[ai][bj][m][n]) : "v"(Bt[n]), "v"(At[m]), "v"(scb), "v"(sca)); \
        else { acc[ai][bj][m][n] = __builtin_amdgcn_mfma_f32_16x16x32_bf16(frag_lo(Bt[n]), frag_lo(At[m]), acc[ai][bj][m][n], 0, 0, 0); \
               acc[ai][bj][m][n] = __builtin_amdgcn_mfma_f32_16x16x32_bf16(frag_hi(Bt[n]), frag_hi(At[m]), acc[ai][bj][m][n], 0, 0, 0); } } __builtin_amdgcn_s_setprio(0); } while (0)
#define PG8_WAIT_V(n) asm volatile("s_waitcnt vmcnt(" #n ")" ::: "memory")
#define PG8_WAIT_L(n) asm volatile("s_waitcnt lgkmcnt(" #n ")" ::: "memory")
#define PG8_BAR __builtin_amdgcn_s_barrier()
#define PG8_SCHED __builtin_amdgcn_sched_barrier(0)
#define PG8_GATHER_OFFS(ui_, d0, d1) do { _Pragma("unroll") for (int _i = 0; _i < 2; ++_i) { int R_, C_; stage_rc(tid * 16 + _i * 8192, R_, C_); \
        d0[_i] = (unsigned)(prob.a_row(ui_, R_) * prob.lda * ES + C_ * 2); d1[_i] = (unsigned)(prob.a_row(ui_, HALF + R_) * prob.lda * ES + C_ * 2); } } while (0)
    Unit cur, nxt; int ui = 0;
    if (!prob.next(0, cur)) return;
    f32x4 acc[2][2][4][2];
#pragma unroll
    for (int a = 0; a < 2; ++a)
#pragma unroll
        for (int b = 0; b < 2; ++b)
#pragma unroll
            for (int m = 0; m < 4; ++m)
#pragma unroll
                for (int n = 0; n < 2; ++n) acc[a][b][m][n] = (f32x4){0.f, 0.f, 0.f, 0.f};
    const int sca = prob.sc_a, scb = prob.sc_b;
    i32x8 At[4], B0[2], B1[2];
    const char* cA = prob.a_ptr(cur); const char* cB = prob.b_ptr(cur);
    if constexpr (P::GATHER) PG8_GATHER_OFFS(0, voffA, voffA1);
    PG8_STAGE(PG8_SB(0, 0), cB, voffB); PG8_STAGE(PG8_SB(0, 1), cB + hstepB, voffB); PG8_STAGE(PG8_SA(0, 0), cA, voffA); PG8_STAGE(PG8_SA(0, 1), cA + hstepA, voffA1);
    if (wr == 1) PG8_BAR;
    PG8_WAIT_V(2); PG8_BAR;
    PG8_STAGE(PG8_SB(1, 0), cB + kstep, voffB); PG8_STAGE(PG8_SA(1, 0), cA + kstep, voffA); PG8_STAGE(PG8_SB(1, 1), cB + hstepB + kstep, voffB);
    PG8_WAIT_V(6); PG8_BAR;
    for (;;) {
        const bool has_next = prob.next(ui + 1, nxt);
        const char* nA = has_next ? prob.a_ptr(nxt) : cA; const char* nB = has_next ? prob.b_ptr(nxt) : cB;
        for (int t = 0; t < nt; t += 2) {
            const bool last = (t == nt - 2);
            const char* a1 = cA + (size_t)(t + 1) * kstep;
            const char* a2 = last ? nA : cA + (size_t)(t + 2) * kstep; const char* b2 = last ? nB : cB + (size_t)(t + 2) * kstep;
            const char* a3 = a2 + kstep; const char* b3 = b2 + kstep;
            if constexpr (P::GATHER) {
                unsigned v0[2], v1[2];
#pragma unroll
                for (int i = 0; i < 2; ++i) { v0[i] = voffA[i]; v1[i] = voffA1[i]; }
                if (last && has_next) PG8_GATHER_OFFS(ui + 1, v0, v1);
                PG8_LDB(B0, 0, 0); PG8_LDB(B1, 0, 1); PG8_SCHED; PG8_LDA(At, 0, 0); PG8_STAGE(PG8_SA(1, 1), a1, voffA1);
                PG8_WAIT_V(8); PG8_WAIT_L(0); PG8_BAR; PG8_MMA(0, 0, At, B0); PG8_MMA(0, 1, At, B1); PG8_BAR; PG8_SCHED;
                PG8_LDA(At, 0, 1); PG8_STAGE(PG8_SB(0, 0), b2, voffB); PG8_STAGE(PG8_SB(0, 1), b2 + hstepB, voffB); PG8_STAGE(PG8_SA(0, 0), a2, v0);
                PG8_WAIT_V(8); PG8_WAIT_L(0); PG8_BAR; PG8_MMA(1, 0, At, B0); PG8_MMA(1, 1, At, B1); PG8_BAR; PG8_SCHED;
                PG8_LDB(B0, 1, 0); PG8_LDB(B1, 1, 1); PG8_SCHED; PG8_LDA(At, 1, 0); PG8_STAGE(PG8_SA(0, 1), a2, v1);
                PG8_WAIT_V(8); PG8_WAIT_L(0); PG8_BAR; PG8_MMA(0, 0, At, B0); PG8_MMA(0, 1, At, B1); PG8_BAR; PG8_SCHED;
                PG8_LDA(At, 1, 1); PG8_STAGE(PG8_SB(1, 0), b3, voffB); PG8_STAGE(PG8_SB(1, 1), b3 + hstepB, voffB); PG8_STAGE(PG8_SA(1, 0), a3, v0);
                PG8_WAIT_V(8); PG8_WAIT_L(0); PG8_BAR; PG8_MMA(1, 0, At, B0); PG8_MMA(1, 1, At, B1); PG8_BAR; PG8_SCHED;
#pragma unroll
                for (int i = 0; i < 2; ++i) { voffA[i] = v0[i]; voffA1[i] = v1[i]; }
            } else {
                PG8_LDB(B0, 0, 0); PG8_LDB(B1, 0, 1); PG8_SCHED; PG8_LDA(At, 0, 0); PG8_STAGE(PG8_SA(1, 1), a1 + hstepA, voffA);
                PG8_WAIT_V(8); PG8_WAIT_L(0); PG8_BAR; PG8_MMA(0, 0, At, B0); PG8_MMA(0, 1, At, B1); PG8_BAR; PG8_SCHED;
                PG8_LDA(At, 0, 1); PG8_STAGE(PG8_SB(0, 0), b2, voffB); PG8_STAGE(PG8_SB(0, 1), b2 + hstepB, voffB); PG8_STAGE(PG8_SA(0, 0), a2, voffA);
                PG8_WAIT_V(8); PG8_WAIT_L(0); PG8_BAR; PG8_MMA(1, 0, At, B0); PG8_MMA(1, 1, At, B1); PG8_BAR; PG8_SCHED;
                PG8_LDB(B0, 1, 0); PG8_LDB(B1, 1, 1); PG8_SCHED; PG8_LDA(At, 1, 0); PG8_STAGE(PG8_SA(0, 1), a2 + hstepA, voffA);
                PG8_WAIT_V(8); PG8_WAIT_L(0); PG8_BAR; PG8_MMA(0, 0, At, B0); PG8_MMA(0, 1, At, B1); PG8_BAR; PG8_SCHED;
                PG8_LDA(At, 1, 1); PG8_STAGE(PG8_SB(1, 0), b3, voffB); PG8_STAGE(PG8_SB(1, 1), b3 + hstepB, voffB); PG8_STAGE(PG8_SA(1, 0), a3, voffA);
                PG8_WAIT_V(8); PG8_WAIT_L(0); PG8_BAR; PG8_MMA(1, 0, At, B0); PG8_MMA(1, 1, At, B1); PG8_BAR; PG8_SCHED;
            }
        }
        if (wr == 0) PG8_BAR;
        if constexpr (P::FP8) asm volatile("s_nop 15\n\ts_nop 15" ::: "memory");
        const bool keep = prob.epi(acc, cur, wr, wc, fr, fq);
        if (!has_next) break;
        if (!P::KEEPS || !keep) {
#pragma unroll
            for (int a = 0; a < 2; ++a)
#pragma unroll
                for (int b = 0; b < 2; ++b)
#pragma unroll
                    for (int m = 0; m < 4; ++m)
#pragma unroll
                        for (int n = 0; n < 2; ++n) acc[a][b][m][n] = (f32x4){0.f, 0.f, 0.f, 0.f};
        }
        cur = nxt; cA = nA; cB = nB; ++ui;
        if (wr == 1) PG8_BAR;
    }
    PG8_WAIT_V(0);
    PG8_BAR;
#undef PG8_SA
#undef PG8_SB
#undef PG8_STAGE
#undef PG8_LDA
#undef PG8_LDB
#undef PG8_MMA
#undef PG8_WAIT_V
#undef PG8_WAIT_L
#undef PG8_BAR
#undef PG8_SCHED
#undef PG8_GATHER_OFFS
}
}

template <class Epi>
__device__ __forceinline__ void skinny16_once(LAS unsigned char* lds, const bf16* A, int lda, const bf16* Bt, int ldb, int K, int N, const Epi& epi) {
    const int tid = threadIdx.x, wid = __builtin_amdgcn_readfirstlane(tid >> 6), lane = tid & 63, r = lane & 15, kg = lane >> 4;
    const int kw = K / 8, k0 = wid * kw;
    LAS float* part = (LAS float*)lds;
    for (int ct = blockIdx.x; ct < N / 16; ct += gridDim.x) {
        const bf16* ap = A + (size_t)r * lda + k0 + 8 * kg; const bf16* bp = Bt + (size_t)(16 * ct + r) * ldb + k0 + 8 * kg;
        f32x4 acc = {0.f, 0.f, 0.f, 0.f};
#pragma unroll 8
        for (int ks = 0; ks < kw; ks += 32) acc = __builtin_amdgcn_mfma_f32_16x16x32_bf16(*(const pg8::bf16x8*)(ap + ks), *(const pg8::bf16x8*)(bp + ks), acc, 0, 0, 0);
#pragma unroll
        for (int i = 0; i < 4; ++i) part[wid * 256 + (4 * kg + i) * 16 + r] = acc[i];
        LDS_WAIT(); __syncthreads();
        if (tid < 256) { const float s0 = (part[tid] + part[256 + tid]) + (part[512 + tid] + part[768 + tid]), s1 = (part[1024 + tid] + part[1280 + tid]) + (part[1536 + tid] + part[1792 + tid]);
            epi(tid >> 4, 16 * ct + (tid & 15), s0, s1); }
        LDS_WAIT(); __syncthreads();
    }
}
template <class Epi>
__device__ __forceinline__ void skinny16_f8(LAS unsigned char* lds, const unsigned char* A, int lda, const unsigned char* Bt, int ldb, int K, int N, int sc_a, int sc_b, const Epi& epi) {
    const int tid = threadIdx.x, wid = __builtin_amdgcn_readfirstlane(tid >> 6), lane = tid & 63, r = lane & 15, kg = lane >> 4;
    const int kw = K / 8, k0 = wid * kw;
    LAS float* part = (LAS float*)lds;
    for (int ct = blockIdx.x; ct < N / 16; ct += gridDim.x) {
        const unsigned char* ap = A + (size_t)r * lda + k0 + 32 * kg; const unsigned char* bp = Bt + (size_t)(16 * ct + r) * ldb + k0 + 32 * kg;
        f32x4 acc = {0.f, 0.f, 0.f, 0.f};
#pragma unroll 2
        for (int ks = 0; ks < kw; ks += 128) { const pg8::i32x8 av = *(const pg8::i32x8*)(ap + ks), bv = *(const pg8::i32x8*)(bp + ks);
            acc = __builtin_amdgcn_mfma_scale_f32_16x16x128_f8f6f4(av, bv, acc, 0, 0, 0, sc_a, 0, sc_b); }
#pragma unroll
        for (int i = 0; i < 4; ++i) part[wid * 256 + (4 * kg + i) * 16 + r] = acc[i];
        LDS_WAIT(); __syncthreads();
        if (tid < 256) { const float s0 = (part[tid] + part[256 + tid]) + (part[512 + tid] + part[768 + tid]), s1 = (part[1024 + tid] + part[1280 + tid]) + (part[1536 + tid] + part[1792 + tid]);
            epi(tid >> 4, 16 * ct + (tid & 15), s0, s1); }
        LDS_WAIT(); __syncthreads();
    }
}
template <class Epi>
__device__ __forceinline__ void skinny16(LAS unsigned char* lds, const bf16* A, int lda, const bf16* Bt, int ldb, int K, int N, const Epi& epi) {
    skinny16_once(lds, A, lda, Bt, ldb, K, N, epi); if ((DBL_MASK >> 10) & 1u) skinny16_once(lds, A, lda, Bt, ldb, K, N, epi);
}
struct SkinnyInProj { unsigned char* ws; unsigned* kmax; __device__ __forceinline__ void operator()(int j, int n, float s0, float s1) const { inproj_store(ws, SEQ + j, n, s0 + s1, kmax); } };
struct SkinnyBranch { unsigned char* ws; __device__ __forceinline__ void operator()(int j, int n, float s0, float s1) const {
    const size_t r = SEQ + j; const bf16* G = (const bf16*)(ws + WS_GB); const float v = __builtin_amdgcn_fmed3f((bf2f(G[r * G_N + n]) * s0 + bf2f(G[r * G_N + DM + n]) * s1) * MG8_SCALE, -448.f, 448.f);
    (ws + WS_MG)[r * DM + n] = (unsigned char)(__builtin_amdgcn_cvt_pk_fp8_f32(v, 0.f, 0, false) & 0xff); } };
struct SkinnyOut { unsigned char* ws; __device__ __forceinline__ void operator()(int j, int n, float s0, float s1) const {
    const size_t o = (size_t)(SEQ + j) * DM + n; ((float*)(ws + WS_RB))[o] = ALPHA * ((const float*)(ws + WS_HF))[o] + (s0 + s1); } };

using pg8::Unit;
struct ProbInProj {
    static constexpr bool PERM = true, GATHER = false, KEEPS = false, FP8 = true;
    int K, lda, ldb, G, c; const unsigned char* A; const unsigned char* B; unsigned char* ws; int sc_a, sc_b; unsigned* kmax;
    __device__ __forceinline__ bool next(int i, Unit& u) const { u.aux = 0; return pg8::static_tile(SEQ / 256, INP_N / 256, G, c, i, u.pm, u.pn); }
    __device__ __forceinline__ const char* a_ptr(const Unit& u) const { return (const char*)(A + (size_t)u.pm * 256 * lda); }
    __device__ __forceinline__ const char* b_ptr(const Unit& u) const { return (const char*)(B + (size_t)u.pn * 256 * ldb); }
    __device__ __forceinline__ bool epi(f32x4 (&acc)[2][2][4][2], const Unit& u, int wr, int wc, int fr, int fq) const {
        const int row0 = u.pm * 256 + wr * 64 + fr, ct = u.pn * 256 + wc * 32 + 8 * fq;
        const bool isg = u.pn >= 24, isq = (u.pn < 4) || (u.pn >= 12 && u.pn < 16);
        if (u.pn >= 16 && u.pn < 20) {
#pragma unroll
            for (int bj = 0; bj < 2; ++bj) { float mx = 0.f;
#pragma unroll
                for (int ai = 0; ai < 2; ++ai)
#pragma unroll
                    for (int m = 0; m < 4; ++m)
#pragma unroll
                        for (int n = 0; n < 2; ++n)
#pragma unroll
                            for (int j = 0; j < 4; ++j) mx = fmaxf(mx, __builtin_fabsf(acc[ai][bj][m][n][j]));
                mx = wave_max(mx);
                if ((threadIdx.x & 63) == 0) atomicMax(kmax + (2 * (u.pn - 16) + bj) * 64, __builtin_bit_cast(unsigned, mx)); } }
        bf16* base = isg ? (bf16*)(ws + WS_GB) + (ct - QKV_N) : (bf16*)(ws + WS_QKV) + ct; const int ldc = isg ? G_N : QKV_N; const float sc = isq ? QSCALE : 1.0f;
#pragma unroll
        for (int ai = 0; ai < 2; ++ai)
#pragma unroll
            for (int m = 0; m < 4; ++m) { bf16* rowp = base + (size_t)(row0 + ai * 128 + m * 16) * ldc;
#pragma unroll
                for (int bj = 0; bj < 2; ++bj) { f32x4 v0 = acc[ai][bj][m][0], v1 = acc[ai][bj][m][1];
                    if (isg) {
#pragma unroll
                        for (int j = 0; j < 4; ++j) { v0[j] = __builtin_amdgcn_rcpf(1.0f + __builtin_amdgcn_exp2f(-LOG2E * v0[j])); v1[j] = __builtin_amdgcn_rcpf(1.0f + __builtin_amdgcn_exp2f(-LOG2E * v1[j])); } }
                    else { v0 = v0 * sc; v1 = v1 * sc; }
                    u32x4 w; w.x = pg8::cvt_pk_bf16(v0[0], v0[1]); w.y = pg8::cvt_pk_bf16(v0[2], v0[3]); w.z = pg8::cvt_pk_bf16(v1[0], v1[1]); w.w = pg8::cvt_pk_bf16(v1[2], v1[3]);
                    *(u32x4*)(rowp + bj * 128) = w; } }
        return false;
    }
};
struct ProbOutProj {
    static constexpr bool PERM = false, GATHER = false, KEEPS = false, FP8 = true;
    int K, lda, ldb, G, c; const unsigned char* A; const unsigned char* B; unsigned char* ws; int sc_a, sc_b;
    __device__ __forceinline__ bool next(int i, Unit& u) const { u.aux = 0; return pg8::static_tile(SEQ / 256, DM / 256, G, c, i, u.pm, u.pn); }
    __device__ __forceinline__ const char* a_ptr(const Unit& u) const { return (const char*)(A + (size_t)u.pm * 256 * lda); }
    __device__ __forceinline__ const char* b_ptr(const Unit& u) const { return (const char*)(B + (size_t)u.pn * 256 * ldb); }
    __device__ __forceinline__ bool epi(f32x4 (&acc)[2][2][4][2], const Unit& u, int wr, int wc, int fr, int fq) const {
        const int row0 = u.pm * 256 + wr * 64 + fr, col0 = u.pn * 256 + wc * 32 + 4 * fq;
        const float* HF = (const float*)(ws + WS_HF); float* R = (float*)(ws + WS_RB);
#pragma unroll
        for (int ai = 0; ai < 2; ++ai)
#pragma unroll
            for (int m = 0; m < 4; ++m) { const size_t off = (size_t)(row0 + ai * 128 + m * 16) * DM + col0;
#pragma unroll
                for (int bj = 0; bj < 2; ++bj)
#pragma unroll
                    for (int n = 0; n < 2; ++n) { const f32x4 hv = *(const f32x4*)(HF + off + bj * 128 + n * 16); *(f32x4*)(R + off + bj * 128 + n * 16) = hv * ALPHA + acc[ai][bj][m][n]; }
                asm volatile("" ::: "memory"); }
        return false;
    }
};

struct ProbBranch {
    static constexpr bool PERM = true, GATHER = false, KEEPS = true, FP8 = false;
    int K, lda, ldb, G, c; const bf16* A; const bf16* B; unsigned char* ws; int sc_a, sc_b;
    __device__ __forceinline__ bool next(int i, Unit& u) const { u.aux = i & 1; return pg8::static_tile(SEQ / 256, DM / 256, G, c, i >> 1, u.pm, u.pn); }
    __device__ __forceinline__ const char* a_ptr(const Unit& u) const { return (const char*)(A + (size_t)u.pm * 256 * lda + u.aux * 1024); }
    __device__ __forceinline__ const char* b_ptr(const Unit& u) const { return (const char*)(B + (size_t)u.pn * 256 * ldb + u.aux * 1024); }
    __device__ __forceinline__ bool epi(f32x4 (&acc)[2][2][4][2], const Unit& u, int wr, int wc, int fr, int fq) const {
        const int row0 = u.pm * 256 + wr * 64 + fr, ct = u.pn * 256 + wc * 32 + 8 * fq;
        const bf16* Gs = (const bf16*)(ws + WS_GB) + ct; const bf16* Gf = Gs + DM; unsigned char* MG = ws + WS_MG + ct;
        const bool first = u.aux == 0;
#pragma unroll
        for (int ai = 0; ai < 2; ++ai)
#pragma unroll
            for (int m = 0; m < 4; ++m) { const size_t r = (size_t)(row0 + ai * 128 + m * 16);
#pragma unroll
                for (int bj = 0; bj < 2; ++bj) { const u32x4 gf = *(const u32x4*)(Gf + r * G_N + bj * 128);
                    f32x4 f0 = {bflo(gf.x), bfhi(gf.x), bflo(gf.y), bfhi(gf.y)}, f1 = {bflo(gf.z), bfhi(gf.z), bflo(gf.w), bfhi(gf.w)};
                    if (first) { const u32x4 gs = *(const u32x4*)(Gs + r * G_N + bj * 128);
                        const f32x4 s0 = {bflo(gs.x), bfhi(gs.x), bflo(gs.y), bfhi(gs.y)}, s1 = {bflo(gs.z), bfhi(gs.z), bflo(gs.w), bfhi(gs.w)};
#pragma unroll
                        for (int j = 0; j < 4; ++j) { acc[ai][bj][m][0][j] *= s0[j] * __builtin_amdgcn_rcpf(fmaxf(f0[j], 1e-30f)); acc[ai][bj][m][1][j] *= s1[j] * __builtin_amdgcn_rcpf(fmaxf(f1[j], 1e-30f)); } }
                    else { const f32x4 v0 = acc[ai][bj][m][0] * f0 * MG8_SCALE, v1 = acc[ai][bj][m][1] * f1 * MG8_SCALE;
                        u32x2 w; w.x = pk4_fp8(v0[0], v0[1], v0[2], v0[3]); w.y = pk4_fp8(v1[0], v1[1], v1[2], v1[3]);
                        *(u32x2*)(MG + r * DM + bj * 128) = w; } }
                asm volatile("" ::: "memory"); }
        return first;
    }
};
constexpr int IDX_OFF = RING_BYTES + 1024, MOE_MAXU = 3;
struct ProbMoeGU {
    static constexpr bool PERM = true, GATHER = true, KEEPS = false, FP8 = true;
    int K, lda, ldb, G, c, layer; const unsigned char* A; const unsigned char* B; unsigned char* ws; const unsigned* ctl; LAS unsigned char* lds; int sc_a, sc_b;
    __device__ __forceinline__ bool next(int i, Unit& u) const { const int L = i * G + c; u.pm = L >> 3; u.pn = L & 7; int cnt, ps; return moe_find(ctl, layer, u.pm * 256, u.aux, cnt, ps); }
    __device__ __forceinline__ const char* a_ptr(const Unit&) const { return (const char*)A; }
    __device__ __forceinline__ const char* b_ptr(const Unit& u) const { return (const char*)(B + (size_t)u.aux * WGU_E + (size_t)u.pn * 256 * ldb); }
    __device__ __forceinline__ int a_row(int ui, int r) const { return *(const LAS int*)(lds + IDX_OFF + (ui * 256 + r) * 4); }
    __device__ __forceinline__ void fill_idx(int tid) const {
        for (int ui = 0; ui < MOE_MAXU; ++ui) { const int L = ui * G + c; int e, cnt, ps; if (!moe_find(ctl, layer, (L >> 3) * 256, e, cnt, ps)) break;
            if (tid < 256) { const int rank = (L >> 3) * 256 - ps + tid; *(LAS int*)(lds + IDX_OFF + (ui * 256 + tid) * 4) = rank < cnt ? ((const int*)(ws + WS_ELIST))[(size_t)e * MROWS + rank] : 0; } }
        LDS_WAIT(); __syncthreads();
    }
    __device__ __forceinline__ bool epi(f32x4 (&acc)[2][2][4][2], const Unit& u, int wr, int wc, int fr, int fq) const {
        const int row0 = u.pm * 256 + wr * 64 + fr, ct = u.pn * 128 + wc * 32 + 8 * fq; unsigned char* act = ws + WS_ACT + ct;
#pragma unroll
        for (int ai = 0; ai < 2; ++ai)
#pragma unroll
            for (int m = 0; m < 4; ++m) { f32x4 v[2];
#pragma unroll
                for (int n = 0; n < 2; ++n)
#pragma unroll
                    for (int j = 0; j < 4; ++j) { const float g = acc[ai][0][m][n][j]; v[n][j] = g * __builtin_amdgcn_rcpf(1.0f + __builtin_amdgcn_exp2f(-LOG2E * g)) * acc[ai][1][m][n][j]; }
                u32x2 w; w.x = pk4_fp8(v[0][0] * ACT8_SCALE, v[0][1] * ACT8_SCALE, v[0][2] * ACT8_SCALE, v[0][3] * ACT8_SCALE); w.y = pk4_fp8(v[1][0] * ACT8_SCALE, v[1][1] * ACT8_SCALE, v[1][2] * ACT8_SCALE, v[1][3] * ACT8_SCALE);
                *(u32x2*)(act + (size_t)(row0 + ai * 128 + m * 16) * FF) = w; }
        return false;
    }
};
struct ProbMoeDown {
    static constexpr bool PERM = true, GATHER = false, KEEPS = false, FP8 = true;
    int K, lda, ldb, G, c, layer; const unsigned char* A; const unsigned char* B; unsigned char* ws; const unsigned* ctl; int sc_a, sc_b;
    __device__ __forceinline__ bool next(int i, Unit& u) const { const int L = i * G + c; u.pm = L >> 3; u.pn = L & 7; int cnt, ps; return moe_find(ctl, layer, u.pm * 256, u.aux, cnt, ps); }
    __device__ __forceinline__ const char* a_ptr(const Unit& u) const { return (const char*)(A + (size_t)u.pm * 256 * lda); }
    __device__ __forceinline__ const char* b_ptr(const Unit& u) const { return (const char*)(B + (size_t)u.aux * WD_E + (size_t)u.pn * 256 * ldb); }
    __device__ __forceinline__ bool epi(f32x4 (&acc)[2][2][4][2], const Unit& u, int wr, int wc, int fr, int fq) const {
        const int row0 = u.pm * 256 + wr * 64 + fr, ct = u.pn * 256 + wc * 32 + 8 * fq; bf16* O = (bf16*)(ws + WS_OSL) + ct;
#pragma unroll
        for (int ai = 0; ai < 2; ++ai)
#pragma unroll
            for (int m = 0; m < 4; ++m)
#pragma unroll
                for (int bj = 0; bj < 2; ++bj) { const f32x4 v0 = acc[ai][bj][m][0], v1 = acc[ai][bj][m][1];
                    u32x4 w; w.x = pg8::cvt_pk_bf16(v0[0], v0[1]); w.y = pg8::cvt_pk_bf16(v0[2], v0[3]); w.z = pg8::cvt_pk_bf16(v1[0], v1[1]); w.w = pg8::cvt_pk_bf16(v1[2], v1[3]);
                    *(u32x4*)(O + (size_t)(row0 + ai * 128 + m * 16) * DM + bj * 128) = w; }
        return false;
    }
};

#ifndef ATT_DBL
#define ATT_DBL 0
#endif
namespace att {
typedef short bf16x8 __attribute__((ext_vector_type(8)));
typedef short s16x4 __attribute__((ext_vector_type(4)));
typedef float f32x16 __attribute__((ext_vector_type(16)));
constexpr int TILE_B = 16384;
constexpr float EXIT_THR = -140.f;
constexpr int L_V = 0, L_K = 3 * TILE_B, L_C2 = 6 * TILE_B, L_WS = L_C2 + 1024, L_ITEM = L_WS + 8 * 256, L_VOTE = L_ITEM + 16, L_FT = L_VOTE + 64, L_END = L_FT + 16;
#define KSWZ(row, colB) ((row) * 256 + ((colB) ^ (((row) & 7) << 4)))
#define SBAR() __builtin_amdgcn_sched_barrier(0)
__device__ __forceinline__ int v_st(int k, int c) { const int kk = (k & ~0xC) | ((k & 4) << 1) | ((k & 8) >> 1); return ((kk >> 3) * 4 + (c >> 5)) * 512 + ((kk & 7) * 32 + (c & 31)) * 2; }
__device__ __forceinline__ int v_rd_base(int lane) { return ((lane & 3) << 3) | (((lane >> 2) & 3) << 6) | (((lane >> 4) & 1) << 5) | (((lane >> 5) & 1) << 8); }
constexpr int v_rd_off(int d0, int ks, int half) { return d0 * 512 + ks * 4096 + half * 2048; }
__device__ __forceinline__ int crow(int r, int hi) { return (r & 3) + 8 * (r >> 2) + 4 * hi; }
__device__ __forceinline__ unsigned cvtpk(float lo, float hi) { unsigned r; asm volatile("v_cvt_pk_bf16_f32 %0, %1, %2" : "=v"(r) : "v"(lo), "v"(hi)); return r; }
__device__ __forceinline__ float xchg_sum(float v) { auto rr = __builtin_amdgcn_permlane32_swap(__float_as_uint(v), __float_as_uint(v), false, false); return __uint_as_float(rr[0]) + __uint_as_float(rr[1]); }
__device__ __forceinline__ float xchg_max(float v) { auto rr = __builtin_amdgcn_permlane32_swap(__float_as_uint(v), __float_as_uint(v), false, false); return fmaxf(__uint_as_float(rr[0]), __uint_as_float(rr[1])); }
#define PK4(P, B_, OUT) do { unsigned a0 = cvtpk(P[B_+0], P[B_+1]), a1 = cvtpk(P[B_+2], P[B_+3]); unsigned b0 = cvtpk(P[B_+4], P[B_+5]), b1 = cvtpk(P[B_+6], P[B_+7]); \
        auto r0 = __builtin_amdgcn_permlane32_swap(a0, b0, false, false); auto r1 = __builtin_amdgcn_permlane32_swap(a1, b1, false, false); \
        u32x4 w = {r0[0], r1[0], r0[1], r1[1]}; OUT = *reinterpret_cast<bf16x8*>(&w); } while (0)
__device__ __forceinline__ void qkt(f32x16& p0, f32x16& p1, const LAS unsigned char* kt, int r32, int hi, const bf16x8* qr) {
    p0 = f32x16{}; p1 = f32x16{};
    const LAS unsigned char* kb[4];
#pragma unroll
    for (int dd = 0; dd < 4; ++dd) kb[dd] = kt + KSWZ(r32, (dd * 16 + hi * 8) * 2);
#pragma unroll
    for (int d0 = 0; d0 < 8; ++d0) { const LAS unsigned char* a = kb[d0 & 3] + (d0 >> 2) * 128;
        const bf16x8 b0 = *(const LAS bf16x8*)(a); const bf16x8 b1 = *(const LAS bf16x8*)(a + 32 * 256);
        p0 = __builtin_amdgcn_mfma_f32_32x32x16_bf16(b0, qr[d0], p0, 0, 0, 0);
        p1 = __builtin_amdgcn_mfma_f32_32x32x16_bf16(b1, qr[d0], p1, 0, 0, 0); }
}
__device__ __forceinline__ void pv_tile(f32x16* o, unsigned vb0, bf16x8 pa0, bf16x8 pa1, bf16x8 pa2, bf16x8 pa3) {
#define TRRD(dst, off) asm volatile("ds_read_b64_tr_b16 %0, %1 offset:%2" : "=&v"(dst) : "v"(vb0), "i"(off) : "memory")
#define PV_D0(d0) do { s16x4 l0, l1, l2, l3, h0, h1, h2, h3; constexpr int b_ = v_rd_off(d0, 0, 0); \
        TRRD(l0, b_); TRRD(h0, b_ + 2048); TRRD(l1, b_ + 4096); TRRD(h1, b_ + 6144); TRRD(l2, b_ + 8192); TRRD(h2, b_ + 10240); TRRD(l3, b_ + 12288); TRRD(h3, b_ + 14336); \
        asm volatile("s_waitcnt lgkmcnt(0)" ::: "memory"); SBAR(); \
        o[d0] = __builtin_amdgcn_mfma_f32_32x32x16_bf16(pa0, (bf16x8){l0[0], l0[1], l0[2], l0[3], h0[0], h0[1], h0[2], h0[3]}, o[d0], 0, 0, 0); \
        o[d0] = __builtin_amdgcn_mfma_f32_32x32x16_bf16(pa1, (bf16x8){l1[0], l1[1], l1[2], l1[3], h1[0], h1[1], h1[2], h1[3]}, o[d0], 0, 0, 0); \
        o[d0] = __builtin_amdgcn_mfma_f32_32x32x16_bf16(pa2, (bf16x8){l2[0], l2[1], l2[2], l2[3], h2[0], h2[1], h2[2], h2[3]}, o[d0], 0, 0, 0); \
        o[d0] = __builtin_amdgcn_mfma_f32_32x32x16_bf16(pa3, (bf16x8){l3[0], l3[1], l3[2], l3[3], h3[0], h3[1], h3[2], h3[3]}, o[d0], 0, 0, 0); } while (0)
    PV_D0(0); PV_D0(1); PV_D0(2); PV_D0(3);
#undef PV_D0
#undef TRRD
}
#define VIS(cc) (((dqh) - (cc)) >= NEED && (cc) < (nvh))
__device__ __forceinline__ void sb_tile(f32x16& p0, f32x16& p1, float& carry, bool domask, int dqh, int nvh, int hi, bf16x8& pa0, bf16x8& pa1, bf16x8& pa2, bf16x8& pa3) {
    constexpr int NEED = 1;
    f32x16 x0, x1;
#pragma unroll
    for (int r = 0; r < 16; ++r) {
        { const float u = __builtin_amdgcn_fmed3f(p0[r], -126.f, 126.f), b = __builtin_amdgcn_logf(1.0f + __builtin_amdgcn_exp2f(-u)); x0[r] = -b; p0[r] = -u - b; }
        { const float u = __builtin_amdgcn_fmed3f(p1[r], -126.f, 126.f), b = __builtin_amdgcn_logf(1.0f + __builtin_amdgcn_exp2f(-u)); x1[r] = -b; p1[r] = -u - b; } }
    if (domask) { const float NEG = -__builtin_inff();
#pragma unroll
        for (int r = 0; r < 16; ++r) { const int cc = (r & 3) + 8 * (r >> 2);
            if (!VIS(cc)) { p0[r] = 0.f; x0[r] = NEG; }
            if (!VIS(cc + 32)) { p1[r] = 0.f; x1[r] = NEG; } } }
    float A[9]; A[8] = 0.f;
#pragma unroll
    for (int g = 3; g >= 0; --g) A[4 + g] = A[5 + g] + ((p1[4 * g] + p1[4 * g + 1]) + (p1[4 * g + 2] + p1[4 * g + 3]));
#pragma unroll
    for (int g = 3; g >= 0; --g) A[g] = A[1 + g] + ((p0[4 * g] + p0[4 * g + 1]) + (p0[4 * g + 2] + p0[4 * g + 3]));
    float off[8];
#pragma unroll
    for (int i = 0; i < 8; ++i) { auto rr = __builtin_amdgcn_permlane32_swap(__float_as_uint(A[i]), __float_as_uint(A[i + 1]), false, false);
        const float recv = hi ? __uint_as_float(rr[0]) : __uint_as_float(rr[1]); off[i] = carry + A[i + 1] + recv; }
    carry += xchg_sum(A[0]);
#pragma unroll
    for (int g = 0; g < 4; ++g) {
        { float af = off[g]; const float l3 = p0[4 * g + 3], l2 = p0[4 * g + 2], l1 = p0[4 * g + 1];
          x0[4 * g + 3] = __builtin_amdgcn_exp2f(x0[4 * g + 3] + af); af += l3; x0[4 * g + 2] = __builtin_amdgcn_exp2f(x0[4 * g + 2] + af); af += l2;
          x0[4 * g + 1] = __builtin_amdgcn_exp2f(x0[4 * g + 1] + af); af += l1; x0[4 * g] = __builtin_amdgcn_exp2f(x0[4 * g] + af); }
        { float af = off[4 + g]; const float l3 = p1[4 * g + 3], l2 = p1[4 * g + 2], l1 = p1[4 * g + 1];
          x1[4 * g + 3] = __builtin_amdgcn_exp2f(x1[4 * g + 3] + af); af += l3; x1[4 * g + 2] = __builtin_amdgcn_exp2f(x1[4 * g + 2] + af); af += l2;
          x1[4 * g + 1] = __builtin_amdgcn_exp2f(x1[4 * g + 1] + af); af += l1; x1[4 * g] = __builtin_amdgcn_exp2f(x1[4 * g] + af); } }
    PK4(x0, 0, pa0); PK4(x0, 8, pa1); PK4(x1, 0, pa2); PK4(x1, 8, pa3);
}
__device__ __forceinline__ float fox_tile(f32x16& p0, f32x16& p1, const LAS float* c2t, float& m_reg, float& l_reg, bool domask, int dqh, int nvh, int hi, bf16x8& pa0, bf16x8& pa1, bf16x8& pa2, bf16x8& pa3) {
    constexpr int NEED = 0;
#pragma unroll
    for (int g = 0; g < 4; ++g) { const f32x4 c0 = *(const LAS f32x4*)(c2t + 8 * g + 4 * hi), c1 = *(const LAS f32x4*)(c2t + 32 + 8 * g + 4 * hi);
#pragma unroll
        for (int j = 0; j < 4; ++j) { p0[4 * g + j] -= c0[j]; p1[4 * g + j] -= c1[j]; } }
    if (domask) { const float NEG = -__builtin_inff();
#pragma unroll
        for (int r = 0; r < 16; ++r) { const int cc = (r & 3) + 8 * (r >> 2);
            if (!VIS(cc)) p0[r] = NEG;
            if (!VIS(cc + 32)) p1[r] = NEG; } }
    float pmax = p0[0];
#pragma unroll
    for (int r = 1; r < 16; ++r) pmax = fmaxf(pmax, p0[r]);
#pragma unroll
    for (int r = 0; r < 16; ++r) pmax = fmaxf(pmax, p1[r]);
    pmax = xchg_max(pmax);
    const float mn = fmaxf(m_reg, pmax), alpha = __builtin_amdgcn_exp2f(m_reg - mn); m_reg = mn;
    float ps = 0.f;
#pragma unroll
    for (int r = 0; r < 16; ++r) { p0[r] = __builtin_amdgcn_exp2f(p0[r] - mn); p1[r] = __builtin_amdgcn_exp2f(p1[r] - mn); ps += p0[r] + p1[r]; }
    l_reg = l_reg * alpha + xchg_sum(ps);
    PK4(p0, 0, pa0); PK4(p0, 8, pa1); PK4(p1, 0, pa2); PK4(p1, 8, pa3);
    return alpha;
}
#undef VIS
template <int TYPE>
__device__ __forceinline__ void attn_unit(LAS unsigned char* lds, unsigned char* ws, const unsigned* kmaxw, int head, int qb) {
    const int tid = threadIdx.x, wid = __builtin_amdgcn_readfirstlane(tid >> 6), lane = tid & 63, r32 = lane & 31, hi = lane >> 5;
    const bool grpY = wid >= 4;
    const bf16* QKV = (const bf16*)(ws + WS_QKV);
    const int qcol = (TYPE ? 3072 : 0) + head * HD, kcol = qcol + 1024, vcol = qcol + 2048;
    const float* fsuf = (const float*)(ws + WS_CUM) + (size_t)head * MROWS; const float* ftot = (const float*)(ws + WS_CUM) + (size_t)NHEAD * MROWS + head * 256;
    float fcarry = 0.f, st_tot = 0.f;
    LAS int* vote = (LAS int*)(lds + L_VOTE); LAS float* ftl = (LAS float*)(lds + L_FT);
    const int qrow0 = qb * 256, NT = qb < 32 ? 4 * qb + 5 : 1;
    const int qbase = qb < 32 ? qrow0 : -NMETA;
    const int qlo = qbase + wid * 32, qpos = qlo + r32;
    LAS unsigned char* V_lds = lds + L_V; LAS unsigned char* K_lds = lds + L_K; LAS float* c2_lds = (LAS float*)(lds + L_C2);
    LAS float* wsl = (LAS float*)(lds + L_WS) + wid * 64;
    bf16x8 qr[8];
#pragma unroll
    for (int d0 = 0; d0 < 8; ++d0) qr[d0] = *(const bf16x8*)(QKV + (size_t)(qrow0 + wid * 32 + r32) * QKV_N + qcol + d0 * 16 + hi * 8);
    const int sr = tid >> 4, sc = (tid & 15) * 8, vst0 = v_st(sr, sc), vst1 = v_st(32 + sr, sc), kws = KSWZ(sr, sc * 2);
    const unsigned vrd = (unsigned)(size_t)V_lds + (unsigned)v_rd_base(lane);
    bf16x8 st_k0, st_k1, st_v0, st_v1; float st_c = 0.f;
    float ub = 0.f;
    if (TYPE == 1) { float s1 = 0.f;
#pragma unroll
        for (int d0 = 0; d0 < 8; ++d0) { const u32x4 w = __builtin_bit_cast(u32x4, qr[d0]);
            s1 += (__builtin_fabsf(bflo(w.x)) + __builtin_fabsf(bfhi(w.x))) + (__builtin_fabsf(bflo(w.y)) + __builtin_fabsf(bfhi(w.y))) + (__builtin_fabsf(bflo(w.z)) + __builtin_fabsf(bfhi(w.z))) + (__builtin_fabsf(bflo(w.w)) + __builtin_fabsf(bfhi(w.w))); }
        ub = 1.02f * xchg_sum(s1) * __builtin_bit_cast(float, kmaxw[head * 64]); }
#define TISMETA(t) ((t) == NT - 1)
#define SLOAD(t) do { const int row_ = TISMETA(t) ? SEQ : 64 * (4 * qb + 3 - (t)); const bf16* kp_ = QKV + (size_t)(row_ + sr) * QKV_N + sc; \
        st_k0 = *(const bf16x8*)(kp_ + kcol); st_k1 = *(const bf16x8*)(kp_ + (size_t)32 * QKV_N + kcol); st_v0 = *(const bf16x8*)(kp_ + vcol); st_v1 = *(const bf16x8*)(kp_ + (size_t)32 * QKV_N + vcol); \
        if (TYPE == 1 && tid < 64) { st_c = fsuf[row_ + tid]; st_tot = ftot[row_ >> 6]; } } while (0)
#define SWRITE(bo) do { *(LAS bf16x8*)(K_lds + (bo) + kws) = st_k0; *(LAS bf16x8*)(K_lds + (bo) + kws + 32 * 256) = st_k1; \
        *(LAS bf16x8*)(V_lds + (bo) + vst0) = st_v0; *(LAS bf16x8*)(V_lds + (bo) + vst1) = st_v1; if (TYPE == 1 && tid < 64) { c2_lds[((bo) >> 8) + tid] = -(fcarry + st_c); fcarry += st_tot; if (tid == 0) ftl[(bo) >> 14] = fcarry; } } while (0)
#define BAR() asm volatile("s_waitcnt lgkmcnt(0)\n\ts_barrier" ::: "memory")
    SLOAD(0); SWRITE(0);
    if (NT > 1) { SLOAD(1); SWRITE(TILE_B); }
    __builtin_amdgcn_s_waitcnt(0x0F70);
    if (NT > 2) SLOAD(2);
    BAR();
    if (grpY) BAR();
    f32x16 o[4] = {}; float carry = 0.f, m_reg = -1e30f, l_reg = 0.f;
    constexpr int NEEDW = TYPE == 0 ? 1 : 0;
#define KBASE(t) (TISMETA(t) ? -NMETA : 64 * (4 * qb + 3 - (t)))
#define ACTW(t) ((qlo + 31 - KBASE(t)) >= NEEDW && (qb < 32 || wid == 0))
    f32x16 p0, p1;
    if (ACTW(0)) qkt(p0, p1, K_lds, r32, hi, qr);
    int bo = 0, bo1 = TILE_B, bo2 = 2 * TILE_B;
    for (int t = 0; t < NT; ++t) {
        BAR();
        if (t > 0) { const LAS int* vp = vote + ((t - 1) & 1) * 8; const int all8 = (vp[0] & vp[1]) & (vp[2] & vp[3]) & (vp[4] & vp[5]) & (vp[6] & vp[7]); if (__builtin_amdgcn_readfirstlane(all8)) break; }
        const int kbase = KBASE(t), nvalid = TISMETA(t) ? NMETA : 64;
        const bool actw = ACTW(t);
        const bool domask = (qlo - (kbase + 63) < NEEDW) || nvalid < 64;
        bf16x8 pa0, pa1, pa2, pa3;
        if (actw) {
            const int dqh = qpos - kbase - 4 * hi, nvh = nvalid - 4 * hi;
            if (TYPE == 0) sb_tile(p0, p1, carry, domask, dqh, nvh, hi, pa0, pa1, pa2, pa3);
            else { const float alpha = fox_tile(p0, p1, c2_lds + (bo >> 8), m_reg, l_reg, domask, dqh, nvh, hi, pa0, pa1, pa2, pa3);
                if (__any(alpha < 1.f)) { if (hi == 0) wsl[r32] = alpha; asm volatile("s_waitcnt lgkmcnt(0)" ::: "memory");
#pragma unroll
                    for (int r = 0; r < 16; ++r) { const float al = wsl[crow(r, hi)];
#pragma unroll
                        for (int d = 0; d < 4; ++d) o[d][r] *= al; } } }
        }
        { const bool done = TYPE == 0 ? __all(carry < EXIT_THR) : __all(ub + ftl[bo >> 14] - m_reg < EXIT_THR);
          if (lane == 0) vote[(t & 1) * 8 + wid] = (done && qb < 32) ? 1 : 0; }
        BAR();
        if (t + 2 < NT) SWRITE(bo2);
        if (t + 3 < NT) SLOAD(t + 3);
        if (actw) pv_tile(o, vrd + bo, pa0, pa1, pa2, pa3);
        if (t + 1 < NT) { if (ACTW(t + 1)) qkt(p0, p1, K_lds + bo1, r32, hi, qr); }
        { const int tmp = bo; bo = bo1; bo1 = bo2; bo2 = tmp; }
    }
    if (!grpY) BAR();
    float rli[16];
    if (TYPE == 1) { if (hi == 0) wsl[32 + r32] = l_reg; asm volatile("s_waitcnt lgkmcnt(0)" ::: "memory");
#pragma unroll
        for (int r = 0; r < 16; ++r) rli[r] = __builtin_amdgcn_rcpf(wsl[32 + crow(r, hi)]); }
    bf16* Yw = (bf16*)(ws + WS_YB) + (size_t)(qrow0 + wid * 32) * DM + TYPE * 1024 + head * HD;
    if (qb < 32 || wid == 0)
#pragma unroll
    for (int r = 0; r < 16; ++r) { const int orow = crow(r, hi);
#pragma unroll
        for (int d0 = 0; d0 < 4; ++d0) { const float v = TYPE == 1 ? o[d0][r] * rli[r] : o[d0][r]; const float vn = __shfl_xor(v, 1);
            if ((r32 & 1) == 0) *(unsigned*)(Yw + (size_t)orow * DM + d0 * 32 + r32) = cvtpk(v, vn); } }
#undef TISMETA
#undef SLOAD
#undef SWRITE
#undef BAR
#undef KBASE
#undef ACTW
}
constexpr int CW_ATTNQ = 3072;
__device__ __forceinline__ void attn_phase(Frame& F, int layer, int qoff) {
    LAS unsigned char* lds = F.lds; unsigned char* ws = F.ws; unsigned* ctl = F.ctl; const int G = F.G, b = blockIdx.x;
    const int NA = 512 + (layer == 0 ? 16 : 0);
    const int cv0 = layer == 0 ? CV_G0_END : CV_G1_END, NB_ = ((layer == 0 ? CV_G1_END : N_CONVERT_ITEMS) - cv0) / CV_BUNDLE;
    const bool copier = (b % 3) == 2; const int ncop = (G + 1) / 3, nfree = G - ncop;
    LAS int* itemw = (LAS int*)(lds + L_ITEM); const unsigned* kmaxw = ctl + CW_KMAX + layer * 8 * 64;
    int it;
    if (copier) {
        for (int j = b / 3; j < NB_; j += ncop) convert_bundle(F, cv0 + j * CV_BUNDLE);
        __syncthreads();
        if (threadIdx.x == 0) *itemw = nfree + (int)atomicAdd(ctl + CW_ATTNQ + layer * 64 + qoff, 1u);
        asm volatile("s_waitcnt lgkmcnt(0)" ::: "memory"); __syncthreads();
        it = __builtin_amdgcn_readfirstlane(*itemw);
    } else it = b - b / 3;
    while (it < NA) {
        int qb, th; if (it < 256) { qb = 31 - (it >> 3); th = 8 + (it & 7); } else if (it < 512) { qb = 31 - ((it - 256) >> 3); th = it & 7; } else { qb = 32; th = it - 512; }
        if (th < 8) attn_unit<0>(lds, ws, kmaxw, th, qb); else attn_unit<1>(lds, ws, kmaxw, th - 8, qb);
        __syncthreads();
        if (threadIdx.x == 0) *itemw = nfree + (int)atomicAdd(ctl + CW_ATTNQ + layer * 64 + qoff, 1u);
        asm volatile("s_waitcnt lgkmcnt(0)" ::: "memory"); __syncthreads();
        it = __builtin_amdgcn_readfirstlane(*itemw);
    }
}
#undef KSWZ
#undef SBAR
#undef PK4
}

__global__ void __launch_bounds__(NTHREADS, 2) mk_fwd(Args args) {
    extern __shared__ __attribute__((aligned(16))) unsigned char lds_raw[];
    Frame F;
    F.lds = (LAS unsigned char*)lds_raw; F.ws = args.ws; F.ctl = (unsigned*)(args.ws + WS_CTL);
    F.tid = threadIdx.x; F.lane = F.tid & 63; F.wave = __builtin_amdgcn_readfirstlane(F.tid >> 6);
    F.G = gridDim.x; F.gw = blockIdx.x * NWAVES + F.wave; F.NGW = F.G * NWAVES;
    F.in = (const float* const*)__builtin_amdgcn_kernarg_segment_ptr();
    F.out = args.out;
    volatile LAS unsigned* MISC = (volatile LAS unsigned*)(F.lds + MISC_OFF);
    for (int u = F.tid; u < (LDS_BYTES - RING_BYTES) / 4; u += NTHREADS) ((LAS unsigned*)(F.lds + RING_BYTES))[u] = 0u;
    __syncthreads();
    XcdBarrier bar = xcd_barrier_post(F.ctl + CW_BAR + args.li * XCD_BAR_WORDS, MISC + 8);
    const int lo = args.ph_lo, hi = args.ph_hi; const unsigned naive = args.naive;
#define IN(k) (lo <= (k) && (k) < hi)
#define SEAM(k) do { if (IN(k) && IN((k) + 1)) { xcd_barrier(bar); if ((DBL_MASK >> 9) & 1u) xcd_barrier(bar); } } while (0)
#define NAIVE(t) ((naive >> (t)) & 1u)
    if (IN(0)) { phase_prologue(F); SEAM(0); }
#define LAYER_PHASES(l, pb) do { \
        if (IN(pb + PH_A)) { phase_cumsum(F, NAIVE(PH_B)); if (!NAIVE(PH_B)) phase_tilesuf(F); \
            if (!NAIVE(PH_A)) { skinny16_f8(F.lds, F.ws + WS_H8 + (size_t)SEQ * DM, DM, F.ws + WS_WIN + l * WIN_L, DM, DM, INP_N, SC_H, SC_W, SkinnyInProj{F.ws, F.ctl + CW_KMAX + l * 8 * 64}); \
              ProbInProj P{DM, DM, DM, F.G, (int)blockIdx.x, F.ws + WS_H8, F.ws + WS_WIN + l * WIN_L, F.ws, SC_H, SC_W, F.ctl + CW_KMAX + l * 8 * 64}; pg8::gemm_phase(F.lds, P); if ((DBL_MASK >> PH_A) & 1u) pg8::gemm_phase(F.lds, P); } \
            SEAM(pb + PH_A); } \
        if (IN(pb + PH_B)) { \
            if (!NAIVE(PH_B)) att::attn_phase(F, l, 0); \
            SEAM(pb + PH_B); } \
        if (IN(pb + PH_C)) { \
            if (!NAIVE(PH_C)) { if (l == 0) skinny16(F.lds, (const bf16*)(F.ws + WS_YB) + (size_t)SEQ * DM, DM, (const bf16*)(F.ws + WS_WB + l * WB_L), DM, DM, DM, SkinnyBranch{F.ws}); \
              ProbBranch P{1024, DM, DM, F.G, (int)blockIdx.x, (const bf16*)(F.ws + WS_YB), (const bf16*)(F.ws + WS_WB + l * WB_L), F.ws, 0, 0}; pg8::gemm_phase(F.lds, P); if ((DBL_MASK >> PH_C) & 1u) pg8::gemm_phase(F.lds, P); } \
            SEAM(pb + PH_C); } \
        if (IN(pb + PH_D)) { \
            if (!NAIVE(PH_D)) { if (l == 0) skinny16_f8(F.lds, F.ws + WS_MG + (size_t)SEQ * DM, DM, F.ws + WS_WOUT + l * WOUT_L, DM, DM, DM, SC_MG, SC_W, SkinnyOut{F.ws}); \
              ProbOutProj P{DM, DM, DM, F.G, (int)blockIdx.x, F.ws + WS_MG, F.ws + WS_WOUT + l * WOUT_L, F.ws, SC_MG, SC_W}; pg8::gemm_phase(F.lds, P); if ((DBL_MASK >> PH_D) & 1u) pg8::gemm_phase(F.lds, P); } \
            SEAM(pb + PH_D); } \
        if (IN(pb + PH_E)) { if ((DBL_MASK >> PH_E) & 1u) phase_ln_router(F, l, true); phase_ln_router(F, l); SEAM(pb + PH_E); } \
        if (IN(pb + PH_F)) { \
            if (!NAIVE(PH_F)) { ProbMoeGU P{DM, DM, DM, F.G, (int)blockIdx.x, l, F.ws + WS_H8, F.ws + WS_WGU + l * WGU_L, F.ws, F.ctl, F.lds, SC_H, SC_W}; P.fill_idx(F.tid); pg8::gemm_phase(F.lds, P); if ((DBL_MASK >> PH_F) & 1u) pg8::gemm_phase(F.lds, P); } \
            SEAM(pb + PH_F); } \
        if (IN(pb + PH_G)) { \
            if (!NAIVE(PH_G)) { ProbMoeDown P{FF, FF, FF, F.G, (int)blockIdx.x, l, F.ws + WS_ACT, F.ws + WS_WD + l * WD_L, F.ws, F.ctl, SC_ACT, SC_W}; pg8::gemm_phase(F.lds, P); if ((DBL_MASK >> PH_G) & 1u) pg8::gemm_phase(F.lds, P); } \
            SEAM(pb + PH_G); } \
        if (IN(pb + PH_H)) { if ((DBL_MASK >> PH_H) & 1u) phase_ln_final(F, l, true); phase_ln_final(F, l); SEAM(pb + PH_H); } \
    } while (0)
    LAYER_PHASES(0, 1);
    LAYER_PHASES(1, 9);
#undef LAYER_PHASES
#undef IN
#undef SEAM
#undef NAIVE
}

static void launch_naive(int type, int layer, const Args& a, hipStream_t stream) {
    switch (type) {
    case PH_A: hipLaunchKernelGGL(naive_inproj, dim3(INP_N / 256, MROWS / 4), dim3(256), 0, stream, a, layer); break;
    case PH_B: { const int nq = NTOK; hipLaunchKernelGGL(naive_attn, dim3((16 * nq + 3) / 4), dim3(256), 0, stream, a, nq); } break;
    case PH_C: hipLaunchKernelGGL(naive_branch, dim3(DM / 256, MROWS / 4), dim3(256), 0, stream, a, layer); break;
    case PH_D: hipLaunchKernelGGL(naive_outproj, dim3(DM / 256, MROWS / 4), dim3(256), 0, stream, a, layer); break;
    case PH_F: hipLaunchKernelGGL(naive_moe_gu, dim3(FF / 256, NSLOT_MAX / 4), dim3(256), 0, stream, a, layer); break;
    case PH_G: hipLaunchKernelGGL(naive_moe_down, dim3(DM / 256, NSLOT_MAX / 4), dim3(256), 0, stream, a, layer); break;
    default: break;
    }
}
extern "C" void kernel_launch(void* const* d_in, const int* in_sizes, int n_in, void* d_out, int out_size, void* d_ws, size_t ws_size, hipStream_t stream) {
    static int grid = 0;
    if (grid == 0) {
        if (n_in != 18 || out_size != SEQ * DM || ws_size < WS_END) { fprintf(stderr, "kernel_launch: unexpected shapes (n_in %d out %d ws %zu)\n", n_in, out_size, ws_size); grid = -1; return; }
        int dev = 0, cus = 0;
        if (hipGetDevice(&dev) != hipSuccess || hipDeviceGetAttribute(&cus, hipDeviceAttributeMultiprocessorCount, dev) != hipSuccess) { grid = -1; return; }
        if (hipFuncSetAttribute((const void*)mk_fwd, hipFuncAttributeMaxDynamicSharedMemorySize, LDS_BYTES) != hipSuccess) { fprintf(stderr, "kernel_launch: hipFuncSetAttribute failed\n"); grid = -1; return; }
        int per_cu = 0;
        if (hipOccupancyMaxActiveBlocksPerMultiprocessor(&per_cu, (const void*)mk_fwd, NTHREADS, LDS_BYTES) != hipSuccess || per_cu < 1) fprintf(stderr, "kernel_launch: occupancy query says %d\n", per_cu);
        (void)hipGetLastError();
        grid = cus;
    }
    if (grid < 0) return;
    (void)hipMemsetAsync((char*)d_ws + WS_CTL, 0, CTL_ZERO_BYTES, stream);
    Args a{};
    for (int i = 0; i < 18; ++i) a.in[i] = (const float*)d_in[i];
    a.out = (float*)d_out; a.ws = (unsigned char*)d_ws; a.naive = NAIVE_MASK;
    int li = 0, lo = 0;
    auto flush = [&](int hi) { if (hi > lo) { a.ph_lo = lo; a.ph_hi = hi; a.li = li++; hipLaunchKernelGGL(mk_fwd, dim3(grid), dim3(NTHREADS), LDS_BYTES, stream, a); } lo = hi; };
    for (int ph = 1; ph < NPHASE; ++ph) {
        const int type = (ph - 1) & 7, layer = (ph - 1) >> 3;
        if ((NAIVE_MASK >> type) & 1u) {
            if (type == PH_A) flush(ph + 1); else { flush(ph); lo = ph + 1; }
            launch_naive(type, layer, a, stream); }
    }
    flush(NPHASE);
}
```

```cpp
#include <hip/hip_runtime.h>
#include <cstdio>
#include <cstdint>

#define GAS __attribute__((address_space(1)))
#define LAS __attribute__((address_space(3)))
typedef unsigned short bf16;
typedef float f32x4 __attribute__((ext_vector_type(4)));
typedef float f32x2 __attribute__((ext_vector_type(2)));
typedef unsigned u32x4 __attribute__((ext_vector_type(4)));
typedef unsigned u32x2 __attribute__((ext_vector_type(2)));
typedef GAS unsigned gu32;

constexpr int DM = 2048, SEQ = 8192, NMETA = 16, NTOK = SEQ + NMETA, MROWS = 8448;
constexpr int HD = 128, NHEAD = 8;
constexpr int QKV_N = 6144, G_N = 4096, INP_N = 10240, INP_SRC = 10248, FCOL = 6144;
constexpr int NE = 16, FF = 1024, NSLOT_MAX = 20480;
constexpr float ALPHA = 1.4142135623730951f, LN_EPS = 1e-5f;
constexpr float LOG2E = 1.4426950408889634f;
constexpr float QSCALE = 0.08838834764831845f * 1.4426950408889634f;
constexpr int NLAYER = 2, NPHASE = 1 + 8 * NLAYER;
enum { PH_A = 0, PH_B = 1, PH_C = 2, PH_D = 3, PH_E = 4, PH_F = 5, PH_G = 6, PH_H = 7 };

#ifndef NAIVE_MASK
#define NAIVE_MASK 0x00u
#endif
#ifndef DBL_MASK
#define DBL_MASK 0u
#endif
constexpr size_t MiB = 1u << 20;
constexpr size_t WS_CTL = 0, CTL_ZERO_BYTES = 1 * MiB;
constexpr size_t WS_WIN = 2 * MiB, WIN_L = 40 * MiB;
constexpr size_t WS_WB = 82 * MiB, WB_L = 8 * MiB;
constexpr size_t WS_WOUT = 98 * MiB, WOUT_L = 8 * MiB;
constexpr size_t WS_WGU = 114 * MiB, WGU_L = 128 * MiB, WGU_E = 8 * MiB;
constexpr size_t WS_WD = 370 * MiB, WD_L = 64 * MiB, WD_E = 4 * MiB;
constexpr size_t WS_HF = 498 * MiB;
constexpr size_t WS_HB = 564 * MiB;
constexpr size_t WS_RB = 597 * MiB;
constexpr size_t WS_QKV = 663 * MiB;
constexpr size_t WS_GB = 762 * MiB;
constexpr size_t WS_YB = 828 * MiB;
constexpr size_t WS_MG = 861 * MiB;
constexpr size_t WS_ACT = 663 * MiB;
constexpr size_t WS_OSL = 703 * MiB;
constexpr size_t WS_LOGF = 894 * MiB;
constexpr size_t WS_CUM = 895 * MiB;
constexpr size_t WS_ELIST = 896 * MiB;
constexpr size_t WS_TOKI = 897 * MiB;
constexpr size_t WS_H8 = 898 * MiB;
constexpr size_t WS_END = 916 * MiB;
constexpr int CW_CNT = 1024;
constexpr int CW_KMAX = 4096;
constexpr int CW_BAR = 8192;
#define XCD_BAR_WORDS 3456
constexpr int MAX_LAUNCH = 20;
static_assert((CW_BAR + MAX_LAUNCH * XCD_BAR_WORDS) * 4 <= (int)CTL_ZERO_BYTES, "ctl");

constexpr int NWAVES = 8, NTHREADS = 512;
constexpr int RING_BYTES = 131072, MISC_OFF = RING_BYTES + 320, LDS_BYTES = 147456;

constexpr float W8_SCALE = 64.f, H8_SCALE = 4.f, MG8_SCALE = 16.f, ACT8_SCALE = 4.f;
constexpr int SC_W = 0x79797979, SC_H = 0x7D7D7D7D, SC_MG = 0x7B7B7B7B, SC_ACT = 0x7D7D7D7D;
__device__ __forceinline__ unsigned f2bf(float f) { unsigned u = __builtin_bit_cast(unsigned, f); return (u + 0x7fffu + ((u >> 16) & 1u)) >> 16; }
__device__ __forceinline__ unsigned pk2(float lo, float hi) { return f2bf(lo) | (f2bf(hi) << 16); }
__device__ __forceinline__ unsigned pk4_fp8(float a, float b, float c, float d) {
    a = __builtin_amdgcn_fmed3f(a, -448.f, 448.f); b = __builtin_amdgcn_fmed3f(b, -448.f, 448.f); c = __builtin_amdgcn_fmed3f(c, -448.f, 448.f); d = __builtin_amdgcn_fmed3f(d, -448.f, 448.f);
    int w = 0; w = __builtin_amdgcn_cvt_pk_fp8_f32(a, b, w, false); w = __builtin_amdgcn_cvt_pk_fp8_f32(c, d, w, true); return (unsigned)w; }
__device__ __forceinline__ float bflo(unsigned w) { return __builtin_bit_cast(float, w << 16); }
__device__ __forceinline__ float bfhi(unsigned w) { return __builtin_bit_cast(float, w & 0xffff0000u); }
__device__ __forceinline__ float bf2f(bf16 b) { return __builtin_bit_cast(float, ((unsigned)b) << 16); }
__device__ __forceinline__ float wave_sum(float v) {
#pragma unroll
    for (int o = 1; o < 64; o <<= 1) v += __shfl_xor(v, o);
    return v;
}
__device__ __forceinline__ float wave_max(float v) {
#pragma unroll
    for (int o = 1; o < 64; o <<= 1) v = fmaxf(v, __shfl_xor(v, o));
    return v;
}
__device__ __forceinline__ int row_of_p(int p) { return p < NMETA ? SEQ + p : p - NMETA; }
__device__ __forceinline__ float sigmoidf_(float x) { return 1.0f / (1.0f + __expf(-x)); }
__device__ __forceinline__ float dot8(u32x4 a, u32x4 b, float acc) {
    acc = fmaf(bflo(a.x), bflo(b.x), acc); acc = fmaf(bfhi(a.x), bfhi(b.x), acc);
    acc = fmaf(bflo(a.y), bflo(b.y), acc); acc = fmaf(bfhi(a.y), bfhi(b.y), acc);
    acc = fmaf(bflo(a.z), bflo(b.z), acc); acc = fmaf(bfhi(a.z), bfhi(b.z), acc);
    acc = fmaf(bflo(a.w), bflo(b.w), acc); acc = fmaf(bfhi(a.w), bfhi(b.w), acc);
    return acc;
}

struct Args { const float* in[18]; float* out; unsigned char* ws; int ph_lo, ph_hi; unsigned naive; int li; };
enum { I_X = 0, I_META, I_LNIN_G, I_LNIN_B, I_WIN, I_BF, I_WBSB, I_WBFX, I_WOUT, I_LNMIX_G, I_LNMIX_B, I_WR, I_RB, I_WG, I_WU, I_WD, I_LNFFN_G, I_LNFFN_B };

__device__ __forceinline__ int moe_cnt(const unsigned* ctl, int layer, int e) { return (int)ctl[CW_CNT + (layer * NE + e) * 64]; }
__device__ __forceinline__ bool moe_find(const unsigned* ctl, int layer, int s0, int& e_out, int& cnt_out, int& ps_out) {
    int acc = 0; e_out = -1; cnt_out = 0; ps_out = 0;
#pragma unroll
    for (int e = 0; e < NE; ++e) { const int c = moe_cnt(ctl, layer, e), nb = (c + 255) >> 8;
        if (e_out < 0 && s0 < (acc + nb) * 256) { e_out = e; cnt_out = c; ps_out = acc * 256; }
        acc += nb; }
    return e_out >= 0;
}
__device__ __forceinline__ int moe_nb(const unsigned* ctl, int layer) { int acc = 0;
#pragma unroll
    for (int e = 0; e < NE; ++e) acc += (moe_cnt(ctl, layer, e) + 255) >> 8;
    return acc; }
__device__ __forceinline__ int moe_pstart(const unsigned* ctl, int layer, int ex) {
    int acc = 0, r = 0;
#pragma unroll
    for (int e = 0; e < NE; ++e) { const int c = moe_cnt(ctl, layer, e); if (e == ex) r = acc * 256; acc += (c + 255) >> 8; }
    return r;
}

__device__ __forceinline__ void inproj_store(unsigned char* ws, int row, int n, float v, unsigned* kmax = nullptr) {
    if (kmax && n >= 4096 && n < 5120) atomicMax(kmax + ((n - 4096) >> 7) * 64, __builtin_bit_cast(unsigned, __builtin_fabsf(v)));
    if (n < QKV_N) { const bool isq = (n < 1024) || (n >= 3072 && n < 4096); ((bf16*)(ws + WS_QKV))[(size_t)row * QKV_N + n] = (bf16)f2bf(isq ? v * QSCALE : v); }
    else ((bf16*)(ws + WS_GB))[(size_t)row * G_N + (n - QKV_N)] = (bf16)f2bf(sigmoidf_(v));
}

__device__ __forceinline__ void dot4(const bf16* a0, const bf16* a1, const bf16* a2, const bf16* a3, const bf16* b, int K, float (&acc)[4]) {
    for (int k = 0; k < K; k += 8) {
        const u32x4 bv = *(const u32x4*)(b + k);
        acc[0] = dot8(*(const u32x4*)(a0 + k), bv, acc[0]); acc[1] = dot8(*(const u32x4*)(a1 + k), bv, acc[1]);
        acc[2] = dot8(*(const u32x4*)(a2 + k), bv, acc[2]); acc[3] = dot8(*(const u32x4*)(a3 + k), bv, acc[3]);
    }
}
__global__ void __launch_bounds__(256) naive_inproj(Args a, int layer) {
    const int n = blockIdx.x * 256 + threadIdx.x, r0 = blockIdx.y * 4;
    const bf16* A = (const bf16*)(a.ws + WS_HB) + (size_t)r0 * DM; const bf16* B = (const bf16*)(a.ws + WS_WIN + layer * WIN_L) + (size_t)n * DM;
    float acc[4] = {0.f, 0.f, 0.f, 0.f};
    dot4(A, A + DM, A + 2 * DM, A + 3 * DM, B, DM, acc);
    for (int i = 0; i < 4; ++i) inproj_store(a.ws, r0 + i, n, acc[i]);
}
__global__ void __launch_bounds__(256) naive_branch(Args a, int layer) {
    const int n = blockIdx.x * 256 + threadIdx.x, r0 = blockIdx.y * 4;
    const bf16* A = (const bf16*)(a.ws + WS_YB) + (size_t)r0 * DM; const bf16* B = (const bf16*)(a.ws + WS_WB + layer * WB_L) + (size_t)n * DM;
    float s[4] = {0.f, 0.f, 0.f, 0.f}, f[4] = {0.f, 0.f, 0.f, 0.f};
    dot4(A, A + DM, A + 2 * DM, A + 3 * DM, B, 1024, s);
    dot4(A + 1024, A + DM + 1024, A + 2 * DM + 1024, A + 3 * DM + 1024, B + 1024, 1024, f);
    const bf16* G = (const bf16*)(a.ws + WS_GB);
    for (int i = 0; i < 4; ++i) { const size_t r = r0 + i; const float gs = bf2f(G[r * G_N + n]), gf = bf2f(G[r * G_N + DM + n]);
        ((bf16*)(a.ws + WS_MG))[r * DM + n] = (bf16)f2bf(gs * s[i] + gf * f[i]); }
}
__global__ void __launch_bounds__(256) naive_outproj(Args a, int layer) {
    const int n = blockIdx.x * 256 + threadIdx.x, r0 = blockIdx.y * 4;
    const bf16* A = (const bf16*)(a.ws + WS_MG) + (size_t)r0 * DM; const bf16* B = (const bf16*)(a.ws + WS_WOUT + layer * WOUT_L) + (size_t)n * DM;
    float acc[4] = {0.f, 0.f, 0.f, 0.f};
    dot4(A, A + DM, A + 2 * DM, A + 3 * DM, B, DM, acc);
    const float* HF = (const float*)(a.ws + WS_HF); float* R = (float*)(a.ws + WS_RB);
    for (int i = 0; i < 4; ++i) { const size_t o = (size_t)(r0 + i) * DM + n; R[o] = ALPHA * HF[o] + acc[i]; }
}
__global__ void __launch_bounds__(256) naive_moe_gu(Args a, int layer) {
    const int j = blockIdx.x * 256 + threadIdx.x, s0 = blockIdx.y * 4;
    int e, cnt, ps; if (!moe_find((const unsigned*)(a.ws + WS_CTL), layer, s0, e, cnt, ps)) return;
    const int* elist = (const int*)(a.ws + WS_ELIST) + (size_t)e * MROWS;
    const bf16* HB = (const bf16*)(a.ws + WS_HB);
    const int rank = s0 - ps;
    const bf16* ap0 = HB + (size_t)(rank + 0 < cnt ? elist[rank + 0] : 0) * DM; const bf16* ap1 = HB + (size_t)(rank + 1 < cnt ? elist[rank + 1] : 0) * DM;
    const bf16* ap2 = HB + (size_t)(rank + 2 < cnt ? elist[rank + 2] : 0) * DM; const bf16* ap3 = HB + (size_t)(rank + 3 < cnt ? elist[rank + 3] : 0) * DM;
    const bf16* W = (const bf16*)(a.ws + WS_WGU + layer * WGU_L + e * WGU_E);
    const int rg = 256 * (j >> 7) + (j & 127);
    float g[4] = {0.f, 0.f, 0.f, 0.f}, u[4] = {0.f, 0.f, 0.f, 0.f};
    dot4(ap0, ap1, ap2, ap3, W + (size_t)rg * DM, DM, g);
    dot4(ap0, ap1, ap2, ap3, W + (size_t)(rg + 128) * DM, DM, u);
    bf16* act = (bf16*)(a.ws + WS_ACT);
#pragma unroll
    for (int i = 0; i < 4; ++i) act[(size_t)(s0 + i) * FF + j] = (bf16)f2bf(g[i] * sigmoidf_(g[i]) * u[i]);
}
__global__ void __launch_bounds__(256) naive_moe_down(Args a, int layer) {
    const int n = blockIdx.x * 256 + threadIdx.x, s0 = blockIdx.y * 4;
    int e, cnt, ps; if (!moe_find((const unsigned*)(a.ws + WS_CTL), layer, s0, e, cnt, ps)) return;
    const bf16* A = (const bf16*)(a.ws + WS_ACT) + (size_t)s0 * FF; const bf16* B = (const bf16*)(a.ws + WS_WD + layer * WD_L + e * WD_E) + (size_t)n * FF;
    float acc[4] = {0.f, 0.f, 0.f, 0.f};
    dot4(A, A + FF, A + 2 * FF, A + 3 * FF, B, FF, acc);
    bf16* O = (bf16*)(a.ws + WS_OSL);
#pragma unroll
    for (int i = 0; i < 4; ++i) O[(size_t)(s0 + i) * DM + n] = (bf16)f2bf(acc[i]);
}
__global__ void __launch_bounds__(256) naive_attn(Args a, int nq) {
    const int lane = threadIdx.x & 63, widx = blockIdx.x * 4 + (threadIdx.x >> 6);
    const int th = widx / nq, pq = nq - 1 - (widx % nq);
    if (th >= 16) return;
    const int type = th >> 3, head = th & 7;
    const bf16* QKV = (const bf16*)(a.ws + WS_QKV);
    const int qcol = (type ? 3072 : 0) + head * HD, kcol = qcol + 1024, vcol = qcol + 2048;
    const int rowq = row_of_p(pq);
    u32x4 q[16];
#pragma unroll
    for (int i = 0; i < 16; ++i) q[i] = *(const u32x4*)(QKV + (size_t)rowq * QKV_N + qcol + 8 * i);
    const float* cum = (const float*)(a.ws + WS_CUM) + (size_t)head * MROWS;
    float o0 = 0.f, o1 = 0.f, carry = 0.f, m = -1e30f, l = 0.f;
    const float cq = type ? cum[pq] : 0.f;
    for (int phi = type ? pq : pq - 1; phi >= 0; phi -= 64) {
        const int p = phi - lane; const bool valid = p >= 0; const int pr = row_of_p(valid ? p : 0);
        float u = 0.f;
        const bf16* kp = QKV + (size_t)pr * QKV_N + kcol;
#pragma unroll
        for (int i = 0; i < 16; ++i) u = dot8(q[i], *(const u32x4*)(kp + 8 * i), u);
        float w;
        if (type == 0) {
            const float aa = exp2f(-fabsf(u)), b = log2f(1.0f + aa);
            float lk = fminf(-u, 0.f) - b; const float lb = lk + u;
            if (!valid) lk = 0.f;
            float inc = lk;
#pragma unroll
            for (int off = 1; off < 64; off <<= 1) { const float t = __shfl_up(inc, off); if (lane >= off) inc += t; }
            const float after = carry + inc - lk;
            w = valid ? exp2f(lb + after) : 0.f;
            carry += __shfl(inc, 63);
        } else {
            const float s = valid ? u + cq - cum[valid ? p : 0] : -__builtin_inff();
            const float cm = wave_max(s), mn = fmaxf(m, cm), alpha = exp2f(m - mn);
            w = valid ? exp2f(s - mn) : 0.f;
            l = l * alpha + wave_sum(w); o0 *= alpha; o1 *= alpha; m = mn;
        }
        for (int j = 0; j < 64; ++j) {
            const float wj = __shfl(w, j); const int prj = __shfl(pr, j);
            const unsigned vv = *(const unsigned*)(QKV + (size_t)prj * QKV_N + vcol + 2 * lane);
            o0 = fmaf(wj, bflo(vv), o0); o1 = fmaf(wj, bfhi(vv), o1);
        }
    }
    if (type) { const float rl = 1.0f / l; o0 *= rl; o1 *= rl; }
    *(unsigned*)((bf16*)(a.ws + WS_YB) + (size_t)rowq * DM + type * 1024 + head * HD + 2 * lane) = pk2(o0, o1);
}

#define XB_TMO      128
#define XB_XCNT(j)  (256  + 64 * (j))
#define XB_XSUB(j)  (1280 + 64 * (j))
#define XB_XGEN(j)  (2304 + 64 * (j))
#define XB_TOP      3328
#define XB_TOPGEN   3392
#define XB_SPIN_CAP (1u << 18)
__device__ __forceinline__ unsigned xb_ld(unsigned* p)              { return __hip_atomic_load(p, __ATOMIC_RELAXED, __HIP_MEMORY_SCOPE_AGENT); }
__device__ __forceinline__ unsigned xb_add(unsigned* p, unsigned v) { return __hip_atomic_fetch_add(p, v, __ATOMIC_RELAXED, __HIP_MEMORY_SCOPE_AGENT); }
__device__ __forceinline__ unsigned xb_xcc_id() { return (unsigned)__builtin_amdgcn_s_getreg((3 << 11) | 20) & 0xFu; }
#define XB_SPIN(cond, bar) do { unsigned _sp = 0; while (cond) { __builtin_amdgcn_s_sleep(1); \
    if ((++_sp & 255u) == 0u) { if (xb_ld(&(bar)[XB_TMO])) break; if (_sp > XB_SPIN_CAP) { atomicAdd(&(bar)[XB_TMO], 1u); break; } } } } while (0)
struct XcdBarrier { unsigned* bar; unsigned x; volatile LAS unsigned* st; };
__device__ __forceinline__ XcdBarrier xcd_barrier_post(unsigned* bar, volatile LAS unsigned* st) {
    XcdBarrier b; b.bar = bar; b.x = xb_xcc_id(); b.st = st;
    if (threadIdx.x == 0) (void)xb_add(&bar[XB_XCNT(b.x)], 1u);
    return b;
}
__device__ __forceinline__ void xcd_barrier_complete(unsigned* bar, unsigned x, unsigned& nloc, unsigned& nx) {
    const unsigned G = gridDim.x * gridDim.y * gridDim.z;
    unsigned sum, cnt, mine, sp = 0u;
    for (;;) {
        sum = 0u; cnt = 0u; mine = 0u;
#pragma unroll
        for (unsigned j = 0; j < 16; ++j) { const unsigned c = xb_ld(&bar[XB_XCNT(j)]); sum += c; cnt += (c > 0u) ? 1u : 0u; mine = (j == x) ? c : mine; }
        if (sum == G) break;
        __builtin_amdgcn_s_sleep(1);
        if ((++sp & 255u) == 0u) { if (xb_ld(&bar[XB_TMO])) break; if (sp > XB_SPIN_CAP) { atomicAdd(&bar[XB_TMO], 1u); break; } }
    }
    nloc = mine > 0u ? mine : 1u; nx = cnt > 0u ? cnt : 1u;
}
__device__ __forceinline__ void xcd_barrier(const XcdBarrier& b) {
    asm volatile("s_waitcnt vmcnt(0)" ::: "memory");
    __syncthreads();
    if (threadIdx.x == 0) {
        unsigned* bar = b.bar;
        __builtin_amdgcn_s_waitcnt(0);
        unsigned nloc = b.st[0], nx = b.st[1];
        if (nloc == 0u) { xcd_barrier_complete(bar, b.x, nloc, nx); b.st[0] = nloc; b.st[1] = nx; }
        const unsigned old = xb_add(&bar[XB_XSUB(b.x)], 1u);
        const unsigned gen = old / nloc;
        if (old + 1u == (gen + 1u) * nloc) {
            __builtin_amdgcn_fence(__ATOMIC_RELEASE, "agent");
            asm volatile("s_waitcnt vmcnt(0)" ::: "memory");
            const unsigned og = xb_add(&bar[XB_TOP], 1u);
            const unsigned tg = og / nx;
            if (og + 1u == (tg + 1u) * nx) xb_add(&bar[XB_TOPGEN], 1u);
            else XB_SPIN(xb_ld(&bar[XB_TOPGEN]) == tg, bar);
            __builtin_amdgcn_fence(__ATOMIC_ACQUIRE, "agent");
            xb_add(&bar[XB_XGEN(b.x)], 1u);
            asm volatile("s_waitcnt vmcnt(0)" ::: "memory");
        } else {
            XB_SPIN(xb_ld(&bar[XB_XGEN(b.x)]) == gen, bar);
            __builtin_amdgcn_fence(__ATOMIC_ACQUIRE, "agent");
            asm volatile("s_waitcnt vmcnt(0)" ::: "memory");
        }
    }
    __syncthreads();
}

struct Frame {
    LAS unsigned char* lds; unsigned char* ws; unsigned* ctl;
    int tid, lane, wave, G, gw, NGW;
    const float* const* in; float* out;
};
#define LDS_WAIT() asm volatile("s_waitcnt lgkmcnt(0)" ::: "memory")

__device__ __forceinline__ void transpose_item(const float* W, size_t ldw, bf16* WT, size_t ldt, LAS float* scr, int lane) {
#pragma unroll 8
    for (int i = 0; i < 32; ++i) { const int kk = 2 * i + (lane >> 5); scr[kk * 33 + (lane & 31)] = W[(size_t)kk * ldw + (lane & 31)]; }
    LDS_WAIT(); asm volatile("" ::: "memory");
    const int c = lane & 7;
#pragma unroll
    for (int j = 0; j < 4; ++j) { const int n = (lane >> 3) + 8 * j; const LAS float* s = scr + (8 * c) * 33 + n;
        u32x4 o; o.x = pk2(s[0 * 33], s[1 * 33]); o.y = pk2(s[2 * 33], s[3 * 33]); o.z = pk2(s[4 * 33], s[5 * 33]); o.w = pk2(s[6 * 33], s[7 * 33]);
        *(u32x4*)(WT + (size_t)n * ldt + 8 * c) = o; }
    LDS_WAIT(); asm volatile("" ::: "memory");
}
__device__ __forceinline__ void transpose_item8(const float* W, size_t ldw, unsigned char* WT, size_t ldt, LAS float* scr, int lane) {
#pragma unroll 8
    for (int i = 0; i < 32; ++i) { const int kk = 2 * i + (lane >> 5); scr[kk * 33 + (lane & 31)] = W[(size_t)kk * ldw + (lane & 31)]; }
    LDS_WAIT(); asm volatile("" ::: "memory");
    const int c = lane & 3;
#pragma unroll
    for (int j = 0; j < 2; ++j) { const int n = (lane >> 2) + 16 * j; const LAS float* p = scr + (16 * c) * 33 + n;
        u32x4 o;
        o.x = pk4_fp8(p[0 * 33] * W8_SCALE, p[1 * 33] * W8_SCALE, p[2 * 33] * W8_SCALE, p[3 * 33] * W8_SCALE); o.y = pk4_fp8(p[4 * 33] * W8_SCALE, p[5 * 33] * W8_SCALE, p[6 * 33] * W8_SCALE, p[7 * 33] * W8_SCALE);
        o.z = pk4_fp8(p[8 * 33] * W8_SCALE, p[9 * 33] * W8_SCALE, p[10 * 33] * W8_SCALE, p[11 * 33] * W8_SCALE); o.w = pk4_fp8(p[12 * 33] * W8_SCALE, p[13 * 33] * W8_SCALE, p[14 * 33] * W8_SCALE, p[15 * 33] * W8_SCALE);
        *(u32x4*)(WT + (size_t)n * ldt + 16 * c) = o; }
    LDS_WAIT(); asm volatile("" ::: "memory");
}
__device__ __forceinline__ void convert_item(Frame& F, int it, LAS float* scr) {
    constexpr int I_IN = 32 * 320, I_BS = 16 * 64, I_OUT = 32 * 64, I_GE = 32 * 32, I_DE = 16 * 64;
    constexpr int PER_LAYER = I_IN + 2 * I_BS + I_OUT + NE * (2 * I_GE + I_DE);
    const int l = it / PER_LAYER; int r = it % PER_LAYER;
    if (r < I_IN) { const int kb = r / 320, nb = r % 320, nd = 32 * nb, ns = nd + (nd >= FCOL ? 8 : 0);
        transpose_item8(F.in[I_WIN] + (size_t)l * DM * INP_SRC + (size_t)(64 * kb) * INP_SRC + ns, INP_SRC, F.ws + WS_WIN + l * WIN_L + (size_t)nd * DM + 64 * kb, DM, scr, F.lane); return; }
    r -= I_IN;
    if (r < 2 * I_BS) { const int which = r / I_BS; r %= I_BS; const int kb = r / 64, nb = r % 64;
        transpose_item((which ? F.in[I_WBFX] : F.in[I_WBSB]) + (size_t)l * 1024 * DM + (size_t)(64 * kb) * DM + 32 * nb, DM, (bf16*)(F.ws + WS_WB + l * WB_L) + (size_t)(32 * nb) * DM + which * 1024 + 64 * kb, DM, scr, F.lane); return; }
    r -= 2 * I_BS;
    if (r < I_OUT) { const int kb = r / 64, nb = r % 64;
        transpose_item8(F.in[I_WOUT] + (size_t)l * DM * DM + (size_t)(64 * kb) * DM + 32 * nb, DM, F.ws + WS_WOUT + l * WOUT_L + (size_t)(32 * nb) * DM + 64 * kb, DM, scr, F.lane); return; }
    r -= I_OUT;
    const int e = r / (2 * I_GE + I_DE); r %= (2 * I_GE + I_DE);
    if (r < 2 * I_GE) { const int which = r / I_GE; r %= I_GE; const int kb = r / 32, nb = r % 32, n0 = 32 * nb, rho = 256 * (n0 >> 7) + (n0 & 127) + which * 128;
        transpose_item8((which ? F.in[I_WU] : F.in[I_WG]) + ((size_t)(l * NE + e) * DM + 64 * kb) * FF + n0, FF, F.ws + WS_WGU + l * WGU_L + e * WGU_E + (size_t)rho * DM + 64 * kb, DM, scr, F.lane); return; }
    r -= 2 * I_GE;
    { const int kb = r / 64, nb = r % 64;
        transpose_item8(F.in[I_WD] + ((size_t)(l * NE + e) * FF + 64 * kb) * DM + 32 * nb, DM, F.ws + WS_WD + l * WD_L + e * WD_E + (size_t)(32 * nb) * FF + 64 * kb, FF, scr, F.lane); }
}
constexpr int N_CONVERT_ITEMS = NLAYER * (32 * 320 + 2 * 16 * 64 + 32 * 64 + NE * (2 * 32 * 32 + 16 * 64));
constexpr int CV_PER_LAYER = N_CONVERT_ITEMS / NLAYER, CV_G0_END = 32 * 320, CV_G1_END = CV_PER_LAYER + 32 * 320, CV_BUNDLE = 128;
static_assert((CV_G1_END - CV_G0_END) % CV_BUNDLE == 0 && (N_CONVERT_ITEMS - CV_G1_END) % CV_BUNDLE == 0, "bundles");
__device__ __forceinline__ void convert_bundle(Frame& F, int first_item) {
    LAS float* scr = (LAS float*)(F.lds + F.wave * 16384);
    for (int i = 0; i < CV_BUNDLE / NWAVES; ++i) convert_item(F, first_item + F.wave + NWAVES * i, scr);
}

__device__ __forceinline__ int tab_rowpos(int c) { return (c & 3) * 512 + (c >> 8) * 64 + ((c >> 2) & 63); }
template <int NC> __device__ __forceinline__ void stage_table(Frame& F, const float* src, size_t pitch) {
    constexpr int CH = NC / 4;
    for (int ci = F.tid; ci < DM * CH; ci += NTHREADS) { const int c = ci / CH, q = ci % CH;
        const f32x4 v = *(const f32x4*)(src + (size_t)c * pitch + 4 * q);
        const int sw = (NC == 16) ? ((c >> 4) & 3) : ((c >> 5) & 1);
        *(LAS f32x4*)(F.lds + tab_rowpos(c) * (NC * 4) + ((q ^ sw) << 4)) = v; }
    LDS_WAIT(); __syncthreads();
}
template <int NC> __device__ __forceinline__ void table_dot(Frame& F, const f32x4 (&y)[8], float (&acc)[NC]) {
    constexpr int CH = NC / 4; const int l = F.lane; const int sw = (NC == 16) ? ((l >> 2) & 3) : ((l >> 3) & 1);
#pragma unroll
    for (int e = 0; e < NC; ++e) acc[e] = 0.f;
#pragma unroll
    for (int j = 0; j < 8; ++j)
#pragma unroll
        for (int i = 0; i < 4; ++i) { const float yv = y[j][i]; const int rp = i * 512 + j * 64 + l; if (i == 0) asm volatile("" ::: "memory");
#pragma unroll
            for (int q = 0; q < CH; ++q) { const f32x4 w = *(const LAS f32x4*)(F.lds + rp * (NC * 4) + ((q ^ sw) << 4));
                acc[4 * q + 0] = fmaf(yv, w.x, acc[4 * q + 0]); acc[4 * q + 1] = fmaf(yv, w.y, acc[4 * q + 1]); acc[4 * q + 2] = fmaf(yv, w.z, acc[4 * q + 2]); acc[4 * q + 3] = fmaf(yv, w.w, acc[4 * q + 3]); } }
#pragma unroll
    for (int e = 0; e < NC; ++e) acc[e] = wave_sum(acc[e]);
}
__device__ __forceinline__ void ln_row(Frame& F, f32x4 (&v)[8], const float* g, const float* b) {
    float s = 0.f;
#pragma unroll
    for (int j = 0; j < 8; ++j) s += (v[j].x + v[j].y) + (v[j].z + v[j].w);
    const float mean = wave_sum(s) * (1.f / DM); float s2 = 0.f;
#pragma unroll
    for (int j = 0; j < 8; ++j) { v[j] = v[j] - mean; s2 += (v[j].x * v[j].x + v[j].y * v[j].y) + (v[j].z * v[j].z + v[j].w * v[j].w); }
    const float rstd = 1.0f / sqrtf(wave_sum(s2) * (1.f / DM) + LN_EPS);
#pragma unroll
    for (int j = 0; j < 8; ++j) { const f32x4 gv = *(const f32x4*)(g + 256 * j + 4 * F.lane), bv = *(const f32x4*)(b + 256 * j + 4 * F.lane); v[j] = v[j] * rstd * gv + bv; }
}
__device__ __forceinline__ void store_h(Frame& F, int row, const f32x4 (&y)[8], bool dry = false) {
    float* hf = (float*)(F.ws + (dry ? WS_YB : WS_HF)) + (size_t)row * DM; bf16* hb = (bf16*)(F.ws + (dry ? WS_GB + 21 * MiB : WS_HB)) + (size_t)row * DM;
    unsigned char* h8 = F.ws + (dry ? WS_GB + 21 * MiB : WS_H8) + (size_t)row * DM;
#pragma unroll
    for (int j = 0; j < 8; ++j) { *(f32x4*)(hf + 256 * j + 4 * F.lane) = y[j]; if (NAIVE_MASK != 0u) { u32x2 w; w.x = pk2(y[j].x, y[j].y); w.y = pk2(y[j].z, y[j].w); *(u32x2*)(hb + 256 * j + 4 * F.lane) = w; }
        *(unsigned*)(h8 + 256 * j + 4 * F.lane) = pk4_fp8(y[j].x * H8_SCALE, y[j].y * H8_SCALE, y[j].z * H8_SCALE, y[j].w * H8_SCALE); }
}
__device__ __forceinline__ void store_logf(Frame& F, int row, const f32x4 (&y)[8], const float* bfor) {
    float acc[8]; table_dot<8>(F, y, acc);
    if (F.lane < 8) { float a = acc[0];
#pragma unroll
        for (int h = 1; h < 8; ++h) a = (F.lane == h) ? acc[h] : a;
        const float x = a + bfor[F.lane];
        const float ls = fminf(x, 0.f) - log1pf(__expf(-fabsf(x)));
        ((float*)(F.ws + WS_LOGF))[(size_t)row * 8 + F.lane] = ls; }
}

__device__ __forceinline__ void phase_prologue(Frame& F) {
    LAS float* scr = (LAS float*)(F.lds + F.wave * 16384);
    for (int it = F.gw; it < CV_G0_END; it += F.NGW) convert_item(F, it, scr);
    __syncthreads();
    stage_table<8>(F, F.in[I_WIN] + FCOL, INP_SRC);
    for (int row = F.gw; row < NTOK; row += F.NGW) {
        const float* src = row < SEQ ? F.in[I_X] + (size_t)row * DM : F.in[I_META] + (size_t)(row - SEQ) * DM;
        f32x4 v[8];
#pragma unroll
        for (int j = 0; j < 8; ++j) v[j] = *(const f32x4*)(src + 256 * j + 4 * F.lane);
        ln_row(F, v, F.in[I_LNIN_G], F.in[I_LNIN_B]);
        store_h(F, row, v);
        store_logf(F, row, v, F.in[I_BF]);
    }
    for (int row = NTOK + F.gw; row < MROWS; row += F.NGW) { bf16* hb = (bf16*)(F.ws + WS_HB) + (size_t)row * DM;
#pragma unroll
        for (int j = 0; j < 4; ++j) *(u32x4*)(hb + 512 * j + 8 * F.lane) = (u32x4){0u, 0u, 0u, 0u}; }
    __syncthreads();
}
__device__ __forceinline__ void phase_tilesuf(Frame& F) {
    if (blockIdx.x > SEQ / 64) return;
    const int tile = blockIdx.x, h = F.wave, row = tile * 64 + F.lane;
    const float v = (row < NTOK) ? LOG2E * ((const float*)(F.ws + WS_LOGF))[(size_t)row * 8 + h] : 0.f;
    float inc = v;
#pragma unroll
    for (int off = 1; off < 64; off <<= 1) { const float t = __shfl_down(inc, off); if (F.lane + off < 64) inc += t; }
    float* base = (float*)(F.ws + WS_CUM);
    base[(size_t)h * MROWS + row] = inc - v;
    if (F.lane == 0) base[(size_t)NHEAD * MROWS + h * 256 + tile] = inc;
}
__device__ __forceinline__ void phase_cumsum(Frame& F, bool do_scan) {
    if (blockIdx.x >= NHEAD) {
        if (blockIdx.x < NHEAD + 48) { bf16* q = (bf16*)(F.ws + WS_QKV) + (size_t)(NTOK + blockIdx.x - NHEAD) * QKV_N;
            for (int i = F.tid; i < QKV_N / 8; i += NTHREADS) *(u32x4*)(q + 8 * i) = (u32x4){0u, 0u, 0u, 0u}; }
        return; }
    if (!do_scan) return;
    const int h = blockIdx.x; const float* logf = (const float*)(F.ws + WS_LOGF); float* cum = (float*)(F.ws + WS_CUM) + (size_t)h * MROWS;
    constexpr int PER = 17; const int p0 = F.tid * PER;
    float loc[PER]; float s = 0.f;
#pragma unroll
    for (int i = 0; i < PER; ++i) { const int p = p0 + i; const float v = p < NTOK ? logf[(size_t)row_of_p(p) * 8 + h] : 0.f; s += v; loc[i] = s; }
    float inc = s;
#pragma unroll
    for (int off = 1; off < 64; off <<= 1) { const float t = __shfl_up(inc, off); if (F.lane >= off) inc += t; }
    LAS float* wt = (LAS float*)(F.lds);
    if (F.lane == 63) wt[F.wave] = inc;
    LDS_WAIT(); __syncthreads();
    float base = inc - s;
    for (int w = 0; w < F.wave; ++w) base += wt[w];
#pragma unroll
    for (int i = 0; i < PER; ++i) { const int p = p0 + i; if (p < NTOK) cum[p] = (base + loc[i]) * LOG2E; }
    LDS_WAIT(); __syncthreads();
}
__device__ __forceinline__ void phase_ln_router(Frame& F, int layer, bool dry = false) {
    stage_table<16>(F, F.in[I_WR], 16);
    const float* g = F.in[I_LNMIX_G] + layer * DM; const float* b = F.in[I_LNMIX_B] + layer * DM;
    const float* rbias = F.in[I_RB];
    const int nrows_e = layer == NLAYER - 1 ? SEQ : NTOK;
    f32x4 vn[8];
    if (F.gw < nrows_e) { const float* src = (const float*)(F.ws + WS_RB) + (size_t)F.gw * DM;
#pragma unroll
        for (int j = 0; j < 8; ++j) vn[j] = *(const f32x4*)(src + 256 * j + 4 * F.lane); }
    for (int row = F.gw; row < nrows_e; row += F.NGW) {
        f32x4 v[8];
#pragma unroll
        for (int j = 0; j < 8; ++j) v[j] = vn[j];
        if (row + F.NGW < nrows_e) { const float* src = (const float*)(F.ws + WS_RB) + (size_t)(row + F.NGW) * DM;
#pragma unroll
            for (int j = 0; j < 8; ++j) vn[j] = *(const f32x4*)(src + 256 * j + 4 * F.lane); }
        ln_row(F, v, g, b);
        store_h(F, row, v, dry);
        float lg[16]; table_dot<16>(F, v, lg);
        float aff[16], sel[16];
#pragma unroll
        for (int e = 0; e < 16; ++e) { aff[e] = 1.0f / (1.0f + __expf(-lg[e])); sel[e] = aff[e] + rbias[e]; }
        int bg = 0; float bs = -__builtin_inff();
#pragma unroll
        for (int gi = 0; gi < 4; ++gi) { const float a0 = sel[4 * gi], a1 = sel[4 * gi + 1], a2 = sel[4 * gi + 2], a3 = sel[4 * gi + 3];
            const float h1 = fmaxf(a0, a1), l1 = fminf(a0, a1), h2 = fmaxf(a2, a3), l2 = fminf(a2, a3);
            const float top = fmaxf(h1, h2), sec = fmaxf(fminf(h1, h2), fmaxf(l1, l2)), sc = top + sec;
            if (sc > bs) { bs = sc; bg = gi; } }
        float s4[4], a4[4];
#pragma unroll
        for (int i = 0; i < 4; ++i) { s4[i] = sel[i]; a4[i] = aff[i]; }
#pragma unroll
        for (int gi = 1; gi < 4; ++gi) if (bg == gi) {
#pragma unroll
            for (int i = 0; i < 4; ++i) { s4[i] = sel[4 * gi + i]; a4[i] = aff[4 * gi + i]; } }
        int i1 = 0; float m1 = s4[0];
#pragma unroll
        for (int i = 1; i < 4; ++i) if (s4[i] > m1) { m1 = s4[i]; i1 = i; }
        int i2 = -1; float m2 = -__builtin_inff();
#pragma unroll
        for (int i = 0; i < 4; ++i) if (i != i1 && s4[i] > m2) { m2 = s4[i]; i2 = i; }
        float af1 = a4[0], af2 = a4[0];
#pragma unroll
        for (int i = 1; i < 4; ++i) { if (i1 == i) af1 = a4[i]; if (i2 == i) af2 = a4[i]; }
        const float wsum = af1 + af2, w1 = af1 / wsum, w2 = af2 / wsum;
        const int e1 = 4 * bg + i1, e2 = 4 * bg + i2;
        if (dry) { if (F.lane == 0) ((float*)(F.ws + WS_GB + 60 * MiB))[row] = w1 + w2 + (float)(e1 + e2); }
        if (F.lane == 0 && !dry) {
            const int r1 = (int)atomicAdd(F.ctl + CW_CNT + (layer * NE + e1) * 64, 1u), r2 = (int)atomicAdd(F.ctl + CW_CNT + (layer * NE + e2) * 64, 1u);
            int* el = (int*)(F.ws + WS_ELIST); el[(size_t)e1 * MROWS + r1] = row; el[(size_t)e2 * MROWS + r2] = row;
            int* ti = (int*)(F.ws + WS_TOKI) + (size_t)row * 8;
            ti[0] = e1; ti[1] = e2; ti[2] = r1; ti[3] = r2; ti[4] = __builtin_bit_cast(int, w1); ti[5] = __builtin_bit_cast(int, w2);
        }
    }
    __syncthreads();
}
__device__ __forceinline__ void phase_ln_final(Frame& F, int layer, bool dry = false) {
    const bool last = layer == NLAYER - 1;
    if (!last) stage_table<8>(F, F.in[I_WIN] + (size_t)(layer + 1) * DM * INP_SRC + FCOL, INP_SRC);
    const float* g = F.in[I_LNFFN_G] + layer * DM; const float* b = F.in[I_LNFFN_B] + layer * DM;
    const int nrows = last ? SEQ : NTOK;
    const int* TI = (const int*)(F.ws + WS_TOKI); const bf16* OSL = (const bf16*)(F.ws + WS_OSL); const float* HFp = (const float*)(F.ws + WS_HF);
    int tA[6], tB[6]; f32x4 hvn[8]; u32x2 an[8], cn[8]; float w1n = 0.f, w2n = 0.f;
#define H_LOADTOK(dst, r_) do { _Pragma("unroll") for (int q_ = 0; q_ < 6; ++q_) dst[q_] = TI[(size_t)(r_) * 8 + q_]; } while (0)
#define H_ISSUE(tk, r_) do { const int ps1_ = moe_pstart(F.ctl, layer, tk[0]), ps2_ = moe_pstart(F.ctl, layer, tk[1]); \
        const bf16* o1_ = OSL + (size_t)(ps1_ + tk[2]) * DM; const bf16* o2_ = OSL + (size_t)(ps2_ + tk[3]) * DM; const float* hf_ = HFp + (size_t)(r_) * DM; \
        w1n = __builtin_bit_cast(float, tk[4]); w2n = __builtin_bit_cast(float, tk[5]); \
        _Pragma("unroll") for (int j = 0; j < 8; ++j) { hvn[j] = *(const f32x4*)(hf_ + 256 * j + 4 * F.lane); an[j] = *(const u32x2*)(o1_ + 256 * j + 4 * F.lane); cn[j] = *(const u32x2*)(o2_ + 256 * j + 4 * F.lane); } } while (0)
    if (F.gw < nrows) { H_LOADTOK(tA, F.gw); H_ISSUE(tA, F.gw); }
    if (F.gw + F.NGW < nrows) H_LOADTOK(tB, F.gw + F.NGW);
    for (int row = F.gw; row < nrows; row += F.NGW) {
        f32x4 v[8]; const float w1 = w1n, w2 = w2n;
#pragma unroll
        for (int j = 0; j < 8; ++j) { const f32x4 hv = hvn[j]; const u32x2 a = an[j], c = cn[j];
            v[j].x = ALPHA * hv.x + w1 * bflo(a.x) + w2 * bflo(c.x); v[j].y = ALPHA * hv.y + w1 * bfhi(a.x) + w2 * bfhi(c.x);
            v[j].z = ALPHA * hv.z + w1 * bflo(a.y) + w2 * bflo(c.y); v[j].w = ALPHA * hv.w + w1 * bfhi(a.y) + w2 * bfhi(c.y); }
        if (row + F.NGW < nrows) { H_ISSUE(tB, row + F.NGW); if (row + 2 * F.NGW < nrows) H_LOADTOK(tB, row + 2 * F.NGW); }
        ln_row(F, v, g, b);
        if (dry) { store_h(F, row, v, true); if (!last) { float acc8[8]; table_dot<8>(F, v, acc8); if (F.lane == 0) ((float*)(F.ws + WS_GB + 60 * MiB))[row] = acc8[0] + acc8[7]; } }
        else if (last) { float* o = F.out + (size_t)row * DM;
#pragma unroll
            for (int j = 0; j < 8; ++j) *(f32x4*)(o + 256 * j + 4 * F.lane) = v[j]; }
        else { store_h(F, row, v); store_logf(F, row, v, F.in[I_BF] + (layer + 1) * NHEAD); }
    }
#undef H_LOADTOK
#undef H_ISSUE
    __syncthreads();
}

namespace pg8 {
typedef short bf16x8 __attribute__((ext_vector_type(8)));
typedef int i32x4 __attribute__((ext_vector_type(4)));
typedef int i32x8 __attribute__((ext_vector_type(8)));
__device__ __forceinline__ i32x8 ld_frag(const LAS unsigned char* p) { const i32x4 x = *(const LAS i32x4*)p, y = *(const LAS i32x4*)(p + 1024); return __builtin_shufflevector(x, y, 0, 1, 2, 3, 4, 5, 6, 7); }
__device__ __forceinline__ bf16x8 frag_lo(i32x8 f) { return __builtin_bit_cast(bf16x8, (i32x4)__builtin_shufflevector(f, f, 0, 1, 2, 3)); }
__device__ __forceinline__ bf16x8 frag_hi(i32x8 f) { return __builtin_bit_cast(bf16x8, (i32x4)__builtin_shufflevector(f, f, 4, 5, 6, 7)); }
constexpr int BM = 256, BK = 64, HALF = 128, HTB = HALF * BK * 2, STAGE_BYTES = 8 * HTB, NXCD = 8, WGM = 8;
__host__ __device__ __forceinline__ int lds_byte(int r, int c) { const int st = (r >> 4) * 2 + (c >> 5), rr = r & 15, cc = c & 31, ob = rr * 64 + cc * 2; return st * 1024 + (ob ^ (((ob >> 9) & 1) << 5)); }
__host__ __device__ __forceinline__ void stage_rc(int b, int& R, int& C) { const int st = b / 1024, sb = b % 1024, swz = sb ^ (((sb >> 9) & 1) << 5); R = (st >> 1) * 16 + swz / 64; C = (st & 1) * 32 + (swz % 64) / 2; }
__host__ __device__ __forceinline__ int perm32(int rho) { const int n = rho >> 4, i = rho & 15; return 8 * (i >> 2) + 4 * n + (i & 3); }
struct Unit { int pm, pn, aux; };
__device__ __forceinline__ bool static_tile(int nM, int nN, int G, int c, int i, int& pm, int& pn) {
    const int nwg = nM * nN; const long L = (long)i * G + c; if (L >= nwg) return false;
    int wgid = (int)L; { const int q = nwg / NXCD, r = nwg % NXCD, xcd = wgid % NXCD, off = wgid / NXCD; wgid = (xcd < r ? xcd * (q + 1) : r * (q + 1) + (xcd - r) * q) + off; }
    const int nig = WGM * nN, gid = wgid / nig, fm = gid * WGM, gsz = (nM - fm) < WGM ? (nM - fm) : WGM;
    pm = fm + ((wgid % nig) % gsz); pn = (wgid % nig) / gsz; return true;
}
__device__ __forceinline__ unsigned cvt_pk_bf16(float lo, float hi) { unsigned r; asm volatile("v_cvt_pk_bf16_f32 %0, %1, %2" : "=v"(r) : "v"(lo), "v"(hi)); return r; }

template <class P>
__device__ __forceinline__ void gemm_phase(LAS unsigned char* lds, const P& prob) {
    const int tid = threadIdx.x, wid = __builtin_amdgcn_readfirstlane(tid >> 6), lane = tid & 63, wr = wid >> 2, wc = wid & 3, fr = lane & 15, fq = lane >> 4;
    constexpr int ES = P::FP8 ? 1 : 2;
    const int nt = prob.K * ES / (BK * 2);
    unsigned voffA[2], voffA1[2], voffB[2];
#pragma unroll
    for (int i = 0; i < 2; ++i) { int R, C; stage_rc(tid * 16 + i * 8192, R, C); const int Rb = P::PERM ? ((R & ~31) + perm32(R & 31)) : R;
        voffA[i] = (unsigned)(R * prob.lda * ES + C * 2); voffA1[i] = voffA[i]; voffB[i] = (unsigned)(Rb * prob.ldb * ES + C * 2); }
    const size_t kstep = (size_t)(BK * 2);
    const size_t hstepA = P::GATHER ? (size_t)0 : (size_t)HALF * prob.lda * ES, hstepB = (size_t)HALF * prob.ldb * ES;
    const unsigned ldsw = (unsigned)wid * 1024u;
    const int aoff = lds_byte(wr * 64 + fr, fq * 8), boff = lds_byte(wc * 32 + fr, fq * 8);
#define PG8_SA(b, h) (((b) * 2 + (h)) * HTB)
#define PG8_SB(b, h) ((4 + (b) * 2 + (h)) * HTB)
#define PG8_STAGE(bufoff, gbase, voff) do { _Pragma("unroll") for (int _i = 0; _i < 2; ++_i) \
        __builtin_amdgcn_global_load_lds((const unsigned*)((const char*)(gbase) + (voff)[_i]), (LAS unsigned*)(lds + (bufoff) + ldsw + _i * 8192), 16, 0, 0); } while (0)
#define PG8_LDA(dst, b, h) do { _Pragma("unroll") for (int m = 0; m < 4; ++m) dst[m] = ld_frag(lds + PG8_SA(b, h) + aoff + m * 2048); } while (0)
#define PG8_LDB(dst, b, h) do { _Pragma("unroll") for (int n = 0; n < 2; ++n) dst[n] = ld_frag(lds + PG8_SB(b, h) + boff + n * 2048); } while (0)
#define PG8_MMA(ai, bj, At, Bt) do { __builtin_amdgcn_s_setprio(1); _Pragma("unroll") for (int m = 0; m < 4; ++m) _Pragma("unroll") for (int n = 0; n < 2; ++n) { \
        if constexpr (P::FP8) asm volatile("v_mfma_scale_f32_16x16x128_f8f6f4 %0, %1, %2, %0, %3, %4 op_sel_hi:[0,0,0]" : "+v"(acc[ai][bj][m][n]) : "v"(Bt[n]), "v"(At[m]), "v"(scb), "v"(sca)); \
        else { acc[ai][bj][m][n] = __builtin_amdgcn_mfma_f32_16x16x32_bf16(frag_lo(Bt[n]), frag_lo(At[m]), acc[ai][bj][m][n], 0, 0, 0); \
               acc[ai][bj][m][n] = __builtin_amdgcn_mfma_f32_16x16x32_bf16(frag_hi(Bt[n]), frag_hi(At[m]), acc[ai][bj][m][n], 0, 0, 0); } } __builtin_amdgcn_s_setprio(0); } while (0)
#define PG8_WAIT_V(n) asm volatile("s_waitcnt vmcnt(" #n ")" ::: "memory")
#define PG8_WAIT_L(n) asm volatile("s_waitcnt lgkmcnt(" #n ")" ::: "memory")
#define PG8_BAR __builtin_amdgcn_s_barrier()
#define PG8_SCHED __builtin_amdgcn_sched_barrier(0)
#define PG8_GATHER_OFFS(ui_, d0, d1) do { _Pragma("unroll") for (int _i = 0; _i < 2; ++_i) { int R_, C_; stage_rc(tid * 16 + _i * 8192, R_, C_); \
        d0[_i] = (unsigned)(prob.a_row(ui_, R_) * prob.lda * ES + C_ * 2); d1[_i] = (unsigned)(prob.a_row(ui_, HALF + R_) * prob.lda * ES + C_ * 2); } } while (0)
    Unit cur, nxt; int ui = 0;
    if (!prob.next(0, cur)) return;
    f32x4 acc[2][2][4][2];
#pragma unroll
    for (int a = 0; a < 2; ++a)
#pragma unroll
        for (int b = 0; b < 2; ++b)
#pragma unroll
            for (int m = 0; m < 4; ++m)
#pragma unroll
                for (int n = 0; n < 2; ++n) acc[a][b][m][n] = (f32x4){0.f, 0.f, 0.f, 0.f};
    const int sca = prob.sc_a, scb = prob.sc_b;
    i32x8 At[4], B0[2], B1[2];
    const char* cA = prob.a_ptr(cur); const char* cB = prob.b_ptr(cur);
    if constexpr (P::GATHER) PG8_GATHER_OFFS(0, voffA, voffA1);
    PG8_STAGE(PG8_SB(0, 0), cB, voffB); PG8_STAGE(PG8_SB(0, 1), cB + hstepB, voffB); PG8_STAGE(PG8_SA(0, 0), cA, voffA); PG8_STAGE(PG8_SA(0, 1), cA + hstepA, voffA1);
    if (wr == 1) PG8_BAR;
    PG8_WAIT_V(2); PG8_BAR;
    PG8_STAGE(PG8_SB(1, 0), cB + kstep, voffB); PG8_STAGE(PG8_SA(1, 0), cA + kstep, voffA); PG8_STAGE(PG8_SB(1, 1), cB + hstepB + kstep, voffB);
    PG8_WAIT_V(6); PG8_BAR;
    for (;;) {
        const bool has_next = prob.next(ui + 1, nxt);
        const char* nA = has_next ? prob.a_ptr(nxt) : cA; const char* nB = has_next ? prob.b_ptr(nxt) : cB;
        for (int t = 0; t < nt; t += 2) {
            const bool last = (t == nt - 2);
            const char* a1 = cA + (size_t)(t + 1) * kstep;
            const char* a2 = last ? nA : cA + (size_t)(t + 2) * kstep; const char* b2 = last ? nB : cB + (size_t)(t + 2) * kstep;
            const char* a3 = a2 + kstep; const char* b3 = b2 + kstep;
            if constexpr (P::GATHER) {
                unsigned v0[2], v1[2];
#pragma unroll
                for (int i = 0; i < 2; ++i) { v0[i] = voffA[i]; v1[i] = voffA1[i]; }
                if (last && has_next) PG8_GATHER_OFFS(ui + 1, v0, v1);
                PG8_LDB(B0, 0, 0); PG8_LDB(B1, 0, 1); PG8_SCHED; PG8_LDA(At, 0, 0); PG8_STAGE(PG8_SA(1, 1), a1, voffA1);
                PG8_WAIT_V(8); PG8_WAIT_L(0); PG8_BAR; PG8_MMA(0, 0, At, B0); PG8_MMA(0, 1, At, B1); PG8_BAR; PG8_SCHED;
                PG8_LDA(At, 0, 1); PG8_STAGE(PG8_SB(0, 0), b2, voffB); PG8_STAGE(PG8_SB(0, 1), b2 + hstepB, voffB); PG8_STAGE(PG8_SA(0, 0), a2, v0);
                PG8_WAIT_V(8); PG8_WAIT_L(0); PG8_BAR; PG8_MMA(1, 0, At, B0); PG8_MMA(1, 1, At, B1); PG8_BAR; PG8_SCHED;
                PG8_LDB(B0, 1, 0); PG8_LDB(B1, 1, 1); PG8_SCHED; PG8_LDA(At, 1, 0); PG8_STAGE(PG8_SA(0, 1), a2, v1);
                PG8_WAIT_V(8); PG8_WAIT_L(0); PG8_BAR; PG8_MMA(0, 0, At, B0); PG8_MMA(0, 1, At, B1); PG8_BAR; PG8_SCHED;
                PG8_LDA(At, 1, 1); PG8_STAGE(PG8_SB(1, 0), b3, voffB); PG8_STAGE(PG8_SB(1, 1), b3 + hstepB, voffB); PG8_STAGE(PG8_SA(1, 0), a3, v0);
                PG8_WAIT_V(8); PG8_WAIT_L(0); PG8_BAR; PG8_MMA(1, 0, At, B0); PG8_MMA(1, 1, At, B1); PG8_BAR; PG8_SCHED;
#pragma unroll
                for (int i = 0; i < 2; ++i) { voffA[i] = v0[i]; voffA1[i] = v1[i]; }
            } else {
                PG8_LDB(B0, 0, 0); PG8_LDB(B1, 0, 1); PG8_SCHED; PG8_LDA(At, 0, 0); PG8_STAGE(PG8_SA(1, 1), a1 + hstepA, voffA);
                PG8_WAIT_V(8); PG8_WAIT_L(0); PG8_BAR; PG8_MMA(0, 0, At, B0); PG8_MMA(0, 1, At, B1); PG8_BAR; PG8_SCHED;
                PG8_LDA(At, 0, 1); PG8_STAGE(PG8_SB(0, 0), b2, voffB); PG8_STAGE(PG8_SB(0, 1), b2 + hstepB, voffB); PG8_STAGE(PG8_SA(0, 0), a2, voffA);
                PG8_WAIT_V(8); PG8_WAIT_L(0); PG8_BAR; PG8_MMA(1, 0, At, B0); PG8_MMA(1, 1, At, B1); PG8_BAR; PG8_SCHED;
                PG8_LDB(B0, 1, 0); PG8_LDB(B1, 1, 1); PG8_SCHED; PG8_LDA(At, 1, 0); PG8_STAGE(PG8_SA(0, 1), a2 + hstepA, voffA);
                PG8_WAIT_V(8); PG8_WAIT_L(0); PG8_BAR; PG8_MMA(0, 0, At, B0); PG8_MMA(0, 1, At, B1); PG8_BAR; PG8_SCHED;
                PG8_LDA(At, 1, 1); PG8_STAGE(PG8_SB(1, 0), b3, voffB); PG8_STAGE(PG8_SB(1, 1), b3 + hstepB, voffB); PG8_STAGE(PG8_SA(1, 0), a3, voffA);
                PG8_WAIT_V(8); PG8_WAIT_L(0); PG8_BAR; PG8_MMA(1, 0, At, B0); PG8_MMA(1, 1, At, B1); PG8_BAR; PG8_SCHED;
            }
        }
        if (wr == 0) PG8_BAR;
        if constexpr (P::FP8) asm volatile("s_nop 15\n\ts_nop 15" ::: "memory");
        const bool keep = prob.epi(acc, cur, wr, wc, fr, fq);
        if (!has_next) break;
        if (!P::KEEPS || !keep) {
#pragma unroll
            for (int a = 0; a < 2; ++a)
#pragma unroll
                for (int b = 0; b < 2; ++b)
#pragma unroll
                    for (int m = 0; m < 4; ++m)
#pragma unroll
                        for (int n = 0; n < 2; ++n) acc[a][b][m][n] = (f32x4){0.f, 0.f, 0.f, 0.f};
        }
        cur = nxt; cA = nA; cB = nB; ++ui;
        if (wr == 1) PG8_BAR;
    }
    PG8_WAIT_V(0);
    PG8_BAR;
#undef PG8_SA
#undef PG8_SB
#undef PG8_STAGE
#undef PG8_LDA
#undef PG8_LDB
#undef PG8_MMA
#undef PG8_WAIT_V
#undef PG8_WAIT_L
#undef PG8_BAR
#undef PG8_SCHED
#undef PG8_GATHER_OFFS
}
}

template <class Epi>
__device__ __forceinline__ void skinny16_once(LAS unsigned char* lds, const bf16* A, int lda, const bf16* Bt, int ldb, int K, int N, const Epi& epi) {
    const int tid = threadIdx.x, wid = __builtin_amdgcn_readfirstlane(tid >> 6), lane = tid & 63, r = lane & 15, kg = lane >> 4;
    const int kw = K / 8, k0 = wid * kw;
    LAS float* part = (LAS float*)lds;
    for (int ct = blockIdx.x; ct < N / 16; ct += gridDim.x) {
        const bf16* ap = A + (size_t)r * lda + k0 + 8 * kg; const bf16* bp = Bt + (size_t)(16 * ct + r) * ldb + k0 + 8 * kg;
        f32x4 acc = {0.f, 0.f, 0.f, 0.f};
#pragma unroll 8
        for (int ks = 0; ks < kw; ks += 32) acc = __builtin_amdgcn_mfma_f32_16x16x32_bf16(*(const pg8::bf16x8*)(ap + ks), *(const pg8::bf16x8*)(bp + ks), acc, 0, 0, 0);
#pragma unroll
        for (int i = 0; i < 4; ++i) part[wid * 256 + (4 * kg + i) * 16 + r] = acc[i];
        LDS_WAIT(); __syncthreads();
        if (tid < 256) { const float s0 = (part[tid] + part[256 + tid]) + (part[512 + tid] + part[768 + tid]), s1 = (part[1024 + tid] + part[1280 + tid]) + (part[1536 + tid] + part[1792 + tid]);
            epi(tid >> 4, 16 * ct + (tid & 15), s0, s1); }
        LDS_WAIT(); __syncthreads();
    }
}
template <class Epi>
__device__ __forceinline__ void skinny16_f8(LAS unsigned char* lds, const unsigned char* A, int lda, const unsigned char* Bt, int ldb, int K, int N, int sc_a, int sc_b, const Epi& epi) {
    const int tid = threadIdx.x, wid = __builtin_amdgcn_readfirstlane(tid >> 6), lane = tid & 63, r = lane & 15, kg = lane >> 4;
    const int kw = K / 8, k0 = wid * kw;
    LAS float* part = (LAS float*)lds;
    for (int ct = blockIdx.x; ct < N / 16; ct += gridDim.x) {
        const unsigned char* ap = A + (size_t)r * lda + k0 + 32 * kg; const unsigned char* bp = Bt + (size_t)(16 * ct + r) * ldb + k0 + 32 * kg;
        f32x4 acc = {0.f, 0.f, 0.f, 0.f};
#pragma unroll 2
        for (int ks = 0; ks < kw; ks += 128) { const pg8::i32x8 av = *(const pg8::i32x8*)(ap + ks), bv = *(const pg8::i32x8*)(bp + ks);
            acc = __builtin_amdgcn_mfma_scale_f32_16x16x128_f8f6f4(av, bv, acc, 0, 0, 0, sc_a, 0, sc_b); }
#pragma unroll
        for (int i = 0; i < 4; ++i) part[wid * 256 + (4 * kg + i) * 16 + r] = acc[i];
        LDS_WAIT(); __syncthreads();
        if (tid < 256) { const float s0 = (part[tid] + part[256 + tid]) + (part[512 + tid] + part[768 + tid]), s1 = (part[1024 + tid] + part[1280 + tid]) + (part[1536 + tid] + part[1792 + tid]);
            epi(tid >> 4, 16 * ct + (tid & 15), s0, s1); }
        LDS_WAIT(); __syncthreads();
    }
}
template <class Epi>
__device__ __forceinline__ void skinny16(LAS unsigned char* lds, const bf16* A, int lda, const bf16* Bt, int ldb, int K, int N, const Epi& epi) {
    skinny16_once(lds, A, lda, Bt, ldb, K, N, epi); if ((DBL_MASK >> 10) & 1u) skinny16_once(lds, A, lda, Bt, ldb, K, N, epi);
}
struct SkinnyInProj { unsigned char* ws; unsigned* kmax; __device__ __forceinline__ void operator()(int j, int n, float s0, float s1) const { inproj_store(ws, SEQ + j, n, s0 + s1, kmax); } };
struct SkinnyBranch { unsigned char* ws; __device__ __forceinline__ void operator()(int j, int n, float s0, float s1) const {
    const size_t r = SEQ + j; const bf16* G = (const bf16*)(ws + WS_GB); const float v = __builtin_amdgcn_fmed3f((bf2f(G[r * G_N + n]) * s0 + bf2f(G[r * G_N + DM + n]) * s1) * MG8_SCALE, -448.f, 448.f);
    (ws + WS_MG)[r * DM + n] = (unsigned char)(__builtin_amdgcn_cvt_pk_fp8_f32(v, 0.f, 0, false) & 0xff); } };
struct SkinnyOut { unsigned char* ws; __device__ __forceinline__ void operator()(int j, int n, float s0, float s1) const {
    const size_t o = (size_t)(SEQ + j) * DM + n; ((float*)(ws + WS_RB))[o] = ALPHA * ((const float*)(ws + WS_HF))[o] + (s0 + s1); } };

using pg8::Unit;
struct ProbInProj {
    static constexpr bool PERM = true, GATHER = false, KEEPS = false, FP8 = true;
    int K, lda, ldb, G, c; const unsigned char* A; const unsigned char* B; unsigned char* ws; int sc_a, sc_b; unsigned* kmax;
    __device__ __forceinline__ bool next(int i, Unit& u) const { u.aux = 0; return pg8::static_tile(SEQ / 256, INP_N / 256, G, c, i, u.pm, u.pn); }
    __device__ __forceinline__ const char* a_ptr(const Unit& u) const { return (const char*)(A + (size_t)u.pm * 256 * lda); }
    __device__ __forceinline__ const char* b_ptr(const Unit& u) const { return (const char*)(B + (size_t)u.pn * 256 * ldb); }
    __device__ __forceinline__ bool epi(f32x4 (&acc)[2][2][4][2], const Unit& u, int wr, int wc, int fr, int fq) const {
        const int row0 = u.pm * 256 + wr * 64 + fr, ct = u.pn * 256 + wc * 32 + 8 * fq;
        const bool isg = u.pn >= 24, isq = (u.pn < 4) || (u.pn >= 12 && u.pn < 16);
        if (u.pn >= 16 && u.pn < 20) {
#pragma unroll
            for (int bj = 0; bj < 2; ++bj) { float mx = 0.f;
#pragma unroll
                for (int ai = 0; ai < 2; ++ai)
#pragma unroll
                    for (int m = 0; m < 4; ++m)
#pragma unroll
                        for (int n = 0; n < 2; ++n)
#pragma unroll
                            for (int j = 0; j < 4; ++j) mx = fmaxf(mx, __builtin_fabsf(acc[ai][bj][m][n][j]));
                mx = wave_max(mx);
                if ((threadIdx.x & 63) == 0) atomicMax(kmax + (2 * (u.pn - 16) + bj) * 64, __builtin_bit_cast(unsigned, mx)); } }
        bf16* base = isg ? (bf16*)(ws + WS_GB) + (ct - QKV_N) : (bf16*)(ws + WS_QKV) + ct; const int ldc = isg ? G_N : QKV_N; const float sc = isq ? QSCALE : 1.0f;
#pragma unroll
        for (int ai = 0; ai < 2; ++ai)
#pragma unroll
            for (int m = 0; m < 4; ++m) { bf16* rowp = base + (size_t)(row0 + ai * 128 + m * 16) * ldc;
#pragma unroll
                for (int bj = 0; bj < 2; ++bj) { f32x4 v0 = acc[ai][bj][m][0], v1 = acc[ai][bj][m][1];
                    if (isg) {
#pragma unroll
                        for (int j = 0; j < 4; ++j) { v0[j] = __builtin_amdgcn_rcpf(1.0f + __builtin_amdgcn_exp2f(-LOG2E * v0[j])); v1[j] = __builtin_amdgcn_rcpf(1.0f + __builtin_amdgcn_exp2f(-LOG2E * v1[j])); } }
                    else { v0 = v0 * sc; v1 = v1 * sc; }
                    u32x4 w; w.x = pg8::cvt_pk_bf16(v0[0], v0[1]); w.y = pg8::cvt_pk_bf16(v0[2], v0[3]); w.z = pg8::cvt_pk_bf16(v1[0], v1[1]); w.w = pg8::cvt_pk_bf16(v1[2], v1[3]);
                    *(u32x4*)(rowp + bj * 128) = w; } }
        return false;
    }
};
struct ProbOutProj {
    static constexpr bool PERM = false, GATHER = false, KEEPS = false, FP8 = true;
    int K, lda, ldb, G, c; const unsigned char* A; const unsigned char* B; unsigned char* ws; int sc_a, sc_b;
    __device__ __forceinline__ bool next(int i, Unit& u) const { u.aux = 0; return pg8::static_tile(SEQ / 256, DM / 256, G, c, i, u.pm, u.pn); }
    __device__ __forceinline__ const char* a_ptr(const Unit& u) const { return (const char*)(A + (size_t)u.pm * 256 * lda); }
    __device__ __forceinline__ const char* b_ptr(const Unit& u) const { return (const char*)(B + (size_t)u.pn * 256 * ldb); }
    __device__ __forceinline__ bool epi(f32x4 (&acc)[2][2][4][2], const Unit& u, int wr, int wc, int fr, int fq) const {
        const int row0 = u.pm * 256 + wr * 64 + fr, col0 = u.pn * 256 + wc * 32 + 4 * fq;
        const float* HF = (const float*)(ws + WS_HF); float* R = (float*)(ws + WS_RB);
#pragma unroll
        for (int ai = 0; ai < 2; ++ai)
#pragma unroll
            for (int m = 0; m < 4; ++m) { const size_t off = (size_t)(row0 + ai * 128 + m * 16) * DM + col0;
#pragma unroll
                for (int bj = 0; bj < 2; ++bj)
#pragma unroll
                    for (int n = 0; n < 2; ++n) { const f32x4 hv = *(const f32x4*)(HF + off + bj * 128 + n * 16); *(f32x4*)(R + off + bj * 128 + n * 16) = hv * ALPHA + acc[ai][bj][m][n]; }
                asm volatile("" ::: "memory"); }
        return false;
    }
};

struct ProbBranch {
    static constexpr bool PERM = true, GATHER = false, KEEPS = true, FP8 = false;
    int K, lda, ldb, G, c; const bf16* A; const bf16* B; unsigned char* ws; int sc_a, sc_b;
    __device__ __forceinline__ bool next(int i, Unit& u) const { u.aux = i & 1; return pg8::static_tile(SEQ / 256, DM / 256, G, c, i >> 1, u.pm, u.pn); }
    __device__ __forceinline__ const char* a_ptr(const Unit& u) const { return (const char*)(A + (size_t)u.pm * 256 * lda + u.aux * 1024); }
    __device__ __forceinline__ const char* b_ptr(const Unit& u) const { return (const char*)(B + (size_t)u.pn * 256 * ldb + u.aux * 1024); }
    __device__ __forceinline__ bool epi(f32x4 (&acc)[2][2][4][2], const Unit& u, int wr, int wc, int fr, int fq) const {
        const int row0 = u.pm * 256 + wr * 64 + fr, ct = u.pn * 256 + wc * 32 + 8 * fq;
        const bf16* Gs = (const bf16*)(ws + WS_GB) + ct; const bf16* Gf = Gs + DM; unsigned char* MG = ws + WS_MG + ct;
        const bool first = u.aux == 0;
#pragma unroll
        for (int ai = 0; ai < 2; ++ai)
#pragma unroll
            for (int m = 0; m < 4; ++m) { const size_t r = (size_t)(row0 + ai * 128 + m * 16);
#pragma unroll
                for (int bj = 0; bj < 2; ++bj) { const u32x4 gf = *(const u32x4*)(Gf + r * G_N + bj * 128);
                    f32x4 f0 = {bflo(gf.x), bfhi(gf.x), bflo(gf.y), bfhi(gf.y)}, f1 = {bflo(gf.z), bfhi(gf.z), bflo(gf.w), bfhi(gf.w)};
                    if (first) { const u32x4 gs = *(const u32x4*)(Gs + r * G_N + bj * 128);
                        const f32x4 s0 = {bflo(gs.x), bfhi(gs.x), bflo(gs.y), bfhi(gs.y)}, s1 = {bflo(gs.z), bfhi(gs.z), bflo(gs.w), bfhi(gs.w)};
#pragma unroll
                        for (int j = 0; j < 4; ++j) { acc[ai][bj][m][0][j] *= s0[j] * __builtin_amdgcn_rcpf(fmaxf(f0[j], 1e-30f)); acc[ai][bj][m][1][j] *= s1[j] * __builtin_amdgcn_rcpf(fmaxf(f1[j], 1e-30f)); } }
                    else { const f32x4 v0 = acc[ai][bj][m][0] * f0 * MG8_SCALE, v1 = acc[ai][bj][m][1] * f1 * MG8_SCALE;
                        u32x2 w; w.x = pk4_fp8(v0[0], v0[1], v0[2], v0[3]); w.y = pk4_fp8(v1[0], v1[1], v1[2], v1[3]);
                        *(u32x2*)(MG + r * DM + bj * 128) = w; } }
                asm volatile("" ::: "memory"); }
        return first;
    }
};
constexpr int IDX_OFF = RING_BYTES + 1024, MOE_MAXU = 3;
struct ProbMoeGU {
    static constexpr bool PERM = true, GATHER = true, KEEPS = false, FP8 = true;
    int K, lda, ldb, G, c, layer; const unsigned char* A; const unsigned char* B; unsigned char* ws; const unsigned* ctl; LAS unsigned char* lds; int sc_a, sc_b;
    __device__ __forceinline__ bool next(int i, Unit& u) const { const int L = i * G + c; u.pm = L >> 3; u.pn = L & 7; int cnt, ps; return moe_find(ctl, layer, u.pm * 256, u.aux, cnt, ps); }
    __device__ __forceinline__ const char* a_ptr(const Unit&) const { return (const char*)A; }
    __device__ __forceinline__ const char* b_ptr(const Unit& u) const { return (const char*)(B + (size_t)u.aux * WGU_E + (size_t)u.pn * 256 * ldb); }
    __device__ __forceinline__ int a_row(int ui, int r) const { return *(const LAS int*)(lds + IDX_OFF + (ui * 256 + r) * 4); }
    __device__ __forceinline__ void fill_idx(int tid) const {
        for (int ui = 0; ui < MOE_MAXU; ++ui) { const int L = ui * G + c; int e, cnt, ps; if (!moe_find(ctl, layer, (L >> 3) * 256, e, cnt, ps)) break;
            if (tid < 256) { const int rank = (L >> 3) * 256 - ps + tid; *(LAS int*)(lds + IDX_OFF + (ui * 256 + tid) * 4) = rank < cnt ? ((const int*)(ws + WS_ELIST))[(size_t)e * MROWS + rank] : 0; } }
        LDS_WAIT(); __syncthreads();
    }
    __device__ __forceinline__ bool epi(f32x4 (&acc)[2][2][4][2], const Unit& u, int wr, int wc, int fr, int fq) const {
        const int row0 = u.pm * 256 + wr * 64 + fr, ct = u.pn * 128 + wc * 32 + 8 * fq; unsigned char* act = ws + WS_ACT + ct;
#pragma unroll
        for (int ai = 0; ai < 2; ++ai)
#pragma unroll
            for (int m = 0; m < 4; ++m) { f32x4 v[2];
#pragma unroll
                for (int n = 0; n < 2; ++n)
#pragma unroll
                    for (int j = 0; j < 4; ++j) { const float g = acc[ai][0][m][n][j]; v[n][j] = g * __builtin_amdgcn_rcpf(1.0f + __builtin_amdgcn_exp2f(-LOG2E * g)) * acc[ai][1][m][n][j]; }
                u32x2 w; w.x = pk4_fp8(v[0][0] * ACT8_SCALE, v[0][1] * ACT8_SCALE, v[0][2] * ACT8_SCALE, v[0][3] * ACT8_SCALE); w.y = pk4_fp8(v[1][0] * ACT8_SCALE, v[1][1] * ACT8_SCALE, v[1][2] * ACT8_SCALE, v[1][3] * ACT8_SCALE);
                *(u32x2*)(act + (size_t)(row0 + ai * 128 + m * 16) * FF) = w; }
        return false;
    }
};
struct ProbMoeDown {
    static constexpr bool PERM = true, GATHER = false, KEEPS = false, FP8 = true;
    int K, lda, ldb, G, c, layer; const unsigned char* A; const unsigned char* B; unsigned char* ws; const unsigned* ctl; int sc_a, sc_b;
    __device__ __forceinline__ bool next(int i, Unit& u) const { const int L = i * G + c; u.pm = L >> 3; u.pn = L & 7; int cnt, ps; return moe_find(ctl, layer, u.pm * 256, u.aux, cnt, ps); }
    __device__ __forceinline__ const char* a_ptr(const Unit& u) const { return (const char*)(A + (size_t)u.pm * 256 * lda); }
    __device__ __forceinline__ const char* b_ptr(const Unit& u) const { return (const char*)(B + (size_t)u.aux * WD_E + (size_t)u.pn * 256 * ldb); }
    __device__ __forceinline__ bool epi(f32x4 (&acc)[2][2][4][2], const Unit& u, int wr, int wc, int fr, int fq) const {
        const int row0 = u.pm * 256 + wr * 64 + fr, ct = u.pn * 256 + wc * 32 + 8 * fq; bf16* O = (bf16*)(ws + WS_OSL) + ct;
#pragma unroll
        for (int ai = 0; ai < 2; ++ai)
#pragma unroll
            for (int m = 0; m < 4; ++m)
#pragma unroll
                for (int bj = 0; bj < 2; ++bj) { const f32x4 v0 = acc[ai][bj][m][0], v1 = acc[ai][bj][m][1];
                    u32x4 w; w.x = pg8::cvt_pk_bf16(v0[0], v0[1]); w.y = pg8::cvt_pk_bf16(v0[2], v0[3]); w.z = pg8::cvt_pk_bf16(v1[0], v1[1]); w.w = pg8::cvt_pk_bf16(v1[2], v1[3]);
                    *(u32x4*)(O + (size_t)(row0 + ai * 128 + m * 16) * DM + bj * 128) = w; }
        return false;
    }
};

#ifndef ATT_DBL
#define ATT_DBL 0
#endif
namespace att {
typedef short bf16x8 __attribute__((ext_vector_type(8)));
typedef short s16x4 __attribute__((ext_vector_type(4)));
typedef float f32x16 __attribute__((ext_vector_type(16)));
constexpr int TILE_B = 16384;
constexpr float EXIT_THR = -140.f;
constexpr int L_V = 0, L_K = 3 * TILE_B, L_C2 = 6 * TILE_B, L_WS = L_C2 + 1024, L_END = L_WS + 8 * 256, L_ITEM = 131072 + 8192, L_VOTE = L_ITEM + 16, L_FT = L_VOTE + 64;
#define KSWZ(row, colB) ((row) * 256 + ((colB) ^ (((row) & 7) << 4)))
#define SBAR() __builtin_amdgcn_sched_barrier(0)
__device__ __forceinline__ int v_st(int k, int c) { const int kk = (k & ~0xC) | ((k & 4) << 1) | ((k & 8) >> 1); return ((kk >> 3) * 4 + (c >> 5)) * 512 + ((kk & 7) * 32 + (c & 31)) * 2; }
__device__ __forceinline__ int v_rd_base(int lane) { return ((lane & 3) << 3) | (((lane >> 2) & 3) << 6) | (((lane >> 4) & 1) << 5) | (((lane >> 5) & 1) << 8); }
constexpr int v_rd_off(int d0, int ks, int half) { return d0 * 512 + ks * 4096 + half * 2048; }
__device__ __forceinline__ int crow(int r, int hi) { return (r & 3) + 8 * (r >> 2) + 4 * hi; }
__device__ __forceinline__ unsigned cvtpk(float lo, float hi) { unsigned r; asm volatile("v_cvt_pk_bf16_f32 %0, %1, %2" : "=v"(r) : "v"(lo), "v"(hi)); return r; }
__device__ __forceinline__ float xchg_sum(float v) { auto rr = __builtin_amdgcn_permlane32_swap(__float_as_uint(v), __float_as_uint(v), false, false); return __uint_as_float(rr[0]) + __uint_as_float(rr[1]); }
__device__ __forceinline__ float xchg_max(float v) { auto rr = __builtin_amdgcn_permlane32_swap(__float_as_uint(v), __float_as_uint(v), false, false); return fmaxf(__uint_as_float(rr[0]), __uint_as_float(rr[1])); }
#define PK4(P, B_, OUT) do { unsigned a0 = cvtpk(P[B_+0], P[B_+1]), a1 = cvtpk(P[B_+2], P[B_+3]); unsigned b0 = cvtpk(P[B_+4], P[B_+5]), b1 = cvtpk(P[B_+6], P[B_+7]); \
        auto r0 = __builtin_amdgcn_permlane32_swap(a0, b0, false, false); auto r1 = __builtin_amdgcn_permlane32_swap(a1, b1, false, false); \
        u32x4 w = {r0[0], r1[0], r0[1], r1[1]}; OUT = *reinterpret_cast<bf16x8*>(&w); } while (0)
__device__ __forceinline__ void qkt(f32x16& p0, f32x16& p1, const LAS unsigned char* kt, int r32, int hi, const bf16x8* qr) {
    p0 = f32x16{}; p1 = f32x16{};
    const LAS unsigned char* kb[4];
#pragma unroll
    for (int dd = 0; dd < 4; ++dd) kb[dd] = kt + KSWZ(r32, (dd * 16 + hi * 8) * 2);
#pragma unroll
    for (int d0 = 0; d0 < 8; ++d0) { const LAS unsigned char* a = kb[d0 & 3] + (d0 >> 2) * 128;
        const bf16x8 b0 = *(const LAS bf16x8*)(a); const bf16x8 b1 = *(const LAS bf16x8*)(a + 32 * 256);
        p0 = __builtin_amdgcn_mfma_f32_32x32x16_bf16(b0, qr[d0], p0, 0, 0, 0);
        p1 = __builtin_amdgcn_mfma_f32_32x32x16_bf16(b1, qr[d0], p1, 0, 0, 0); }
}
__device__ __forceinline__ void pv_tile(f32x16* o, unsigned vb0, bf16x8 pa0, bf16x8 pa1, bf16x8 pa2, bf16x8 pa3) {
#define TRRD(dst, off) asm volatile("ds_read_b64_tr_b16 %0, %1 offset:%2" : "=&v"(dst) : "v"(vb0), "i"(off) : "memory")
#define PV_D0(d0) do { s16x4 l0, l1, l2, l3, h0, h1, h2, h3; constexpr int b_ = v_rd_off(d0, 0, 0); \
        TRRD(l0, b_); TRRD(h0, b_ + 2048); TRRD(l1, b_ + 4096); TRRD(h1, b_ + 6144); TRRD(l2, b_ + 8192); TRRD(h2, b_ + 10240); TRRD(l3, b_ + 12288); TRRD(h3, b_ + 14336); \
        asm volatile("s_waitcnt lgkmcnt(0)" ::: "memory"); SBAR(); \
        o[d0] = __builtin_amdgcn_mfma_f32_32x32x16_bf16(pa0, (bf16x8){l0[0], l0[1], l0[2], l0[3], h0[0], h0[1], h0[2], h0[3]}, o[d0], 0, 0, 0); \
        o[d0] = __builtin_amdgcn_mfma_f32_32x32x16_bf16(pa1, (bf16x8){l1[0], l1[1], l1[2], l1[3], h1[0], h1[1], h1[2], h1[3]}, o[d0], 0, 0, 0); \
        o[d0] = __builtin_amdgcn_mfma_f32_32x32x16_bf16(pa2, (bf16x8){l2[0], l2[1], l2[2], l2[3], h2[0], h2[1], h2[2], h2[3]}, o[d0], 0, 0, 0); \
        o[d0] = __builtin_amdgcn_mfma_f32_32x32x16_bf16(pa3, (bf16x8){l3[0], l3[1], l3[2], l3[3], h3[0], h3[1], h3[2], h3[3]}, o[d0], 0, 0, 0); } while (0)
    PV_D0(0); PV_D0(1); PV_D0(2); PV_D0(3);
#undef PV_D0
#undef TRRD
}
#define VIS(cc) (((dqh) - (cc)) >= NEED && (cc) < (nvh))
__device__ __forceinline__ void sb_tile(f32x16& p0, f32x16& p1, float& carry, bool domask, int dqh, int nvh, int hi, bf16x8& pa0, bf16x8& pa1, bf16x8& pa2, bf16x8& pa3) {
    constexpr int NEED = 1;
    f32x16 x0, x1;
#pragma unroll
    for (int r = 0; r < 16; ++r) {
        { const float u = __builtin_amdgcn_fmed3f(p0[r], -126.f, 126.f), b = __builtin_amdgcn_logf(1.0f + __builtin_amdgcn_exp2f(-u)); x0[r] = -b; p0[r] = -u - b; }
        { const float u = __builtin_amdgcn_fmed3f(p1[r], -126.f, 126.f), b = __builtin_amdgcn_logf(1.0f + __builtin_amdgcn_exp2f(-u)); x1[r] = -b; p1[r] = -u - b; } }
    if (domask) { const float NEG = -__builtin_inff();
#pragma unroll
        for (int r = 0; r < 16; ++r) { const int cc = (r & 3) + 8 * (r >> 2);
            if (!VIS(cc)) { p0[r] = 0.f; x0[r] = NEG; }
            if (!VIS(cc + 32)) { p1[r] = 0.f; x1[r] = NEG; } } }
    float A[9]; A[8] = 0.f;
#pragma unroll
    for (int g = 3; g >= 0; --g) A[4 + g] = A[5 + g] + ((p1[4 * g] + p1[4 * g + 1]) + (p1[4 * g + 2] + p1[4 * g + 3]));
#pragma unroll
    for (int g = 3; g >= 0; --g) A[g] = A[1 + g] + ((p0[4 * g] + p0[4 * g + 1]) + (p0[4 * g + 2] + p0[4 * g + 3]));
    float off[8];
#pragma unroll
    for (int i = 0; i < 8; ++i) { auto rr = __builtin_amdgcn_permlane32_swap(__float_as_uint(A[i]), __float_as_uint(A[i + 1]), false, false);
        const float recv = hi ? __uint_as_float(rr[0]) : __uint_as_float(rr[1]); off[i] = carry + A[i + 1] + recv; }
    carry += xchg_sum(A[0]);
#pragma unroll
    for (int g = 0; g < 4; ++g) {
        { float af = off[g]; const float l3 = p0[4 * g + 3], l2 = p0[4 * g + 2], l1 = p0[4 * g + 1];
          x0[4 * g + 3] = __builtin_amdgcn_exp2f(x0[4 * g + 3] + af); af += l3; x0[4 * g + 2] = __builtin_amdgcn_exp2f(x0[4 * g + 2] + af); af += l2;
          x0[4 * g + 1] = __builtin_amdgcn_exp2f(x0[4 * g + 1] + af); af += l1; x0[4 * g] = __builtin_amdgcn_exp2f(x0[4 * g] + af); }
        { float af = off[4 + g]; const float l3 = p1[4 * g + 3], l2 = p1[4 * g + 2], l1 = p1[4 * g + 1];
          x1[4 * g + 3] = __builtin_amdgcn_exp2f(x1[4 * g + 3] + af); af += l3; x1[4 * g + 2] = __builtin_amdgcn_exp2f(x1[4 * g + 2] + af); af += l2;
          x1[4 * g + 1] = __builtin_amdgcn_exp2f(x1[4 * g + 1] + af); af += l1; x1[4 * g] = __builtin_amdgcn_exp2f(x1[4 * g] + af); } }
    PK4(x0, 0, pa0); PK4(x0, 8, pa1); PK4(x1, 0, pa2); PK4(x1, 8, pa3);
}
__device__ __forceinline__ float fox_tile(f32x16& p0, f32x16& p1, const LAS float* c2t, float& m_reg, float& l_reg, bool domask, int dqh, int nvh, int hi, bf16x8& pa0, bf16x8& pa1, bf16x8& pa2, bf16x8& pa3) {
    constexpr int NEED = 0;
#pragma unroll
    for (int g = 0; g < 4; ++g) { const f32x4 c0 = *(const LAS f32x4*)(c2t + 8 * g + 4 * hi), c1 = *(const LAS f32x4*)(c2t + 32 + 8 * g + 4 * hi);
#pragma unroll
        for (int j = 0; j < 4; ++j) { p0[4 * g + j] -= c0[j]; p1[4 * g + j] -= c1[j]; } }
    if (domask) { const float NEG = -__builtin_inff();
#pragma unroll
        for (int r = 0; r < 16; ++r) { const int cc = (r & 3) + 8 * (r >> 2);
            if (!VIS(cc)) p0[r] = NEG;
            if (!VIS(cc + 32)) p1[r] = NEG; } }
    float pmax = p0[0];
#pragma unroll
    for (int r = 1; r < 16; ++r) pmax = fmaxf(pmax, p0[r]);
#pragma unroll
    for (int r = 0; r < 16; ++r) pmax = fmaxf(pmax, p1[r]);
    pmax = xchg_max(pmax);
    const float mn = fmaxf(m_reg, pmax), alpha = __builtin_amdgcn_exp2f(m_reg - mn); m_reg = mn;
    float ps = 0.f;
#pragma unroll
    for (int r = 0; r < 16; ++r) { p0[r] = __builtin_amdgcn_exp2f(p0[r] - mn); p1[r] = __builtin_amdgcn_exp2f(p1[r] - mn); ps += p0[r] + p1[r]; }
    l_reg = l_reg * alpha + xchg_sum(ps);
    PK4(p0, 0, pa0); PK4(p0, 8, pa1); PK4(p1, 0, pa2); PK4(p1, 8, pa3);
    return alpha;
}
#undef VIS
template <int TYPE>
__device__ __forceinline__ void attn_unit(LAS unsigned char* lds, unsigned char* ws, const unsigned* kmaxw, int head, int qb) {
    const int tid = threadIdx.x, wid = __builtin_amdgcn_readfirstlane(tid >> 6), lane = tid & 63, r32 = lane & 31, hi = lane >> 5;
    const bool grpY = wid >= 4;
    const bf16* QKV = (const bf16*)(ws + WS_QKV);
    const int qcol = (TYPE ? 3072 : 0) + head * HD, kcol = qcol + 1024, vcol = qcol + 2048;
    const float* fsuf = (const float*)(ws + WS_CUM) + (size_t)head * MROWS; const float* ftot = (const float*)(ws + WS_CUM) + (size_t)NHEAD * MROWS + head * 256;
    float fcarry = 0.f, st_tot = 0.f;
    LAS int* vote = (LAS int*)(lds + L_VOTE); LAS float* ftl = (LAS float*)(lds + L_FT);
    const int qrow0 = qb * 256, NT = qb < 32 ? 4 * qb + 5 : 1;
    const int qbase = qb < 32 ? qrow0 : -NMETA;
    const int qlo = qbase + wid * 32, qpos = qlo + r32;
    LAS unsigned char* V_lds = lds + L_V; LAS unsigned char* K_lds = lds + L_K; LAS float* c2_lds = (LAS float*)(lds + L_C2);
    LAS float* wsl = (LAS float*)(lds + L_WS) + wid * 64;
    bf16x8 qr[8];
#pragma unroll
    for (int d0 = 0; d0 < 8; ++d0) qr[d0] = *(const bf16x8*)(QKV + (size_t)(qrow0 + wid * 32 + r32) * QKV_N + qcol + d0 * 16 + hi * 8);
    const int sr = tid >> 4, sc = (tid & 15) * 8, vst0 = v_st(sr, sc), vst1 = v_st(32 + sr, sc), kws = KSWZ(sr, sc * 2);
    const unsigned vrd = (unsigned)(size_t)V_lds + (unsigned)v_rd_base(lane);
    bf16x8 st_k0, st_k1, st_v0, st_v1; float st_c = 0.f;
    float ub = 0.f;
    if (TYPE == 1) { float s1 = 0.f;
#pragma unroll
        for (int d0 = 0; d0 < 8; ++d0) { const u32x4 w = __builtin_bit_cast(u32x4, qr[d0]);
            s1 += (__builtin_fabsf(bflo(w.x)) + __builtin_fabsf(bfhi(w.x))) + (__builtin_fabsf(bflo(w.y)) + __builtin_fabsf(bfhi(w.y))) + (__builtin_fabsf(bflo(w.z)) + __builtin_fabsf(bfhi(w.z))) + (__builtin_fabsf(bflo(w.w)) + __builtin_fabsf(bfhi(w.w))); }
        ub = 1.02f * xchg_sum(s1) * __builtin_bit_cast(float, kmaxw[head * 64]); }
#define TISMETA(t) ((t) == NT - 1)
#define SLOAD(t) do { const int row_ = TISMETA(t) ? SEQ : 64 * (4 * qb + 3 - (t)); const bf16* kp_ = QKV + (size_t)(row_ + sr) * QKV_N + sc; \
        st_k0 = *(const bf16x8*)(kp_ + kcol); st_k1 = *(const bf16x8*)(kp_ + (size_t)32 * QKV_N + kcol); st_v0 = *(const bf16x8*)(kp_ + vcol); st_v1 = *(const bf16x8*)(kp_ + (size_t)32 * QKV_N + vcol); \
        if (TYPE == 1 && tid < 64) { st_c = fsuf[row_ + tid]; st_tot = ftot[row_ >> 6]; } } while (0)
#define SWRITE(bo) do { *(LAS bf16x8*)(K_lds + (bo) + kws) = st_k0; *(LAS bf16x8*)(K_lds + (bo) + kws + 32 * 256) = st_k1; \
        *(LAS bf16x8*)(V_lds + (bo) + vst0) = st_v0; *(LAS bf16x8*)(V_lds + (bo) + vst1) = st_v1; if (TYPE == 1 && tid < 64) { c2_lds[((bo) >> 8) + tid] = -(fcarry + st_c); fcarry += st_tot; if (tid == 0) ftl[(bo) >> 14] = fcarry; } } while (0)
#define BAR() asm volatile("s_waitcnt lgkmcnt(0)\n\ts_barrier" ::: "memory")
    SLOAD(0); SWRITE(0);
    if (NT > 1) { SLOAD(1); SWRITE(TILE_B); }
    __builtin_amdgcn_s_waitcnt(0x0F70);
    if (NT > 2) SLOAD(2);
    BAR();
    if (grpY) BAR();
    f32x16 o[4] = {}; float carry = 0.f, m_reg = -1e30f, l_reg = 0.f;
    constexpr int NEEDW = TYPE == 0 ? 1 : 0;
#define KBASE(t) (TISMETA(t) ? -NMETA : 64 * (4 * qb + 3 - (t)))
#define ACTW(t) ((qlo + 31 - KBASE(t)) >= NEEDW && (qb < 32 || wid == 0))
    f32x16 p0, p1;
    if (ACTW(0)) qkt(p0, p1, K_lds, r32, hi, qr);
    int bo = 0, bo1 = TILE_B, bo2 = 2 * TILE_B;
    for (int t = 0; t < NT; ++t) {
        BAR();
        if (t > 0) { const LAS int* vp = vote + ((t - 1) & 1) * 8; const int all8 = (vp[0] & vp[1]) & (vp[2] & vp[3]) & (vp[4] & vp[5]) & (vp[6] & vp[7]); if (__builtin_amdgcn_readfirstlane(all8)) break; }
        const int kbase = KBASE(t), nvalid = TISMETA(t) ? NMETA : 64;
        const bool actw = ACTW(t);
        const bool domask = (qlo - (kbase + 63) < NEEDW) || nvalid < 64;
        bf16x8 pa0, pa1, pa2, pa3;
        if (actw) {
            const int dqh = qpos - kbase - 4 * hi, nvh = nvalid - 4 * hi;
            if (TYPE == 0) sb_tile(p0, p1, carry, domask, dqh, nvh, hi, pa0, pa1, pa2, pa3);
            else { const float alpha = fox_tile(p0, p1, c2_lds + (bo >> 8), m_reg, l_reg, domask, dqh, nvh, hi, pa0, pa1, pa2, pa3);
                if (__any(alpha < 1.f)) { if (hi == 0) wsl[r32] = alpha; asm volatile("s_waitcnt lgkmcnt(0)" ::: "memory");
#pragma unroll
                    for (int r = 0; r < 16; ++r) { const float al = wsl[crow(r, hi)];
#pragma unroll
                        for (int d = 0; d < 4; ++d) o[d][r] *= al; } } }
        }
        { const bool done = TYPE == 0 ? __all(carry < EXIT_THR) : __all(ub + ftl[bo >> 14] - m_reg < EXIT_THR);
          if (lane == 0) vote[(t & 1) * 8 + wid] = (done && qb < 32) ? 1 : 0; }
        BAR();
        if (t + 2 < NT) SWRITE(bo2);
        if (t + 3 < NT) SLOAD(t + 3);
        if (actw) pv_tile(o, vrd + bo, pa0, pa1, pa2, pa3);
        if (t + 1 < NT) { if (ACTW(t + 1)) qkt(p0, p1, K_lds + bo1, r32, hi, qr); }
        { const int tmp = bo; bo = bo1; bo1 = bo2; bo2 = tmp; }
    }
    if (!grpY) BAR();
    float rli[16];
    if (TYPE == 1) { if (hi == 0) wsl[32 + r32] = l_reg; asm volatile("s_waitcnt lgkmcnt(0)" ::: "memory");
#pragma unroll
        for (int r = 0; r < 16; ++r) rli[r] = __builtin_amdgcn_rcpf(wsl[32 + crow(r, hi)]); }
    bf16* Yw = (bf16*)(ws + WS_YB) + (size_t)(qrow0 + wid * 32) * DM + TYPE * 1024 + head * HD;
    if (qb < 32 || wid == 0)
#pragma unroll
    for (int r = 0; r < 16; ++r) { const int orow = crow(r, hi);
#pragma unroll
        for (int d0 = 0; d0 < 4; ++d0) { const float v = TYPE == 1 ? o[d0][r] * rli[r] : o[d0][r]; const float vn = __shfl_xor(v, 1);
            if ((r32 & 1) == 0) *(unsigned*)(Yw + (size_t)orow * DM + d0 * 32 + r32) = cvtpk(v, vn); } }
#undef TISMETA
#undef SLOAD
#undef SWRITE
#undef BAR
#undef KBASE
#undef ACTW
}
constexpr int CW_ATTNQ = 3072;
__device__ __forceinline__ void copy_loop(Frame& F, int layer, int cv0, int NB_, int limit = 1 << 30) {
    LAS int* itemw = (LAS int*)(F.lds + L_ITEM);
    for (int n = 0; n < limit; ++n) {
        __syncthreads();
        if (threadIdx.x == 0) *itemw = (int)atomicAdd(F.ctl + CW_ATTNQ + layer * 64 + 16, 1u);
        asm volatile("s_waitcnt lgkmcnt(0)" ::: "memory"); __syncthreads();
        const int j = __builtin_amdgcn_readfirstlane(*itemw);
        if (j >= NB_) break;
        convert_bundle(F, cv0 + j * CV_BUNDLE);
    }
}
__device__ __forceinline__ void attn_phase(Frame& F, int layer, int qoff) {
    LAS unsigned char* lds = F.lds; unsigned char* ws = F.ws; unsigned* ctl = F.ctl; const int G = F.G, b = blockIdx.x;
    const int NA = 512 + (layer == 0 ? 16 : 0);
    const int cv0 = layer == 0 ? CV_G0_END : CV_G1_END, NB_ = ((layer == 0 ? CV_G1_END : N_CONVERT_ITEMS) - cv0) / CV_BUNDLE;
    const bool copier = (b & 1) == 1; const int nfree = G - G / 2;
    LAS int* itemw = (LAS int*)(lds + L_ITEM); const unsigned* kmaxw = ctl + CW_KMAX + layer * 8 * 64;
    int it;
    if (copier) {
        copy_loop(F, layer, cv0, NB_);
        __syncthreads();
        if (threadIdx.x == 0) *itemw = nfree + (int)atomicAdd(ctl + CW_ATTNQ + layer * 64 + qoff, 1u);
        asm volatile("s_waitcnt lgkmcnt(0)" ::: "memory"); __syncthreads();
        it = __builtin_amdgcn_readfirstlane(*itemw);
    } else it = b >> 1;
    while (it < NA) {
        int qb, th; if (it < 256) { qb = 31 - (it >> 3); th = 8 + (it & 7); } else if (it < 512) { qb = 31 - ((it - 256) >> 3); th = it & 7; } else { qb = 32; th = it - 512; }
        if (th < 8) attn_unit<0>(lds, ws, kmaxw, th, qb); else attn_unit<1>(lds, ws, kmaxw, th - 8, qb);
        __syncthreads();
        if (threadIdx.x == 0) *itemw = nfree + (int)atomicAdd(ctl + CW_ATTNQ + layer * 64 + qoff, 1u);
        asm volatile("s_waitcnt lgkmcnt(0)" ::: "memory"); __syncthreads();
        it = __builtin_amdgcn_readfirstlane(*itemw);
    }
}
#undef KSWZ
#undef SBAR
#undef PK4
}

__global__ void __launch_bounds__(NTHREADS, 2) mk_fwd(Args args) {
    extern __shared__ __attribute__((aligned(16))) unsigned char lds_raw[];
    Frame F;
    F.lds = (LAS unsigned char*)lds_raw; F.ws = args.ws; F.ctl = (unsigned*)(args.ws + WS_CTL);
    F.tid = threadIdx.x; F.lane = F.tid & 63; F.wave = __builtin_amdgcn_readfirstlane(F.tid >> 6);
    F.G = gridDim.x; F.gw = blockIdx.x * NWAVES + F.wave; F.NGW = F.G * NWAVES;
    F.in = (const float* const*)__builtin_amdgcn_kernarg_segment_ptr();
    F.out = args.out;
    volatile LAS unsigned* MISC = (volatile LAS unsigned*)(F.lds + MISC_OFF);
    for (int u = F.tid; u < (LDS_BYTES - RING_BYTES) / 4; u += NTHREADS) ((LAS unsigned*)(F.lds + RING_BYTES))[u] = 0u;
    __syncthreads();
    XcdBarrier bar = xcd_barrier_post(F.ctl + CW_BAR + args.li * XCD_BAR_WORDS, MISC + 8);
    const int lo = args.ph_lo, hi = args.ph_hi; const unsigned naive = args.naive;
#define IN(k) (lo <= (k) && (k) < hi)
#define SEAM(k) do { if (IN(k) && IN((k) + 1)) { xcd_barrier(bar); if ((DBL_MASK >> 9) & 1u) xcd_barrier(bar); } } while (0)
#define NAIVE(t) ((naive >> (t)) & 1u)
    if (IN(0)) { phase_prologue(F); SEAM(0); }
#define LAYER_PHASES(l, pb) do { \
        if (IN(pb + PH_A)) { phase_cumsum(F, NAIVE(PH_B)); if (!NAIVE(PH_B)) phase_tilesuf(F); \
            if (!NAIVE(PH_A)) { skinny16_f8(F.lds, F.ws + WS_H8 + (size_t)SEQ * DM, DM, F.ws + WS_WIN + l * WIN_L, DM, DM, INP_N, SC_H, SC_W, SkinnyInProj{F.ws, F.ctl + CW_KMAX + l * 8 * 64}); \
              ProbInProj P{DM, DM, DM, F.G, (int)blockIdx.x, F.ws + WS_H8, F.ws + WS_WIN + l * WIN_L, F.ws, SC_H, SC_W, F.ctl + CW_KMAX + l * 8 * 64}; pg8::gemm_phase(F.lds, P); if ((DBL_MASK >> PH_A) & 1u) pg8::gemm_phase(F.lds, P); } \
            SEAM(pb + PH_A); } \
        if (IN(pb + PH_B)) { \
            if (!NAIVE(PH_B)) att::attn_phase(F, l, 0); \
            SEAM(pb + PH_B); } \
        if (IN(pb + PH_C)) { \
            if (!NAIVE(PH_C)) { if (l == 0) skinny16(F.lds, (const bf16*)(F.ws + WS_YB) + (size_t)SEQ * DM, DM, (const bf16*)(F.ws + WS_WB + l * WB_L), DM, DM, DM, SkinnyBranch{F.ws}); \
              ProbBranch P{1024, DM, DM, F.G, (int)blockIdx.x, (const bf16*)(F.ws + WS_YB), (const bf16*)(F.ws + WS_WB + l * WB_L), F.ws, 0, 0}; pg8::gemm_phase(F.lds, P); if ((DBL_MASK >> PH_C) & 1u) pg8::gemm_phase(F.lds, P); } \
            SEAM(pb + PH_C); } \
        if (IN(pb + PH_D)) { \
            if (!NAIVE(PH_D)) { if (l == 0) skinny16_f8(F.lds, F.ws + WS_MG + (size_t)SEQ * DM, DM, F.ws + WS_WOUT + l * WOUT_L, DM, DM, DM, SC_MG, SC_W, SkinnyOut{F.ws}); \
              ProbOutProj P{DM, DM, DM, F.G, (int)blockIdx.x, F.ws + WS_MG, F.ws + WS_WOUT + l * WOUT_L, F.ws, SC_MG, SC_W}; pg8::gemm_phase(F.lds, P); if ((DBL_MASK >> PH_D) & 1u) pg8::gemm_phase(F.lds, P); } \
            SEAM(pb + PH_D); } \
        if (IN(pb + PH_E)) { if ((DBL_MASK >> PH_E) & 1u) phase_ln_router(F, l, true); phase_ln_router(F, l); SEAM(pb + PH_E); } \
        if (IN(pb + PH_F)) { \
            if (!NAIVE(PH_F)) { ProbMoeGU P{DM, DM, DM, F.G, (int)blockIdx.x, l, F.ws + WS_H8, F.ws + WS_WGU + l * WGU_L, F.ws, F.ctl, F.lds, SC_H, SC_W}; P.fill_idx(F.tid); pg8::gemm_phase(F.lds, P); if ((DBL_MASK >> PH_F) & 1u) pg8::gemm_phase(F.lds, P);  } \
            SEAM(pb + PH_F); } \
        if (IN(pb + PH_G)) { \
            if (!NAIVE(PH_G)) { ProbMoeDown P{FF, FF, FF, F.G, (int)blockIdx.x, l, F.ws + WS_ACT, F.ws + WS_WD + l * WD_L, F.ws, F.ctl, SC_ACT, SC_W}; pg8::gemm_phase(F.lds, P); if ((DBL_MASK >> PH_G) & 1u) pg8::gemm_phase(F.lds, P);  } \
            SEAM(pb + PH_G); } \
        if (IN(pb + PH_H)) { if ((DBL_MASK >> PH_H) & 1u) phase_ln_final(F, l, true); phase_ln_final(F, l); SEAM(pb + PH_H); } \
    } while (0)
    LAYER_PHASES(0, 1);
    LAYER_PHASES(1, 9);
#undef LAYER_PHASES
#undef IN
#undef SEAM
#undef NAIVE
}

static void launch_naive(int type, int layer, const Args& a, hipStream_t stream) {
    switch (type) {
    case PH_A: hipLaunchKernelGGL(naive_inproj, dim3(INP_N / 256, MROWS / 4), dim3(256), 0, stream, a, layer); break;
    case PH_B: { const int nq = NTOK; hipLaunchKernelGGL(naive_attn, dim3((16 * nq + 3) / 4), dim3(256), 0, stream, a, nq); } break;
    case PH_C: hipLaunchKernelGGL(naive_branch, dim3(DM / 256, MROWS / 4), dim3(256), 0, stream, a, layer); break;
    case PH_D: hipLaunchKernelGGL(naive_outproj, dim3(DM / 256, MROWS / 4), dim3(256), 0, stream, a, layer); break;
    case PH_F: hipLaunchKernelGGL(naive_moe_gu, dim3(FF / 256, NSLOT_MAX / 4), dim3(256), 0, stream, a, layer); break;
    case PH_G: hipLaunchKernelGGL(naive_moe_down, dim3(DM / 256, NSLOT_MAX / 4), dim3(256), 0, stream, a, layer); break;
    default: break;
    }
}
extern "C" void kernel_launch(void* const* d_in, const int* in_sizes, int n_in, void* d_out, int out_size, void* d_ws, size_t ws_size, hipStream_t stream) {
    static int grid = 0;
    if (grid == 0) {
        if (n_in != 18 || out_size != SEQ * DM || ws_size < WS_END) { fprintf(stderr, "kernel_launch: unexpected shapes (n_in %d out %d ws %zu)\n", n_in, out_size, ws_size); grid = -1; return; }
        int dev = 0, cus = 0;
        if (hipGetDevice(&dev) != hipSuccess || hipDeviceGetAttribute(&cus, hipDeviceAttributeMultiprocessorCount, dev) != hipSuccess) { grid = -1; return; }
        if (hipFuncSetAttribute((const void*)mk_fwd, hipFuncAttributeMaxDynamicSharedMemorySize, LDS_BYTES) != hipSuccess) { fprintf(stderr, "kernel_launch: hipFuncSetAttribute failed\n"); grid = -1; return; }
        int per_cu = 0;
        if (hipOccupancyMaxActiveBlocksPerMultiprocessor(&per_cu, (const void*)mk_fwd, NTHREADS, LDS_BYTES) != hipSuccess || per_cu < 1) fprintf(stderr, "kernel_launch: occupancy query says %d\n", per_cu);
        (void)hipGetLastError();
        grid = cus;
    }
    if (grid < 0) return;
    (void)hipMemsetAsync((char*)d_ws + WS_CTL, 0, CTL_ZERO_BYTES, stream);
    Args a{};
    for (int i = 0; i < 18; ++i) a.in[i] = (const float*)d_in[i];
    a.out = (float*)d_out; a.ws = (unsigned char*)d_ws; a.naive = NAIVE_MASK;
    int li = 0, lo = 0;
    auto flush = [&](int hi) { if (hi > lo) { a.ph_lo = lo; a.ph_hi = hi; a.li = li++; hipLaunchKernelGGL(mk_fwd, dim3(grid), dim3(NTHREADS), LDS_BYTES, stream, a); } lo = hi; };
    for (int ph = 1; ph < NPHASE; ++ph) {
        const int type = (ph - 1) & 7, layer = (ph - 1) >> 3;
        if ((NAIVE_MASK >> type) & 1u) {
            if (type == PH_A) flush(ph + 1); else { flush(ph); lo = ph + 1; }
            launch_naive(type, layer, a, stream); }
    }
    flush(NPHASE);
}
```

```cpp
#include <hip/hip_runtime.h>
#include <cstdio>
#include <cstdint>

#define GAS __attribute__((address_space(1)))
#define LAS __attribute__((address_space(3)))
typedef unsigned short bf16;
typedef float f32x4 __attribute__((ext_vector_type(4)));
typedef float f32x2 __attribute__((ext_vector_type(2)));
typedef unsigned u32x4 __attribute__((ext_vector_type(4)));
typedef unsigned u32x2 __attribute__((ext_vector_type(2)));
typedef GAS unsigned gu32;

constexpr int DM = 2048, SEQ = 8192, NMETA = 16, NTOK = SEQ + NMETA, MROWS = 8448;
constexpr int HD = 128, NHEAD = 8;
constexpr int QKV_N = 6144, G_N = 4096, INP_N = 10240, INP_SRC = 10248, FCOL = 6144;
constexpr int NE = 16, FF = 1024, NSLOT_MAX = 20480;
constexpr float ALPHA = 1.4142135623730951f, LN_EPS = 1e-5f;
constexpr float LOG2E = 1.4426950408889634f;
constexpr float QSCALE = 0.08838834764831845f * 1.4426950408889634f;
constexpr int NLAYER = 2, NPHASE = 1 + 8 * NLAYER;
enum { PH_A = 0, PH_B = 1, PH_C = 2, PH_D = 3, PH_E = 4, PH_F = 5, PH_G = 6, PH_H = 7 };

#ifndef NAIVE_MASK
#define NAIVE_MASK 0x00u
#endif
#ifndef DBL_MASK
#define DBL_MASK 0u
#endif
constexpr size_t MiB = 1u << 20;
constexpr size_t WS_CTL = 0, CTL_ZERO_BYTES = 1 * MiB;
constexpr size_t WS_WIN = 2 * MiB, WIN_L = 40 * MiB;
constexpr size_t WS_WB = 82 * MiB, WB_L = 8 * MiB;
constexpr size_t WS_WOUT = 98 * MiB, WOUT_L = 8 * MiB;
constexpr size_t WS_WGU = 114 * MiB, WGU_L = 128 * MiB, WGU_E = 8 * MiB;
constexpr size_t WS_WD = 370 * MiB, WD_L = 64 * MiB, WD_E = 4 * MiB;
constexpr size_t WS_HF = 498 * MiB;
constexpr size_t WS_HB = 564 * MiB;
constexpr size_t WS_RB = 597 * MiB;
constexpr size_t WS_QKV = 663 * MiB;
constexpr size_t WS_GB = 762 * MiB;
constexpr size_t WS_YB = 828 * MiB;
constexpr size_t WS_MG = 861 * MiB;
constexpr size_t WS_ACT = 663 * MiB;
constexpr size_t WS_OSL = 703 * MiB;
constexpr size_t WS_LOGF = 894 * MiB;
constexpr size_t WS_CUM = 895 * MiB;
constexpr size_t WS_ELIST = 896 * MiB;
constexpr size_t WS_TOKI = 897 * MiB;
constexpr size_t WS_H8 = 898 * MiB;
constexpr size_t WS_END = 916 * MiB;
constexpr int CW_CNT = 1024;
constexpr int CW_KMAX = 4096;
constexpr int CW_BAR = 8192;
#define XCD_BAR_WORDS 3456
constexpr int MAX_LAUNCH = 20;
static_assert((CW_BAR + MAX_LAUNCH * XCD_BAR_WORDS) * 4 <= (int)CTL_ZERO_BYTES, "ctl");

constexpr int NWAVES = 8, NTHREADS = 512;
constexpr int RING_BYTES = 131072, MISC_OFF = RING_BYTES + 320, LDS_BYTES = 147456;

constexpr float W8_SCALE = 64.f, H8_SCALE = 4.f, MG8_SCALE = 16.f, ACT8_SCALE = 4.f, Y8_SCALE = 16.f;
constexpr int SC_W = 0x79797979, SC_H = 0x7D7D7D7D, SC_MG = 0x7B7B7B7B, SC_ACT = 0x7D7D7D7D, SC_Y = 0x7B7B7B7B;
__device__ __forceinline__ unsigned f2bf(float f) { unsigned u = __builtin_bit_cast(unsigned, f); return (u + 0x7fffu + ((u >> 16) & 1u)) >> 16; }
__device__ __forceinline__ unsigned pk2(float lo, float hi) { return f2bf(lo) | (f2bf(hi) << 16); }
__device__ __forceinline__ unsigned pk4_fp8(float a, float b, float c, float d) {
    a = __builtin_amdgcn_fmed3f(a, -448.f, 448.f); b = __builtin_amdgcn_fmed3f(b, -448.f, 448.f); c = __builtin_amdgcn_fmed3f(c, -448.f, 448.f); d = __builtin_amdgcn_fmed3f(d, -448.f, 448.f);
    int w = 0; w = __builtin_amdgcn_cvt_pk_fp8_f32(a, b, w, false); w = __builtin_amdgcn_cvt_pk_fp8_f32(c, d, w, true); return (unsigned)w; }
__device__ __forceinline__ float bflo(unsigned w) { return __builtin_bit_cast(float, w << 16); }
__device__ __forceinline__ float bfhi(unsigned w) { return __builtin_bit_cast(float, w & 0xffff0000u); }
__device__ __forceinline__ float bf2f(bf16 b) { return __builtin_bit_cast(float, ((unsigned)b) << 16); }
__device__ __forceinline__ float wave_sum(float v) {
#pragma unroll
    for (int o = 1; o < 64; o <<= 1) v += __shfl_xor(v, o);
    return v;
}
__device__ __forceinline__ float wave_max(float v) {
#pragma unroll
    for (int o = 1; o < 64; o <<= 1) v = fmaxf(v, __shfl_xor(v, o));
    return v;
}
__device__ __forceinline__ int row_of_p(int p) { return p < NMETA ? SEQ + p : p - NMETA; }
__device__ __forceinline__ float sigmoidf_(float x) { return 1.0f / (1.0f + __expf(-x)); }
__device__ __forceinline__ float dot8(u32x4 a, u32x4 b, float acc) {
    acc = fmaf(bflo(a.x), bflo(b.x), acc); acc = fmaf(bfhi(a.x), bfhi(b.x), acc);
    acc = fmaf(bflo(a.y), bflo(b.y), acc); acc = fmaf(bfhi(a.y), bfhi(b.y), acc);
    acc = fmaf(bflo(a.z), bflo(b.z), acc); acc = fmaf(bfhi(a.z), bfhi(b.z), acc);
    acc = fmaf(bflo(a.w), bflo(b.w), acc); acc = fmaf(bfhi(a.w), bfhi(b.w), acc);
    return acc;
}

struct Args { const float* in[18]; float* out; unsigned char* ws; int ph_lo, ph_hi; unsigned naive; int li; };
enum { I_X = 0, I_META, I_LNIN_G, I_LNIN_B, I_WIN, I_BF, I_WBSB, I_WBFX, I_WOUT, I_LNMIX_G, I_LNMIX_B, I_WR, I_RB, I_WG, I_WU, I_WD, I_LNFFN_G, I_LNFFN_B };

__device__ __forceinline__ int moe_cnt(const unsigned* ctl, int layer, int e) { return (int)ctl[CW_CNT + (layer * NE + e) * 64]; }
__device__ __forceinline__ bool moe_find(const unsigned* ctl, int layer, int s0, int& e_out, int& cnt_out, int& ps_out) {
    int acc = 0; e_out = -1; cnt_out = 0; ps_out = 0;
#pragma unroll
    for (int e = 0; e < NE; ++e) { const int c = moe_cnt(ctl, layer, e), nb = (c + 255) >> 8;
        if (e_out < 0 && s0 < (acc + nb) * 256) { e_out = e; cnt_out = c; ps_out = acc * 256; }
        acc += nb; }
    return e_out >= 0;
}
__device__ __forceinline__ int moe_nb(const unsigned* ctl, int layer) { int acc = 0;
#pragma unroll
    for (int e = 0; e < NE; ++e) acc += (moe_cnt(ctl, layer, e) + 255) >> 8;
    return acc; }
__device__ __forceinline__ int moe_pstart(const unsigned* ctl, int layer, int ex) {
    int acc = 0, r = 0;
#pragma unroll
    for (int e = 0; e < NE; ++e) { const int c = moe_cnt(ctl, layer, e); if (e == ex) r = acc * 256; acc += (c + 255) >> 8; }
    return r;
}

__device__ __forceinline__ void inproj_store(unsigned char* ws, int row, int n, float v, unsigned* kmax = nullptr) {
    if (n < QKV_N) { const bool isq = (n < 1024) || (n >= 3072 && n < 4096); ((bf16*)(ws + WS_QKV))[(size_t)row * QKV_N + n] = (bf16)f2bf(isq ? v * QSCALE : v); }
    else ((bf16*)(ws + WS_GB))[(size_t)row * G_N + (n - QKV_N)] = (bf16)f2bf(sigmoidf_(v));
}

__device__ __forceinline__ void dot4(const bf16* a0, const bf16* a1, const bf16* a2, const bf16* a3, const bf16* b, int K, float (&acc)[4]) {
    for (int k = 0; k < K; k += 8) {
        const u32x4 bv = *(const u32x4*)(b + k);
        acc[0] = dot8(*(const u32x4*)(a0 + k), bv, acc[0]); acc[1] = dot8(*(const u32x4*)(a1 + k), bv, acc[1]);
        acc[2] = dot8(*(const u32x4*)(a2 + k), bv, acc[2]); acc[3] = dot8(*(const u32x4*)(a3 + k), bv, acc[3]);
    }
}
__global__ void __launch_bounds__(256) naive_inproj(Args a, int layer) {
    const int n = blockIdx.x * 256 + threadIdx.x, r0 = blockIdx.y * 4;
    const bf16* A = (const bf16*)(a.ws + WS_HB) + (size_t)r0 * DM; const bf16* B = (const bf16*)(a.ws + WS_WIN + layer * WIN_L) + (size_t)n * DM;
    float acc[4] = {0.f, 0.f, 0.f, 0.f};
    dot4(A, A + DM, A + 2 * DM, A + 3 * DM, B, DM, acc);
    for (int i = 0; i < 4; ++i) inproj_store(a.ws, r0 + i, n, acc[i]);
}
__global__ void __launch_bounds__(256) naive_branch(Args a, int layer) {
    const int n = blockIdx.x * 256 + threadIdx.x, r0 = blockIdx.y * 4;
    const bf16* A = (const bf16*)(a.ws + WS_YB) + (size_t)r0 * DM; const bf16* B = (const bf16*)(a.ws + WS_WB + layer * WB_L) + (size_t)n * DM;
    float s[4] = {0.f, 0.f, 0.f, 0.f}, f[4] = {0.f, 0.f, 0.f, 0.f};
    dot4(A, A + DM, A + 2 * DM, A + 3 * DM, B, 1024, s);
    dot4(A + 1024, A + DM + 1024, A + 2 * DM + 1024, A + 3 * DM + 1024, B + 1024, 1024, f);
    const bf16* G = (const bf16*)(a.ws + WS_GB);
    for (int i = 0; i < 4; ++i) { const size_t r = r0 + i; const float gs = bf2f(G[r * G_N + n]), gf = bf2f(G[r * G_N + DM + n]);
        ((bf16*)(a.ws + WS_MG))[r * DM + n] = (bf16)f2bf(gs * s[i] + gf * f[i]); }
}
__global__ void __launch_bounds__(256) naive_outproj(Args a, int layer) {
    const int n = blockIdx.x * 256 + threadIdx.x, r0 = blockIdx.y * 4;
    const bf16* A = (const bf16*)(a.ws + WS_MG) + (size_t)r0 * DM; const bf16* B = (const bf16*)(a.ws + WS_WOUT + layer * WOUT_L) + (size_t)n * DM;
    float acc[4] = {0.f, 0.f, 0.f, 0.f};
    dot4(A, A + DM, A + 2 * DM, A + 3 * DM, B, DM, acc);
    const float* HF = (const float*)(a.ws + WS_HF); float* R = (float*)(a.ws + WS_RB);
    for (int i = 0; i < 4; ++i) { const size_t o = (size_t)(r0 + i) * DM + n; R[o] = ALPHA * HF[o] + acc[i]; }
}
__global__ void __launch_bounds__(256) naive_moe_gu(Args a, int layer) {
    const int j = blockIdx.x * 256 + threadIdx.x, s0 = blockIdx.y * 4;
    int e, cnt, ps; if (!moe_find((const unsigned*)(a.ws + WS_CTL), layer, s0, e, cnt, ps)) return;
    const int* elist = (const int*)(a.ws + WS_ELIST) + (size_t)e * MROWS;
    const bf16* HB = (const bf16*)(a.ws + WS_HB);
    const int rank = s0 - ps;
    const bf16* ap0 = HB + (size_t)(rank + 0 < cnt ? elist[rank + 0] : 0) * DM; const bf16* ap1 = HB + (size_t)(rank + 1 < cnt ? elist[rank + 1] : 0) * DM;
    const bf16* ap2 = HB + (size_t)(rank + 2 < cnt ? elist[rank + 2] : 0) * DM; const bf16* ap3 = HB + (size_t)(rank + 3 < cnt ? elist[rank + 3] : 0) * DM;
    const bf16* W = (const bf16*)(a.ws + WS_WGU + layer * WGU_L + e * WGU_E);
    const int rg = 256 * (j >> 7) + (j & 127);
    float g[4] = {0.f, 0.f, 0.f, 0.f}, u[4] = {0.f, 0.f, 0.f, 0.f};
    dot4(ap0, ap1, ap2, ap3, W + (size_t)rg * DM, DM, g);
    dot4(ap0, ap1, ap2, ap3, W + (size_t)(rg + 128) * DM, DM, u);
    bf16* act = (bf16*)(a.ws + WS_ACT);
#pragma unroll
    for (int i = 0; i < 4; ++i) act[(size_t)(s0 + i) * FF + j] = (bf16)f2bf(g[i] * sigmoidf_(g[i]) * u[i]);
}
__global__ void __launch_bounds__(256) naive_moe_down(Args a, int layer) {
    const int n = blockIdx.x * 256 + threadIdx.x, s0 = blockIdx.y * 4;
    int e, cnt, ps; if (!moe_find((const unsigned*)(a.ws + WS_CTL), layer, s0, e, cnt, ps)) return;
    const bf16* A = (const bf16*)(a.ws + WS_ACT) + (size_t)s0 * FF; const bf16* B = (const bf16*)(a.ws + WS_WD + layer * WD_L + e * WD_E) + (size_t)n * FF;
    float acc[4] = {0.f, 0.f, 0.f, 0.f};
    dot4(A, A + FF, A + 2 * FF, A + 3 * FF, B, FF, acc);
    bf16* O = (bf16*)(a.ws + WS_OSL);
#pragma unroll
    for (int i = 0; i < 4; ++i) O[(size_t)(s0 + i) * DM + n] = (bf16)f2bf(acc[i]);
}
__global__ void __launch_bounds__(256) naive_attn(Args a, int nq) {
    const int lane = threadIdx.x & 63, widx = blockIdx.x * 4 + (threadIdx.x >> 6);
    const int th = widx / nq, pq = nq - 1 - (widx % nq);
    if (th >= 16) return;
    const int type = th >> 3, head = th & 7;
    const bf16* QKV = (const bf16*)(a.ws + WS_QKV);
    const int qcol = (type ? 3072 : 0) + head * HD, kcol = qcol + 1024, vcol = qcol + 2048;
    const int rowq = row_of_p(pq);
    u32x4 q[16];
#pragma unroll
    for (int i = 0; i < 16; ++i) q[i] = *(const u32x4*)(QKV + (size_t)rowq * QKV_N + qcol + 8 * i);
    const float* cum = (const float*)(a.ws + WS_CUM) + (size_t)head * MROWS;
    float o0 = 0.f, o1 = 0.f, carry = 0.f, m = -1e30f, l = 0.f;
    const float cq = type ? cum[pq] : 0.f;
    for (int phi = type ? pq : pq - 1; phi >= 0; phi -= 64) {
        const int p = phi - lane; const bool valid = p >= 0; const int pr = row_of_p(valid ? p : 0);
        float u = 0.f;
        const bf16* kp = QKV + (size_t)pr * QKV_N + kcol;
#pragma unroll
        for (int i = 0; i < 16; ++i) u = dot8(q[i], *(const u32x4*)(kp + 8 * i), u);
        float w;
        if (type == 0) {
            const float aa = exp2f(-fabsf(u)), b = log2f(1.0f + aa);
            float lk = fminf(-u, 0.f) - b; const float lb = lk + u;
            if (!valid) lk = 0.f;
            float inc = lk;
#pragma unroll
            for (int off = 1; off < 64; off <<= 1) { const float t = __shfl_up(inc, off); if (lane >= off) inc += t; }
            const float after = carry + inc - lk;
            w = valid ? exp2f(lb + after) : 0.f;
            carry += __shfl(inc, 63);
        } else {
            const float s = valid ? u + cq - cum[valid ? p : 0] : -__builtin_inff();
            const float cm = wave_max(s), mn = fmaxf(m, cm), alpha = exp2f(m - mn);
            w = valid ? exp2f(s - mn) : 0.f;
            l = l * alpha + wave_sum(w); o0 *= alpha; o1 *= alpha; m = mn;
        }
        for (int j = 0; j < 64; ++j) {
            const float wj = __shfl(w, j); const int prj = __shfl(pr, j);
            const unsigned vv = *(const unsigned*)(QKV + (size_t)prj * QKV_N + vcol + 2 * lane);
            o0 = fmaf(wj, bflo(vv), o0); o1 = fmaf(wj, bfhi(vv), o1);
        }
    }
    if (type) { const float rl = 1.0f / l; o0 *= rl; o1 *= rl; }
    *(unsigned*)((bf16*)(a.ws + WS_YB) + (size_t)rowq * DM + type * 1024 + head * HD + 2 * lane) = pk2(o0, o1);
}

#define XB_TMO      128
#define XB_XCNT(j)  (256  + 64 * (j))
#define XB_XSUB(j)  (1280 + 64 * (j))
#define XB_XGEN(j)  (2304 + 64 * (j))
#define XB_TOP      3328
#define XB_TOPGEN   3392
#define XB_SPIN_CAP (1u << 18)
__device__ __forceinline__ unsigned xb_ld(unsigned* p)              { return __hip_atomic_load(p, __ATOMIC_RELAXED, __HIP_MEMORY_SCOPE_AGENT); }
__device__ __forceinline__ unsigned xb_add(unsigned* p, unsigned v) { return __hip_atomic_fetch_add(p, v, __ATOMIC_RELAXED, __HIP_MEMORY_SCOPE_AGENT); }
__device__ __forceinline__ unsigned xb_xcc_id() { return (unsigned)__builtin_amdgcn_s_getreg((3 << 11) | 20) & 0xFu; }
#define XB_SPIN(cond, bar) do { unsigned _sp = 0; while (cond) { __builtin_amdgcn_s_sleep(1); \
    if ((++_sp & 255u) == 0u) { if (xb_ld(&(bar)[XB_TMO])) break; if (_sp > XB_SPIN_CAP) { atomicAdd(&(bar)[XB_TMO], 1u); break; } } } } while (0)
struct XcdBarrier { unsigned* bar; unsigned x; volatile LAS unsigned* st; };
__device__ __forceinline__ XcdBarrier xcd_barrier_post(unsigned* bar, volatile LAS unsigned* st) {
    XcdBarrier b; b.bar = bar; b.x = xb_xcc_id(); b.st = st;
    if (threadIdx.x == 0) (void)xb_add(&bar[XB_XCNT(b.x)], 1u);
    return b;
}
__device__ __forceinline__ void xcd_barrier_complete(unsigned* bar, unsigned x, unsigned& nloc, unsigned& nx) {
    const unsigned G = gridDim.x * gridDim.y * gridDim.z;
    unsigned sum, cnt, mine, sp = 0u;
    for (;;) {
        sum = 0u; cnt = 0u; mine = 0u;
#pragma unroll
        for (unsigned j = 0; j < 16; ++j) { const unsigned c = xb_ld(&bar[XB_XCNT(j)]); sum += c; cnt += (c > 0u) ? 1u : 0u; mine = (j == x) ? c : mine; }
        if (sum == G) break;
        __builtin_amdgcn_s_sleep(1);
        if ((++sp & 255u) == 0u) { if (xb_ld(&bar[XB_TMO])) break; if (sp > XB_SPIN_CAP) { atomicAdd(&bar[XB_TMO], 1u); break; } }
    }
    nloc = mine > 0u ? mine : 1u; nx = cnt > 0u ? cnt : 1u;
}
__device__ __forceinline__ void xcd_barrier(const XcdBarrier& b) {
    asm volatile("s_waitcnt vmcnt(0)" ::: "memory");
    __syncthreads();
    if (threadIdx.x == 0) {
        unsigned* bar = b.bar;
        __builtin_amdgcn_s_waitcnt(0);
        unsigned nloc = b.st[0], nx = b.st[1];
        if (nloc == 0u) { xcd_barrier_complete(bar, b.x, nloc, nx); b.st[0] = nloc; b.st[1] = nx; }
        const unsigned old = xb_add(&bar[XB_XSUB(b.x)], 1u);
        const unsigned gen = old / nloc;
        if (old + 1u == (gen + 1u) * nloc) {
            __builtin_amdgcn_fence(__ATOMIC_RELEASE, "agent");
            asm volatile("s_waitcnt vmcnt(0)" ::: "memory");
            const unsigned og = xb_add(&bar[XB_TOP], 1u);
            const unsigned tg = og / nx;
            if (og + 1u == (tg + 1u) * nx) xb_add(&bar[XB_TOPGEN], 1u);
            else XB_SPIN(xb_ld(&bar[XB_TOPGEN]) == tg, bar);
            __builtin_amdgcn_fence(__ATOMIC_ACQUIRE, "agent");
            xb_add(&bar[XB_XGEN(b.x)], 1u);
            asm volatile("s_waitcnt vmcnt(0)" ::: "memory");
        } else {
            XB_SPIN(xb_ld(&bar[XB_XGEN(b.x)]) == gen, bar);
            __builtin_amdgcn_fence(__ATOMIC_ACQUIRE, "agent");
            asm volatile("s_waitcnt vmcnt(0)" ::: "memory");
        }
    }
    __syncthreads();
}

struct Frame {
    LAS unsigned char* lds; unsigned char* ws; unsigned* ctl;
    int tid, lane, wave, G, gw, NGW;
    const float* const* in; float* out;
};
#define LDS_WAIT() asm volatile("s_waitcnt lgkmcnt(0)" ::: "memory")

__device__ __forceinline__ void transpose_item(const float* W, size_t ldw, bf16* WT, size_t ldt, LAS float* scr, int lane) {
#pragma unroll 8
    for (int i = 0; i < 32; ++i) { const int kk = 2 * i + (lane >> 5); scr[kk * 33 + (lane & 31)] = W[(size_t)kk * ldw + (lane & 31)]; }
    LDS_WAIT(); asm volatile("" ::: "memory");
    const int c = lane & 7;
#pragma unroll
    for (int j = 0; j < 4; ++j) { const int n = (lane >> 3) + 8 * j; const LAS float* s = scr + (8 * c) * 33 + n;
        u32x4 o; o.x = pk2(s[0 * 33], s[1 * 33]); o.y = pk2(s[2 * 33], s[3 * 33]); o.z = pk2(s[4 * 33], s[5 * 33]); o.w = pk2(s[6 * 33], s[7 * 33]);
        *(u32x4*)(WT + (size_t)n * ldt + 8 * c) = o; }
    LDS_WAIT(); asm volatile("" ::: "memory");
}
__device__ __forceinline__ void transpose_item8(const float* W, size_t ldw, unsigned char* WT, size_t ldt, LAS float* scr, int lane) {
#pragma unroll 8
    for (int i = 0; i < 32; ++i) { const int kk = 2 * i + (lane >> 5); scr[kk * 33 + (lane & 31)] = W[(size_t)kk * ldw + (lane & 31)]; }
    LDS_WAIT(); asm volatile("" ::: "memory");
    const int c = lane & 3;
#pragma unroll
    for (int j = 0; j < 2; ++j) { const int n = (lane >> 2) + 16 * j; const LAS float* p = scr + (16 * c) * 33 + n;
        u32x4 o;
        o.x = pk4_fp8(p[0 * 33] * W8_SCALE, p[1 * 33] * W8_SCALE, p[2 * 33] * W8_SCALE, p[3 * 33] * W8_SCALE); o.y = pk4_fp8(p[4 * 33] * W8_SCALE, p[5 * 33] * W8_SCALE, p[6 * 33] * W8_SCALE, p[7 * 33] * W8_SCALE);
        o.z = pk4_fp8(p[8 * 33] * W8_SCALE, p[9 * 33] * W8_SCALE, p[10 * 33] * W8_SCALE, p[11 * 33] * W8_SCALE); o.w = pk4_fp8(p[12 * 33] * W8_SCALE, p[13 * 33] * W8_SCALE, p[14 * 33] * W8_SCALE, p[15 * 33] * W8_SCALE);
        *(u32x4*)(WT + (size_t)n * ldt + 16 * c) = o; }
    LDS_WAIT(); asm volatile("" ::: "memory");
}
__device__ __forceinline__ void convert_item(Frame& F, int it, LAS float* scr) {
    constexpr int I_IN = 32 * 320, I_BS = 16 * 64, I_OUT = 32 * 64, I_GE = 32 * 32, I_DE = 16 * 64;
    constexpr int PER_LAYER = I_IN + 2 * I_BS + I_OUT + NE * (2 * I_GE + I_DE);
    const int l = it / PER_LAYER; int r = it % PER_LAYER;
    if (r < I_IN) { const int kb = r / 320, nb = r % 320, nd = 32 * nb, ns = nd + (nd >= FCOL ? 8 : 0);
        transpose_item8(F.in[I_WIN] + (size_t)l * DM * INP_SRC + (size_t)(64 * kb) * INP_SRC + ns, INP_SRC, F.ws + WS_WIN + l * WIN_L + (size_t)nd * DM + 64 * kb, DM, scr, F.lane); return; }
    r -= I_IN;
    if (r < 2 * I_BS) { const int which = r / I_BS; r %= I_BS; const int kb = r / 64, nb = r % 64;
        transpose_item8((which ? F.in[I_WBFX] : F.in[I_WBSB]) + (size_t)l * 1024 * DM + (size_t)(64 * kb) * DM + 32 * nb, DM, F.ws + WS_WB + l * WB_L + (size_t)(32 * nb) * DM + which * 1024 + 64 * kb, DM, scr, F.lane); return; }
    r -= 2 * I_BS;
    if (r < I_OUT) { const int kb = r / 64, nb = r % 64;
        transpose_item8(F.in[I_WOUT] + (size_t)l * DM * DM + (size_t)(64 * kb) * DM + 32 * nb, DM, F.ws + WS_WOUT + l * WOUT_L + (size_t)(32 * nb) * DM + 64 * kb, DM, scr, F.lane); return; }
    r -= I_OUT;
    const int e = r / (2 * I_GE + I_DE); r %= (2 * I_GE + I_DE);
    if (r < 2 * I_GE) { const int which = r / I_GE; r %= I_GE; const int kb = r / 32, nb = r % 32, n0 = 32 * nb, rho = 256 * (n0 >> 7) + (n0 & 127) + which * 128;
        transpose_item8((which ? F.in[I_WU] : F.in[I_WG]) + ((size_t)(l * NE + e) * DM + 64 * kb) * FF + n0, FF, F.ws + WS_WGU + l * WGU_L + e * WGU_E + (size_t)rho * DM + 64 * kb, DM, scr, F.lane); return; }
    r -= 2 * I_GE;
    { const int kb = r / 64, nb = r % 64;
        transpose_item8(F.in[I_WD] + ((size_t)(l * NE + e) * FF + 64 * kb) * DM + 32 * nb, DM, F.ws + WS_WD + l * WD_L + e * WD_E + (size_t)(32 * nb) * FF + 64 * kb, FF, scr, F.lane); }
}
constexpr int N_CONVERT_ITEMS = NLAYER * (32 * 320 + 2 * 16 * 64 + 32 * 64 + NE * (2 * 32 * 32 + 16 * 64));
constexpr int CV_PER_LAYER = N_CONVERT_ITEMS / NLAYER, CV_G0_END = 32 * 320, CV_G1_END = CV_PER_LAYER + 32 * 320, CV_BUNDLE = 128;
static_assert((CV_G1_END - CV_G0_END) % CV_BUNDLE == 0 && (N_CONVERT_ITEMS - CV_G1_END) % CV_BUNDLE == 0, "bundles");
__device__ __forceinline__ void convert_bundle(Frame& F, int first_item) {
    LAS float* scr = (LAS float*)(F.lds + F.wave * 16384);
    for (int i = 0; i < CV_BUNDLE / NWAVES; ++i) convert_item(F, first_item + F.wave + NWAVES * i, scr);
}

__device__ __forceinline__ int tab_rowpos(int c) { return (c & 3) * 512 + (c >> 8) * 64 + ((c >> 2) & 63); }
template <int NC> __device__ __forceinline__ void stage_table(Frame& F, const float* src, size_t pitch) {
    constexpr int CH = NC / 4;
    for (int ci = F.tid; ci < DM * CH; ci += NTHREADS) { const int c = ci / CH, q = ci % CH;
        const f32x4 v = *(const f32x4*)(src + (size_t)c * pitch + 4 * q);
        const int sw = (NC == 16) ? ((c >> 4) & 3) : ((c >> 5) & 1);
        *(LAS f32x4*)(F.lds + tab_rowpos(c) * (NC * 4) + ((q ^ sw) << 4)) = v; }
    LDS_WAIT(); __syncthreads();
}
template <int NC> __device__ __forceinline__ void table_dot(Frame& F, const f32x4 (&y)[8], float (&acc)[NC]) {
    constexpr int CH = NC / 4; const int l = F.lane; const int sw = (NC == 16) ? ((l >> 2) & 3) : ((l >> 3) & 1);
#pragma unroll
    for (int e = 0; e < NC; ++e) acc[e] = 0.f;
#pragma unroll
    for (int j = 0; j < 8; ++j)
#pragma unroll
        for (int i = 0; i < 4; ++i) { const float yv = y[j][i]; const int rp = i * 512 + j * 64 + l; if (i == 0) asm volatile("" ::: "memory");
#pragma unroll
            for (int q = 0; q < CH; ++q) { const f32x4 w = *(const LAS f32x4*)(F.lds + rp * (NC * 4) + ((q ^ sw) << 4));
                acc[4 * q + 0] = fmaf(yv, w.x, acc[4 * q + 0]); acc[4 * q + 1] = fmaf(yv, w.y, acc[4 * q + 1]); acc[4 * q + 2] = fmaf(yv, w.z, acc[4 * q + 2]); acc[4 * q + 3] = fmaf(yv, w.w, acc[4 * q + 3]); } }
#pragma unroll
    for (int e = 0; e < NC; ++e) acc[e] = wave_sum(acc[e]);
}
__device__ __forceinline__ void ln_row(Frame& F, f32x4 (&v)[8], const float* g, const float* b) {
    float s = 0.f;
#pragma unroll
    for (int j = 0; j < 8; ++j) s += (v[j].x + v[j].y) + (v[j].z + v[j].w);
    const float mean = wave_sum(s) * (1.f / DM); float s2 = 0.f;
#pragma unroll
    for (int j = 0; j < 8; ++j) { v[j] = v[j] - mean; s2 += (v[j].x * v[j].x + v[j].y * v[j].y) + (v[j].z * v[j].z + v[j].w * v[j].w); }
    const float rstd = 1.0f / sqrtf(wave_sum(s2) * (1.f / DM) + LN_EPS);
#pragma unroll
    for (int j = 0; j < 8; ++j) { const f32x4 gv = *(const f32x4*)(g + 256 * j + 4 * F.lane), bv = *(const f32x4*)(b + 256 * j + 4 * F.lane); v[j] = v[j] * rstd * gv + bv; }
}
__device__ __forceinline__ void store_h(Frame& F, int row, const f32x4 (&y)[8], bool dry = false) {
    float* hf = (float*)(F.ws + (dry ? WS_YB : WS_HF)) + (size_t)row * DM; bf16* hb = (bf16*)(F.ws + (dry ? WS_GB + 21 * MiB : WS_HB)) + (size_t)row * DM;
    unsigned char* h8 = F.ws + (dry ? WS_GB + 21 * MiB : WS_H8) + (size_t)row * DM;
#pragma unroll
    for (int j = 0; j < 8; ++j) { *(f32x4*)(hf + 256 * j + 4 * F.lane) = y[j]; if (NAIVE_MASK != 0u) { u32x2 w; w.x = pk2(y[j].x, y[j].y); w.y = pk2(y[j].z, y[j].w); *(u32x2*)(hb + 256 * j + 4 * F.lane) = w; }
        *(unsigned*)(h8 + 256 * j + 4 * F.lane) = pk4_fp8(y[j].x * H8_SCALE, y[j].y * H8_SCALE, y[j].z * H8_SCALE, y[j].w * H8_SCALE); }
}
__device__ __forceinline__ void store_logf(Frame& F, int row, const f32x4 (&y)[8], const float* bfor) {
    float acc[8]; table_dot<8>(F, y, acc);
    if (F.lane < 8) { float a = acc[0];
#pragma unroll
        for (int h = 1; h < 8; ++h) a = (F.lane == h) ? acc[h] : a;
        const float x = a + bfor[F.lane];
        const float ls = fminf(x, 0.f) - log1pf(__expf(-fabsf(x)));
        ((float*)(F.ws + WS_LOGF))[(size_t)row * 8 + F.lane] = ls; }
}

__device__ __forceinline__ void phase_prologue(Frame& F) {
    LAS float* scr = (LAS float*)(F.lds + F.wave * 16384);
    for (int it = F.gw; it < CV_G0_END; it += F.NGW) convert_item(F, it, scr);
    __syncthreads();
    stage_table<8>(F, F.in[I_WIN] + FCOL, INP_SRC);
    for (int row = F.gw; row < NTOK; row += F.NGW) {
        const float* src = row < SEQ ? F.in[I_X] + (size_t)row * DM : F.in[I_META] + (size_t)(row - SEQ) * DM;
        f32x4 v[8];
#pragma unroll
        for (int j = 0; j < 8; ++j) v[j] = *(const f32x4*)(src + 256 * j + 4 * F.lane);
        ln_row(F, v, F.in[I_LNIN_G], F.in[I_LNIN_B]);
        store_h(F, row, v);
        store_logf(F, row, v, F.in[I_BF]);
    }
    for (int row = NTOK + F.gw; row < MROWS; row += F.NGW) { bf16* hb = (bf16*)(F.ws + WS_HB) + (size_t)row * DM;
#pragma unroll
        for (int j = 0; j < 4; ++j) *(u32x4*)(hb + 512 * j + 8 * F.lane) = (u32x4){0u, 0u, 0u, 0u}; }
    __syncthreads();
}
__device__ __forceinline__ void phase_tilesuf(Frame& F) {
    if (blockIdx.x > SEQ / 64) return;
    const int tile = blockIdx.x, h = F.wave, row = tile * 64 + F.lane;
    const float v = (row < NTOK) ? LOG2E * ((const float*)(F.ws + WS_LOGF))[(size_t)row * 8 + h] : 0.f;
    float inc = v;
#pragma unroll
    for (int off = 1; off < 64; off <<= 1) { const float t = __shfl_down(inc, off); if (F.lane + off < 64) inc += t; }
    float* base = (float*)(F.ws + WS_CUM);
    base[(size_t)h * MROWS + row] = inc - v;
    if (F.lane == 0) base[(size_t)NHEAD * MROWS + h * 256 + tile] = inc;
}
__device__ __forceinline__ void phase_cumsum(Frame& F, bool do_scan) {
    if (blockIdx.x >= NHEAD) {
        if (blockIdx.x < NHEAD + 48) { bf16* q = (bf16*)(F.ws + WS_QKV) + (size_t)(NTOK + blockIdx.x - NHEAD) * QKV_N;
            for (int i = F.tid; i < QKV_N / 8; i += NTHREADS) *(u32x4*)(q + 8 * i) = (u32x4){0u, 0u, 0u, 0u}; }
        return; }
    if (!do_scan) return;
    const int h = blockIdx.x; const float* logf = (const float*)(F.ws + WS_LOGF); float* cum = (float*)(F.ws + WS_CUM) + (size_t)h * MROWS;
    constexpr int PER = 17; const int p0 = F.tid * PER;
    float loc[PER]; float s = 0.f;
#pragma unroll
    for (int i = 0; i < PER; ++i) { const int p = p0 + i; const float v = p < NTOK ? logf[(size_t)row_of_p(p) * 8 + h] : 0.f; s += v; loc[i] = s; }
    float inc = s;
#pragma unroll
    for (int off = 1; off < 64; off <<= 1) { const float t = __shfl_up(inc, off); if (F.lane >= off) inc += t; }
    LAS float* wt = (LAS float*)(F.lds);
    if (F.lane == 63) wt[F.wave] = inc;
    LDS_WAIT(); __syncthreads();
    float base = inc - s;
    for (int w = 0; w < F.wave; ++w) base += wt[w];
#pragma unroll
    for (int i = 0; i < PER; ++i) { const int p = p0 + i; if (p < NTOK) cum[p] = (base + loc[i]) * LOG2E; }
    LDS_WAIT(); __syncthreads();
}
__device__ __forceinline__ void phase_ln_router(Frame& F, int layer, bool dry = false) {
    stage_table<16>(F, F.in[I_WR], 16);
    const float* g = F.in[I_LNMIX_G] + layer * DM; const float* b = F.in[I_LNMIX_B] + layer * DM;
    const float* rbias = F.in[I_RB];
    const int nrows_e = layer == NLAYER - 1 ? SEQ : NTOK;
    f32x4 vn[8];
    if (F.gw < nrows_e) { const float* src = (const float*)(F.ws + WS_RB) + (size_t)F.gw * DM;
#pragma unroll
        for (int j = 0; j < 8; ++j) vn[j] = *(const f32x4*)(src + 256 * j + 4 * F.lane); }
    for (int row = F.gw; row < nrows_e; row += F.NGW) {
        f32x4 v[8];
#pragma unroll
        for (int j = 0; j < 8; ++j) v[j] = vn[j];
        if (row + F.NGW < nrows_e) { const float* src = (const float*)(F.ws + WS_RB) + (size_t)(row + F.NGW) * DM;
#pragma unroll
            for (int j = 0; j < 8; ++j) vn[j] = *(const f32x4*)(src + 256 * j + 4 * F.lane); }
        ln_row(F, v, g, b);
        store_h(F, row, v, dry);
        float lg[16]; table_dot<16>(F, v, lg);
        float aff[16], sel[16];
#pragma unroll
        for (int e = 0; e < 16; ++e) { aff[e] = 1.0f / (1.0f + __expf(-lg[e])); sel[e] = aff[e] + rbias[e]; }
        int bg = 0; float bs = -__builtin_inff();
#pragma unroll
        for (int gi = 0; gi < 4; ++gi) { const float a0 = sel[4 * gi], a1 = sel[4 * gi + 1], a2 = sel[4 * gi + 2], a3 = sel[4 * gi + 3];
            const float h1 = fmaxf(a0, a1), l1 = fminf(a0, a1), h2 = fmaxf(a2, a3), l2 = fminf(a2, a3);
            const float top = fmaxf(h1, h2), sec = fmaxf(fminf(h1, h2), fmaxf(l1, l2)), sc = top + sec;
            if (sc > bs) { bs = sc; bg = gi; } }
        float s4[4], a4[4];
#pragma unroll
        for (int i = 0; i < 4; ++i) { s4[i] = sel[i]; a4[i] = aff[i]; }
#pragma unroll
        for (int gi = 1; gi < 4; ++gi) if (bg == gi) {
#pragma unroll
            for (int i = 0; i < 4; ++i) { s4[i] = sel[4 * gi + i]; a4[i] = aff[4 * gi + i]; } }
        int i1 = 0; float m1 = s4[0];
#pragma unroll
        for (int i = 1; i < 4; ++i) if (s4[i] > m1) { m1 = s4[i]; i1 = i; }
        int i2 = -1; float m2 = -__builtin_inff();
#pragma unroll
        for (int i = 0; i < 4; ++i) if (i != i1 && s4[i] > m2) { m2 = s4[i]; i2 = i; }
        float af1 = a4[0], af2 = a4[0];
#pragma unroll
        for (int i = 1; i < 4; ++i) { if (i1 == i) af1 = a4[i]; if (i2 == i) af2 = a4[i]; }
        const float wsum = af1 + af2, w1 = af1 / wsum, w2 = af2 / wsum;
        const int e1 = 4 * bg + i1, e2 = 4 * bg + i2;
        if (dry) { if (F.lane == 0) ((float*)(F.ws + WS_GB + 60 * MiB))[row] = w1 + w2 + (float)(e1 + e2); }
        if (F.lane == 0 && !dry) {
            const int r1 = (int)atomicAdd(F.ctl + CW_CNT + (layer * NE + e1) * 64, 1u), r2 = (int)atomicAdd(F.ctl + CW_CNT + (layer * NE + e2) * 64, 1u);
            int* el = (int*)(F.ws + WS_ELIST); el[(size_t)e1 * MROWS + r1] = row; el[(size_t)e2 * MROWS + r2] = row;
            int* ti = (int*)(F.ws + WS_TOKI) + (size_t)row * 8;
            ti[0] = e1; ti[1] = e2; ti[2] = r1; ti[3] = r2; ti[4] = __builtin_bit_cast(int, w1); ti[5] = __builtin_bit_cast(int, w2);
        }
    }
    __syncthreads();
}
__device__ __forceinline__ void phase_ln_final(Frame& F, int layer, bool dry = false) {
    const bool last = layer == NLAYER - 1;
    if (!last) stage_table<8>(F, F.in[I_WIN] + (size_t)(layer + 1) * DM * INP_SRC + FCOL, INP_SRC);
    const float* g = F.in[I_LNFFN_G] + layer * DM; const float* b = F.in[I_LNFFN_B] + layer * DM;
    const int nrows = last ? SEQ : NTOK;
    const int* TI = (const int*)(F.ws + WS_TOKI); const bf16* OSL = (const bf16*)(F.ws + WS_OSL); const float* HFp = (const float*)(F.ws + WS_HF);
    int tA[6], tB[6]; f32x4 hvn[8]; u32x2 an[8], cn[8]; float w1n = 0.f, w2n = 0.f;
#define H_LOADTOK(dst, r_) do { _Pragma("unroll") for (int q_ = 0; q_ < 6; ++q_) dst[q_] = TI[(size_t)(r_) * 8 + q_]; } while (0)
#define H_ISSUE(tk, r_) do { const int ps1_ = moe_pstart(F.ctl, layer, tk[0]), ps2_ = moe_pstart(F.ctl, layer, tk[1]); \
        const bf16* o1_ = OSL + (size_t)(ps1_ + tk[2]) * DM; const bf16* o2_ = OSL + (size_t)(ps2_ + tk[3]) * DM; const float* hf_ = HFp + (size_t)(r_) * DM; \
        w1n = __builtin_bit_cast(float, tk[4]); w2n = __builtin_bit_cast(float, tk[5]); \
        _Pragma("unroll") for (int j = 0; j < 8; ++j) { hvn[j] = *(const f32x4*)(hf_ + 256 * j + 4 * F.lane); an[j] = *(const u32x2*)(o1_ + 256 * j + 4 * F.lane); cn[j] = *(const u32x2*)(o2_ + 256 * j + 4 * F.lane); } } while (0)
    if (F.gw < nrows) { H_LOADTOK(tA, F.gw); H_ISSUE(tA, F.gw); }
    if (F.gw + F.NGW < nrows) H_LOADTOK(tB, F.gw + F.NGW);
    for (int row = F.gw; row < nrows; row += F.NGW) {
        f32x4 v[8]; const float w1 = w1n, w2 = w2n;
#pragma unroll
        for (int j = 0; j < 8; ++j) { const f32x4 hv = hvn[j]; const u32x2 a = an[j], c = cn[j];
            v[j].x = ALPHA * hv.x + w1 * bflo(a.x) + w2 * bflo(c.x); v[j].y = ALPHA * hv.y + w1 * bfhi(a.x) + w2 * bfhi(c.x);
            v[j].z = ALPHA * hv.z + w1 * bflo(a.y) + w2 * bflo(c.y); v[j].w = ALPHA * hv.w + w1 * bfhi(a.y) + w2 * bfhi(c.y); }
        if (row + F.NGW < nrows) { H_ISSUE(tB, row + F.NGW); if (row + 2 * F.NGW < nrows) H_LOADTOK(tB, row + 2 * F.NGW); }
        ln_row(F, v, g, b);
        if (dry) { store_h(F, row, v, true); if (!last) { float acc8[8]; table_dot<8>(F, v, acc8); if (F.lane == 0) ((float*)(F.ws + WS_GB + 60 * MiB))[row] = acc8[0] + acc8[7]; } }
        else if (last) { float* o = F.out + (size_t)row * DM;
#pragma unroll
            for (int j = 0; j < 8; ++j) *(f32x4*)(o + 256 * j + 4 * F.lane) = v[j]; }
        else { store_h(F, row, v); store_logf(F, row, v, F.in[I_BF] + (layer + 1) * NHEAD); }
    }
#undef H_LOADTOK
#undef H_ISSUE
    __syncthreads();
}

namespace pg8 {
typedef short bf16x8 __attribute__((ext_vector_type(8)));
typedef int i32x4 __attribute__((ext_vector_type(4)));
typedef int i32x8 __attribute__((ext_vector_type(8)));
__device__ __forceinline__ i32x8 ld_frag(const LAS unsigned char* p) { const i32x4 x = *(const LAS i32x4*)p, y = *(const LAS i32x4*)(p + 1024); return __builtin_shufflevector(x, y, 0, 1, 2, 3, 4, 5, 6, 7); }
__device__ __forceinline__ bf16x8 frag_lo(i32x8 f) { return __builtin_bit_cast(bf16x8, (i32x4)__builtin_shufflevector(f, f, 0, 1, 2, 3)); }
__device__ __forceinline__ bf16x8 frag_hi(i32x8 f) { return __builtin_bit_cast(bf16x8, (i32x4)__builtin_shufflevector(f, f, 4, 5, 6, 7)); }
constexpr int BM = 256, BK = 64, HALF = 128, HTB = HALF * BK * 2, STAGE_BYTES = 8 * HTB, NXCD = 8, WGM = 8;
__host__ __device__ __forceinline__ int lds_byte(int r, int c) { const int st = (r >> 4) * 2 + (c >> 5), rr = r & 15, cc = c & 31, ob = rr * 64 + cc * 2; return st * 1024 + (ob ^ (((ob >> 9) & 1) << 5)); }
__host__ __device__ __forceinline__ void stage_rc(int b, int& R, int& C) { const int st = b / 1024, sb = b % 1024, swz = sb ^ (((sb >> 9) & 1) << 5); R = (st >> 1) * 16 + swz / 64; C = (st & 1) * 32 + (swz % 64) / 2; }
__host__ __device__ __forceinline__ int perm32(int rho) { const int n = rho >> 4, i = rho & 15; return 8 * (i >> 2) + 4 * n + (i & 3); }
struct Unit { int pm, pn, aux; };
__device__ __forceinline__ bool static_tile(int nM, int nN, int G, int c, int i, int& pm, int& pn) {
    const int nwg = nM * nN; const long L = (long)i * G + c; if (L >= nwg) return false;
    int wgid = (int)L; { const int q = nwg / NXCD, r = nwg % NXCD, xcd = wgid % NXCD, off = wgid / NXCD; wgid = (xcd < r ? xcd * (q + 1) : r * (q + 1) + (xcd - r) * q) + off; }
    const int nig = WGM * nN, gid = wgid / nig, fm = gid * WGM, gsz = (nM - fm) < WGM ? (nM - fm) : WGM;
    pm = fm + ((wgid % nig) % gsz); pn = (wgid % nig) / gsz; return true;
}
__device__ __forceinline__ unsigned cvt_pk_bf16(float lo, float hi) { unsigned r; asm volatile("v_cvt_pk_bf16_f32 %0, %1, %2" : "=v"(r) : "v"(lo), "v"(hi)); return r; }

template <class P>
__device__ __forceinline__ void gemm_phase(LAS unsigned char* lds, const P& prob) {
    const int tid = threadIdx.x, wid = __builtin_amdgcn_readfirstlane(tid >> 6), lane = tid & 63, wr = wid >> 2, wc = wid & 3, fr = lane & 15, fq = lane >> 4;
    constexpr int ES = P::FP8 ? 1 : 2;
    const int nt = prob.K * ES / (BK * 2);
    unsigned voffA[2], voffA1[2], voffB[2];
#pragma unroll
    for (int i = 0; i < 2; ++i) { int R, C; stage_rc(tid * 16 + i * 8192, R, C); const int Rb = P::PERM ? ((R & ~31) + perm32(R & 31)) : R;
        voffA[i] = (unsigned)(R * prob.lda * ES + C * 2); voffA1[i] = voffA[i]; voffB[i] = (unsigned)(Rb * prob.ldb * ES + C * 2); }
    const size_t kstep = (size_t)(BK * 2);
    const size_t hstepA = P::GATHER ? (size_t)0 : (size_t)HALF * prob.lda * ES, hstepB = (size_t)HALF * prob.ldb * ES;
    const unsigned ldsw = (unsigned)wid * 1024u;
    const int aoff = lds_byte(wr * 64 + fr, fq * 8), boff = lds_byte(wc * 32 + fr, fq * 8);
#define PG8_SA(b, h) (((b) * 2 + (h)) * HTB)
#define PG8_SB(b, h) ((4 + (b) * 2 + (h)) * HTB)
#define PG8_STAGE(bufoff, gbase, voff) do { _Pragma("unroll") for (int _i = 0; _i < 2; ++_i) \
        __builtin_amdgcn_global_load_lds((const unsigned*)((const char*)(gbase) + (voff)[_i]), (LAS unsigned*)(lds + (bufoff) + ldsw + _i * 8192), 16, 0, 0); } while (0)
#define PG8_LDA(dst, b, h) do { _Pragma("unroll") for (int m = 0; m < 4; ++m) dst[m] = ld_frag(lds + PG8_SA(b, h) + aoff + m * 2048); } while (0)
#define PG8_LDB(dst, b, h) do { _Pragma("unroll") for (int n = 0; n < 2; ++n) dst[n] = ld_frag(lds + PG8_SB(b, h) + boff + n * 2048); } while (0)
#define PG8_MMA(ai, bj, At, Bt) do { __builtin_amdgcn_s_setprio(1); _Pragma("unroll") for (int m = 0; m < 4; ++m) _Pragma("unroll") for (int n = 0; n < 2; ++n) { \
        if constexpr (P::FP8) asm volatile("v_mfma_scale_f32_16x16x128_f8f6f4 %0, %1, %2, %0, %3, %4 op_sel_hi:[0,0,0]" : "+v"(acc[ai][bj][m][n]) : "v"(Bt[n]), "v"(At[m]), "v"(scb), "v"(sca)); \
        else { acc[ai][bj][m][n] = __builtin_amdgcn_mfma_f32_16x16x32_bf16(frag_lo(Bt[n]), frag_lo(At[m]), acc[ai][bj][m][n], 0, 0, 0); \
               acc[ai][bj][m][n] = __builtin_amdgcn_mfma_f32_16x16x32_bf16(frag_hi(Bt[n]), frag_hi(At[m]), acc[ai][bj][m][n], 0, 0, 0); } } __builtin_amdgcn_s_setprio(0); } while (0)
#define PG8_WAIT_V(n) asm volatile("s_waitcnt vmcnt(" #n ")" ::: "memory")
#define PG8_WAIT_L(n) asm volatile("s_waitcnt lgkmcnt(" #n ")" ::: "memory")
#define PG8_BAR __builtin_amdgcn_s_barrier()
#define PG8_SCHED __builtin_amdgcn_sched_barrier(0)
#define PG8_GATHER_OFFS(ui_, d0, d1) do { _Pragma("unroll") for (int _i = 0; _i < 2; ++_i) { int R_, C_; stage_rc(tid * 16 + _i * 8192, R_, C_); \
        d0[_i] = (unsigned)(prob.a_row(ui_, R_) * prob.lda * ES + C_ * 2); d1[_i] = (unsigned)(prob.a_row(ui_, HALF + R_) * prob.lda * ES + C_ * 2); } } while (0)
    Unit cur, nxt; int ui = 0;
    if (!prob.next(0, cur)) return;
    f32x4 acc[2][2][4][2];
#pragma unroll
    for (int a = 0; a < 2; ++a)
#pragma unroll
        for (int b = 0; b < 2; ++b)
#pragma unroll
            for (int m = 0; m < 4; ++m)
#pragma unroll
                for (int n = 0; n < 2; ++n) acc[a][b][m][n] = (f32x4){0.f, 0.f, 0.f, 0.f};
    const int sca = prob.sc_a, scb = prob.sc_b;
    i32x8 At[4], B0[2], B1[2];
    const char* cA = prob.a_ptr(cur); const char* cB = prob.b_ptr(cur);
    if constexpr (P::GATHER) PG8_GATHER_OFFS(0, voffA, voffA1);
    PG8_STAGE(PG8_SB(0, 0), cB, voffB); PG8_STAGE(PG8_SB(0, 1), cB + hstepB, voffB); PG8_STAGE(PG8_SA(0, 0), cA, voffA); PG8_STAGE(PG8_SA(0, 1), cA + hstepA, voffA1);
    if (wr == 1) PG8_BAR;
    PG8_WAIT_V(2); PG8_BAR;
    PG8_STAGE(PG8_SB(1, 0), cB + kstep, voffB); PG8_STAGE(PG8_SA(1, 0), cA + kstep, voffA); PG8_STAGE(PG8_SB(1, 1), cB + hstepB + kstep, voffB);
    PG8_WAIT_V(6); PG8_BAR;
    for (;;) {
        const bool has_next = prob.next(ui + 1, nxt);
        const char* nA = has_next ? prob.a_ptr(nxt) : cA; const char* nB = has_next ? prob.b_ptr(nxt) : cB;
        for (int t = 0; t < nt; t += 2) {
            const bool last = (t == nt - 2);
            const char* a1 = cA + (size_t)(t + 1) * kstep;
            const char* a2 = last ? nA : cA + (size_t)(t + 2) * kstep; const char* b2 = last ? nB : cB + (size_t)(t + 2) * kstep;
            const char* a3 = a2 + kstep; const char* b3 = b2 + kstep;
            if constexpr (P::GATHER) {
                unsigned v0[2], v1[2];
#pragma unroll
                for (int i = 0; i < 2; ++i) { v0[i] = voffA[i]; v1[i] = voffA1[i]; }
                if (last && has_next) PG8_GATHER_OFFS(ui + 1, v0, v1);
                PG8_LDB(B0, 0, 0); PG8_LDB(B1, 0, 1); PG8_SCHED; PG8_LDA(At, 0, 0); PG8_STAGE(PG8_SA(1, 1), a1, voffA1);
                PG8_WAIT_V(8); PG8_WAIT_L(0); PG8_BAR; PG8_MMA(0, 0, At, B0); PG8_MMA(0, 1, At, B1); PG8_BAR; PG8_SCHED;
                PG8_LDA(At, 0, 1); PG8_STAGE(PG8_SB(0, 0), b2, voffB); PG8_STAGE(PG8_SB(0, 1), b2 + hstepB, voffB); PG8_STAGE(PG8_SA(0, 0), a2, v0);
                PG8_WAIT_V(8); PG8_WAIT_L(0); PG8_BAR; PG8_MMA(1, 0, At, B0); PG8_MMA(1, 1, At, B1); PG8_BAR; PG8_SCHED;
                PG8_LDB(B0, 1, 0); PG8_LDB(B1, 1, 1); PG8_SCHED; PG8_LDA(At, 1, 0); PG8_STAGE(PG8_SA(0, 1), a2, v1);
                PG8_WAIT_V(8); PG8_WAIT_L(0); PG8_BAR; PG8_MMA(0, 0, At, B0); PG8_MMA(0, 1, At, B1); PG8_BAR; PG8_SCHED;
                PG8_LDA(At, 1, 1); PG8_STAGE(PG8_SB(1, 0), b3, voffB); PG8_STAGE(PG8_SB(1, 1), b3 + hstepB, voffB); PG8_STAGE(PG8_SA(1, 0), a3, v0);
                PG8_WAIT_V(8); PG8_WAIT_L(0); PG8_BAR; PG8_MMA(1, 0, At, B0); PG8_MMA(1, 1, At, B1); PG8_BAR; PG8_SCHED;
#pragma unroll
                for (int i = 0; i < 2; ++i) { voffA[i] = v0[i]; voffA1[i] = v1[i]; }
            } else {
                PG8_LDB(B0, 0, 0); PG8_LDB(B1, 0, 1); PG8_SCHED; PG8_LDA(At, 0, 0); PG8_STAGE(PG8_SA(1, 1), a1 + hstepA, voffA);
                PG8_WAIT_V(8); PG8_WAIT_L(0); PG8_BAR; PG8_MMA(0, 0, At, B0); PG8_MMA(0, 1, At, B1); PG8_BAR; PG8_SCHED;
                PG8_LDA(At, 0, 1); PG8_STAGE(PG8_SB(0, 0), b2, voffB); PG8_STAGE(PG8_SB(0, 1), b2 + hstepB, voffB); PG8_STAGE(PG8_SA(0, 0), a2, voffA);
                PG8_WAIT_V(8); PG8_WAIT_L(0); PG8_BAR; PG8_MMA(1, 0, At, B0); PG8_MMA(1, 1, At, B1); PG8_BAR; PG8_SCHED;
                PG8_LDB(B0, 1, 0); PG8_LDB(B1, 1, 1); PG8_SCHED; PG8_LDA(At, 1, 0); PG8_STAGE(PG8_SA(0, 1), a2 + hstepA, voffA);
                PG8_WAIT_V(8); PG8_WAIT_L(0); PG8_BAR; PG8_MMA(0, 0, At, B0); PG8_MMA(0, 1, At, B1); PG8_BAR; PG8_SCHED;
                PG8_LDA(At, 1, 1); PG8_STAGE(PG8_SB(1, 0), b3, voffB); PG8_STAGE(PG8_SB(1, 1), b3 + hstepB, voffB); PG8_STAGE(PG8_SA(1, 0), a3, voffA);
                PG8_WAIT_V(8); PG8_WAIT_L(0); PG8_BAR; PG8_MMA(1, 0, At, B0); PG8_MMA(1, 1, At, B1); PG8_BAR; PG8_SCHED;
            }
        }
        if (wr == 0) PG8_BAR;
        if constexpr (P::FP8) asm volatile("s_nop 15\n\ts_nop 15" ::: "memory");
        const bool keep = prob.epi(acc, cur, wr, wc, fr, fq);
        if (!has_next) break;
        if (!P::KEEPS || !keep) {
#pragma unroll
            for (int a = 0; a < 2; ++a)
#pragma unroll
                for (int b = 0; b < 2; ++b)
#pragma unroll
                    for (int m = 0; m < 4; ++m)
#pragma unroll
                        for (int n = 0; n < 2; ++n) acc[a][b][m][n] = (f32x4){0.f, 0.f, 0.f, 0.f};
        }
        cur = nxt; cA = nA; cB = nB; ++ui;
        if (wr == 1) PG8_BAR;
    }
    PG8_WAIT_V(0);
    PG8_BAR;
#undef PG8_SA
#undef PG8_SB
#undef PG8_STAGE
#undef PG8_LDA
#undef PG8_LDB
#undef PG8_MMA
#undef PG8_WAIT_V
#undef PG8_WAIT_L
#undef PG8_BAR
#undef PG8_SCHED
#undef PG8_GATHER_OFFS
}
}

template <class Epi>
__device__ __forceinline__ void skinny16_once(LAS unsigned char* lds, const bf16* A, int lda, const bf16* Bt, int ldb, int K, int N, const Epi& epi) {
    const int tid = threadIdx.x, wid = __builtin_amdgcn_readfirstlane(tid >> 6), lane = tid & 63, r = lane & 15, kg = lane >> 4;
    const int kw = K / 8, k0 = wid * kw;
    LAS float* part = (LAS float*)lds;
    for (int ct = blockIdx.x; ct < N / 16; ct += gridDim.x) {
        const bf16* ap = A + (size_t)r * lda + k0 + 8 * kg; const bf16* bp = Bt + (size_t)(16 * ct + r) * ldb + k0 + 8 * kg;
        f32x4 acc = {0.f, 0.f, 0.f, 0.f};
#pragma unroll 8
        for (int ks = 0; ks < kw; ks += 32) acc = __builtin_amdgcn_mfma_f32_16x16x32_bf16(*(const pg8::bf16x8*)(ap + ks), *(const pg8::bf16x8*)(bp + ks), acc, 0, 0, 0);
#pragma unroll
        for (int i = 0; i < 4; ++i) part[wid * 256 + (4 * kg + i) * 16 + r] = acc[i];
        LDS_WAIT(); __syncthreads();
        if (tid < 256) { const float s0 = (part[tid] + part[256 + tid]) + (part[512 + tid] + part[768 + tid]), s1 = (part[1024 + tid] + part[1280 + tid]) + (part[1536 + tid] + part[1792 + tid]);
            epi(tid >> 4, 16 * ct + (tid & 15), s0, s1); }
        LDS_WAIT(); __syncthreads();
    }
}
template <class Epi>
__device__ __forceinline__ void skinny16_f8(LAS unsigned char* lds, const unsigned char* A, int lda, const unsigned char* Bt, int ldb, int K, int N, int sc_a, int sc_b, const Epi& epi) {
    const int tid = threadIdx.x, wid = __builtin_amdgcn_readfirstlane(tid >> 6), lane = tid & 63, r = lane & 15, kg = lane >> 4;
    const int kw = K / 8, k0 = wid * kw;
    LAS float* part = (LAS float*)lds;
    for (int ct = blockIdx.x; ct < N / 16; ct += gridDim.x) {
        const unsigned char* ap = A + (size_t)r * lda + k0 + 32 * kg; const unsigned char* bp = Bt + (size_t)(16 * ct + r) * ldb + k0 + 32 * kg;
        f32x4 acc = {0.f, 0.f, 0.f, 0.f};
#pragma unroll 2
        for (int ks = 0; ks < kw; ks += 128) { const pg8::i32x8 av = *(const pg8::i32x8*)(ap + ks), bv = *(const pg8::i32x8*)(bp + ks);
            acc = __builtin_amdgcn_mfma_scale_f32_16x16x128_f8f6f4(av, bv, acc, 0, 0, 0, sc_a, 0, sc_b); }
#pragma unroll
        for (int i = 0; i < 4; ++i) part[wid * 256 + (4 * kg + i) * 16 + r] = acc[i];
        LDS_WAIT(); __syncthreads();
        if (tid < 256) { const float s0 = (part[tid] + part[256 + tid]) + (part[512 + tid] + part[768 + tid]), s1 = (part[1024 + tid] + part[1280 + tid]) + (part[1536 + tid] + part[1792 + tid]);
            epi(tid >> 4, 16 * ct + (tid & 15), s0, s1); }
        LDS_WAIT(); __syncthreads();
    }
}
template <class Epi>
__device__ __forceinline__ void skinny16(LAS unsigned char* lds, const bf16* A, int lda, const bf16* Bt, int ldb, int K, int N, const Epi& epi) {
    skinny16_once(lds, A, lda, Bt, ldb, K, N, epi); if ((DBL_MASK >> 10) & 1u) skinny16_once(lds, A, lda, Bt, ldb, K, N, epi);
}
struct SkinnyInProj { unsigned char* ws; unsigned* kmax; __device__ __forceinline__ void operator()(int j, int n, float s0, float s1) const { inproj_store(ws, SEQ + j, n, s0 + s1, kmax); } };
struct SkinnyBranch { unsigned char* ws; __device__ __forceinline__ void operator()(int j, int n, float s0, float s1) const {
    const size_t r = SEQ + j; const bf16* G = (const bf16*)(ws + WS_GB); const float v = __builtin_amdgcn_fmed3f((bf2f(G[r * G_N + n]) * s0 + bf2f(G[r * G_N + DM + n]) * s1) * MG8_SCALE, -448.f, 448.f);
    (ws + WS_MG)[r * DM + n] = (unsigned char)(__builtin_amdgcn_cvt_pk_fp8_f32(v, 0.f, 0, false) & 0xff); } };
struct SkinnyOut { unsigned char* ws; __device__ __forceinline__ void operator()(int j, int n, float s0, float s1) const {
    const size_t o = (size_t)(SEQ + j) * DM + n; ((float*)(ws + WS_RB))[o] = ALPHA * ((const float*)(ws + WS_HF))[o] + (s0 + s1); } };

constexpr int KN_OFF = RING_BYTES + 4096;
using pg8::Unit;
struct ProbInProj {
    static constexpr bool PERM = true, GATHER = false, KEEPS = false, FP8 = true;
    int K, lda, ldb, G, c; const unsigned char* A; const unsigned char* B; unsigned char* ws; int sc_a, sc_b; unsigned* kmax; LAS unsigned char* lds;
    __device__ __forceinline__ bool next(int i, Unit& u) const { u.aux = 0; return pg8::static_tile(SEQ / 256, INP_N / 256, G, c, i, u.pm, u.pn); }
    __device__ __forceinline__ const char* a_ptr(const Unit& u) const { return (const char*)(A + (size_t)u.pm * 256 * lda); }
    __device__ __forceinline__ const char* b_ptr(const Unit& u) const { return (const char*)(B + (size_t)u.pn * 256 * ldb); }
    __device__ __forceinline__ bool epi(f32x4 (&acc)[2][2][4][2], const Unit& u, int wr, int wc, int fr, int fq) const {
        const int row0 = u.pm * 256 + wr * 64 + fr, ct = u.pn * 256 + wc * 32 + 8 * fq;
        const bool isg = u.pn >= 24, isq = (u.pn < 4) || (u.pn >= 12 && u.pn < 16);
        if (u.pn >= 16 && u.pn < 20) {
            LAS float* P = (LAS float*)(lds + KN_OFF);
#pragma unroll
            for (int bj = 0; bj < 2; ++bj) {
#pragma unroll
                for (int ai = 0; ai < 2; ++ai)
#pragma unroll
                    for (int m = 0; m < 4; ++m) { float q = 0.f;
#pragma unroll
                        for (int n = 0; n < 2; ++n)
#pragma unroll
                            for (int j = 0; j < 4; ++j) q = fmaf(acc[ai][bj][m][n][j], acc[ai][bj][m][n][j], q);
                        q += __shfl_xor(q, 16); q += __shfl_xor(q, 32);
                        if (fq == 0) P[(ai * 128 + wr * 64 + m * 16 + fr) * 4 + wc] = q; }
                asm volatile("s_waitcnt lgkmcnt(0)" ::: "memory"); __builtin_amdgcn_s_barrier(); asm volatile("" ::: "memory");
                if (threadIdx.x < 256) { const f32x4 v = *(const LAS f32x4*)(P + threadIdx.x * 4); float t = (v.x + v.y) + (v.z + v.w); t = wave_max(t);
                    if ((threadIdx.x & 63) == 0) atomicMax(kmax + (2 * (u.pn - 16) + bj) * 64, __builtin_bit_cast(unsigned, t)); }
                asm volatile("s_waitcnt lgkmcnt(0)" ::: "memory"); __builtin_amdgcn_s_barrier(); asm volatile("" ::: "memory"); } }
        bf16* base = isg ? (bf16*)(ws + WS_GB) + (ct - QKV_N) : (bf16*)(ws + WS_QKV) + ct; const int ldc = isg ? G_N : QKV_N; const float sc = isq ? QSCALE : 1.0f;
#pragma unroll
        for (int ai = 0; ai < 2; ++ai)
#pragma unroll
            for (int m = 0; m < 4; ++m) { bf16* rowp = base + (size_t)(row0 + ai * 128 + m * 16) * ldc;
#pragma unroll
                for (int bj = 0; bj < 2; ++bj) { f32x4 v0 = acc[ai][bj][m][0], v1 = acc[ai][bj][m][1];
                    if (isg) {
#pragma unroll
                        for (int j = 0; j < 4; ++j) { v0[j] = __builtin_amdgcn_rcpf(1.0f + __builtin_amdgcn_exp2f(-LOG2E * v0[j])); v1[j] = __builtin_amdgcn_rcpf(1.0f + __builtin_amdgcn_exp2f(-LOG2E * v1[j])); } }
                    else { v0 = v0 * sc; v1 = v1 * sc; }
                    u32x4 w; w.x = pg8::cvt_pk_bf16(v0[0], v0[1]); w.y = pg8::cvt_pk_bf16(v0[2], v0[3]); w.z = pg8::cvt_pk_bf16(v1[0], v1[1]); w.w = pg8::cvt_pk_bf16(v1[2], v1[3]);
                    *(u32x4*)(rowp + bj * 128) = w; } }
        return false;
    }
};
struct ProbOutProj {
    static constexpr bool PERM = false, GATHER = false, KEEPS = false, FP8 = true;
    int K, lda, ldb, G, c; const unsigned char* A; const unsigned char* B; unsigned char* ws; int sc_a, sc_b;
    __device__ __forceinline__ bool next(int i, Unit& u) const { u.aux = 0; return pg8::static_tile(SEQ / 256, DM / 256, G, c, i, u.pm, u.pn); }
    __device__ __forceinline__ const char* a_ptr(const Unit& u) const { return (const char*)(A + (size_t)u.pm * 256 * lda); }
    __device__ __forceinline__ const char* b_ptr(const Unit& u) const { return (const char*)(B + (size_t)u.pn * 256 * ldb); }
    __device__ __forceinline__ bool epi(f32x4 (&acc)[2][2][4][2], const Unit& u, int wr, int wc, int fr, int fq) const {
        const int row0 = u.pm * 256 + wr * 64 + fr, col0 = u.pn * 256 + wc * 32 + 4 * fq;
        const float* HF = (const float*)(ws + WS_HF); float* R = (float*)(ws + WS_RB);
#pragma unroll
        for (int ai = 0; ai < 2; ++ai)
#pragma unroll
            for (int m = 0; m < 4; ++m) { const size_t off = (size_t)(row0 + ai * 128 + m * 16) * DM + col0;
#pragma unroll
                for (int bj = 0; bj < 2; ++bj)
#pragma unroll
                    for (int n = 0; n < 2; ++n) { const f32x4 hv = *(const f32x4*)(HF + off + bj * 128 + n * 16); *(f32x4*)(R + off + bj * 128 + n * 16) = hv * ALPHA + acc[ai][bj][m][n]; }
                asm volatile("" ::: "memory"); }
        return false;
    }
};

struct ProbBranch {
    static constexpr bool PERM = true, GATHER = false, KEEPS = true, FP8 = true;
    int K, lda, ldb, G, c; const unsigned char* A; const unsigned char* B; unsigned char* ws; int sc_a, sc_b;
    __device__ __forceinline__ bool next(int i, Unit& u) const { u.aux = i & 1; return pg8::static_tile(SEQ / 256, DM / 256, G, c, i >> 1, u.pm, u.pn); }
    __device__ __forceinline__ const char* a_ptr(const Unit& u) const { return (const char*)(A + (size_t)u.pm * 256 * lda + u.aux * 1024); }
    __device__ __forceinline__ const char* b_ptr(const Unit& u) const { return (const char*)(B + (size_t)u.pn * 256 * ldb + u.aux * 1024); }
    __device__ __forceinline__ bool epi(f32x4 (&acc)[2][2][4][2], const Unit& u, int wr, int wc, int fr, int fq) const {
        const int row0 = u.pm * 256 + wr * 64 + fr, ct = u.pn * 256 + wc * 32 + 8 * fq;
        const bf16* Gs = (const bf16*)(ws + WS_GB) + ct; const bf16* Gf = Gs + DM; unsigned char* MG = ws + WS_MG + ct;
        const bool first = u.aux == 0;
#pragma unroll
        for (int ai = 0; ai < 2; ++ai)
#pragma unroll
            for (int m = 0; m < 4; ++m) { const size_t r = (size_t)(row0 + ai * 128 + m * 16);
#pragma unroll
                for (int bj = 0; bj < 2; ++bj) { const u32x4 gf = *(const u32x4*)(Gf + r * G_N + bj * 128);
                    f32x4 f0 = {bflo(gf.x), bfhi(gf.x), bflo(gf.y), bfhi(gf.y)}, f1 = {bflo(gf.z), bfhi(gf.z), bflo(gf.w), bfhi(gf.w)};
                    if (first) { const u32x4 gs = *(const u32x4*)(Gs + r * G_N + bj * 128);
                        const f32x4 s0 = {bflo(gs.x), bfhi(gs.x), bflo(gs.y), bfhi(gs.y)}, s1 = {bflo(gs.z), bfhi(gs.z), bflo(gs.w), bfhi(gs.w)};
#pragma unroll
                        for (int j = 0; j < 4; ++j) { acc[ai][bj][m][0][j] *= s0[j] * __builtin_amdgcn_rcpf(fmaxf(f0[j], 1e-30f)); acc[ai][bj][m][1][j] *= s1[j] * __builtin_amdgcn_rcpf(fmaxf(f1[j], 1e-30f)); } }
                    else { const f32x4 v0 = acc[ai][bj][m][0] * f0 * MG8_SCALE, v1 = acc[ai][bj][m][1] * f1 * MG8_SCALE;
                        u32x2 w; w.x = pk4_fp8(v0[0], v0[1], v0[2], v0[3]); w.y = pk4_fp8(v1[0], v1[1], v1[2], v1[3]);
                        *(u32x2*)(MG + r * DM + bj * 128) = w; } }
                asm volatile("" ::: "memory"); }
        return first;
    }
};
constexpr int IDX_OFF = RING_BYTES + 1024, MOE_MAXU = 3;
struct ProbMoeGU {
    static constexpr bool PERM = true, GATHER = true, KEEPS = false, FP8 = true;
    int K, lda, ldb, G, c, layer; const unsigned char* A; const unsigned char* B; unsigned char* ws; const unsigned* ctl; LAS unsigned char* lds; int sc_a, sc_b;
    __device__ __forceinline__ bool next(int i, Unit& u) const { const int L = i * G + c; u.pm = L >> 3; u.pn = L & 7; int cnt, ps; return moe_find(ctl, layer, u.pm * 256, u.aux, cnt, ps); }
    __device__ __forceinline__ const char* a_ptr(const Unit&) const { return (const char*)A; }
    __device__ __forceinline__ const char* b_ptr(const Unit& u) const { return (const char*)(B + (size_t)u.aux * WGU_E + (size_t)u.pn * 256 * ldb); }
    __device__ __forceinline__ int a_row(int ui, int r) const { return *(const LAS int*)(lds + IDX_OFF + (ui * 256 + r) * 4); }
    __device__ __forceinline__ void fill_idx(int tid) const {
        for (int ui = 0; ui < MOE_MAXU; ++ui) { const int L = ui * G + c; int e, cnt, ps; if (!moe_find(ctl, layer, (L >> 3) * 256, e, cnt, ps)) break;
            if (tid < 256) { const int rank = (L >> 3) * 256 - ps + tid; *(LAS int*)(lds + IDX_OFF + (ui * 256 + tid) * 4) = rank < cnt ? ((const int*)(ws + WS_ELIST))[(size_t)e * MROWS + rank] : 0; } }
        LDS_WAIT(); __syncthreads();
    }
    __device__ __forceinline__ bool epi(f32x4 (&acc)[2][2][4][2], const Unit& u, int wr, int wc, int fr, int fq) const {
        const int row0 = u.pm * 256 + wr * 64 + fr, ct = u.pn * 128 + wc * 32 + 8 * fq; unsigned char* act = ws + WS_ACT + ct;
#pragma unroll
        for (int ai = 0; ai < 2; ++ai)
#pragma unroll
            for (int m = 0; m < 4; ++m) { f32x4 v[2];
#pragma unroll
                for (int n = 0; n < 2; ++n)
#pragma unroll
                    for (int j = 0; j < 4; ++j) { const float g = acc[ai][0][m][n][j]; v[n][j] = g * __builtin_amdgcn_rcpf(1.0f + __builtin_amdgcn_exp2f(-LOG2E * g)) * acc[ai][1][m][n][j]; }
                u32x2 w; w.x = pk4_fp8(v[0][0] * ACT8_SCALE, v[0][1] * ACT8_SCALE, v[0][2] * ACT8_SCALE, v[0][3] * ACT8_SCALE); w.y = pk4_fp8(v[1][0] * ACT8_SCALE, v[1][1] * ACT8_SCALE, v[1][2] * ACT8_SCALE, v[1][3] * ACT8_SCALE);
                *(u32x2*)(act + (size_t)(row0 + ai * 128 + m * 16) * FF) = w; }
        return false;
    }
};
struct ProbMoeDown {
    static constexpr bool PERM = true, GATHER = false, KEEPS = false, FP8 = true;
    int K, lda, ldb, G, c, layer; const unsigned char* A; const unsigned char* B; unsigned char* ws; const unsigned* ctl; int sc_a, sc_b;
    __device__ __forceinline__ bool next(int i, Unit& u) const { const int L = i * G + c; u.pm = L >> 3; u.pn = L & 7; int cnt, ps; return moe_find(ctl, layer, u.pm * 256, u.aux, cnt, ps); }
    __device__ __forceinline__ const char* a_ptr(const Unit& u) const { return (const char*)(A + (size_t)u.pm * 256 * lda); }
    __device__ __forceinline__ const char* b_ptr(const Unit& u) const { return (const char*)(B + (size_t)u.aux * WD_E + (size_t)u.pn * 256 * ldb); }
    __device__ __forceinline__ bool epi(f32x4 (&acc)[2][2][4][2], const Unit& u, int wr, int wc, int fr, int fq) const {
        const int row0 = u.pm * 256 + wr * 64 + fr, ct = u.pn * 256 + wc * 32 + 8 * fq; bf16* O = (bf16*)(ws + WS_OSL) + ct;
#pragma unroll
        for (int ai = 0; ai < 2; ++ai)
#pragma unroll
            for (int m = 0; m < 4; ++m)
#pragma unroll
                for (int bj = 0; bj < 2; ++bj) { const f32x4 v0 = acc[ai][bj][m][0], v1 = acc[ai][bj][m][1];
                    u32x4 w; w.x = pg8::cvt_pk_bf16(v0[0], v0[1]); w.y = pg8::cvt_pk_bf16(v0[2], v0[3]); w.z = pg8::cvt_pk_bf16(v1[0], v1[1]); w.w = pg8::cvt_pk_bf16(v1[2], v1[3]);
                    *(u32x4*)(O + (size_t)(row0 + ai * 128 + m * 16) * DM + bj * 128) = w; }
        return false;
    }
};

#ifndef ATT_DBL
#define ATT_DBL 0
#endif
namespace att {
typedef short bf16x8 __attribute__((ext_vector_type(8)));
typedef short s16x4 __attribute__((ext_vector_type(4)));
typedef float f32x16 __attribute__((ext_vector_type(16)));
constexpr int TILE_B = 16384;
constexpr float EXIT_THR = -140.f;
constexpr int L_V = 0, L_K = 3 * TILE_B, L_C2 = 6 * TILE_B, L_WS = L_C2 + 1024, L_END = L_WS + 8 * 256, L_ITEM = 131072 + 8192, L_VOTE = L_ITEM + 16, L_FT = L_VOTE + 64, L_KN = L_FT + 16;
#define KSWZ(row, colB) ((row) * 256 + ((colB) ^ (((row) & 7) << 4)))
#define SBAR() __builtin_amdgcn_sched_barrier(0)
__device__ __forceinline__ int v_st(int k, int c) { const int kk = (k & ~0xC) | ((k & 4) << 1) | ((k & 8) >> 1); return ((kk >> 3) * 4 + (c >> 5)) * 512 + ((kk & 7) * 32 + (c & 31)) * 2; }
__device__ __forceinline__ int v_rd_base(int lane) { return ((lane & 3) << 3) | (((lane >> 2) & 3) << 6) | (((lane >> 4) & 1) << 5) | (((lane >> 5) & 1) << 8); }
constexpr int v_rd_off(int d0, int ks, int half) { return d0 * 512 + ks * 4096 + half * 2048; }
__device__ __forceinline__ int crow(int r, int hi) { return (r & 3) + 8 * (r >> 2) + 4 * hi; }
__device__ __forceinline__ unsigned cvtpk(float lo, float hi) { unsigned r; asm volatile("v_cvt_pk_bf16_f32 %0, %1, %2" : "=v"(r) : "v"(lo), "v"(hi)); return r; }
__device__ __forceinline__ float xchg_sum(float v) { auto rr = __builtin_amdgcn_permlane32_swap(__float_as_uint(v), __float_as_uint(v), false, false); return __uint_as_float(rr[0]) + __uint_as_float(rr[1]); }
__device__ __forceinline__ float xchg_max(float v) { auto rr = __builtin_amdgcn_permlane32_swap(__float_as_uint(v), __float_as_uint(v), false, false); return fmaxf(__uint_as_float(rr[0]), __uint_as_float(rr[1])); }
#define PK4(P, B_, OUT) do { unsigned a0 = cvtpk(P[B_+0], P[B_+1]), a1 = cvtpk(P[B_+2], P[B_+3]); unsigned b0 = cvtpk(P[B_+4], P[B_+5]), b1 = cvtpk(P[B_+6], P[B_+7]); \
        auto r0 = __builtin_amdgcn_permlane32_swap(a0, b0, false, false); auto r1 = __builtin_amdgcn_permlane32_swap(a1, b1, false, false); \
        u32x4 w = {r0[0], r1[0], r0[1], r1[1]}; OUT = *reinterpret_cast<bf16x8*>(&w); } while (0)
__device__ __forceinline__ void qkt(f32x16& p0, f32x16& p1, const LAS unsigned char* kt, int r32, int hi, const bf16x8* qr) {
    p0 = f32x16{}; p1 = f32x16{};
    const LAS unsigned char* kb[4];
#pragma unroll
    for (int dd = 0; dd < 4; ++dd) kb[dd] = kt + KSWZ(r32, (dd * 16 + hi * 8) * 2);
#pragma unroll
    for (int d0 = 0; d0 < 8; ++d0) { const LAS unsigned char* a = kb[d0 & 3] + (d0 >> 2) * 128;
        const bf16x8 b0 = *(const LAS bf16x8*)(a); const bf16x8 b1 = *(const LAS bf16x8*)(a + 32 * 256);
        p0 = __builtin_amdgcn_mfma_f32_32x32x16_bf16(b0, qr[d0], p0, 0, 0, 0);
        p1 = __builtin_amdgcn_mfma_f32_32x32x16_bf16(b1, qr[d0], p1, 0, 0, 0); }
}
__device__ __forceinline__ void pv_tile(f32x16* o, unsigned vb0, bf16x8 pa0, bf16x8 pa1, bf16x8 pa2, bf16x8 pa3) {
#define TRRD(dst, off) asm volatile("ds_read_b64_tr_b16 %0, %1 offset:%2" : "=&v"(dst) : "v"(vb0), "i"(off) : "memory")
#define PV_RD(S, d0) do { constexpr int b_ = v_rd_off(d0, 0, 0); TRRD(S##l0, b_); TRRD(S##h0, b_ + 2048); TRRD(S##l1, b_ + 4096); TRRD(S##h1, b_ + 6144); TRRD(S##l2, b_ + 8192); TRRD(S##h2, b_ + 10240); TRRD(S##l3, b_ + 12288); TRRD(S##h3, b_ + 14336); } while (0)
#define PV_MM(S, d0) do { \
        o[d0] = __builtin_amdgcn_mfma_f32_32x32x16_bf16(pa0, (bf16x8){S##l0[0], S##l0[1], S##l0[2], S##l0[3], S##h0[0], S##h0[1], S##h0[2], S##h0[3]}, o[d0], 0, 0, 0); \
        o[d0] = __builtin_amdgcn_mfma_f32_32x32x16_bf16(pa1, (bf16x8){S##l1[0], S##l1[1], S##l1[2], S##l1[3], S##h1[0], S##h1[1], S##h1[2], S##h1[3]}, o[d0], 0, 0, 0); \
        o[d0] = __builtin_amdgcn_mfma_f32_32x32x16_bf16(pa2, (bf16x8){S##l2[0], S##l2[1], S##l2[2], S##l2[3], S##h2[0], S##h2[1], S##h2[2], S##h2[3]}, o[d0], 0, 0, 0); \
        o[d0] = __builtin_amdgcn_mfma_f32_32x32x16_bf16(pa3, (bf16x8){S##l3[0], S##l3[1], S##l3[2], S##l3[3], S##h3[0], S##h3[1], S##h3[2], S##h3[3]}, o[d0], 0, 0, 0); } while (0)
    s16x4 Al0, Al1, Al2, Al3, Ah0, Ah1, Ah2, Ah3, Bl0, Bl1, Bl2, Bl3, Bh0, Bh1, Bh2, Bh3;
    PV_RD(A, 0); PV_RD(B, 1);
    asm volatile("s_waitcnt lgkmcnt(8)" ::: "memory"); SBAR(); PV_MM(A, 0); SBAR();
    PV_RD(A, 2);
    asm volatile("s_waitcnt lgkmcnt(8)" ::: "memory"); SBAR(); PV_MM(B, 1); SBAR();
    PV_RD(B, 3);
    asm volatile("s_waitcnt lgkmcnt(8)" ::: "memory"); SBAR(); PV_MM(A, 2); SBAR();
    asm volatile("s_waitcnt lgkmcnt(0)" ::: "memory"); SBAR(); PV_MM(B, 3);
#undef PV_MM
#undef PV_RD
#undef TRRD
}
#define VIS(cc) (((dqh) - (cc)) >= NEED && (cc) < (nvh))
__device__ __forceinline__ void sb_tile(f32x16& p0, f32x16& p1, float& carry, bool domask, int dqh, int nvh, int hi, bf16x8& pa0, bf16x8& pa1, bf16x8& pa2, bf16x8& pa3) {
    constexpr int NEED = 1;
    f32x16 x0, x1;
#pragma unroll
    for (int r = 0; r < 16; ++r) {
        { const float u = __builtin_amdgcn_fmed3f(p0[r], -126.f, 126.f), b = __builtin_amdgcn_logf(1.0f + __builtin_amdgcn_exp2f(-u)); x0[r] = -b; p0[r] = -u - b; }
        { const float u = __builtin_amdgcn_fmed3f(p1[r], -126.f, 126.f), b = __builtin_amdgcn_logf(1.0f + __builtin_amdgcn_exp2f(-u)); x1[r] = -b; p1[r] = -u - b; } }
    if (domask) { const float NEG = -__builtin_inff();
#pragma unroll
        for (int r = 0; r < 16; ++r) { const int cc = (r & 3) + 8 * (r >> 2);
            if (!VIS(cc)) { p0[r] = 0.f; x0[r] = NEG; }
            if (!VIS(cc + 32)) { p1[r] = 0.f; x1[r] = NEG; } } }
    float A[9]; A[8] = 0.f;
#pragma unroll
    for (int g = 3; g >= 0; --g) A[4 + g] = A[5 + g] + ((p1[4 * g] + p1[4 * g + 1]) + (p1[4 * g + 2] + p1[4 * g + 3]));
#pragma unroll
    for (int g = 3; g >= 0; --g) A[g] = A[1 + g] + ((p0[4 * g] + p0[4 * g + 1]) + (p0[4 * g + 2] + p0[4 * g + 3]));
    float off[8];
#pragma unroll
    for (int i = 0; i < 8; ++i) { auto rr = __builtin_amdgcn_permlane32_swap(__float_as_uint(A[i]), __float_as_uint(A[i + 1]), false, false);
        const float recv = hi ? __uint_as_float(rr[0]) : __uint_as_float(rr[1]); off[i] = carry + A[i + 1] + recv; }
    carry += xchg_sum(A[0]);
#pragma unroll
    for (int g = 0; g < 4; ++g) {
        { float af = off[g]; const float l3 = p0[4 * g + 3], l2 = p0[4 * g + 2], l1 = p0[4 * g + 1];
          x0[4 * g + 3] = __builtin_amdgcn_exp2f(x0[4 * g + 3] + af); af += l3; x0[4 * g + 2] = __builtin_amdgcn_exp2f(x0[4 * g + 2] + af); af += l2;
          x0[4 * g + 1] = __builtin_amdgcn_exp2f(x0[4 * g + 1] + af); af += l1; x0[4 * g] = __builtin_amdgcn_exp2f(x0[4 * g] + af); }
        { float af = off[4 + g]; const float l3 = p1[4 * g + 3], l2 = p1[4 * g + 2], l1 = p1[4 * g + 1];
          x1[4 * g + 3] = __builtin_amdgcn_exp2f(x1[4 * g + 3] + af); af += l3; x1[4 * g + 2] = __builtin_amdgcn_exp2f(x1[4 * g + 2] + af); af += l2;
          x1[4 * g + 1] = __builtin_amdgcn_exp2f(x1[4 * g + 1] + af); af += l1; x1[4 * g] = __builtin_amdgcn_exp2f(x1[4 * g] + af); } }
    PK4(x0, 0, pa0); PK4(x0, 8, pa1); PK4(x1, 0, pa2); PK4(x1, 8, pa3);
}
__device__ __forceinline__ float fox_tile(f32x16& p0, f32x16& p1, const LAS float* c2t, float& m_reg, float& l_reg, bool domask, int dqh, int nvh, int hi, bf16x8& pa0, bf16x8& pa1, bf16x8& pa2, bf16x8& pa3) {
    constexpr int NEED = 0;
#pragma unroll
    for (int g = 0; g < 4; ++g) { const f32x4 c0 = *(const LAS f32x4*)(c2t + 8 * g + 4 * hi), c1 = *(const LAS f32x4*)(c2t + 32 + 8 * g + 4 * hi);
#pragma unroll
        for (int j = 0; j < 4; ++j) { p0[4 * g + j] -= c0[j]; p1[4 * g + j] -= c1[j]; } }
    if (domask) { const float NEG = -__builtin_inff();
#pragma unroll
        for (int r = 0; r < 16; ++r) { const int cc = (r & 3) + 8 * (r >> 2);
            if (!VIS(cc)) p0[r] = NEG;
            if (!VIS(cc + 32)) p1[r] = NEG; } }
    float pmax = p0[0];
#pragma unroll
    for (int r = 1; r < 16; ++r) pmax = fmaxf(pmax, p0[r]);
#pragma unroll
    for (int r = 0; r < 16; ++r) pmax = fmaxf(pmax, p1[r]);
    pmax = xchg_max(pmax);
    const float mn = fmaxf(m_reg, pmax), alpha = __builtin_amdgcn_exp2f(m_reg - mn); m_reg = mn;
    float ps = 0.f;
#pragma unroll
    for (int r = 0; r < 16; ++r) { p0[r] = __builtin_amdgcn_exp2f(p0[r] - mn); p1[r] = __builtin_amdgcn_exp2f(p1[r] - mn); ps += p0[r] + p1[r]; }
    l_reg = l_reg * alpha + xchg_sum(ps);
    PK4(p0, 0, pa0); PK4(p0, 8, pa1); PK4(p1, 0, pa2); PK4(p1, 8, pa3);
    return alpha;
}
#undef VIS
template <int TYPE>
__device__ __forceinline__ void attn_unit(LAS unsigned char* lds, unsigned char* ws, const unsigned* kmaxw, int head, int qb) {
    const int tid = threadIdx.x, wid = __builtin_amdgcn_readfirstlane(tid >> 6), lane = tid & 63, r32 = lane & 31, hi = lane >> 5;
    const bool grpY = wid >= 4;
    const bf16* QKV = (const bf16*)(ws + WS_QKV);
    const int qcol = (TYPE ? 3072 : 0) + head * HD, kcol = qcol + 1024, vcol = qcol + 2048;
    const float* fsuf = (const float*)(ws + WS_CUM) + (size_t)head * MROWS; const float* ftot = (const float*)(ws + WS_CUM) + (size_t)NHEAD * MROWS + head * 256;
    float fcarry = 0.f, st_tot = 0.f;
    LAS int* vote = (LAS int*)(lds + L_VOTE); LAS float* ftl = (LAS float*)(lds + L_FT);
    const int qrow0 = qb * 256, NT = qb < 32 ? 4 * qb + 5 : 1;
    const int qbase = qb < 32 ? qrow0 : -NMETA;
    const int qlo = qbase + wid * 32, qpos = qlo + r32;
    LAS unsigned char* V_lds = lds + L_V; LAS unsigned char* K_lds = lds + L_K; LAS float* c2_lds = (LAS float*)(lds + L_C2);
    LAS float* wsl = (LAS float*)(lds + L_WS) + wid * 64;
    bf16x8 qr[8];
#pragma unroll
    for (int d0 = 0; d0 < 8; ++d0) qr[d0] = *(const bf16x8*)(QKV + (size_t)(qrow0 + wid * 32 + r32) * QKV_N + qcol + d0 * 16 + hi * 8);
    const int sr = tid >> 4, sc = (tid & 15) * 8, vst0 = v_st(sr, sc), vst1 = v_st(32 + sr, sc), kws = KSWZ(sr, sc * 2);
    const unsigned vrd = (unsigned)(size_t)V_lds + (unsigned)v_rd_base(lane);
    bf16x8 st_k0, st_k1, st_v0, st_v1; float st_c = 0.f;
    float ub = 0.f;
    if (TYPE == 1) { float s1 = 0.f;
#pragma unroll
        for (int d0 = 0; d0 < 8; ++d0) { const u32x4 w = __builtin_bit_cast(u32x4, qr[d0]);
            s1 += (bflo(w.x) * bflo(w.x) + bfhi(w.x) * bfhi(w.x)) + (bflo(w.y) * bflo(w.y) + bfhi(w.y) * bfhi(w.y)) + (bflo(w.z) * bflo(w.z) + bfhi(w.z) * bfhi(w.z)) + (bflo(w.w) * bflo(w.w) + bfhi(w.w) * bfhi(w.w)); }
        ub = 1.02f * sqrtf(xchg_sum(s1) * ((const LAS float*)(lds + L_KN))[head]); }
#define TISMETA(t) ((t) == NT - 1)
#define SLOAD(t) do { const int row_ = TISMETA(t) ? SEQ : 64 * (4 * qb + 3 - (t)); const bf16* kp_ = QKV + (size_t)(row_ + sr) * QKV_N + sc; \
        st_k0 = *(const bf16x8*)(kp_ + kcol); st_k1 = *(const bf16x8*)(kp_ + (size_t)32 * QKV_N + kcol); st_v0 = *(const bf16x8*)(kp_ + vcol); st_v1 = *(const bf16x8*)(kp_ + (size_t)32 * QKV_N + vcol); \
        if (TYPE == 1 && tid < 64) { st_c = fsuf[row_ + tid]; st_tot = ftot[row_ >> 6]; } } while (0)
#define SWRITE(bo) do { *(LAS bf16x8*)(K_lds + (bo) + kws) = st_k0; *(LAS bf16x8*)(K_lds + (bo) + kws + 32 * 256) = st_k1; \
        *(LAS bf16x8*)(V_lds + (bo) + vst0) = st_v0; *(LAS bf16x8*)(V_lds + (bo) + vst1) = st_v1; if (TYPE == 1 && tid < 64) { c2_lds[((bo) >> 8) + tid] = -(fcarry + st_c); fcarry += st_tot; if (tid == 0) ftl[(bo) >> 14] = fcarry; } } while (0)
#define BAR() asm volatile("s_waitcnt lgkmcnt(0)\n\ts_barrier" ::: "memory")
    SLOAD(0); SWRITE(0);
    if (NT > 1) { SLOAD(1); SWRITE(TILE_B); }
    __builtin_amdgcn_s_waitcnt(0x0F70);
    if (NT > 2) SLOAD(2);
    BAR();
    if (grpY) BAR();
    f32x16 o[4] = {}; float carry = 0.f, m_reg = -1e30f, l_reg = 0.f;
    constexpr int NEEDW = TYPE == 0 ? 1 : 0;
#define KBASE(t) (TISMETA(t) ? -NMETA : 64 * (4 * qb + 3 - (t)))
#define ACTW(t) ((qlo + 31 - KBASE(t)) >= NEEDW && (qb < 32 || wid == 0))
    f32x16 p0, p1;
    if (ACTW(0)) qkt(p0, p1, K_lds, r32, hi, qr);
    int bo = 0, bo1 = TILE_B, bo2 = 2 * TILE_B;
    for (int t = 0; t < NT; ++t) {
        BAR();
        if (t > 0) { const LAS int* vp = vote + ((t - 1) & 1) * 8; const int all8 = (vp[0] & vp[1]) & (vp[2] & vp[3]) & (vp[4] & vp[5]) & (vp[6] & vp[7]); if (__builtin_amdgcn_readfirstlane(all8)) break; }
        const int kbase = KBASE(t), nvalid = TISMETA(t) ? NMETA : 64;
        const bool actw = ACTW(t);
        const bool domask = (qlo - (kbase + 63) < NEEDW) || nvalid < 64;
        bf16x8 pa0, pa1, pa2, pa3;
        if (actw) {
            const int dqh = qpos - kbase - 4 * hi, nvh = nvalid - 4 * hi;
            if (TYPE == 0) sb_tile(p0, p1, carry, domask, dqh, nvh, hi, pa0, pa1, pa2, pa3);
            else { const float alpha = fox_tile(p0, p1, c2_lds + (bo >> 8), m_reg, l_reg, domask, dqh, nvh, hi, pa0, pa1, pa2, pa3);
                if (__any(alpha < 1.f)) { if (hi == 0) wsl[r32] = alpha; asm volatile("s_waitcnt lgkmcnt(0)" ::: "memory");
#pragma unroll
                    for (int r = 0; r < 16; ++r) { const float al = wsl[crow(r, hi)];
#pragma unroll
                        for (int d = 0; d < 4; ++d) o[d][r] *= al; } } }
        }
        { const bool done = TYPE == 0 ? __all(carry < EXIT_THR) : __all(ub + ftl[bo >> 14] - m_reg < EXIT_THR);
          if (lane == 0) vote[(t & 1) * 8 + wid] = (done && qb < 32) ? 1 : 0; }
        BAR();
        if (t + 2 < NT) SWRITE(bo2);
        if (t + 3 < NT) SLOAD(t + 3);
        if (actw) pv_tile(o, vrd + bo, pa0, pa1, pa2, pa3);
        if (t + 1 < NT) { if (ACTW(t + 1)) qkt(p0, p1, K_lds + bo1, r32, hi, qr); }
        { const int tmp = bo; bo = bo1; bo1 = bo2; bo2 = tmp; }
    }
    if (!grpY) BAR();
    float rli[16];
    if (TYPE == 1) { if (hi == 0) wsl[32 + r32] = l_reg; asm volatile("s_waitcnt lgkmcnt(0)" ::: "memory");
#pragma unroll
        for (int r = 0; r < 16; ++r) rli[r] = __builtin_amdgcn_rcpf(wsl[32 + crow(r, hi)]); }
    unsigned char* Yw = ws + WS_YB + (size_t)(qrow0 + wid * 32) * DM + TYPE * 1024 + head * HD;
    if (qb < 32 || wid == 0)
#pragma unroll
    for (int r = 0; r < 16; ++r) { const int orow = crow(r, hi);
#pragma unroll
        for (int d0 = 0; d0 < 4; ++d0) { const float v = __builtin_amdgcn_fmed3f((TYPE == 1 ? o[d0][r] * rli[r] : o[d0][r]) * Y8_SCALE, -448.f, 448.f); const float vn = __shfl_xor(v, 1);
            const int p = __builtin_amdgcn_cvt_pk_fp8_f32(v, vn, 0, false) & 0xffff; const int p2 = __shfl_xor(p, 2);
            if ((r32 & 3) == 0) *(unsigned*)(Yw + (size_t)orow * DM + d0 * 32 + r32) = (unsigned)p | ((unsigned)p2 << 16); } }
#undef TISMETA
#undef SLOAD
#undef SWRITE
#undef BAR
#undef KBASE
#undef ACTW
}
constexpr int CW_ATTNQ = 3072;
__device__ __forceinline__ void copy_loop(Frame& F, int layer, int cv0, int NB_, int limit = 1 << 30) {
    LAS int* itemw = (LAS int*)(F.lds + L_ITEM);
    for (int n = 0; n < limit; ++n) {
        __syncthreads();
        if (threadIdx.x == 0) *itemw = (int)atomicAdd(F.ctl + CW_ATTNQ + layer * 64 + 16, 1u);
        asm volatile("s_waitcnt lgkmcnt(0)" ::: "memory"); __syncthreads();
        const int j = __builtin_amdgcn_readfirstlane(*itemw);
        if (j >= NB_) break;
        convert_bundle(F, cv0 + j * CV_BUNDLE);
    }
}
__device__ __forceinline__ void attn_phase(Frame& F, int layer, int qoff, bool nocopy = false, int only = 0) {
    LAS unsigned char* lds = F.lds; unsigned char* ws = F.ws; unsigned* ctl = F.ctl; const int G = F.G, b = blockIdx.x;
    const int NA = 512 + (layer == 0 ? 16 : 0);
    const int cv0 = layer == 0 ? CV_G0_END : CV_G1_END, NB_ = ((layer == 0 ? CV_G1_END : N_CONVERT_ITEMS) - cv0) / CV_BUNDLE;
    const bool copier = (b & 1) == 1 && !nocopy; const int nfree = nocopy ? G : G - G / 2;
    LAS int* itemw = (LAS int*)(lds + L_ITEM); const unsigned* kmaxw = ctl + CW_KMAX + layer * 8 * 64;
    int hperm = 0;
    { const float* ftot = (const float*)(ws + WS_CUM) + (size_t)NHEAD * MROWS; const int lane = threadIdx.x & 63; float d[8];
#pragma unroll
        for (int h = 0; h < 8; ++h) { float v = ftot[h * 256 + lane] + ftot[h * 256 + 64 + lane] + (lane == 0 ? ftot[h * 256 + 128] : 0.f); d[h] = wave_sum(v); }
#pragma unroll
        for (int h = 0; h < 8; ++h) { int rank = 0;
#pragma unroll
            for (int g = 0; g < 8; ++g) rank += (d[g] > d[h] || (d[g] == d[h] && g < h)) ? 1 : 0;
            hperm |= h << (4 * rank); }
        hperm = __builtin_amdgcn_readfirstlane(hperm); }
    { const int w = F.wave, lane = threadIdx.x & 63, mr = lane >> 2, part = lane & 3;
      const bf16* kp = (const bf16*)(ws + WS_QKV) + (size_t)(SEQ + mr) * QKV_N + 4096 + w * HD + part * 32; float q = 0.f;
#pragma unroll
      for (int i = 0; i < 4; ++i) { const u32x4 v = *(const u32x4*)(kp + 8 * i);
          q += (bflo(v.x) * bflo(v.x) + bfhi(v.x) * bfhi(v.x)) + (bflo(v.y) * bflo(v.y) + bfhi(v.y) * bfhi(v.y)) + (bflo(v.z) * bflo(v.z) + bfhi(v.z) * bfhi(v.z)) + (bflo(v.w) * bflo(v.w) + bfhi(v.w) * bfhi(v.w)); }
      q += __shfl_xor(q, 1); q += __shfl_xor(q, 2); q = wave_max(q);
      if (lane == 0) ((LAS float*)(lds + L_KN))[w] = fmaxf(q, __builtin_bit_cast(float, kmaxw[w * 64]));
      asm volatile("s_waitcnt lgkmcnt(0)" ::: "memory"); __syncthreads(); }
    int it;
    if (copier) {
        copy_loop(F, layer, cv0, NB_);
        __syncthreads();
        if (threadIdx.x == 0) *itemw = nfree + (int)atomicAdd(ctl + CW_ATTNQ + layer * 64 + qoff, 1u);
        asm volatile("s_waitcnt lgkmcnt(0)" ::: "memory"); __syncthreads();
        it = __builtin_amdgcn_readfirstlane(*itemw);
    } else it = nocopy ? b : b >> 1;
    while (it < NA) {
        if (only == 1 && it >= 256) break; if (only == 2) { if (it + 256 >= NA) break; it += 256; }
        int qb, th; if (it < 256) { qb = 31 - (it & 31); th = 8 + ((hperm >> (4 * (it >> 5))) & 7); } else if (it < 512) { qb = 31 - ((it - 256) >> 3); th = it & 7; } else { qb = 32; th = it - 512; }
        if (th < 8) attn_unit<0>(lds, ws, kmaxw, th, qb); else attn_unit<1>(lds, ws, kmaxw, th - 8, qb);
        __syncthreads();
        if (threadIdx.x == 0) *itemw = nfree + (int)atomicAdd(ctl + CW_ATTNQ + layer * 64 + qoff, 1u);
        asm volatile("s_waitcnt lgkmcnt(0)" ::: "memory"); __syncthreads();
        it = __builtin_amdgcn_readfirstlane(*itemw);
    }
}
#undef KSWZ
#undef SBAR
#undef PK4
}

__global__ void __launch_bounds__(NTHREADS, 2) mk_fwd(Args args) {
    extern __shared__ __attribute__((aligned(16))) unsigned char lds_raw[];
    Frame F;
    F.lds = (LAS unsigned char*)lds_raw; F.ws = args.ws; F.ctl = (unsigned*)(args.ws + WS_CTL);
    F.tid = threadIdx.x; F.lane = F.tid & 63; F.wave = __builtin_amdgcn_readfirstlane(F.tid >> 6);
    F.G = gridDim.x; F.gw = blockIdx.x * NWAVES + F.wave; F.NGW = F.G * NWAVES;
    F.in = (const float* const*)__builtin_amdgcn_kernarg_segment_ptr();
    F.out = args.out;
    volatile LAS unsigned* MISC = (volatile LAS unsigned*)(F.lds + MISC_OFF);
    for (int u = F.tid; u < (LDS_BYTES - RING_BYTES) / 4; u += NTHREADS) ((LAS unsigned*)(F.lds + RING_BYTES))[u] = 0u;
    __syncthreads();
    XcdBarrier bar = xcd_barrier_post(F.ctl + CW_BAR + args.li * XCD_BAR_WORDS, MISC + 8);
    const int lo = args.ph_lo, hi = args.ph_hi; const unsigned naive = args.naive;
#define IN(k) (lo <= (k) && (k) < hi)
#define SEAM(k) do { if (IN(k) && IN((k) + 1)) { xcd_barrier(bar); if ((DBL_MASK >> 9) & 1u) xcd_barrier(bar); } } while (0)
#define NAIVE(t) ((naive >> (t)) & 1u)
    if (IN(0)) { phase_prologue(F); SEAM(0); }
#define LAYER_PHASES(l, pb) do { \
        if (IN(pb + PH_A)) { phase_cumsum(F, NAIVE(PH_B)); if (!NAIVE(PH_B)) phase_tilesuf(F); \
            if (!NAIVE(PH_A)) { skinny16_f8(F.lds, F.ws + WS_H8 + (size_t)SEQ * DM, DM, F.ws + WS_WIN + l * WIN_L, DM, DM, INP_N, SC_H, SC_W, SkinnyInProj{F.ws, F.ctl + CW_KMAX + l * 8 * 64}); \
              ProbInProj P{DM, DM, DM, F.G, (int)blockIdx.x, F.ws + WS_H8, F.ws + WS_WIN + l * WIN_L, F.ws, SC_H, SC_W, F.ctl + CW_KMAX + l * 8 * 64, F.lds}; pg8::gemm_phase(F.lds, P); if ((DBL_MASK >> PH_A) & 1u) pg8::gemm_phase(F.lds, P); } \
            SEAM(pb + PH_A); } \
        if (IN(pb + PH_B)) { \
            if (!NAIVE(PH_B)) { att::attn_phase(F, l, 0); if ((DBL_MASK >> PH_B) & 1u) att::attn_phase(F, l, 32, true, (int)((DBL_MASK >> 12) & 3u)); } \
            SEAM(pb + PH_B); } \
        if (IN(pb + PH_C)) { \
            if (!NAIVE(PH_C)) { if (l == 0) skinny16_f8(F.lds, F.ws + WS_YB + (size_t)SEQ * DM, DM, F.ws + WS_WB + l * WB_L, DM, DM, DM, SC_Y, SC_W, SkinnyBranch{F.ws}); \
              ProbBranch P{1024, DM, DM, F.G, (int)blockIdx.x, F.ws + WS_YB, F.ws + WS_WB + l * WB_L, F.ws, SC_Y, SC_W}; pg8::gemm_phase(F.lds, P); if ((DBL_MASK >> PH_C) & 1u) pg8::gemm_phase(F.lds, P); } \
            SEAM(pb + PH_C); } \
        if (IN(pb + PH_D)) { \
            if (!NAIVE(PH_D)) { if (l == 0) skinny16_f8(F.lds, F.ws + WS_MG + (size_t)SEQ * DM, DM, F.ws + WS_WOUT + l * WOUT_L, DM, DM, DM, SC_MG, SC_W, SkinnyOut{F.ws}); \
              ProbOutProj P{DM, DM, DM, F.G, (int)blockIdx.x, F.ws + WS_MG, F.ws + WS_WOUT + l * WOUT_L, F.ws, SC_MG, SC_W}; pg8::gemm_phase(F.lds, P); if ((DBL_MASK >> PH_D) & 1u) pg8::gemm_phase(F.lds, P); } \
            SEAM(pb + PH_D); } \
        if (IN(pb + PH_E)) { if ((DBL_MASK >> PH_E) & 1u) phase_ln_router(F, l, true); phase_ln_router(F, l); SEAM(pb + PH_E); } \
        if (IN(pb + PH_F)) { \
            if (!NAIVE(PH_F)) { ProbMoeGU P{DM, DM, DM, F.G, (int)blockIdx.x, l, F.ws + WS_H8, F.ws + WS_WGU + l * WGU_L, F.ws, F.ctl, F.lds, SC_H, SC_W}; P.fill_idx(F.tid); pg8::gemm_phase(F.lds, P); if ((DBL_MASK >> PH_F) & 1u) pg8::gemm_phase(F.lds, P);  } \
            SEAM(pb + PH_F); } \
        if (IN(pb + PH_G)) { \
            if (!NAIVE(PH_G)) { ProbMoeDown P{FF, FF, FF, F.G, (int)blockIdx.x, l, F.ws + WS_ACT, F.ws + WS_WD + l * WD_L, F.ws, F.ctl, SC_ACT, SC_W}; pg8::gemm_phase(F.lds, P); if ((DBL_MASK >> PH_G) & 1u) pg8::gemm_phase(F.lds, P);  } \
            SEAM(pb + PH_G); } \
        if (IN(pb + PH_H)) { if ((DBL_MASK >> PH_H) & 1u) phase_ln_final(F, l, true); phase_ln_final(F, l); SEAM(pb + PH_H); } \
    } while (0)
    LAYER_PHASES(0, 1);
    LAYER_PHASES(1, 9);
#undef LAYER_PHASES
#undef IN
#undef SEAM
#undef NAIVE
}

static void launch_naive(int type, int layer, const Args& a, hipStream_t stream) {
    switch (type) {
    case PH_A: hipLaunchKernelGGL(naive_inproj, dim3(INP_N / 256, MROWS / 4), dim3(256), 0, stream, a, layer); break;
    case PH_B: { const int nq = NTOK; hipLaunchKernelGGL(naive_attn, dim3((16 * nq + 3) / 4), dim3(256), 0, stream, a, nq); } break;
    case PH_C: hipLaunchKernelGGL(naive_branch, dim3(DM / 256, MROWS / 4), dim3(256), 0, stream, a, layer); break;
    case PH_D: hipLaunchKernelGGL(naive_outproj, dim3(DM / 256, MROWS / 4), dim3(256), 0, stream, a, layer); break;
    case PH_F: hipLaunchKernelGGL(naive_moe_gu, dim3(FF / 256, NSLOT_MAX / 4), dim3(256), 0, stream, a, layer); break;
    case PH_G: hipLaunchKernelGGL(naive_moe_down, dim3(DM / 256, NSLOT_MAX / 4), dim3(256), 0, stream, a, layer); break;
    default: break;
    }
}
extern "C" void kernel_launch(void* const* d_in, const int* in_sizes, int n_in, void* d_out, int out_size, void* d_ws, size_t ws_size, hipStream_t stream) {
    static int grid = 0;
    if (grid == 0) {
        if (n_in != 18 || out_size != SEQ * DM || ws_size < WS_END) { fprintf(stderr, "kernel_launch: unexpected shapes (n_in %d out %d ws %zu)\n", n_in, out_size, ws_size); grid = -1; return; }
        int dev = 0, cus = 0;
        if (hipGetDevice(&dev) != hipSuccess || hipDeviceGetAttribute(&cus, hipDeviceAttributeMultiprocessorCount, dev) != hipSuccess) { grid = -1; return; }
        if (hipFuncSetAttribute((const void*)mk_fwd, hipFuncAttributeMaxDynamicSharedMemorySize, LDS_BYTES) != hipSuccess) { fprintf(stderr, "kernel_launch: hipFuncSetAttribute failed\n"); grid = -1; return; }
        int per_cu = 0;
        if (hipOccupancyMaxActiveBlocksPerMultiprocessor(&per_cu, (const void*)mk_fwd, NTHREADS, LDS_BYTES) != hipSuccess || per_cu < 1) fprintf(stderr, "kernel_launch: occupancy query says %d\n", per_cu);
        (void)hipGetLastError();
        grid = cus;
    }
    if (grid < 0) return;
    (void)hipMemsetAsync((char*)d_ws + WS_CTL, 0, CTL_ZERO_BYTES, stream);
    Args a{};
    for (int i = 0; i < 18; ++i) a.in[i] = (const float*)d_in[i];
    a.out = (float*)d_out; a.ws = (unsigned char*)d_ws; a.naive = NAIVE_MASK;
    int li = 0, lo = 0;
    auto flush = [&](int hi) { if (hi > lo) { a.ph_lo = lo; a.ph_hi = hi; a.li = li++; hipLaunchKernelGGL(mk_fwd, dim3(grid), dim3(NTHREADS), LDS_BYTES, stream, a); } lo = hi; };
    for (int ph = 1; ph < NPHASE; ++ph) {
        const int type = (ph - 1) & 7, layer = (ph - 1) >> 3;
        if ((NAIVE_MASK >> type) & 1u) {
            if (type == PH_A) flush(ph + 1); else { flush(ph); lo = ph + 1; }
            launch_naive(type, layer, a, stream); }
    }
    flush(NPHASE);
}
```

```cpp
#include <hip/hip_runtime.h>
#include <cstdio>
#include <cstdint>

#define GAS __attribute__((address_space(1)))
#define LAS __attribute__((address_space(3)))
typedef unsigned short bf16;
typedef float f32x4 __attribute__((ext_vector_type(4)));
typedef float f32x2 __attribute__((ext_vector_type(2)));
typedef unsigned u32x4 __attribute__((ext_vector_type(4)));
typedef unsigned u32x2 __attribute__((ext_vector_type(2)));
typedef GAS unsigned gu32;

constexpr int DM = 2048, SEQ = 8192, NMETA = 16, NTOK = SEQ + NMETA, MROWS = 8448;
constexpr int HD = 128, NHEAD = 8;
constexpr int QKV_N = 6144, G_N = 4096, INP_N = 10240, INP_SRC = 10248, FCOL = 6144;
constexpr int NE = 16, FF = 1024, NSLOT_MAX = 20480;
constexpr float ALPHA = 1.4142135623730951f, LN_EPS = 1e-5f;
constexpr float LOG2E = 1.4426950408889634f;
constexpr float QSCALE = 0.08838834764831845f * 1.4426950408889634f;
constexpr int NLAYER = 2, NPHASE = 1 + 8 * NLAYER;
enum { PH_A = 0, PH_B = 1, PH_C = 2, PH_D = 3, PH_E = 4, PH_F = 5, PH_G = 6, PH_H = 7 };

#ifndef NAIVE_MASK
#define NAIVE_MASK 0x00u
#endif
#ifndef DBL_MASK
#define DBL_MASK 0u
#endif
constexpr size_t MiB = 1u << 20;
constexpr size_t WS_CTL = 0, CTL_ZERO_BYTES = 1 * MiB;
constexpr size_t WS_WIN = 2 * MiB, WIN_L = 40 * MiB;
constexpr size_t WS_WB = 82 * MiB, WB_L = 8 * MiB;
constexpr size_t WS_WOUT = 98 * MiB, WOUT_L = 8 * MiB;
constexpr size_t WS_WGU = 114 * MiB, WGU_L = 128 * MiB, WGU_E = 8 * MiB;
constexpr size_t WS_WD = 370 * MiB, WD_L = 64 * MiB, WD_E = 4 * MiB;
constexpr size_t WS_HF = 498 * MiB;
constexpr size_t WS_HB = 564 * MiB;
constexpr size_t WS_RB = 597 * MiB;
constexpr size_t WS_QKV = 663 * MiB;
constexpr size_t WS_GB = 762 * MiB;
constexpr size_t WS_YB = 828 * MiB;
constexpr size_t WS_MG = 861 * MiB;
constexpr size_t WS_ACT = 663 * MiB;
constexpr size_t WS_OSL = 703 * MiB;
constexpr size_t WS_LOGF = 894 * MiB;
constexpr size_t WS_CUM = 895 * MiB;
constexpr size_t WS_ELIST = 896 * MiB;
constexpr size_t WS_TOKI = 897 * MiB;
constexpr size_t WS_H8 = 898 * MiB;
constexpr size_t WS_END = 916 * MiB;
constexpr int CW_CNT = 1024;
constexpr int CW_KMAX = 4096;
constexpr int CW_BAR = 8192;
#define XCD_BAR_WORDS 3456
constexpr int MAX_LAUNCH = 20;
static_assert((CW_BAR + MAX_LAUNCH * XCD_BAR_WORDS) * 4 <= (int)CTL_ZERO_BYTES, "ctl");

constexpr int NWAVES = 8, NTHREADS = 512;
constexpr int RING_BYTES = 131072, MISC_OFF = RING_BYTES + 320, LDS_BYTES = 147456;

constexpr float W8_SCALE = 64.f, H8_SCALE = 4.f, MG8_SCALE = 16.f, ACT8_SCALE = 4.f, Y8_SCALE = 16.f;
constexpr int SC_W = 0x79797979, SC_H = 0x7D7D7D7D, SC_MG = 0x7B7B7B7B, SC_ACT = 0x7D7D7D7D, SC_Y = 0x7B7B7B7B;
__device__ __forceinline__ unsigned f2bf(float f) { unsigned u = __builtin_bit_cast(unsigned, f); return (u + 0x7fffu + ((u >> 16) & 1u)) >> 16; }
__device__ __forceinline__ unsigned pk2(float lo, float hi) { return f2bf(lo) | (f2bf(hi) << 16); }
__device__ __forceinline__ unsigned pk4_fp8(float a, float b, float c, float d) {
    a = __builtin_amdgcn_fmed3f(a, -448.f, 448.f); b = __builtin_amdgcn_fmed3f(b, -448.f, 448.f); c = __builtin_amdgcn_fmed3f(c, -448.f, 448.f); d = __builtin_amdgcn_fmed3f(d, -448.f, 448.f);
    int w = 0; w = __builtin_amdgcn_cvt_pk_fp8_f32(a, b, w, false); w = __builtin_amdgcn_cvt_pk_fp8_f32(c, d, w, true); return (unsigned)w; }
__device__ __forceinline__ float bflo(unsigned w) { return __builtin_bit_cast(float, w << 16); }
__device__ __forceinline__ float bfhi(unsigned w) { return __builtin_bit_cast(float, w & 0xffff0000u); }
__device__ __forceinline__ float bf2f(bf16 b) { return __builtin_bit_cast(float, ((unsigned)b) << 16); }
__device__ __forceinline__ float wave_sum(float v) {
#pragma unroll
    for (int o = 1; o < 64; o <<= 1) v += __shfl_xor(v, o);
    return v;
}
__device__ __forceinline__ float wave_max(float v) {
#pragma unroll
    for (int o = 1; o < 64; o <<= 1) v = fmaxf(v, __shfl_xor(v, o));
    return v;
}
__device__ __forceinline__ int row_of_p(int p) { return p < NMETA ? SEQ + p : p - NMETA; }
__device__ __forceinline__ float sigmoidf_(float x) { return 1.0f / (1.0f + __expf(-x)); }
__device__ __forceinline__ float dot8(u32x4 a, u32x4 b, float acc) {
    acc = fmaf(bflo(a.x), bflo(b.x), acc); acc = fmaf(bfhi(a.x), bfhi(b.x), acc);
    acc = fmaf(bflo(a.y), bflo(b.y), acc); acc = fmaf(bfhi(a.y), bfhi(b.y), acc);
    acc = fmaf(bflo(a.z), bflo(b.z), acc); acc = fmaf(bfhi(a.z), bfhi(b.z), acc);
    acc = fmaf(bflo(a.w), bflo(b.w), acc); acc = fmaf(bfhi(a.w), bfhi(b.w), acc);
    return acc;
}

struct Args { const float* in[18]; float* out; unsigned char* ws; int ph_lo, ph_hi; unsigned naive; int li; };
enum { I_X = 0, I_META, I_LNIN_G, I_LNIN_B, I_WIN, I_BF, I_WBSB, I_WBFX, I_WOUT, I_LNMIX_G, I_LNMIX_B, I_WR, I_RB, I_WG, I_WU, I_WD, I_LNFFN_G, I_LNFFN_B };

__device__ __forceinline__ int moe_cnt(const unsigned* ctl, int layer, int e) { return (int)ctl[CW_CNT + (layer * NE + e) * 64]; }
__device__ __forceinline__ bool moe_find(const unsigned* ctl, int layer, int s0, int& e_out, int& cnt_out, int& ps_out) {
    int acc = 0; e_out = -1; cnt_out = 0; ps_out = 0;
#pragma unroll
    for (int e = 0; e < NE; ++e) { const int c = moe_cnt(ctl, layer, e), nb = (c + 255) >> 8;
        if (e_out < 0 && s0 < (acc + nb) * 256) { e_out = e; cnt_out = c; ps_out = acc * 256; }
        acc += nb; }
    return e_out >= 0;
}
__device__ __forceinline__ int moe_nb(const unsigned* ctl, int layer) { int acc = 0;
#pragma unroll
    for (int e = 0; e < NE; ++e) acc += (moe_cnt(ctl, layer, e) + 255) >> 8;
    return acc; }
__device__ __forceinline__ int moe_pstart(const unsigned* ctl, int layer, int ex) {
    int acc = 0, r = 0;
#pragma unroll
    for (int e = 0; e < NE; ++e) { const int c = moe_cnt(ctl, layer, e); if (e == ex) r = acc * 256; acc += (c + 255) >> 8; }
    return r;
}

__device__ __forceinline__ void inproj_store(unsigned char* ws, int row, int n, float v, unsigned* kmax = nullptr) {
    if (n < QKV_N) { const bool isq = (n < 1024) || (n >= 3072 && n < 4096); ((bf16*)(ws + WS_QKV))[(size_t)row * QKV_N + n] = (bf16)f2bf(isq ? v * QSCALE : v); }
    else ((bf16*)(ws + WS_GB))[(size_t)row * G_N + (n - QKV_N)] = (bf16)f2bf(sigmoidf_(v));
}

__device__ __forceinline__ void dot4(const bf16* a0, const bf16* a1, const bf16* a2, const bf16* a3, const bf16* b, int K, float (&acc)[4]) {
    for (int k = 0; k < K; k += 8) {
        const u32x4 bv = *(const u32x4*)(b + k);
        acc[0] = dot8(*(const u32x4*)(a0 + k), bv, acc[0]); acc[1] = dot8(*(const u32x4*)(a1 + k), bv, acc[1]);
        acc[2] = dot8(*(const u32x4*)(a2 + k), bv, acc[2]); acc[3] = dot8(*(const u32x4*)(a3 + k), bv, acc[3]);
    }
}
__global__ void __launch_bounds__(256) naive_inproj(Args a, int layer) {
    const int n = blockIdx.x * 256 + threadIdx.x, r0 = blockIdx.y * 4;
    const bf16* A = (const bf16*)(a.ws + WS_HB) + (size_t)r0 * DM; const bf16* B = (const bf16*)(a.ws + WS_WIN + layer * WIN_L) + (size_t)n * DM;
    float acc[4] = {0.f, 0.f, 0.f, 0.f};
    dot4(A, A + DM, A + 2 * DM, A + 3 * DM, B, DM, acc);
    for (int i = 0; i < 4; ++i) inproj_store(a.ws, r0 + i, n, acc[i]);
}
__global__ void __launch_bounds__(256) naive_branch(Args a, int layer) {
    const int n = blockIdx.x * 256 + threadIdx.x, r0 = blockIdx.y * 4;
    const bf16* A = (const bf16*)(a.ws + WS_YB) + (size_t)r0 * DM; const bf16* B = (const bf16*)(a.ws + WS_WB + layer * WB_L) + (size_t)n * DM;
    float s[4] = {0.f, 0.f, 0.f, 0.f}, f[4] = {0.f, 0.f, 0.f, 0.f};
    dot4(A, A + DM, A + 2 * DM, A + 3 * DM, B, 1024, s);
    dot4(A + 1024, A + DM + 1024, A + 2 * DM + 1024, A + 3 * DM + 1024, B + 1024, 1024, f);
    const bf16* G = (const bf16*)(a.ws + WS_GB);
    for (int i = 0; i < 4; ++i) { const size_t r = r0 + i; const float gs = bf2f(G[r * G_N + n]), gf = bf2f(G[r * G_N + DM + n]);
        ((bf16*)(a.ws + WS_MG))[r * DM + n] = (bf16)f2bf(gs * s[i] + gf * f[i]); }
}
__global__ void __launch_bounds__(256) naive_outproj(Args a, int layer) {
    const int n = blockIdx.x * 256 + threadIdx.x, r0 = blockIdx.y * 4;
    const bf16* A = (const bf16*)(a.ws + WS_MG) + (size_t)r0 * DM; const bf16* B = (const bf16*)(a.ws + WS_WOUT + layer * WOUT_L) + (size_t)n * DM;
    float acc[4] = {0.f, 0.f, 0.f, 0.f};
    dot4(A, A + DM, A + 2 * DM, A + 3 * DM, B, DM, acc);
    const float* HF = (const float*)(a.ws + WS_HF); float* R = (float*)(a.ws + WS_RB);
    for (int i = 0; i < 4; ++i) { const size_t o = (size_t)(r0 + i) * DM + n; R[o] = ALPHA * HF[o] + acc[i]; }
}
__global__ void __launch_bounds__(256) naive_moe_gu(Args a, int layer) {
    const int j = blockIdx.x * 256 + threadIdx.x, s0 = blockIdx.y * 4;
    int e, cnt, ps; if (!moe_find((const unsigned*)(a.ws + WS_CTL), layer, s0, e, cnt, ps)) return;
    const int* elist = (const int*)(a.ws + WS_ELIST) + (size_t)e * MROWS;
    const bf16* HB = (const bf16*)(a.ws + WS_HB);
    const int rank = s0 - ps;
    const bf16* ap0 = HB + (size_t)(rank + 0 < cnt ? elist[rank + 0] : 0) * DM; const bf16* ap1 = HB + (size_t)(rank + 1 < cnt ? elist[rank + 1] : 0) * DM;
    const bf16* ap2 = HB + (size_t)(rank + 2 < cnt ? elist[rank + 2] : 0) * DM; const bf16* ap3 = HB + (size_t)(rank + 3 < cnt ? elist[rank + 3] : 0) * DM;
    const bf16* W = (const bf16*)(a.ws + WS_WGU + layer * WGU_L + e * WGU_E);
    const int rg = 256 * (j >> 7) + (j & 127);
    float g[4] = {0.f, 0.f, 0.f, 0.f}, u[4] = {0.f, 0.f, 0.f, 0.f};
    dot4(ap0, ap1, ap2, ap3, W + (size_t)rg * DM, DM, g);
    dot4(ap0, ap1, ap2, ap3, W + (size_t)(rg + 128) * DM, DM, u);
    bf16* act = (bf16*)(a.ws + WS_ACT);
#pragma unroll
    for (int i = 0; i < 4; ++i) act[(size_t)(s0 + i) * FF + j] = (bf16)f2bf(g[i] * sigmoidf_(g[i]) * u[i]);
}
__global__ void __launch_bounds__(256) naive_moe_down(Args a, int layer) {
    const int n = blockIdx.x * 256 + threadIdx.x, s0 = blockIdx.y * 4;
    int e, cnt, ps; if (!moe_find((const unsigned*)(a.ws + WS_CTL), layer, s0, e, cnt, ps)) return;
    const bf16* A = (const bf16*)(a.ws + WS_ACT) + (size_t)s0 * FF; const bf16* B = (const bf16*)(a.ws + WS_WD + layer * WD_L + e * WD_E) + (size_t)n * FF;
    float acc[4] = {0.f, 0.f, 0.f, 0.f};
    dot4(A, A + FF, A + 2 * FF, A + 3 * FF, B, FF, acc);
    bf16* O = (bf16*)(a.ws + WS_OSL);
#pragma unroll
    for (int i = 0; i < 4; ++i) O[(size_t)(s0 + i) * DM + n] = (bf16)f2bf(acc[i]);
}
__global__ void __launch_bounds__(256) naive_attn(Args a, int nq) {
    const int lane = threadIdx.x & 63, widx = blockIdx.x * 4 + (threadIdx.x >> 6);
    const int th = widx / nq, pq = nq - 1 - (widx % nq);
    if (th >= 16) return;
    const int type = th >> 3, head = th & 7;
    const bf16* QKV = (const bf16*)(a.ws + WS_QKV);
    const int qcol = (type ? 3072 : 0) + head * HD, kcol = qcol + 1024, vcol = qcol + 2048;
    const int rowq = row_of_p(pq);
    u32x4 q[16];
#pragma unroll
    for (int i = 0; i < 16; ++i) q[i] = *(const u32x4*)(QKV + (size_t)rowq * QKV_N + qcol + 8 * i);
    const float* cum = (const float*)(a.ws + WS_CUM) + (size_t)head * MROWS;
    float o0 = 0.f, o1 = 0.f, carry = 0.f, m = -1e30f, l = 0.f;
    const float cq = type ? cum[pq] : 0.f;
    for (int phi = type ? pq : pq - 1; phi >= 0; phi -= 64) {
        const int p = phi - lane; const bool valid = p >= 0; const int pr = row_of_p(valid ? p : 0);
        float u = 0.f;
        const bf16* kp = QKV + (size_t)pr * QKV_N + kcol;
#pragma unroll
        for (int i = 0; i < 16; ++i) u = dot8(q[i], *(const u32x4*)(kp + 8 * i), u);
        float w;
        if (type == 0) {
            const float aa = exp2f(-fabsf(u)), b = log2f(1.0f + aa);
            float lk = fminf(-u, 0.f) - b; const float lb = lk + u;
            if (!valid) lk = 0.f;
            float inc = lk;
#pragma unroll
            for (int off = 1; off < 64; off <<= 1) { const float t = __shfl_up(inc, off); if (lane >= off) inc += t; }
            const float after = carry + inc - lk;
            w = valid ? exp2f(lb + after) : 0.f;
            carry += __shfl(inc, 63);
        } else {
            const float s = valid ? u + cq - cum[valid ? p : 0] : -__builtin_inff();
            const float cm = wave_max(s), mn = fmaxf(m, cm), alpha = exp2f(m - mn);
            w = valid ? exp2f(s - mn) : 0.f;
            l = l * alpha + wave_sum(w); o0 *= alpha; o1 *= alpha; m = mn;
        }
        for (int j = 0; j < 64; ++j) {
            const float wj = __shfl(w, j); const int prj = __shfl(pr, j);
            const unsigned vv = *(const unsigned*)(QKV + (size_t)prj * QKV_N + vcol + 2 * lane);
            o0 = fmaf(wj, bflo(vv), o0); o1 = fmaf(wj, bfhi(vv), o1);
        }
    }
    if (type) { const float rl = 1.0f / l; o0 *= rl; o1 *= rl; }
    *(unsigned*)((bf16*)(a.ws + WS_YB) + (size_t)rowq * DM + type * 1024 + head * HD + 2 * lane) = pk2(o0, o1);
}

#define XB_TMO      128
#define XB_XCNT(j)  (256  + 64 * (j))
#define XB_XSUB(j)  (1280 + 64 * (j))
#define XB_XGEN(j)  (2304 + 64 * (j))
#define XB_TOP      3328
#define XB_TOPGEN   3392
#define XB_SPIN_CAP (1u << 18)
__device__ __forceinline__ unsigned xb_ld(unsigned* p)              { return __hip_atomic_load(p, __ATOMIC_RELAXED, __HIP_MEMORY_SCOPE_AGENT); }
__device__ __forceinline__ unsigned xb_add(unsigned* p, unsigned v) { return __hip_atomic_fetch_add(p, v, __ATOMIC_RELAXED, __HIP_MEMORY_SCOPE_AGENT); }
__device__ __forceinline__ unsigned xb_xcc_id() { return (unsigned)__builtin_amdgcn_s_getreg((3 << 11) | 20) & 0xFu; }
#define XB_SPIN(cond, bar) do { unsigned _sp = 0; while (cond) { __builtin_amdgcn_s_sleep(1); \
    if ((++_sp & 255u) == 0u) { if (xb_ld(&(bar)[XB_TMO])) break; if (_sp > XB_SPIN_CAP) { atomicAdd(&(bar)[XB_TMO], 1u); break; } } } } while (0)
struct XcdBarrier { unsigned* bar; unsigned x; volatile LAS unsigned* st; };
__device__ __forceinline__ XcdBarrier xcd_barrier_post(unsigned* bar, volatile LAS unsigned* st) {
    XcdBarrier b; b.bar = bar; b.x = xb_xcc_id(); b.st = st;
    if (threadIdx.x == 0) (void)xb_add(&bar[XB_XCNT(b.x)], 1u);
    return b;
}
__device__ __forceinline__ void xcd_barrier_complete(unsigned* bar, unsigned x, unsigned& nloc, unsigned& nx) {
    const unsigned G = gridDim.x * gridDim.y * gridDim.z;
    unsigned sum, cnt, mine, sp = 0u;
    for (;;) {
        sum = 0u; cnt = 0u; mine = 0u;
#pragma unroll
        for (unsigned j = 0; j < 16; ++j) { const unsigned c = xb_ld(&bar[XB_XCNT(j)]); sum += c; cnt += (c > 0u) ? 1u : 0u; mine = (j == x) ? c : mine; }
        if (sum == G) break;
        __builtin_amdgcn_s_sleep(1);
        if ((++sp & 255u) == 0u) { if (xb_ld(&bar[XB_TMO])) break; if (sp > XB_SPIN_CAP) { atomicAdd(&bar[XB_TMO], 1u); break; } }
    }
    nloc = mine > 0u ? mine : 1u; nx = cnt > 0u ? cnt : 1u;
}
__device__ __forceinline__ void xcd_barrier(const XcdBarrier& b) {
    asm volatile("s_waitcnt vmcnt(0)" ::: "memory");
    __syncthreads();
    if (threadIdx.x == 0) {
        unsigned* bar = b.bar;
        __builtin_amdgcn_s_waitcnt(0);
        unsigned nloc = b.st[0], nx = b.st[1];
        if (nloc == 0u) { xcd_barrier_complete(bar, b.x, nloc, nx); b.st[0] = nloc; b.st[1] = nx; }
        const unsigned old = xb_add(&bar[XB_XSUB(b.x)], 1u);
        const unsigned gen = old / nloc;
        if (old + 1u == (gen + 1u) * nloc) {
            __builtin_amdgcn_fence(__ATOMIC_RELEASE, "agent");
            asm volatile("s_waitcnt vmcnt(0)" ::: "memory");
            const unsigned og = xb_add(&bar[XB_TOP], 1u);
            const unsigned tg = og / nx;
            if (og + 1u == (tg + 1u) * nx) xb_add(&bar[XB_TOPGEN], 1u);
            else XB_SPIN(xb_ld(&bar[XB_TOPGEN]) == tg, bar);
            __builtin_amdgcn_fence(__ATOMIC_ACQUIRE, "agent");
            xb_add(&bar[XB_XGEN(b.x)], 1u);
            asm volatile("s_waitcnt vmcnt(0)" ::: "memory");
        } else {
            XB_SPIN(xb_ld(&bar[XB_XGEN(b.x)]) == gen, bar);
            __builtin_amdgcn_fence(__ATOMIC_ACQUIRE, "agent");
            asm volatile("s_waitcnt vmcnt(0)" ::: "memory");
        }
    }
    __syncthreads();
}

__device__ __forceinline__ int lane_id() { return (int)(threadIdx.x & 63); }
struct Frame {
    LAS unsigned char* lds; unsigned char* ws; unsigned* ctl;
    int wave, G, gw, NGW;
    const float* const* in; float* out;
};
#define LDS_WAIT() asm volatile("s_waitcnt lgkmcnt(0)" ::: "memory")

__device__ __forceinline__ void transpose_item(const float* W, size_t ldw, bf16* WT, size_t ldt, LAS float* scr, int lane) {
#pragma unroll 8
    for (int i = 0; i < 32; ++i) { const int kk = 2 * i + (lane >> 5); scr[kk * 33 + (lane & 31)] = W[(size_t)kk * ldw + (lane & 31)]; }
    LDS_WAIT(); asm volatile("" ::: "memory");
    const int c = lane & 7;
#pragma unroll
    for (int j = 0; j < 4; ++j) { const int n = (lane >> 3) + 8 * j; const LAS float* s = scr + (8 * c) * 33 + n;
        u32x4 o; o.x = pk2(s[0 * 33], s[1 * 33]); o.y = pk2(s[2 * 33], s[3 * 33]); o.z = pk2(s[4 * 33], s[5 * 33]); o.w = pk2(s[6 * 33], s[7 * 33]);
        *(u32x4*)(WT + (size_t)n * ldt + 8 * c) = o; }
    LDS_WAIT(); asm volatile("" ::: "memory");
}
__device__ __forceinline__ void transpose_item8(const float* W, size_t ldw, unsigned char* WT, size_t ldt, LAS float* scr, int lane) {
#pragma unroll 8
    for (int i = 0; i < 32; ++i) { const int kk = 2 * i + (lane >> 5); scr[kk * 33 + (lane & 31)] = W[(size_t)kk * ldw + (lane & 31)]; }
    LDS_WAIT(); asm volatile("" ::: "memory");
    const int c = lane & 3;
#pragma unroll
    for (int j = 0; j < 2; ++j) { const int n = (lane >> 2) + 16 * j; const LAS float* p = scr + (16 * c) * 33 + n;
        u32x4 o;
        o.x = pk4_fp8(p[0 * 33] * W8_SCALE, p[1 * 33] * W8_SCALE, p[2 * 33] * W8_SCALE, p[3 * 33] * W8_SCALE); o.y = pk4_fp8(p[4 * 33] * W8_SCALE, p[5 * 33] * W8_SCALE, p[6 * 33] * W8_SCALE, p[7 * 33] * W8_SCALE);
        o.z = pk4_fp8(p[8 * 33] * W8_SCALE, p[9 * 33] * W8_SCALE, p[10 * 33] * W8_SCALE, p[11 * 33] * W8_SCALE); o.w = pk4_fp8(p[12 * 33] * W8_SCALE, p[13 * 33] * W8_SCALE, p[14 * 33] * W8_SCALE, p[15 * 33] * W8_SCALE);
        *(u32x4*)(WT + (size_t)n * ldt + 16 * c) = o; }
    LDS_WAIT(); asm volatile("" ::: "memory");
}
__device__ __forceinline__ void convert_item(Frame& F, int it, LAS float* scr) {
    constexpr int I_IN = 32 * 320, I_BS = 16 * 64, I_OUT = 32 * 64, I_GE = 32 * 32, I_DE = 16 * 64;
    constexpr int PER_LAYER = I_IN + 2 * I_BS + I_OUT + NE * (2 * I_GE + I_DE);
    const int l = it / PER_LAYER; int r = it % PER_LAYER;
    if (r < I_IN) { const int kb = r / 320, nb = r % 320, nd = 32 * nb, ns = nd + (nd >= FCOL ? 8 : 0);
        transpose_item8(F.in[I_WIN] + (size_t)l * DM * INP_SRC + (size_t)(64 * kb) * INP_SRC + ns, INP_SRC, F.ws + WS_WIN + l * WIN_L + (size_t)nd * DM + 64 * kb, DM, scr, lane_id()); return; }
    r -= I_IN;
    if (r < 2 * I_BS) { const int which = r / I_BS; r %= I_BS; const int kb = r / 64, nb = r % 64;
        transpose_item8((which ? F.in[I_WBFX] : F.in[I_WBSB]) + (size_t)l * 1024 * DM + (size_t)(64 * kb) * DM + 32 * nb, DM, F.ws + WS_WB + l * WB_L + (size_t)(32 * nb) * DM + which * 1024 + 64 * kb, DM, scr, lane_id()); return; }
    r -= 2 * I_BS;
    if (r < I_OUT) { const int kb = r / 64, nb = r % 64;
        transpose_item8(F.in[I_WOUT] + (size_t)l * DM * DM + (size_t)(64 * kb) * DM + 32 * nb, DM, F.ws + WS_WOUT + l * WOUT_L + (size_t)(32 * nb) * DM + 64 * kb, DM, scr, lane_id()); return; }
    r -= I_OUT;
    const int e = r / (2 * I_GE + I_DE); r %= (2 * I_GE + I_DE);
    if (r < 2 * I_GE) { const int which = r / I_GE; r %= I_GE; const int kb = r / 32, nb = r % 32, n0 = 32 * nb, rho = 256 * (n0 >> 7) + (n0 & 127) + which * 128;
        transpose_item8((which ? F.in[I_WU] : F.in[I_WG]) + ((size_t)(l * NE + e) * DM + 64 * kb) * FF + n0, FF, F.ws + WS_WGU + l * WGU_L + e * WGU_E + (size_t)rho * DM + 64 * kb, DM, scr, lane_id()); return; }
    r -= 2 * I_GE;
    { const int kb = r / 64, nb = r % 64;
        transpose_item8(F.in[I_WD] + ((size_t)(l * NE + e) * FF + 64 * kb) * DM + 32 * nb, DM, F.ws + WS_WD + l * WD_L + e * WD_E + (size_t)(32 * nb) * FF + 64 * kb, FF, scr, lane_id()); }
}
constexpr int N_CONVERT_ITEMS = NLAYER * (32 * 320 + 2 * 16 * 64 + 32 * 64 + NE * (2 * 32 * 32 + 16 * 64));
constexpr int CV_PER_LAYER = N_CONVERT_ITEMS / NLAYER, CV_G0_END = 32 * 320, CV_G1_END = CV_PER_LAYER + 32 * 320, CV_BUNDLE = 128;
static_assert((CV_G1_END - CV_G0_END) % CV_BUNDLE == 0 && (N_CONVERT_ITEMS - CV_G1_END) % CV_BUNDLE == 0, "bundles");
__device__ __forceinline__ void convert_bundle(Frame& F, int first_item) {
    LAS float* scr = (LAS float*)(F.lds + F.wave * 16384);
    for (int i = 0; i < CV_BUNDLE / NWAVES; ++i) convert_item(F, first_item + F.wave + NWAVES * i, scr);
}

__device__ __forceinline__ int tab_rowpos(int c) { return (c & 3) * 512 + (c >> 8) * 64 + ((c >> 2) & 63); }
template <int NC> __device__ __forceinline__ void stage_table(Frame& F, const float* src, size_t pitch) {
    constexpr int CH = NC / 4;
    for (int ci = ((int)threadIdx.x); ci < DM * CH; ci += NTHREADS) { const int c = ci / CH, q = ci % CH;
        const f32x4 v = *(const f32x4*)(src + (size_t)c * pitch + 4 * q);
        const int sw = (NC == 16) ? ((c >> 4) & 3) : ((c >> 5) & 1);
        *(LAS f32x4*)(F.lds + tab_rowpos(c) * (NC * 4) + ((q ^ sw) << 4)) = v; }
    LDS_WAIT(); __syncthreads();
}
template <int NC> __device__ __forceinline__ void table_dot(Frame& F, const f32x4 (&y)[8], float (&acc)[NC]) {
    constexpr int CH = NC / 4; const int l = lane_id(); const int sw = (NC == 16) ? ((l >> 2) & 3) : ((l >> 3) & 1);
#pragma unroll
    for (int e = 0; e < NC; ++e) acc[e] = 0.f;
#pragma unroll
    for (int j = 0; j < 8; ++j)
#pragma unroll
        for (int i = 0; i < 4; ++i) { const float yv = y[j][i]; const int rp = i * 512 + j * 64 + l; if (i == 0) asm volatile("" ::: "memory");
#pragma unroll
            for (int q = 0; q < CH; ++q) { const f32x4 w = *(const LAS f32x4*)(F.lds + rp * (NC * 4) + ((q ^ sw) << 4));
                acc[4 * q + 0] = fmaf(yv, w.x, acc[4 * q + 0]); acc[4 * q + 1] = fmaf(yv, w.y, acc[4 * q + 1]); acc[4 * q + 2] = fmaf(yv, w.z, acc[4 * q + 2]); acc[4 * q + 3] = fmaf(yv, w.w, acc[4 * q + 3]); } }
#pragma unroll
    for (int e = 0; e < NC; ++e) acc[e] = wave_sum(acc[e]);
}
__device__ __forceinline__ void ln_row(Frame& F, f32x4 (&v)[8], const float* g, const float* b) {
    float s = 0.f;
#pragma unroll
    for (int j = 0; j < 8; ++j) s += (v[j].x + v[j].y) + (v[j].z + v[j].w);
    const float mean = wave_sum(s) * (1.f / DM); float s2 = 0.f;
#pragma unroll
    for (int j = 0; j < 8; ++j) { v[j] = v[j] - mean; s2 += (v[j].x * v[j].x + v[j].y * v[j].y) + (v[j].z * v[j].z + v[j].w * v[j].w); }
    const float rstd = 1.0f / sqrtf(wave_sum(s2) * (1.f / DM) + LN_EPS);
#pragma unroll
    for (int j = 0; j < 8; ++j) { const f32x4 gv = *(const f32x4*)(g + 256 * j + 4 * lane_id()), bv = *(const f32x4*)(b + 256 * j + 4 * lane_id()); v[j] = v[j] * rstd * gv + bv; }
}
__device__ __forceinline__ void store_h(Frame& F, int row, const f32x4 (&y)[8], bool dry = false) {
    float* hf = (float*)(F.ws + (dry ? WS_YB : WS_HF)) + (size_t)row * DM; bf16* hb = (bf16*)(F.ws + (dry ? WS_GB + 21 * MiB : WS_HB)) + (size_t)row * DM;
    unsigned char* h8 = F.ws + (dry ? WS_GB + 21 * MiB : WS_H8) + (size_t)row * DM;
#pragma unroll
    for (int j = 0; j < 8; ++j) { *(f32x4*)(hf + 256 * j + 4 * lane_id()) = y[j]; if (NAIVE_MASK != 0u) { u32x2 w; w.x = pk2(y[j].x, y[j].y); w.y = pk2(y[j].z, y[j].w); *(u32x2*)(hb + 256 * j + 4 * lane_id()) = w; }
        *(unsigned*)(h8 + 256 * j + 4 * lane_id()) = pk4_fp8(y[j].x * H8_SCALE, y[j].y * H8_SCALE, y[j].z * H8_SCALE, y[j].w * H8_SCALE); }
}
__device__ __forceinline__ void store_logf(Frame& F, int row, const f32x4 (&y)[8], const float* bfor) {
    float acc[8]; table_dot<8>(F, y, acc);
    if (lane_id() < 8) { float a = acc[0];
#pragma unroll
        for (int h = 1; h < 8; ++h) a = (lane_id() == h) ? acc[h] : a;
        const float x = a + bfor[lane_id()];
        const float ls = fminf(x, 0.f) - log1pf(__expf(-fabsf(x)));
        ((float*)(F.ws + WS_LOGF))[(size_t)row * 8 + lane_id()] = ls; }
}

__device__ __forceinline__ void phase_prologue(Frame& F) {
    LAS float* scr = (LAS float*)(F.lds + F.wave * 16384);
    for (int it = F.gw; it < CV_G0_END; it += F.NGW) convert_item(F, it, scr);
    __syncthreads();
    stage_table<8>(F, F.in[I_WIN] + FCOL, INP_SRC);
    for (int row = F.gw; row < NTOK; row += F.NGW) {
        const float* src = row < SEQ ? F.in[I_X] + (size_t)row * DM : F.in[I_META] + (size_t)(row - SEQ) * DM;
        f32x4 v[8];
#pragma unroll
        for (int j = 0; j < 8; ++j) v[j] = *(const f32x4*)(src + 256 * j + 4 * lane_id());
        ln_row(F, v, F.in[I_LNIN_G], F.in[I_LNIN_B]);
        store_h(F, row, v);
        store_logf(F, row, v, F.in[I_BF]);
    }
    for (int row = NTOK + F.gw; row < MROWS; row += F.NGW) { bf16* hb = (bf16*)(F.ws + WS_HB) + (size_t)row * DM;
#pragma unroll
        for (int j = 0; j < 4; ++j) *(u32x4*)(hb + 512 * j + 8 * lane_id()) = (u32x4){0u, 0u, 0u, 0u}; }
    __syncthreads();
}
__device__ __forceinline__ void phase_tilesuf(Frame& F) {
    if (blockIdx.x > SEQ / 64) return;
    const int tile = blockIdx.x, h = F.wave, row = tile * 64 + lane_id();
    const float v = (row < NTOK) ? LOG2E * ((const float*)(F.ws + WS_LOGF))[(size_t)row * 8 + h] : 0.f;
    float inc = v;
#pragma unroll
    for (int off = 1; off < 64; off <<= 1) { const float t = __shfl_down(inc, off); if (lane_id() + off < 64) inc += t; }
    float* base = (float*)(F.ws + WS_CUM);
    base[(size_t)h * MROWS + row] = inc - v;
    if (lane_id() == 0) base[(size_t)NHEAD * MROWS + h * 256 + tile] = inc;
}
__device__ __forceinline__ void phase_cumsum(Frame& F, bool do_scan) {
    if (blockIdx.x >= NHEAD) {
        if (blockIdx.x < NHEAD + 48) { bf16* q = (bf16*)(F.ws + WS_QKV) + (size_t)(NTOK + blockIdx.x - NHEAD) * QKV_N;
            for (int i = ((int)threadIdx.x); i < QKV_N / 8; i += NTHREADS) *(u32x4*)(q + 8 * i) = (u32x4){0u, 0u, 0u, 0u}; }
        return; }
    if (!do_scan) return;
    const int h = blockIdx.x; const float* logf = (const float*)(F.ws + WS_LOGF); float* cum = (float*)(F.ws + WS_CUM) + (size_t)h * MROWS;
    constexpr int PER = 17; const int p0 = ((int)threadIdx.x) * PER;
    float loc[PER]; float s = 0.f;
#pragma unroll
    for (int i = 0; i < PER; ++i) { const int p = p0 + i; const float v = p < NTOK ? logf[(size_t)row_of_p(p) * 8 + h] : 0.f; s += v; loc[i] = s; }
    float inc = s;
#pragma unroll
    for (int off = 1; off < 64; off <<= 1) { const float t = __shfl_up(inc, off); if (lane_id() >= off) inc += t; }
    LAS float* wt = (LAS float*)(F.lds);
    if (lane_id() == 63) wt[F.wave] = inc;
    LDS_WAIT(); __syncthreads();
    float base = inc - s;
    for (int w = 0; w < F.wave; ++w) base += wt[w];
#pragma unroll
    for (int i = 0; i < PER; ++i) { const int p = p0 + i; if (p < NTOK) cum[p] = (base + loc[i]) * LOG2E; }
    LDS_WAIT(); __syncthreads();
}
__device__ __forceinline__ void phase_ln_router(Frame& F, int layer, bool dry = false) {
    stage_table<16>(F, F.in[I_WR], 16);
    const float* g = F.in[I_LNMIX_G] + layer * DM; const float* b = F.in[I_LNMIX_B] + layer * DM;
    const float* rbias = F.in[I_RB];
    const int nrows_e = layer == NLAYER - 1 ? SEQ : NTOK;
    LAS int* lcnt = (LAS int*)(F.lds + RING_BYTES + 4096); LAS int* gbase = lcnt + 16; LAS int* rec = lcnt + 32;
    if (((int)threadIdx.x) < 32) lcnt[((int)threadIdx.x)] = 0;
    LDS_WAIT(); __syncthreads();
    const bf16* RBp = (const bf16*)(F.ws + WS_RB);
    u32x2 vn[8];
    if (F.gw < nrows_e) { const bf16* src = RBp + (size_t)F.gw * DM;
#pragma unroll
        for (int j = 0; j < 8; ++j) vn[j] = *(const u32x2*)(src + 256 * j + 4 * lane_id()); }
    int k = 0;
    for (int row = F.gw; row < nrows_e; row += F.NGW, ++k) {
        f32x4 v[8];
#pragma unroll
        for (int j = 0; j < 8; ++j) { v[j].x = bflo(vn[j].x); v[j].y = bfhi(vn[j].x); v[j].z = bflo(vn[j].y); v[j].w = bfhi(vn[j].y); }
        if (row + F.NGW < nrows_e) { const bf16* src = RBp + (size_t)(row + F.NGW) * DM;
#pragma unroll
            for (int j = 0; j < 8; ++j) vn[j] = *(const u32x2*)(src + 256 * j + 4 * lane_id()); }
        ln_row(F, v, g, b);
        store_h(F, row, v, dry);
        float lg[16]; table_dot<16>(F, v, lg);
        float aff[16], sel[16];
#pragma unroll
        for (int e = 0; e < 16; ++e) { aff[e] = 1.0f / (1.0f + __expf(-lg[e])); sel[e] = aff[e] + rbias[e]; }
        int bg = 0; float bs = -__builtin_inff();
#pragma unroll
        for (int gi = 0; gi < 4; ++gi) { const float a0 = sel[4 * gi], a1 = sel[4 * gi + 1], a2 = sel[4 * gi + 2], a3 = sel[4 * gi + 3];
            const float h1 = fmaxf(a0, a1), l1 = fminf(a0, a1), h2 = fmaxf(a2, a3), l2 = fminf(a2, a3);
            const float top = fmaxf(h1, h2), sec = fmaxf(fminf(h1, h2), fmaxf(l1, l2)), sc = top + sec;
            if (sc > bs) { bs = sc; bg = gi; } }
        float s4[4], a4[4];
#pragma unroll
        for (int i = 0; i < 4; ++i) { s4[i] = sel[i]; a4[i] = aff[i]; }
#pragma unroll
        for (int gi = 1; gi < 4; ++gi) if (bg == gi) {
#pragma unroll
            for (int i = 0; i < 4; ++i) { s4[i] = sel[4 * gi + i]; a4[i] = aff[4 * gi + i]; } }
        int i1 = 0; float m1 = s4[0];
#pragma unroll
        for (int i = 1; i < 4; ++i) if (s4[i] > m1) { m1 = s4[i]; i1 = i; }
        int i2 = -1; float m2 = -__builtin_inff();
#pragma unroll
        for (int i = 0; i < 4; ++i) if (i != i1 && s4[i] > m2) { m2 = s4[i]; i2 = i; }
        float af1 = a4[0], af2 = a4[0];
#pragma unroll
        for (int i = 1; i < 4; ++i) { if (i1 == i) af1 = a4[i]; if (i2 == i) af2 = a4[i]; }
        const float wsum = af1 + af2, w1 = af1 / wsum, w2 = af2 / wsum;
        const int e1 = 4 * bg + i1, e2 = 4 * bg + i2;
        if (lane_id() == 0 && !dry) { LAS int* rc = rec + (F.wave * 5 + k) * 8;
            rc[0] = e1; rc[1] = e2; rc[2] = __hip_atomic_fetch_add(lcnt + e1, 1, __ATOMIC_RELAXED, __HIP_MEMORY_SCOPE_WORKGROUP); rc[3] = __hip_atomic_fetch_add(lcnt + e2, 1, __ATOMIC_RELAXED, __HIP_MEMORY_SCOPE_WORKGROUP);
            rc[4] = __builtin_bit_cast(int, w1); rc[5] = __builtin_bit_cast(int, w2); rc[6] = row; }
    }
    LDS_WAIT(); __syncthreads();
    if (((int)threadIdx.x) < NE && !dry) { const int c = lcnt[((int)threadIdx.x)]; gbase[((int)threadIdx.x)] = c > 0 ? (int)atomicAdd(F.ctl + CW_CNT + (layer * NE + ((int)threadIdx.x)) * 64, (unsigned)c) : 0; }
    LDS_WAIT(); __syncthreads();
    if (((int)threadIdx.x) < 40 && !dry) { const int w = ((int)threadIdx.x) / 5, kk = ((int)threadIdx.x) % 5; const int row = F.gw - F.wave + w + kk * F.NGW;
        if (row < nrows_e) { const LAS int* rc = rec + ((int)threadIdx.x) * 8; const int e1 = rc[0], e2 = rc[1], r1 = gbase[e1] + rc[2], r2 = gbase[e2] + rc[3];
            int* el = (int*)(F.ws + WS_ELIST); el[(size_t)e1 * MROWS + r1] = row; el[(size_t)e2 * MROWS + r2] = row;
            int* ti = (int*)(F.ws + WS_TOKI) + (size_t)row * 8;
            ti[0] = e1; ti[1] = e2; ti[2] = r1; ti[3] = r2; ti[4] = rc[4]; ti[5] = rc[5]; } }
    __syncthreads();
}
__device__ __forceinline__ void phase_ln_final(Frame& F, int layer, bool dry = false) {
    const bool last = layer == NLAYER - 1;
    if (!last) stage_table<8>(F, F.in[I_WIN] + (size_t)(layer + 1) * DM * INP_SRC + FCOL, INP_SRC);
    const float* g = F.in[I_LNFFN_G] + layer * DM; const float* b = F.in[I_LNFFN_B] + layer * DM;
    const int nrows = last ? SEQ : NTOK;
    const int* TI = (const int*)(F.ws + WS_TOKI); const bf16* OSL = (const bf16*)(F.ws + WS_OSL); const float* HFp = (const float*)(F.ws + WS_HF);
    int tA[6], tB[6]; f32x4 hvn[8]; u32x2 an[8], cn[8]; float w1n = 0.f, w2n = 0.f;
#define H_LOADTOK(dst, r_) do { _Pragma("unroll") for (int q_ = 0; q_ < 6; ++q_) dst[q_] = TI[(size_t)(r_) * 8 + q_]; } while (0)
#define H_ISSUE(tk, r_) do { const int ps1_ = moe_pstart(F.ctl, layer, tk[0]), ps2_ = moe_pstart(F.ctl, layer, tk[1]); \
        const bf16* o1_ = OSL + (size_t)(ps1_ + tk[2]) * DM; const bf16* o2_ = OSL + (size_t)(ps2_ + tk[3]) * DM; const float* hf_ = HFp + (size_t)(r_) * DM; \
        w1n = __builtin_bit_cast(float, tk[4]); w2n = __builtin_bit_cast(float, tk[5]); \
        _Pragma("unroll") for (int j = 0; j < 8; ++j) { hvn[j] = *(const f32x4*)(hf_ + 256 * j + 4 * lane_id()); an[j] = *(const u32x2*)(o1_ + 256 * j + 4 * lane_id()); cn[j] = *(const u32x2*)(o2_ + 256 * j + 4 * lane_id()); } } while (0)
    if (F.gw < nrows) { H_LOADTOK(tA, F.gw); H_ISSUE(tA, F.gw); }
    if (F.gw + F.NGW < nrows) H_LOADTOK(tB, F.gw + F.NGW);
    for (int row = F.gw; row < nrows; row += F.NGW) {
        f32x4 v[8]; const float w1 = w1n, w2 = w2n;
#pragma unroll
        for (int j = 0; j < 8; ++j) { const f32x4 hv = hvn[j]; const u32x2 a = an[j], c = cn[j];
            v[j].x = ALPHA * hv.x + w1 * bflo(a.x) + w2 * bflo(c.x); v[j].y = ALPHA * hv.y + w1 * bfhi(a.x) + w2 * bfhi(c.x);
            v[j].z = ALPHA * hv.z + w1 * bflo(a.y) + w2 * bflo(c.y); v[j].w = ALPHA * hv.w + w1 * bfhi(a.y) + w2 * bfhi(c.y); }
        if (row + F.NGW < nrows) { H_ISSUE(tB, row + F.NGW); if (row + 2 * F.NGW < nrows) H_LOADTOK(tB, row + 2 * F.NGW); }
        ln_row(F, v, g, b);
        if (dry) { store_h(F, row, v, true); if (!last) { float acc8[8]; table_dot<8>(F, v, acc8); if (lane_id() == 0) ((float*)(F.ws + WS_GB + 60 * MiB))[row] = acc8[0] + acc8[7]; } }
        else if (last) { float* o = F.out + (size_t)row * DM;
#pragma unroll
            for (int j = 0; j < 8; ++j) *(f32x4*)(o + 256 * j + 4 * lane_id()) = v[j]; }
        else { store_h(F, row, v); store_logf(F, row, v, F.in[I_BF] + (layer + 1) * NHEAD); }
    }
#undef H_LOADTOK
#undef H_ISSUE
    __syncthreads();
}

namespace pg8 {
typedef short bf16x8 __attribute__((ext_vector_type(8)));
typedef int i32x4 __attribute__((ext_vector_type(4)));
typedef int i32x8 __attribute__((ext_vector_type(8)));
__device__ __forceinline__ i32x8 ld_frag(const LAS unsigned char* p) { const i32x4 x = *(const LAS i32x4*)p, y = *(const LAS i32x4*)(p + 1024); return __builtin_shufflevector(x, y, 0, 1, 2, 3, 4, 5, 6, 7); }
__device__ __forceinline__ bf16x8 frag_lo(i32x8 f) { return __builtin_bit_cast(bf16x8, (i32x4)__builtin_shufflevector(f, f, 0, 1, 2, 3)); }
__device__ __forceinline__ bf16x8 frag_hi(i32x8 f) { return __builtin_bit_cast(bf16x8, (i32x4)__builtin_shufflevector(f, f, 4, 5, 6, 7)); }
constexpr int BM = 256, BK = 64, HALF = 128, HTB = HALF * BK * 2, STAGE_BYTES = 8 * HTB, NXCD = 8, WGM = 8;
__host__ __device__ __forceinline__ int lds_byte(int r, int c) { const int st = (r >> 4) * 2 + (c >> 5), rr = r & 15, cc = c & 31, ob = rr * 64 + cc * 2; return st * 1024 + (ob ^ (((ob >> 9) & 1) << 5)); }
__host__ __device__ __forceinline__ void stage_rc(int b, int& R, int& C) { const int st = b / 1024, sb = b % 1024, swz = sb ^ (((sb >> 9) & 1) << 5); R = (st >> 1) * 16 + swz / 64; C = (st & 1) * 32 + (swz % 64) / 2; }
__host__ __device__ __forceinline__ int perm32(int rho) { const int n = rho >> 4, i = rho & 15; return 8 * (i >> 2) + 4 * n + (i & 3); }
struct Unit { int pm, pn, aux; };
__device__ __forceinline__ bool static_tile(int nM, int nN, int G, int c, int i, int& pm, int& pn) {
    const int nwg = nM * nN; const long L = (long)i * G + c; if (L >= nwg) return false;
    int wgid = (int)L; { const int q = nwg / NXCD, r = nwg % NXCD, xcd = wgid % NXCD, off = wgid / NXCD; wgid = (xcd < r ? xcd * (q + 1) : r * (q + 1) + (xcd - r) * q) + off; }
    const int nig = WGM * nN, gid = wgid / nig, fm = gid * WGM, gsz = (nM - fm) < WGM ? (nM - fm) : WGM;
    pm = fm + ((wgid % nig) % gsz); pn = (wgid % nig) / gsz; return true;
}
__device__ __forceinline__ unsigned cvt_pk_bf16(float lo, float hi) { unsigned r; asm volatile("v_cvt_pk_bf16_f32 %0, %1, %2" : "=v"(r) : "v"(lo), "v"(hi)); return r; }

template <class P>
__device__ __forceinline__ void gemm_phase(LAS unsigned char* lds, const P& prob) {
    const int tid = threadIdx.x, wid = __builtin_amdgcn_readfirstlane(tid >> 6), lane = tid & 63, wr = wid >> 2, wc = wid & 3, fr = lane & 15, fq = lane >> 4;
    constexpr int ES = P::FP8 ? 1 : 2;
    const int nt = prob.K * ES / (BK * 2);
    unsigned voffA[2], voffA1[2], voffB[2];
#pragma unroll
    for (int i = 0; i < 2; ++i) { int R, C; stage_rc(tid * 16 + i * 8192, R, C); const int Rb = P::PERM ? ((R & ~31) + perm32(R & 31)) : R;
        voffA[i] = (unsigned)(R * prob.lda * ES + C * 2); voffA1[i] = voffA[i]; voffB[i] = (unsigned)(Rb * prob.ldb * ES + C * 2); }
    const size_t kstep = (size_t)(BK * 2);
    const size_t hstepA = P::GATHER ? (size_t)0 : (size_t)HALF * prob.lda * ES, hstepB = (size_t)HALF * prob.ldb * ES;
    const unsigned ldsw = (unsigned)wid * 1024u;
    const int aoff = lds_byte(wr * 64 + fr, fq * 8), boff = lds_byte(wc * 32 + fr, fq * 8);
#define PG8_SA(b, h) (((b) * 2 + (h)) * HTB)
#define PG8_SB(b, h) ((4 + (b) * 2 + (h)) * HTB)
#define PG8_STAGE(bufoff, gbase, voff) do { _Pragma("unroll") for (int _i = 0; _i < 2; ++_i) \
        __builtin_amdgcn_global_load_lds((const unsigned*)((const char*)(gbase) + (voff)[_i]), (LAS unsigned*)(lds + (bufoff) + ldsw + _i * 8192), 16, 0, 0); } while (0)
#define PG8_LDA(dst, b, h) do { _Pragma("unroll") for (int m = 0; m < 4; ++m) dst[m] = ld_frag(lds + PG8_SA(b, h) + aoff + m * 2048); } while (0)
#define PG8_LDB(dst, b, h) do { _Pragma("unroll") for (int n = 0; n < 2; ++n) dst[n] = ld_frag(lds + PG8_SB(b, h) + boff + n * 2048); } while (0)
#define PG8_MMA(ai, bj, At, Bt) do { __builtin_amdgcn_s_setprio(1); _Pragma("unroll") for (int m = 0; m < 4; ++m) _Pragma("unroll") for (int n = 0; n < 2; ++n) { \
        if constexpr (P::FP8) asm volatile("v_mfma_scale_f32_16x16x128_f8f6f4 %0, %1, %2, %0, %3, %4 op_sel_hi:[0,0,0]" : "+v"(acc[ai][bj][m][n]) : "v"(Bt[n]), "v"(At[m]), "v"(scb), "v"(sca)); \
        else { acc[ai][bj][m][n] = __builtin_amdgcn_mfma_f32_16x16x32_bf16(frag_lo(Bt[n]), frag_lo(At[m]), acc[ai][bj][m][n], 0, 0, 0); \
               acc[ai][bj][m][n] = __builtin_amdgcn_mfma_f32_16x16x32_bf16(frag_hi(Bt[n]), frag_hi(At[m]), acc[ai][bj][m][n], 0, 0, 0); } } __builtin_amdgcn_s_setprio(0); } while (0)
#define PG8_WAIT_V(n) asm volatile("s_waitcnt vmcnt(" #n ")" ::: "memory")
#define PG8_WAIT_L(n) asm volatile("s_waitcnt lgkmcnt(" #n ")" ::: "memory")
#define PG8_BAR __builtin_amdgcn_s_barrier()
#define PG8_SCHED __builtin_amdgcn_sched_barrier(0)
#define PG8_GATHER_OFFS(ui_, d0, d1) do { _Pragma("unroll") for (int _i = 0; _i < 2; ++_i) { int R_, C_; stage_rc(tid * 16 + _i * 8192, R_, C_); \
        d0[_i] = (unsigned)(prob.a_row(ui_, R_) * prob.lda * ES + C_ * 2); d1[_i] = (unsigned)(prob.a_row(ui_, HALF + R_) * prob.lda * ES + C_ * 2); } } while (0)
    Unit cur, nxt; int ui = 0;
    if (!prob.next(0, cur)) return;
    f32x4 acc[2][2][4][2];
#pragma unroll
    for (int a = 0; a < 2; ++a)
#pragma unroll
        for (int b = 0; b < 2; ++b)
#pragma unroll
            for (int m = 0; m < 4; ++m)
#pragma unroll
                for (int n = 0; n < 2; ++n) acc[a][b][m][n] = (f32x4){0.f, 0.f, 0.f, 0.f};
    const int sca = prob.sc_a, scb = prob.sc_b;
    i32x8 At[4], B0[2], B1[2];
    const char* cA = prob.a_ptr(cur); const char* cB = prob.b_ptr(cur);
    if constexpr (P::GATHER) PG8_GATHER_OFFS(0, voffA, voffA1);
    PG8_STAGE(PG8_SB(0, 0), cB, voffB); PG8_STAGE(PG8_SB(0, 1), cB + hstepB, voffB); PG8_STAGE(PG8_SA(0, 0), cA, voffA); PG8_STAGE(PG8_SA(0, 1), cA + hstepA, voffA1);
    if (wr == 1) PG8_BAR;
    PG8_WAIT_V(2); PG8_BAR;
    PG8_STAGE(PG8_SB(1, 0), cB + kstep, voffB); PG8_STAGE(PG8_SA(1, 0), cA + kstep, voffA); PG8_STAGE(PG8_SB(1, 1), cB + hstepB + kstep, voffB);
    PG8_WAIT_V(6); PG8_BAR;
    for (;;) {
        const bool has_next = prob.next(ui + 1, nxt);
        const char* nA = has_next ? prob.a_ptr(nxt) : cA; const char* nB = has_next ? prob.b_ptr(nxt) : cB;
        for (int t = 0; t < nt; t += 2) {
            const bool last = (t == nt - 2);
            const char* a1 = cA + (size_t)(t + 1) * kstep;
            const char* a2 = last ? nA : cA + (size_t)(t + 2) * kstep; const char* b2 = last ? nB : cB + (size_t)(t + 2) * kstep;
            const char* a3 = a2 + kstep; const char* b3 = b2 + kstep;
            if constexpr (P::GATHER) {
                unsigned v0[2], v1[2];
#pragma unroll
                for (int i = 0; i < 2; ++i) { v0[i] = voffA[i]; v1[i] = voffA1[i]; }
                if (last && has_next) PG8_GATHER_OFFS(ui + 1, v0, v1);
                PG8_LDB(B0, 0, 0); PG8_LDB(B1, 0, 1); PG8_SCHED; PG8_LDA(At, 0, 0); PG8_STAGE(PG8_SA(1, 1), a1, voffA1);
                PG8_WAIT_V(8); PG8_WAIT_L(0); PG8_BAR; PG8_MMA(0, 0, At, B0); PG8_MMA(0, 1, At, B1); PG8_BAR; PG8_SCHED;
                PG8_LDA(At, 0, 1); PG8_STAGE(PG8_SB(0, 0), b2, voffB); PG8_STAGE(PG8_SB(0, 1), b2 + hstepB, voffB); PG8_STAGE(PG8_SA(0, 0), a2, v0);
                PG8_WAIT_V(8); PG8_WAIT_L(0); PG8_BAR; PG8_MMA(1, 0, At, B0); PG8_MMA(1, 1, At, B1); PG8_BAR; PG8_SCHED;
                PG8_LDB(B0, 1, 0); PG8_LDB(B1, 1, 1); PG8_SCHED; PG8_LDA(At, 1, 0); PG8_STAGE(PG8_SA(0, 1), a2, v1);
                PG8_WAIT_V(8); PG8_WAIT_L(0); PG8_BAR; PG8_MMA(0, 0, At, B0); PG8_MMA(0, 1, At, B1); PG8_BAR; PG8_SCHED;
                PG8_LDA(At, 1, 1); PG8_STAGE(PG8_SB(1, 0), b3, voffB); PG8_STAGE(PG8_SB(1, 1), b3 + hstepB, voffB); PG8_STAGE(PG8_SA(1, 0), a3, v0);
                PG8_WAIT_V(8); PG8_WAIT_L(0); PG8_BAR; PG8_MMA(1, 0, At, B0); PG8_MMA(1, 1, At, B1); PG8_BAR; PG8_SCHED;
#pragma unroll
                for (int i = 0; i < 2; ++i) { voffA[i] = v0[i]; voffA1[i] = v1[i]; }
            } else {
                PG8_LDB(B0, 0, 0); PG8_LDB(B1, 0, 1); PG8_SCHED; PG8_LDA(At, 0, 0); PG8_STAGE(PG8_SA(1, 1), a1 + hstepA, voffA);
                PG8_WAIT_V(8); PG8_WAIT_L(0); PG8_BAR; PG8_MMA(0, 0, At, B0); PG8_MMA(0, 1, At, B1); PG8_BAR; PG8_SCHED;
                PG8_LDA(At, 0, 1); PG8_STAGE(PG8_SB(0, 0), b2, voffB); PG8_STAGE(PG8_SB(0, 1), b2 + hstepB, voffB); PG8_STAGE(PG8_SA(0, 0), a2, voffA);
                PG8_WAIT_V(8); PG8_WAIT_L(0); PG8_BAR; PG8_MMA(1, 0, At, B0); PG8_MMA(1, 1, At, B1); PG8_BAR; PG8_SCHED;
                PG8_LDB(B0, 1, 0); PG8_LDB(B1, 1, 1); PG8_SCHED; PG8_LDA(At, 1, 0); PG8_STAGE(PG8_SA(0, 1), a2 + hstepA, voffA);
                PG8_WAIT_V(8); PG8_WAIT_L(0); PG8_BAR; PG8_MMA(0, 0, At, B0); PG8_MMA(0, 1, At, B1); PG8_BAR; PG8_SCHED;
                PG8_LDA(At, 1, 1); PG8_STAGE(PG8_SB(1, 0), b3, voffB); PG8_STAGE(PG8_SB(1, 1), b3 + hstepB, voffB); PG8_STAGE(PG8_SA(1, 0), a3, voffA);
                PG8_WAIT_V(8); PG8_WAIT_L(0); PG8_BAR; PG8_MMA(1, 0, At, B0); PG8_MMA(1, 1, At, B1); PG8_BAR; PG8_SCHED;
            }
        }
        if (wr == 0) PG8_BAR;
        if constexpr (P::FP8) asm volatile("s_nop 15\n\ts_nop 15" ::: "memory");
        const bool keep = prob.epi(acc, cur, wr, wc, fr, fq);
        if (!has_next) break;
        if (!P::KEEPS || !keep) {
#pragma unroll
            for (int a = 0; a < 2; ++a)
#pragma unroll
                for (int b = 0; b < 2; ++b)
#pragma unroll
                    for (int m = 0; m < 4; ++m)
#pragma unroll
                        for (int n = 0; n < 2; ++n) acc[a][b][m][n] = (f32x4){0.f, 0.f, 0.f, 0.f};
        }
        cur = nxt; cA = nA; cB = nB; ++ui;
        if (wr == 1) PG8_BAR;
    }
    PG8_WAIT_V(0);
    PG8_BAR;
#undef PG8_SA
#undef PG8_SB
#undef PG8_STAGE
#undef PG8_LDA
#undef PG8_LDB
#undef PG8_MMA
#undef PG8_WAIT_V
#undef PG8_WAIT_L
#undef PG8_BAR
#undef PG8_SCHED
#undef PG8_GATHER_OFFS
}
}

template <class Epi>
__device__ __forceinline__ void skinny16_once(LAS unsigned char* lds, const bf16* A, int lda, const bf16* Bt, int ldb, int K, int N, const Epi& epi) {
    const int tid = threadIdx.x, wid = __builtin_amdgcn_readfirstlane(tid >> 6), lane = tid & 63, r = lane & 15, kg = lane >> 4;
    const int kw = K / 8, k0 = wid * kw;
    LAS float* part = (LAS float*)lds;
    for (int ct = blockIdx.x; ct < N / 16; ct += gridDim.x) {
        const bf16* ap = A + (size_t)r * lda + k0 + 8 * kg; const bf16* bp = Bt + (size_t)(16 * ct + r) * ldb + k0 + 8 * kg;
        f32x4 acc = {0.f, 0.f, 0.f, 0.f};
#pragma unroll 8
        for (int ks = 0; ks < kw; ks += 32) acc = __builtin_amdgcn_mfma_f32_16x16x32_bf16(*(const pg8::bf16x8*)(ap + ks), *(const pg8::bf16x8*)(bp + ks), acc, 0, 0, 0);
#pragma unroll
        for (int i = 0; i < 4; ++i) part[wid * 256 + (4 * kg + i) * 16 + r] = acc[i];
        LDS_WAIT(); __syncthreads();
        if (tid < 256) { const float s0 = (part[tid] + part[256 + tid]) + (part[512 + tid] + part[768 + tid]), s1 = (part[1024 + tid] + part[1280 + tid]) + (part[1536 + tid] + part[1792 + tid]);
            epi(tid >> 4, 16 * ct + (tid & 15), s0, s1); }
        LDS_WAIT(); __syncthreads();
    }
}
template <class Epi>
__device__ __forceinline__ void skinny16_f8(LAS unsigned char* lds, const unsigned char* A, int lda, const unsigned char* Bt, int ldb, int K, int N, int sc_a, int sc_b, const Epi& epi) {
    const int tid = threadIdx.x, wid = __builtin_amdgcn_readfirstlane(tid >> 6), lane = tid & 63, r = lane & 15, kg = lane >> 4;
    const int kw = K / 8, k0 = wid * kw;
    LAS float* part = (LAS float*)lds;
    for (int ct = blockIdx.x; ct < N / 16; ct += gridDim.x) {
        const unsigned char* ap = A + (size_t)r * lda + k0 + 32 * kg; const unsigned char* bp = Bt + (size_t)(16 * ct + r) * ldb + k0 + 32 * kg;
        f32x4 acc = {0.f, 0.f, 0.f, 0.f};
#pragma unroll 2
        for (int ks = 0; ks < kw; ks += 128) { const pg8::i32x8 av = *(const pg8::i32x8*)(ap + ks), bv = *(const pg8::i32x8*)(bp + ks);
            acc = __builtin_amdgcn_mfma_scale_f32_16x16x128_f8f6f4(av, bv, acc, 0, 0, 0, sc_a, 0, sc_b); }
#pragma unroll
        for (int i = 0; i < 4; ++i) part[wid * 256 + (4 * kg + i) * 16 + r] = acc[i];
        LDS_WAIT(); __syncthreads();
        if (tid < 256) { const float s0 = (part[tid] + part[256 + tid]) + (part[512 + tid] + part[768 + tid]), s1 = (part[1024 + tid] + part[1280 + tid]) + (part[1536 + tid] + part[1792 + tid]);
            epi(tid >> 4, 16 * ct + (tid & 15), s0, s1); }
        LDS_WAIT(); __syncthreads();
    }
}
template <class Epi>
__device__ __forceinline__ void skinny16(LAS unsigned char* lds, const bf16* A, int lda, const bf16* Bt, int ldb, int K, int N, const Epi& epi) {
    skinny16_once(lds, A, lda, Bt, ldb, K, N, epi); if ((DBL_MASK >> 10) & 1u) skinny16_once(lds, A, lda, Bt, ldb, K, N, epi);
}
struct SkinnyInProj { unsigned char* ws; unsigned* kmax; __device__ __forceinline__ void operator()(int j, int n, float s0, float s1) const { inproj_store(ws, SEQ + j, n, s0 + s1, kmax); } };
struct SkinnyBranch { unsigned char* ws; __device__ __forceinline__ void operator()(int j, int n, float s0, float s1) const {
    const size_t r = SEQ + j; const bf16* G = (const bf16*)(ws + WS_GB); const float v = __builtin_amdgcn_fmed3f((bf2f(G[r * G_N + n]) * s0 + bf2f(G[r * G_N + DM + n]) * s1) * MG8_SCALE, -448.f, 448.f);
    (ws + WS_MG)[r * DM + n] = (unsigned char)(__builtin_amdgcn_cvt_pk_fp8_f32(v, 0.f, 0, false) & 0xff); } };
struct SkinnyOut { unsigned char* ws; __device__ __forceinline__ void operator()(int j, int n, float s0, float s1) const {
    const size_t o = (size_t)(SEQ + j) * DM + n; ((bf16*)(ws + WS_RB))[o] = (bf16)f2bf(ALPHA * ((const float*)(ws + WS_HF))[o] + (s0 + s1)); } };

constexpr int KN_OFF = RING_BYTES + 4096;
using pg8::Unit;
struct ProbInProj {
    static constexpr bool PERM = true, GATHER = false, KEEPS = false, FP8 = true;
    int K, lda, ldb, G, c; const unsigned char* A; const unsigned char* B; unsigned char* ws; int sc_a, sc_b; unsigned* kmax; LAS unsigned char* lds;
    __device__ __forceinline__ bool next(int i, Unit& u) const { u.aux = 0; return pg8::static_tile(SEQ / 256, INP_N / 256, G, c, i, u.pm, u.pn); }
    __device__ __forceinline__ const char* a_ptr(const Unit& u) const { return (const char*)(A + (size_t)u.pm * 256 * lda); }
    __device__ __forceinline__ const char* b_ptr(const Unit& u) const { return (const char*)(B + (size_t)u.pn * 256 * ldb); }
    __device__ __forceinline__ bool epi(f32x4 (&acc)[2][2][4][2], const Unit& u, int wr, int wc, int fr, int fq) const {
        const int row0 = u.pm * 256 + wr * 64 + fr, ct = u.pn * 256 + wc * 32 + 8 * fq;
        const bool isg = u.pn >= 24, isq = (u.pn < 4) || (u.pn >= 12 && u.pn < 16);
        if (u.pn >= 16 && u.pn < 20) {
            LAS float* P = (LAS float*)(lds + KN_OFF);
#pragma unroll
            for (int bj = 0; bj < 2; ++bj) {
#pragma unroll
                for (int ai = 0; ai < 2; ++ai)
#pragma unroll
                    for (int m = 0; m < 4; ++m) { float q = 0.f;
#pragma unroll
                        for (int n = 0; n < 2; ++n)
#pragma unroll
                            for (int j = 0; j < 4; ++j) q = fmaf(acc[ai][bj][m][n][j], acc[ai][bj][m][n][j], q);
                        q += __shfl_xor(q, 16); q += __shfl_xor(q, 32);
                        if (fq == 0) P[(ai * 128 + wr * 64 + m * 16 + fr) * 4 + wc] = q; }
                asm volatile("s_waitcnt lgkmcnt(0)" ::: "memory"); __builtin_amdgcn_s_barrier(); asm volatile("" ::: "memory");
                if (threadIdx.x < 256) { const f32x4 v = *(const LAS f32x4*)(P + threadIdx.x * 4); float t = (v.x + v.y) + (v.z + v.w); t = wave_max(t);
                    if ((threadIdx.x & 63) == 0) atomicMax(kmax + (2 * (u.pn - 16) + bj) * 64, __builtin_bit_cast(unsigned, t)); }
                asm volatile("s_waitcnt lgkmcnt(0)" ::: "memory"); __builtin_amdgcn_s_barrier(); asm volatile("" ::: "memory"); } }
        bf16* base = isg ? (bf16*)(ws + WS_GB) + (ct - QKV_N) : (bf16*)(ws + WS_QKV) + ct; const int ldc = isg ? G_N : QKV_N; const float sc = isq ? QSCALE : 1.0f;
#pragma unroll
        for (int ai = 0; ai < 2; ++ai)
#pragma unroll
            for (int m = 0; m < 4; ++m) { bf16* rowp = base + (size_t)(row0 + ai * 128 + m * 16) * ldc;
#pragma unroll
                for (int bj = 0; bj < 2; ++bj) { f32x4 v0 = acc[ai][bj][m][0], v1 = acc[ai][bj][m][1];
                    if (isg) {
#pragma unroll
                        for (int j = 0; j < 4; ++j) { v0[j] = __builtin_amdgcn_rcpf(1.0f + __builtin_amdgcn_exp2f(-LOG2E * v0[j])); v1[j] = __builtin_amdgcn_rcpf(1.0f + __builtin_amdgcn_exp2f(-LOG2E * v1[j])); } }
                    else { v0 = v0 * sc; v1 = v1 * sc; }
                    u32x4 w; w.x = pg8::cvt_pk_bf16(v0[0], v0[1]); w.y = pg8::cvt_pk_bf16(v0[2], v0[3]); w.z = pg8::cvt_pk_bf16(v1[0], v1[1]); w.w = pg8::cvt_pk_bf16(v1[2], v1[3]);
                    *(u32x4*)(rowp + bj * 128) = w; } }
        return false;
    }
};
struct ProbOutProj {
    static constexpr bool PERM = false, GATHER = false, KEEPS = false, FP8 = true;
    int K, lda, ldb, G, c; const unsigned char* A; const unsigned char* B; unsigned char* ws; int sc_a, sc_b;
    __device__ __forceinline__ bool next(int i, Unit& u) const { u.aux = 0; return pg8::static_tile(SEQ / 256, DM / 256, G, c, i, u.pm, u.pn); }
    __device__ __forceinline__ const char* a_ptr(const Unit& u) const { return (const char*)(A + (size_t)u.pm * 256 * lda); }
    __device__ __forceinline__ const char* b_ptr(const Unit& u) const { return (const char*)(B + (size_t)u.pn * 256 * ldb); }
    __device__ __forceinline__ bool epi(f32x4 (&acc)[2][2][4][2], const Unit& u, int wr, int wc, int fr, int fq) const {
        const int row0 = u.pm * 256 + wr * 64 + fr, col0 = u.pn * 256 + wc * 32 + 4 * fq;
        const float* HF = (const float*)(ws + WS_HF); bf16* R = (bf16*)(ws + WS_RB);
#pragma unroll
        for (int ai = 0; ai < 2; ++ai)
#pragma unroll
            for (int m = 0; m < 4; ++m) { const size_t off = (size_t)(row0 + ai * 128 + m * 16) * DM + col0;
#pragma unroll
                for (int bj = 0; bj < 2; ++bj)
#pragma unroll
                    for (int n = 0; n < 2; ++n) { const f32x4 hv = *(const f32x4*)(HF + off + bj * 128 + n * 16); const f32x4 rv = hv * ALPHA + acc[ai][bj][m][n];
                        u32x2 w; w.x = pg8::cvt_pk_bf16(rv[0], rv[1]); w.y = pg8::cvt_pk_bf16(rv[2], rv[3]); *(u32x2*)(R + off + bj * 128 + n * 16) = w; }
                asm volatile("" ::: "memory"); }
        return false;
    }
};

struct ProbBranch {
    static constexpr bool PERM = true, GATHER = false, KEEPS = true, FP8 = true;
    int K, lda, ldb, G, c; const unsigned char* A; const unsigned char* B; unsigned char* ws; int sc_a, sc_b;
    __device__ __forceinline__ bool next(int i, Unit& u) const { u.aux = i & 1; return pg8::static_tile(SEQ / 256, DM / 256, G, c, i >> 1, u.pm, u.pn); }
    __device__ __forceinline__ const char* a_ptr(const Unit& u) const { return (const char*)(A + (size_t)u.pm * 256 * lda + u.aux * 1024); }
    __device__ __forceinline__ const char* b_ptr(const Unit& u) const { return (const char*)(B + (size_t)u.pn * 256 * ldb + u.aux * 1024); }
    __device__ __forceinline__ bool epi(f32x4 (&acc)[2][2][4][2], const Unit& u, int wr, int wc, int fr, int fq) const {
        const int row0 = u.pm * 256 + wr * 64 + fr, ct = u.pn * 256 + wc * 32 + 8 * fq;
        const bf16* Gs = (const bf16*)(ws + WS_GB) + ct; const bf16* Gf = Gs + DM; unsigned char* MG = ws + WS_MG + ct;
        const bool first = u.aux == 0;
#pragma unroll
        for (int ai = 0; ai < 2; ++ai)
#pragma unroll
            for (int m = 0; m < 4; ++m) { const size_t r = (size_t)(row0 + ai * 128 + m * 16);
#pragma unroll
                for (int bj = 0; bj < 2; ++bj) { const u32x4 gf = *(const u32x4*)(Gf + r * G_N + bj * 128);
                    f32x4 f0 = {bflo(gf.x), bfhi(gf.x), bflo(gf.y), bfhi(gf.y)}, f1 = {bflo(gf.z), bfhi(gf.z), bflo(gf.w), bfhi(gf.w)};
                    if (first) { const u32x4 gs = *(const u32x4*)(Gs + r * G_N + bj * 128);
                        const f32x4 s0 = {bflo(gs.x), bfhi(gs.x), bflo(gs.y), bfhi(gs.y)}, s1 = {bflo(gs.z), bfhi(gs.z), bflo(gs.w), bfhi(gs.w)};
#pragma unroll
                        for (int j = 0; j < 4; ++j) { acc[ai][bj][m][0][j] *= s0[j] * __builtin_amdgcn_rcpf(fmaxf(f0[j], 1e-30f)); acc[ai][bj][m][1][j] *= s1[j] * __builtin_amdgcn_rcpf(fmaxf(f1[j], 1e-30f)); } }
                    else { const f32x4 v0 = acc[ai][bj][m][0] * f0 * MG8_SCALE, v1 = acc[ai][bj][m][1] * f1 * MG8_SCALE;
                        u32x2 w; w.x = pk4_fp8(v0[0], v0[1], v0[2], v0[3]); w.y = pk4_fp8(v1[0], v1[1], v1[2], v1[3]);
                        *(u32x2*)(MG + r * DM + bj * 128) = w; } }
                asm volatile("" ::: "memory"); }
        return first;
    }
};
constexpr int IDX_OFF = RING_BYTES + 1024, MOE_MAXU = 3;
struct ProbMoeGU {
    static constexpr bool PERM = true, GATHER = true, KEEPS = false, FP8 = true;
    int K, lda, ldb, G, c, layer; const unsigned char* A; const unsigned char* B; unsigned char* ws; const unsigned* ctl; LAS unsigned char* lds; int sc_a, sc_b;
    __device__ __forceinline__ bool next(int i, Unit& u) const { const int L = i * G + c; u.pm = L >> 3; u.pn = L & 7; int cnt, ps; return moe_find(ctl, layer, u.pm * 256, u.aux, cnt, ps); }
    __device__ __forceinline__ const char* a_ptr(const Unit&) const { return (const char*)A; }
    __device__ __forceinline__ const char* b_ptr(const Unit& u) const { return (const char*)(B + (size_t)u.aux * WGU_E + (size_t)u.pn * 256 * ldb); }
    __device__ __forceinline__ int a_row(int ui, int r) const { return *(const LAS int*)(lds + IDX_OFF + (ui * 256 + r) * 4); }
    __device__ __forceinline__ void fill_idx(int tid) const {
        for (int ui = 0; ui < MOE_MAXU; ++ui) { const int L = ui * G + c; int e, cnt, ps; if (!moe_find(ctl, layer, (L >> 3) * 256, e, cnt, ps)) break;
            if (tid < 256) { const int rank = (L >> 3) * 256 - ps + tid; *(LAS int*)(lds + IDX_OFF + (ui * 256 + tid) * 4) = rank < cnt ? ((const int*)(ws + WS_ELIST))[(size_t)e * MROWS + rank] : 0; } }
        LDS_WAIT(); __syncthreads();
    }
    __device__ __forceinline__ bool epi(f32x4 (&acc)[2][2][4][2], const Unit& u, int wr, int wc, int fr, int fq) const {
        const int row0 = u.pm * 256 + wr * 64 + fr, ct = u.pn * 128 + wc * 32 + 8 * fq; unsigned char* act = ws + WS_ACT + ct;
#pragma unroll
        for (int ai = 0; ai < 2; ++ai)
#pragma unroll
            for (int m = 0; m < 4; ++m) { f32x4 v[2];
#pragma unroll
                for (int n = 0; n < 2; ++n)
#pragma unroll
                    for (int j = 0; j < 4; ++j) { const float g = acc[ai][0][m][n][j]; v[n][j] = g * __builtin_amdgcn_rcpf(1.0f + __builtin_amdgcn_exp2f(-LOG2E * g)) * acc[ai][1][m][n][j]; }
                u32x2 w; w.x = pk4_fp8(v[0][0] * ACT8_SCALE, v[0][1] * ACT8_SCALE, v[0][2] * ACT8_SCALE, v[0][3] * ACT8_SCALE); w.y = pk4_fp8(v[1][0] * ACT8_SCALE, v[1][1] * ACT8_SCALE, v[1][2] * ACT8_SCALE, v[1][3] * ACT8_SCALE);
                *(u32x2*)(act + (size_t)(row0 + ai * 128 + m * 16) * FF) = w; }
        return false;
    }
};
struct ProbMoeDown {
    static constexpr bool PERM = true, GATHER = false, KEEPS = false, FP8 = true;
    int K, lda, ldb, G, c, layer; const unsigned char* A; const unsigned char* B; unsigned char* ws; const unsigned* ctl; int sc_a, sc_b;
    __device__ __forceinline__ bool next(int i, Unit& u) const { const int L = i * G + c; u.pm = L >> 3; u.pn = L & 7; int cnt, ps; return moe_find(ctl, layer, u.pm * 256, u.aux, cnt, ps); }
    __device__ __forceinline__ const char* a_ptr(const Unit& u) const { return (const char*)(A + (size_t)u.pm * 256 * lda); }
    __device__ __forceinline__ const char* b_ptr(const Unit& u) const { return (const char*)(B + (size_t)u.aux * WD_E + (size_t)u.pn * 256 * ldb); }
    __device__ __forceinline__ bool epi(f32x4 (&acc)[2][2][4][2], const Unit& u, int wr, int wc, int fr, int fq) const {
        const int row0 = u.pm * 256 + wr * 64 + fr, ct = u.pn * 256 + wc * 32 + 8 * fq; bf16* O = (bf16*)(ws + WS_OSL) + ct;
#pragma unroll
        for (int ai = 0; ai < 2; ++ai)
#pragma unroll
            for (int m = 0; m < 4; ++m)
#pragma unroll
                for (int bj = 0; bj < 2; ++bj) { const f32x4 v0 = acc[ai][bj][m][0], v1 = acc[ai][bj][m][1];
                    u32x4 w; w.x = pg8::cvt_pk_bf16(v0[0], v0[1]); w.y = pg8::cvt_pk_bf16(v0[2], v0[3]); w.z = pg8::cvt_pk_bf16(v1[0], v1[1]); w.w = pg8::cvt_pk_bf16(v1[2], v1[3]);
                    *(u32x4*)(O + (size_t)(row0 + ai * 128 + m * 16) * DM + bj * 128) = w; }
        return false;
    }
};

#ifndef ATT_DBL
#define ATT_DBL 0
#endif
namespace att {
typedef short bf16x8 __attribute__((ext_vector_type(8)));
typedef short s16x4 __attribute__((ext_vector_type(4)));
typedef float f32x16 __attribute__((ext_vector_type(16)));
constexpr int TILE_B = 16384;
constexpr float EXIT_THR = -140.f;
constexpr int L_V = 0, L_K = 3 * TILE_B, L_C2 = 6 * TILE_B, L_WS = L_C2 + 1024, L_END = L_WS + 8 * 256, L_ITEM = 131072 + 8192, L_VOTE = L_ITEM + 16, L_FT = L_VOTE + 64, L_KN = L_FT + 16;
#define KSWZ(row, colB) ((row) * 256 + ((colB) ^ (((row) & 7) << 4)))
#define SBAR() __builtin_amdgcn_sched_barrier(0)
__device__ __forceinline__ int v_st(int k, int c) { const int kk = (k & ~0xC) | ((k & 4) << 1) | ((k & 8) >> 1); return ((kk >> 3) * 4 + (c >> 5)) * 512 + ((kk & 7) * 32 + (c & 31)) * 2; }
__device__ __forceinline__ int v_rd_base(int lane) { return ((lane & 3) << 3) | (((lane >> 2) & 3) << 6) | (((lane >> 4) & 1) << 5) | (((lane >> 5) & 1) << 8); }
constexpr int v_rd_off(int d0, int ks, int half) { return d0 * 512 + ks * 4096 + half * 2048; }
__device__ __forceinline__ int crow(int r, int hi) { return (r & 3) + 8 * (r >> 2) + 4 * hi; }
__device__ __forceinline__ unsigned cvtpk(float lo, float hi) { unsigned r; asm volatile("v_cvt_pk_bf16_f32 %0, %1, %2" : "=v"(r) : "v"(lo), "v"(hi)); return r; }
__device__ __forceinline__ float xchg_sum(float v) { auto rr = __builtin_amdgcn_permlane32_swap(__float_as_uint(v), __float_as_uint(v), false, false); return __uint_as_float(rr[0]) + __uint_as_float(rr[1]); }
__device__ __forceinline__ float xchg_max(float v) { auto rr = __builtin_amdgcn_permlane32_swap(__float_as_uint(v), __float_as_uint(v), false, false); return fmaxf(__uint_as_float(rr[0]), __uint_as_float(rr[1])); }
#define PK4(P, B_, OUT) do { unsigned a0 = cvtpk(P[B_+0], P[B_+1]), a1 = cvtpk(P[B_+2], P[B_+3]); unsigned b0 = cvtpk(P[B_+4], P[B_+5]), b1 = cvtpk(P[B_+6], P[B_+7]); \
        auto r0 = __builtin_amdgcn_permlane32_swap(a0, b0, false, false); auto r1 = __builtin_amdgcn_permlane32_swap(a1, b1, false, false); \
        u32x4 w = {r0[0], r1[0], r0[1], r1[1]}; OUT = *reinterpret_cast<bf16x8*>(&w); } while (0)
__device__ __forceinline__ void qkt(f32x16& p0, f32x16& p1, const LAS unsigned char* kt, int r32, int hi, const bf16x8* qr) {
    p0 = f32x16{}; p1 = f32x16{};
    const LAS unsigned char* kb[4];
#pragma unroll
    for (int dd = 0; dd < 4; ++dd) kb[dd] = kt + KSWZ(r32, (dd * 16 + hi * 8) * 2);
#pragma unroll
    for (int d0 = 0; d0 < 8; ++d0) { const LAS unsigned char* a = kb[d0 & 3] + (d0 >> 2) * 128;
        const bf16x8 b0 = *(const LAS bf16x8*)(a); const bf16x8 b1 = *(const LAS bf16x8*)(a + 32 * 256);
        p0 = __builtin_amdgcn_mfma_f32_32x32x16_bf16(b0, qr[d0], p0, 0, 0, 0);
        p1 = __builtin_amdgcn_mfma_f32_32x32x16_bf16(b1, qr[d0], p1, 0, 0, 0); }
}
__device__ __forceinline__ void pv_tile(f32x16* o, unsigned vb0, bf16x8 pa0, bf16x8 pa1, bf16x8 pa2, bf16x8 pa3) {
#define TRRD(dst, off) asm volatile("ds_read_b64_tr_b16 %0, %1 offset:%2" : "=&v"(dst) : "v"(vb0), "i"(off) : "memory")
#define PV_D0(d0) do { s16x4 l0, l1, l2, l3, h0, h1, h2, h3; constexpr int b_ = v_rd_off(d0, 0, 0); \
        TRRD(l0, b_); TRRD(h0, b_ + 2048); TRRD(l1, b_ + 4096); TRRD(h1, b_ + 6144); TRRD(l2, b_ + 8192); TRRD(h2, b_ + 10240); TRRD(l3, b_ + 12288); TRRD(h3, b_ + 14336); \
        asm volatile("s_waitcnt lgkmcnt(0)" ::: "memory"); SBAR(); \
        o[d0] = __builtin_amdgcn_mfma_f32_32x32x16_bf16(pa0, (bf16x8){l0[0], l0[1], l0[2], l0[3], h0[0], h0[1], h0[2], h0[3]}, o[d0], 0, 0, 0); \
        o[d0] = __builtin_amdgcn_mfma_f32_32x32x16_bf16(pa1, (bf16x8){l1[0], l1[1], l1[2], l1[3], h1[0], h1[1], h1[2], h1[3]}, o[d0], 0, 0, 0); \
        o[d0] = __builtin_amdgcn_mfma_f32_32x32x16_bf16(pa2, (bf16x8){l2[0], l2[1], l2[2], l2[3], h2[0], h2[1], h2[2], h2[3]}, o[d0], 0, 0, 0); \
        o[d0] = __builtin_amdgcn_mfma_f32_32x32x16_bf16(pa3, (bf16x8){l3[0], l3[1], l3[2], l3[3], h3[0], h3[1], h3[2], h3[3]}, o[d0], 0, 0, 0); } while (0)
    PV_D0(0); PV_D0(1); PV_D0(2); PV_D0(3);
#undef PV_D0
#undef TRRD
}
#define VIS(cc) (((dqh) - (cc)) >= NEED && (cc) < (nvh))
__device__ __forceinline__ void sb_tile(f32x16& p0, f32x16& p1, float& carry, bool domask, int dqh, int nvh, int hi, bf16x8& pa0, bf16x8& pa1, bf16x8& pa2, bf16x8& pa3) {
    constexpr int NEED = 1;
    f32x16 x0, x1;
#pragma unroll
    for (int r = 0; r < 16; ++r) {
        { const float u = __builtin_amdgcn_fmed3f(p0[r], -126.f, 126.f), b = __builtin_amdgcn_logf(1.0f + __builtin_amdgcn_exp2f(-u)); x0[r] = -b; p0[r] = -u - b; }
        { const float u = __builtin_amdgcn_fmed3f(p1[r], -126.f, 126.f), b = __builtin_amdgcn_logf(1.0f + __builtin_amdgcn_exp2f(-u)); x1[r] = -b; p1[r] = -u - b; } }
    if (domask) { const float NEG = -__builtin_inff();
#pragma unroll
        for (int r = 0; r < 16; ++r) { const int cc = (r & 3) + 8 * (r >> 2);
            if (!VIS(cc)) { p0[r] = 0.f; x0[r] = NEG; }
            if (!VIS(cc + 32)) { p1[r] = 0.f; x1[r] = NEG; } } }
    float A[9]; A[8] = 0.f;
#pragma unroll
    for (int g = 3; g >= 0; --g) A[4 + g] = A[5 + g] + ((p1[4 * g] + p1[4 * g + 1]) + (p1[4 * g + 2] + p1[4 * g + 3]));
#pragma unroll
    for (int g = 3; g >= 0; --g) A[g] = A[1 + g] + ((p0[4 * g] + p0[4 * g + 1]) + (p0[4 * g + 2] + p0[4 * g + 3]));
    float off[8];
#pragma unroll
    for (int i = 0; i < 8; ++i) { auto rr = __builtin_amdgcn_permlane32_swap(__float_as_uint(A[i]), __float_as_uint(A[i + 1]), false, false);
        const float recv = hi ? __uint_as_float(rr[0]) : __uint_as_float(rr[1]); off[i] = carry + A[i + 1] + recv; }
    carry += xchg_sum(A[0]);
#pragma unroll
    for (int g = 0; g < 4; ++g) {
        { float af = off[g]; const float l3 = p0[4 * g + 3], l2 = p0[4 * g + 2], l1 = p0[4 * g + 1];
          x0[4 * g + 3] = __builtin_amdgcn_exp2f(x0[4 * g + 3] + af); af += l3; x0[4 * g + 2] = __builtin_amdgcn_exp2f(x0[4 * g + 2] + af); af += l2;
          x0[4 * g + 1] = __builtin_amdgcn_exp2f(x0[4 * g + 1] + af); af += l1; x0[4 * g] = __builtin_amdgcn_exp2f(x0[4 * g] + af); }
        { float af = off[4 + g]; const float l3 = p1[4 * g + 3], l2 = p1[4 * g + 2], l1 = p1[4 * g + 1];
          x1[4 * g + 3] = __builtin_amdgcn_exp2f(x1[4 * g + 3] + af); af += l3; x1[4 * g + 2] = __builtin_amdgcn_exp2f(x1[4 * g + 2] + af); af += l2;
          x1[4 * g + 1] = __builtin_amdgcn_exp2f(x1[4 * g + 1] + af); af += l1; x1[4 * g] = __builtin_amdgcn_exp2f(x1[4 * g] + af); } }
    PK4(x0, 0, pa0); PK4(x0, 8, pa1); PK4(x1, 0, pa2); PK4(x1, 8, pa3);
}
__device__ __forceinline__ float fox_tile(f32x16& p0, f32x16& p1, const LAS float* c2t, float& m_reg, float& l_reg, bool domask, int dqh, int nvh, int hi, bf16x8& pa0, bf16x8& pa1, bf16x8& pa2, bf16x8& pa3) {
    constexpr int NEED = 0;
#pragma unroll
    for (int g = 0; g < 4; ++g) { const f32x4 c0 = *(const LAS f32x4*)(c2t + 8 * g + 4 * hi), c1 = *(const LAS f32x4*)(c2t + 32 + 8 * g + 4 * hi);
#pragma unroll
        for (int j = 0; j < 4; ++j) { p0[4 * g + j] -= c0[j]; p1[4 * g + j] -= c1[j]; } }
    if (domask) { const float NEG = -__builtin_inff();
#pragma unroll
        for (int r = 0; r < 16; ++r) { const int cc = (r & 3) + 8 * (r >> 2);
            if (!VIS(cc)) p0[r] = NEG;
            if (!VIS(cc + 32)) p1[r] = NEG; } }
    float pmax = p0[0];
#pragma unroll
    for (int r = 1; r < 16; ++r) pmax = fmaxf(pmax, p0[r]);
#pragma unroll
    for (int r = 0; r < 16; ++r) pmax = fmaxf(pmax, p1[r]);
    pmax = xchg_max(pmax);
    const float mn = fmaxf(m_reg, pmax), alpha = __builtin_amdgcn_exp2f(m_reg - mn); m_reg = mn;
    float ps = 0.f;
#pragma unroll
    for (int r = 0; r < 16; ++r) { p0[r] = __builtin_amdgcn_exp2f(p0[r] - mn); p1[r] = __builtin_amdgcn_exp2f(p1[r] - mn); ps += p0[r] + p1[r]; }
    l_reg = l_reg * alpha + xchg_sum(ps);
    PK4(p0, 0, pa0); PK4(p0, 8, pa1); PK4(p1, 0, pa2); PK4(p1, 8, pa3);
    return alpha;
}
#undef VIS
template <int TYPE>
__device__ __forceinline__ void attn_unit(LAS unsigned char* lds, unsigned char* ws, const unsigned* kmaxw, int head, int qb) {
    const int tid = threadIdx.x, wid = __builtin_amdgcn_readfirstlane(tid >> 6), lane = tid & 63, r32 = lane & 31, hi = lane >> 5;
    const bool grpY = wid >= 4;
    const bf16* QKV = (const bf16*)(ws + WS_QKV);
    const int qcol = (TYPE ? 3072 : 0) + head * HD, kcol = qcol + 1024, vcol = qcol + 2048;
    const float* fsuf = (const float*)(ws + WS_CUM) + (size_t)head * MROWS; const float* ftot = (const float*)(ws + WS_CUM) + (size_t)NHEAD * MROWS + head * 256;
    float fcarry = 0.f, st_tot = 0.f;
    LAS int* vote = (LAS int*)(lds + L_VOTE); LAS float* ftl = (LAS float*)(lds + L_FT);
    const int qrow0 = qb * 256, NT = qb < 32 ? 4 * qb + 5 : 1;
    const int qbase = qb < 32 ? qrow0 : -NMETA;
    const int qlo = qbase + wid * 32, qpos = qlo + r32;
    LAS unsigned char* V_lds = lds + L_V; LAS unsigned char* K_lds = lds + L_K; LAS float* c2_lds = (LAS float*)(lds + L_C2);
    LAS float* wsl = (LAS float*)(lds + L_WS) + wid * 64;
    bf16x8 qr[8];
#pragma unroll
    for (int d0 = 0; d0 < 8; ++d0) qr[d0] = *(const bf16x8*)(QKV + (size_t)(qrow0 + wid * 32 + r32) * QKV_N + qcol + d0 * 16 + hi * 8);
    const int sr = tid >> 4, sc = (tid & 15) * 8, vst0 = v_st(sr, sc), vst1 = v_st(32 + sr, sc), kws = KSWZ(sr, sc * 2);
    const unsigned vrd = (unsigned)(size_t)V_lds + (unsigned)v_rd_base(lane);
    bf16x8 st_k0, st_k1, st_v0, st_v1; float st_c = 0.f;
    float ub = 0.f;
    if (TYPE == 1) { float s1 = 0.f;
#pragma unroll
        for (int d0 = 0; d0 < 8; ++d0) { const u32x4 w = __builtin_bit_cast(u32x4, qr[d0]);
            s1 += (bflo(w.x) * bflo(w.x) + bfhi(w.x) * bfhi(w.x)) + (bflo(w.y) * bflo(w.y) + bfhi(w.y) * bfhi(w.y)) + (bflo(w.z) * bflo(w.z) + bfhi(w.z) * bfhi(w.z)) + (bflo(w.w) * bflo(w.w) + bfhi(w.w) * bfhi(w.w)); }
        ub = 1.02f * sqrtf(xchg_sum(s1) * ((const LAS float*)(lds + L_KN))[head]); }
#define TISMETA(t) ((t) == NT - 1)
#define SLOAD(t) do { const int row_ = TISMETA(t) ? SEQ : 64 * (4 * qb + 3 - (t)); const bf16* kp_ = QKV + (size_t)(row_ + sr) * QKV_N + sc; \
        st_k0 = *(const bf16x8*)(kp_ + kcol); st_k1 = *(const bf16x8*)(kp_ + (size_t)32 * QKV_N + kcol); st_v0 = *(const bf16x8*)(kp_ + vcol); st_v1 = *(const bf16x8*)(kp_ + (size_t)32 * QKV_N + vcol); \
        if (TYPE == 1 && tid < 64) { st_c = fsuf[row_ + tid]; st_tot = ftot[row_ >> 6]; } } while (0)
#define SWRITE(bo) do { *(LAS bf16x8*)(K_lds + (bo) + kws) = st_k0; *(LAS bf16x8*)(K_lds + (bo) + kws + 32 * 256) = st_k1; \
        *(LAS bf16x8*)(V_lds + (bo) + vst0) = st_v0; *(LAS bf16x8*)(V_lds + (bo) + vst1) = st_v1; if (TYPE == 1 && tid < 64) { c2_lds[((bo) >> 8) + tid] = -(fcarry + st_c); fcarry += st_tot; if (tid == 0) ftl[(bo) >> 14] = fcarry; } } while (0)
#define BAR() asm volatile("s_waitcnt lgkmcnt(0)\n\ts_barrier" ::: "memory")
    SLOAD(0); SWRITE(0);
    if (NT > 1) { SLOAD(1); SWRITE(TILE_B); }
    __builtin_amdgcn_s_waitcnt(0x0F70);
    if (NT > 2) SLOAD(2);
    BAR();
    if (grpY) BAR();
    f32x16 o[4] = {}; float carry = 0.f, m_reg = -1e30f, l_reg = 0.f;
    constexpr int NEEDW = TYPE == 0 ? 1 : 0;
#define KBASE(t) (TISMETA(t) ? -NMETA : 64 * (4 * qb + 3 - (t)))
#define ACTW(t) ((qlo + 31 - KBASE(t)) >= NEEDW && (qb < 32 || wid == 0))
    f32x16 p0, p1;
    if (ACTW(0)) qkt(p0, p1, K_lds, r32, hi, qr);
    int bo = 0, bo1 = TILE_B, bo2 = 2 * TILE_B;
    for (int t = 0; t < NT; ++t) {
        BAR();
        if (t > 0) { const LAS int* vp = vote + ((t - 1) & 1) * 8; const int all8 = (vp[0] & vp[1]) & (vp[2] & vp[3]) & (vp[4] & vp[5]) & (vp[6] & vp[7]); if (__builtin_amdgcn_readfirstlane(all8)) break; }
        const int kbase = KBASE(t), nvalid = TISMETA(t) ? NMETA : 64;
        const bool actw = ACTW(t);
        const bool domask = (qlo - (kbase + 63) < NEEDW) || nvalid < 64;
        bf16x8 pa0, pa1, pa2, pa3;
        if (actw) {
            const int dqh = qpos - kbase - 4 * hi, nvh = nvalid - 4 * hi;
            if (TYPE == 0) sb_tile(p0, p1, carry, domask, dqh, nvh, hi, pa0, pa1, pa2, pa3);
            else { const float alpha = fox_tile(p0, p1, c2_lds + (bo >> 8), m_reg, l_reg, domask, dqh, nvh, hi, pa0, pa1, pa2, pa3);
                if (__any(alpha < 1.f)) { if (hi == 0) wsl[r32] = alpha; asm volatile("s_waitcnt lgkmcnt(0)" ::: "memory");
#pragma unroll
                    for (int r = 0; r < 16; ++r) { const float al = wsl[crow(r, hi)];
#pragma unroll
                        for (int d = 0; d < 4; ++d) o[d][r] *= al; } } }
        }
        { const bool done = TYPE == 0 ? __all(carry < EXIT_THR) : __all(ub + ftl[bo >> 14] - m_reg < EXIT_THR);
          if (lane == 0) vote[(t & 1) * 8 + wid] = (done && qb < 32) ? 1 : 0; }
        BAR();
        if (t + 2 < NT) SWRITE(bo2);
        if (t + 3 < NT) SLOAD(t + 3);
        if (actw) pv_tile(o, vrd + bo, pa0, pa1, pa2, pa3);
        if (t + 1 < NT) { if (ACTW(t + 1)) qkt(p0, p1, K_lds + bo1, r32, hi, qr); }
        { const int tmp = bo; bo = bo1; bo1 = bo2; bo2 = tmp; }
    }
    if (!grpY) BAR();
    float rli[16];
    if (TYPE == 1) { if (hi == 0) wsl[32 + r32] = l_reg; asm volatile("s_waitcnt lgkmcnt(0)" ::: "memory");
#pragma unroll
        for (int r = 0; r < 16; ++r) rli[r] = __builtin_amdgcn_rcpf(wsl[32 + crow(r, hi)]); }
    unsigned char* Yw = ws + WS_YB + (size_t)(qrow0 + wid * 32) * DM + TYPE * 1024 + head * HD;
    if (qb < 32 || wid == 0)
#pragma unroll
    for (int r = 0; r < 16; ++r) { const int orow = crow(r, hi);
#pragma unroll
        for (int d0 = 0; d0 < 4; ++d0) { const float v = __builtin_amdgcn_fmed3f((TYPE == 1 ? o[d0][r] * rli[r] : o[d0][r]) * Y8_SCALE, -448.f, 448.f); const float vn = __shfl_xor(v, 1);
            const int p = __builtin_amdgcn_cvt_pk_fp8_f32(v, vn, 0, false) & 0xffff; const int p2 = __shfl_xor(p, 2);
            if ((r32 & 3) == 0) *(unsigned*)(Yw + (size_t)orow * DM + d0 * 32 + r32) = (unsigned)p | ((unsigned)p2 << 16); } }
#undef TISMETA
#undef SLOAD
#undef SWRITE
#undef BAR
#undef KBASE
#undef ACTW
}
constexpr int CW_ATTNQ = 3072;
__device__ __forceinline__ void copy_loop(Frame& F, int layer, int cv0, int NB_, int limit = 1 << 30) {
    LAS int* itemw = (LAS int*)(F.lds + L_ITEM);
    for (int n = 0; n < limit; ++n) {
        __syncthreads();
        if (threadIdx.x == 0) *itemw = (int)atomicAdd(F.ctl + CW_ATTNQ + layer * 64 + 16, 1u);
        asm volatile("s_waitcnt lgkmcnt(0)" ::: "memory"); __syncthreads();
        const int j = __builtin_amdgcn_readfirstlane(*itemw);
        if (j >= NB_) break;
        convert_bundle(F, cv0 + j * CV_BUNDLE);
    }
}
__device__ __forceinline__ void attn_phase(Frame& F, int layer, int qoff, bool nocopy = false, int only = 0) {
    LAS unsigned char* lds = F.lds; unsigned char* ws = F.ws; unsigned* ctl = F.ctl; const int G = F.G, b = blockIdx.x;
    const int NA = 512 + (layer == 0 ? 16 : 0);
    const int cv0 = layer == 0 ? CV_G0_END : CV_G1_END, NB_ = ((layer == 0 ? CV_G1_END : N_CONVERT_ITEMS) - cv0) / CV_BUNDLE;
    const bool copier = (b & 1) == 1 && !nocopy; const int nfree = nocopy ? G : G - G / 2;
    LAS int* itemw = (LAS int*)(lds + L_ITEM); const unsigned* kmaxw = ctl + CW_KMAX + layer * 8 * 64;
    int hperm = 0;
    { const float* ftot = (const float*)(ws + WS_CUM) + (size_t)NHEAD * MROWS; const int lane = threadIdx.x & 63; float d[8];
#pragma unroll
        for (int h = 0; h < 8; ++h) { float v = ftot[h * 256 + lane] + ftot[h * 256 + 64 + lane] + (lane == 0 ? ftot[h * 256 + 128] : 0.f); d[h] = wave_sum(v); }
#pragma unroll
        for (int h = 0; h < 8; ++h) { int rank = 0;
#pragma unroll
            for (int g = 0; g < 8; ++g) rank += (d[g] > d[h] || (d[g] == d[h] && g < h)) ? 1 : 0;
            hperm |= h << (4 * rank); }
        hperm = __builtin_amdgcn_readfirstlane(hperm); }
    { const int w = F.wave, lane = threadIdx.x & 63, mr = lane >> 2, part = lane & 3;
      const bf16* kp = (const bf16*)(ws + WS_QKV) + (size_t)(SEQ + mr) * QKV_N + 4096 + w * HD + part * 32; float q = 0.f;
#pragma unroll
      for (int i = 0; i < 4; ++i) { const u32x4 v = *(const u32x4*)(kp + 8 * i);
          q += (bflo(v.x) * bflo(v.x) + bfhi(v.x) * bfhi(v.x)) + (bflo(v.y) * bflo(v.y) + bfhi(v.y) * bfhi(v.y)) + (bflo(v.z) * bflo(v.z) + bfhi(v.z) * bfhi(v.z)) + (bflo(v.w) * bflo(v.w) + bfhi(v.w) * bfhi(v.w)); }
      q += __shfl_xor(q, 1); q += __shfl_xor(q, 2); q = wave_max(q);
      if (lane == 0) ((LAS float*)(lds + L_KN))[w] = fmaxf(q, __builtin_bit_cast(float, kmaxw[w * 64]));
      asm volatile("s_waitcnt lgkmcnt(0)" ::: "memory"); __syncthreads(); }
    int it;
    if (copier) {
        copy_loop(F, layer, cv0, NB_);
        __syncthreads();
        if (threadIdx.x == 0) *itemw = nfree + (int)atomicAdd(ctl + CW_ATTNQ + layer * 64 + qoff, 1u);
        asm volatile("s_waitcnt lgkmcnt(0)" ::: "memory"); __syncthreads();
        it = __builtin_amdgcn_readfirstlane(*itemw);
    } else it = nocopy ? b : b >> 1;
    while (it < NA) {
        if (only == 1 && it >= 256) break; if (only == 2) { if (it + 256 >= NA) break; it += 256; }
        int qb, th; if (it < 256) { qb = 31 - (it & 31); th = 8 + ((hperm >> (4 * (it >> 5))) & 7); } else if (it < 512) { qb = 31 - ((it - 256) >> 3); th = it & 7; } else { qb = 32; th = it - 512; }
        if (th < 8) attn_unit<0>(lds, ws, kmaxw, th, qb); else attn_unit<1>(lds, ws, kmaxw, th - 8, qb);
        __syncthreads();
        if (threadIdx.x == 0) *itemw = nfree + (int)atomicAdd(ctl + CW_ATTNQ + layer * 64 + qoff, 1u);
        asm volatile("s_waitcnt lgkmcnt(0)" ::: "memory"); __syncthreads();
        it = __builtin_amdgcn_readfirstlane(*itemw);
    }
}
#undef KSWZ
#undef SBAR
#undef PK4
}

__global__ void __launch_bounds__(NTHREADS, 2) mk_fwd(Args args) {
    extern __shared__ __attribute__((aligned(16))) unsigned char lds_raw[];
    Frame F;
    F.lds = (LAS unsigned char*)lds_raw; F.ws = args.ws; F.ctl = (unsigned*)(args.ws + WS_CTL);
     F.wave = __builtin_amdgcn_readfirstlane(((int)threadIdx.x) >> 6);
    F.G = gridDim.x; F.gw = blockIdx.x * NWAVES + F.wave; F.NGW = F.G * NWAVES;
    F.in = (const float* const*)__builtin_amdgcn_kernarg_segment_ptr();
    F.out = args.out;
    volatile LAS unsigned* MISC = (volatile LAS unsigned*)(F.lds + MISC_OFF);
    for (int u = ((int)threadIdx.x); u < (LDS_BYTES - RING_BYTES) / 4; u += NTHREADS) ((LAS unsigned*)(F.lds + RING_BYTES))[u] = 0u;
    __syncthreads();
    XcdBarrier bar = xcd_barrier_post(F.ctl + CW_BAR + args.li * XCD_BAR_WORDS, MISC + 8);
    const int lo = args.ph_lo, hi = args.ph_hi; const unsigned naive = args.naive;
#define IN(k) (lo <= (k) && (k) < hi)
#define SEAM(k) do { if (IN(k) && IN((k) + 1)) { xcd_barrier(bar); if ((DBL_MASK >> 9) & 1u) xcd_barrier(bar); } } while (0)
#define NAIVE(t) ((naive >> (t)) & 1u)
    if (IN(0)) { phase_prologue(F); SEAM(0); }
#define LAYER_PHASES(l, pb) do { \
        if (IN(pb + PH_A)) { phase_cumsum(F, NAIVE(PH_B)); if (!NAIVE(PH_B)) phase_tilesuf(F); \
            if (!NAIVE(PH_A)) { skinny16_f8(F.lds, F.ws + WS_H8 + (size_t)SEQ * DM, DM, F.ws + WS_WIN + l * WIN_L, DM, DM, INP_N, SC_H, SC_W, SkinnyInProj{F.ws, F.ctl + CW_KMAX + l * 8 * 64}); \
              ProbInProj P{DM, DM, DM, F.G, (int)blockIdx.x, F.ws + WS_H8, F.ws + WS_WIN + l * WIN_L, F.ws, SC_H, SC_W, F.ctl + CW_KMAX + l * 8 * 64, F.lds}; pg8::gemm_phase(F.lds, P); if ((DBL_MASK >> PH_A) & 1u) pg8::gemm_phase(F.lds, P); } \
            SEAM(pb + PH_A); } \
        if (IN(pb + PH_B)) { \
            if (!NAIVE(PH_B)) { att::attn_phase(F, l, 0); if ((DBL_MASK >> PH_B) & 1u) att::attn_phase(F, l, 32, true, (int)((DBL_MASK >> 12) & 3u)); } \
            SEAM(pb + PH_B); } \
        if (IN(pb + PH_C)) { \
            if (!NAIVE(PH_C)) { if (l == 0) skinny16_f8(F.lds, F.ws + WS_YB + (size_t)SEQ * DM, DM, F.ws + WS_WB + l * WB_L, DM, DM, DM, SC_Y, SC_W, SkinnyBranch{F.ws}); \
              ProbBranch P{1024, DM, DM, F.G, (int)blockIdx.x, F.ws + WS_YB, F.ws + WS_WB + l * WB_L, F.ws, SC_Y, SC_W}; pg8::gemm_phase(F.lds, P); if ((DBL_MASK >> PH_C) & 1u) pg8::gemm_phase(F.lds, P); } \
            SEAM(pb + PH_C); } \
        if (IN(pb + PH_D)) { \
            if (!NAIVE(PH_D)) { if (l == 0) skinny16_f8(F.lds, F.ws + WS_MG + (size_t)SEQ * DM, DM, F.ws + WS_WOUT + l * WOUT_L, DM, DM, DM, SC_MG, SC_W, SkinnyOut{F.ws}); \
              ProbOutProj P{DM, DM, DM, F.G, (int)blockIdx.x, F.ws + WS_MG, F.ws + WS_WOUT + l * WOUT_L, F.ws, SC_MG, SC_W}; pg8::gemm_phase(F.lds, P); if ((DBL_MASK >> PH_D) & 1u) pg8::gemm_phase(F.lds, P); } \
            SEAM(pb + PH_D); } \
        if (IN(pb + PH_E)) { if ((DBL_MASK >> PH_E) & 1u) phase_ln_router(F, l, true); phase_ln_router(F, l); SEAM(pb + PH_E); } \
        if (IN(pb + PH_F)) { \
            if (!NAIVE(PH_F)) { ProbMoeGU P{DM, DM, DM, F.G, (int)blockIdx.x, l, F.ws + WS_H8, F.ws + WS_WGU + l * WGU_L, F.ws, F.ctl, F.lds, SC_H, SC_W}; P.fill_idx(((int)threadIdx.x)); pg8::gemm_phase(F.lds, P); if ((DBL_MASK >> PH_F) & 1u) pg8::gemm_phase(F.lds, P);  } \
            SEAM(pb + PH_F); } \
        if (IN(pb + PH_G)) { \
            if (!NAIVE(PH_G)) { ProbMoeDown P{FF, FF, FF, F.G, (int)blockIdx.x, l, F.ws + WS_ACT, F.ws + WS_WD + l * WD_L, F.ws, F.ctl, SC_ACT, SC_W}; pg8::gemm_phase(F.lds, P); if ((DBL_MASK >> PH_G) & 1u) pg8::gemm_phase(F.lds, P);  } \
            SEAM(pb + PH_G); } \
        if (IN(pb + PH_H)) { if ((DBL_MASK >> PH_H) & 1u) phase_ln_final(F, l, true); phase_ln_final(F, l); SEAM(pb + PH_H); } \
    } while (0)
    LAYER_PHASES(0, 1);
    LAYER_PHASES(1, 9);
#undef LAYER_PHASES
#undef IN
#undef SEAM
#undef NAIVE
}

static void launch_naive(int type, int layer, const Args& a, hipStream_t stream) {
    switch (type) {
    case PH_A: hipLaunchKernelGGL(naive_inproj, dim3(INP_N / 256, MROWS / 4), dim3(256), 0, stream, a, layer); break;
    case PH_B: { const int nq = NTOK; hipLaunchKernelGGL(naive_attn, dim3((16 * nq + 3) / 4), dim3(256), 0, stream, a, nq); } break;
    case PH_C: hipLaunchKernelGGL(naive_branch, dim3(DM / 256, MROWS / 4), dim3(256), 0, stream, a, layer); break;
    case PH_D: hipLaunchKernelGGL(naive_outproj, dim3(DM / 256, MROWS / 4), dim3(256), 0, stream, a, layer); break;
    case PH_F: hipLaunchKernelGGL(naive_moe_gu, dim3(FF / 256, NSLOT_MAX / 4), dim3(256), 0, stream, a, layer); break;
    case PH_G: hipLaunchKernelGGL(naive_moe_down, dim3(DM / 256, NSLOT_MAX / 4), dim3(256), 0, stream, a, layer); break;
    default: break;
    }
}
extern "C" void kernel_launch(void* const* d_in, const int* in_sizes, int n_in, void* d_out, int out_size, void* d_ws, size_t ws_size, hipStream_t stream) {
    static int grid = 0;
    if (grid == 0) {
        if (n_in != 18 || out_size != SEQ * DM || ws_size < WS_END) { fprintf(stderr, "kernel_launch: unexpected shapes (n_in %d out %d ws %zu)\n", n_in, out_size, ws_size); grid = -1; return; }
        int dev = 0, cus = 0;
        if (hipGetDevice(&dev) != hipSuccess || hipDeviceGetAttribute(&cus, hipDeviceAttributeMultiprocessorCount, dev) != hipSuccess) { grid = -1; return; }
        if (hipFuncSetAttribute((const void*)mk_fwd, hipFuncAttributeMaxDynamicSharedMemorySize, LDS_BYTES) != hipSuccess) { fprintf(stderr, "kernel_launch: hipFuncSetAttribute failed\n"); grid = -1; return; }
        int per_cu = 0;
        if (hipOccupancyMaxActiveBlocksPerMultiprocessor(&per_cu, (const void*)mk_fwd, NTHREADS, LDS_BYTES) != hipSuccess || per_cu < 1) fprintf(stderr, "kernel_launch: occupancy query says %d\n", per_cu);
        (void)hipGetLastError();
        grid = cus;
    }
    if (grid < 0) return;
    (void)hipMemsetAsync((char*)d_ws + WS_CTL, 0, CTL_ZERO_BYTES, stream);
    Args a{};
    for (int i = 0; i < 18; ++i) a.in[i] = (const float*)d_in[i];
    a.out = (float*)d_out; a.ws = (unsigned char*)d_ws; a.naive = NAIVE_MASK;
    int li = 0, lo = 0;
    auto flush = [&](int hi) { if (hi > lo) { a.ph_lo = lo; a.ph_hi = hi; a.li = li++; hipLaunchKernelGGL(mk_fwd, dim3(grid), dim3(NTHREADS), LDS_BYTES, stream, a); } lo = hi; };
    for (int ph = 1; ph < NPHASE; ++ph) {
        const int type = (ph - 1) & 7, layer = (ph - 1) >> 3;
        if ((NAIVE_MASK >> type) & 1u) {
            if (type == PH_A) flush(ph + 1); else { flush(ph); lo = ph + 1; }
            launch_naive(type, layer, a, stream); }
    }
    flush(NPHASE);
}
```

```cpp
#include <hip/hip_runtime.h>
#include <cstdio>
#include <cstdint>

#define GAS __attribute__((address_space(1)))
#define LAS __attribute__((address_space(3)))
typedef unsigned short bf16;
typedef float f32x4 __attribute__((ext_vector_type(4)));
typedef float f32x2 __attribute__((ext_vector_type(2)));
typedef unsigned u32x4 __attribute__((ext_vector_type(4)));
typedef unsigned u32x2 __attribute__((ext_vector_type(2)));
typedef GAS unsigned gu32;

constexpr int DM = 2048, SEQ = 8192, NMETA = 16, NTOK = SEQ + NMETA, MROWS = 8448;
constexpr int HD = 128, NHEAD = 8;
constexpr int QKV_N = 6144, G_N = 4096, INP_N = 10240, INP_SRC = 10248, FCOL = 6144;
constexpr int NE = 16, FF = 1024, NSLOT_MAX = 20480;
constexpr float ALPHA = 1.4142135623730951f, LN_EPS = 1e-5f;
constexpr float LOG2E = 1.4426950408889634f;
constexpr float QSCALE = 0.08838834764831845f * 1.4426950408889634f;
constexpr int NLAYER = 2, NPHASE = 1 + 8 * NLAYER;
enum { PH_A = 0, PH_B = 1, PH_C = 2, PH_D = 3, PH_E = 4, PH_F = 5, PH_G = 6, PH_H = 7 };

#ifndef NAIVE_MASK
#define NAIVE_MASK 0x00u
#endif
#ifndef DBL_MASK
#define DBL_MASK 0u
#endif
constexpr size_t MiB = 1u << 20;
constexpr size_t WS_CTL = 0, CTL_ZERO_BYTES = 1 * MiB;
constexpr size_t WS_WIN = 2 * MiB, WIN_L = 40 * MiB;
constexpr size_t WS_WB = 82 * MiB, WB_L = 8 * MiB;
constexpr size_t WS_WOUT = 98 * MiB, WOUT_L = 8 * MiB;
constexpr size_t WS_WGU = 114 * MiB, WGU_L = 128 * MiB, WGU_E = 8 * MiB;
constexpr size_t WS_WD = 370 * MiB, WD_L = 64 * MiB, WD_E = 4 * MiB;
constexpr size_t WS_HF = 498 * MiB;
constexpr size_t WS_HB = 564 * MiB;
constexpr size_t WS_RB = 597 * MiB;
constexpr size_t WS_QKV = 663 * MiB;
constexpr size_t WS_GB = 762 * MiB;
constexpr size_t WS_YB = 828 * MiB;
constexpr size_t WS_MG = 861 * MiB;
constexpr size_t WS_ACT = 663 * MiB;
constexpr size_t WS_OSL = 703 * MiB;
constexpr size_t WS_LOGF = 894 * MiB;
constexpr size_t WS_CUM = 895 * MiB;
constexpr size_t WS_ELIST = 896 * MiB;
constexpr size_t WS_TOKI = 897 * MiB;
constexpr size_t WS_H8 = 898 * MiB;
constexpr size_t WS_END = 916 * MiB;
constexpr int CW_CNT = 1024;
constexpr int CW_KMAX = 4096;
constexpr int CW_BAR = 8192;
#define XCD_BAR_WORDS 3456
constexpr int MAX_LAUNCH = 20;
static_assert((CW_BAR + MAX_LAUNCH * XCD_BAR_WORDS) * 4 <= (int)CTL_ZERO_BYTES, "ctl");

constexpr int NWAVES = 8, NTHREADS = 512;
constexpr int RING_BYTES = 131072, MISC_OFF = RING_BYTES + 320, LDS_BYTES = 147456;

constexpr float W8_SCALE = 64.f, H8_SCALE = 4.f, MG8_SCALE = 16.f, ACT8_SCALE = 4.f, Y8_SCALE = 16.f, OSL8_SCALE = 64.f;
constexpr int SC_W = 0x79797979, SC_H = 0x7D7D7D7D, SC_MG = 0x7B7B7B7B, SC_ACT = 0x7D7D7D7D, SC_Y = 0x7B7B7B7B;
__device__ __forceinline__ unsigned f2bf(float f) { unsigned u = __builtin_bit_cast(unsigned, f); return (u + 0x7fffu + ((u >> 16) & 1u)) >> 16; }
__device__ __forceinline__ unsigned pk2(float lo, float hi) { return f2bf(lo) | (f2bf(hi) << 16); }
__device__ __forceinline__ unsigned pk4_fp8(float a, float b, float c, float d) {
    a = __builtin_amdgcn_fmed3f(a, -448.f, 448.f); b = __builtin_amdgcn_fmed3f(b, -448.f, 448.f); c = __builtin_amdgcn_fmed3f(c, -448.f, 448.f); d = __builtin_amdgcn_fmed3f(d, -448.f, 448.f);
    int w = 0; w = __builtin_amdgcn_cvt_pk_fp8_f32(a, b, w, false); w = __builtin_amdgcn_cvt_pk_fp8_f32(c, d, w, true); return (unsigned)w; }
__device__ __forceinline__ float bflo(unsigned w) { return __builtin_bit_cast(float, w << 16); }
__device__ __forceinline__ float bfhi(unsigned w) { return __builtin_bit_cast(float, w & 0xffff0000u); }
__device__ __forceinline__ float bf2f(bf16 b) { return __builtin_bit_cast(float, ((unsigned)b) << 16); }
__device__ __forceinline__ float wave_sum(float v) {
#pragma unroll
    for (int o = 1; o < 64; o <<= 1) v += __shfl_xor(v, o);
    return v;
}
__device__ __forceinline__ float wave_max(float v) {
#pragma unroll
    for (int o = 1; o < 64; o <<= 1) v = fmaxf(v, __shfl_xor(v, o));
    return v;
}
__device__ __forceinline__ int row_of_p(int p) { return p < NMETA ? SEQ + p : p - NMETA; }
__device__ __forceinline__ float sigmoidf_(float x) { return 1.0f / (1.0f + __expf(-x)); }
__device__ __forceinline__ float dot8(u32x4 a, u32x4 b, float acc) {
    acc = fmaf(bflo(a.x), bflo(b.x), acc); acc = fmaf(bfhi(a.x), bfhi(b.x), acc);
    acc = fmaf(bflo(a.y), bflo(b.y), acc); acc = fmaf(bfhi(a.y), bfhi(b.y), acc);
    acc = fmaf(bflo(a.z), bflo(b.z), acc); acc = fmaf(bfhi(a.z), bfhi(b.z), acc);
    acc = fmaf(bflo(a.w), bflo(b.w), acc); acc = fmaf(bfhi(a.w), bfhi(b.w), acc);
    return acc;
}

struct Args { const float* in[18]; float* out; unsigned char* ws; int ph_lo, ph_hi; unsigned naive; int li; };
enum { I_X = 0, I_META, I_LNIN_G, I_LNIN_B, I_WIN, I_BF, I_WBSB, I_WBFX, I_WOUT, I_LNMIX_G, I_LNMIX_B, I_WR, I_RB, I_WG, I_WU, I_WD, I_LNFFN_G, I_LNFFN_B };

__device__ __forceinline__ int moe_cnt(const unsigned* ctl, int layer, int e) { return (int)ctl[CW_CNT + (layer * NE + e) * 64]; }
__device__ __forceinline__ bool moe_find(const unsigned* ctl, int layer, int s0, int& e_out, int& cnt_out, int& ps_out) {
    int acc = 0; e_out = -1; cnt_out = 0; ps_out = 0;
#pragma unroll
    for (int e = 0; e < NE; ++e) { const int c = moe_cnt(ctl, layer, e), nb = (c + 255) >> 8;
        if (e_out < 0 && s0 < (acc + nb) * 256) { e_out = e; cnt_out = c; ps_out = acc * 256; }
        acc += nb; }
    return e_out >= 0;
}
__device__ __forceinline__ int moe_nb(const unsigned* ctl, int layer) { int acc = 0;
#pragma unroll
    for (int e = 0; e < NE; ++e) acc += (moe_cnt(ctl, layer, e) + 255) >> 8;
    return acc; }
__device__ __forceinline__ int moe_pstart(const unsigned* ctl, int layer, int ex) {
    int acc = 0, r = 0;
#pragma unroll
    for (int e = 0; e < NE; ++e) { const int c = moe_cnt(ctl, layer, e); if (e == ex) r = acc * 256; acc += (c + 255) >> 8; }
    return r;
}

__device__ __forceinline__ void inproj_store(unsigned char* ws, int row, int n, float v, unsigned* kmax = nullptr) {
    if (n < QKV_N) { const bool isq = (n < 1024) || (n >= 3072 && n < 4096); ((bf16*)(ws + WS_QKV))[(size_t)row * QKV_N + n] = (bf16)f2bf(isq ? v * QSCALE : v); }
    else ((bf16*)(ws + WS_GB))[(size_t)row * G_N + (n - QKV_N)] = (bf16)f2bf(sigmoidf_(v));
}

__device__ __forceinline__ void dot4(const bf16* a0, const bf16* a1, const bf16* a2, const bf16* a3, const bf16* b, int K, float (&acc)[4]) {
    for (int k = 0; k < K; k += 8) {
        const u32x4 bv = *(const u32x4*)(b + k);
        acc[0] = dot8(*(const u32x4*)(a0 + k), bv, acc[0]); acc[1] = dot8(*(const u32x4*)(a1 + k), bv, acc[1]);
        acc[2] = dot8(*(const u32x4*)(a2 + k), bv, acc[2]); acc[3] = dot8(*(const u32x4*)(a3 + k), bv, acc[3]);
    }
}
__global__ void __launch_bounds__(256) naive_inproj(Args a, int layer) {
    const int n = blockIdx.x * 256 + threadIdx.x, r0 = blockIdx.y * 4;
    const bf16* A = (const bf16*)(a.ws + WS_HB) + (size_t)r0 * DM; const bf16* B = (const bf16*)(a.ws + WS_WIN + layer * WIN_L) + (size_t)n * DM;
    float acc[4] = {0.f, 0.f, 0.f, 0.f};
    dot4(A, A + DM, A + 2 * DM, A + 3 * DM, B, DM, acc);
    for (int i = 0; i < 4; ++i) inproj_store(a.ws, r0 + i, n, acc[i]);
}
__global__ void __launch_bounds__(256) naive_branch(Args a, int layer) {
    const int n = blockIdx.x * 256 + threadIdx.x, r0 = blockIdx.y * 4;
    const bf16* A = (const bf16*)(a.ws + WS_YB) + (size_t)r0 * DM; const bf16* B = (const bf16*)(a.ws + WS_WB + layer * WB_L) + (size_t)n * DM;
    float s[4] = {0.f, 0.f, 0.f, 0.f}, f[4] = {0.f, 0.f, 0.f, 0.f};
    dot4(A, A + DM, A + 2 * DM, A + 3 * DM, B, 1024, s);
    dot4(A + 1024, A + DM + 1024, A + 2 * DM + 1024, A + 3 * DM + 1024, B + 1024, 1024, f);
    const bf16* G = (const bf16*)(a.ws + WS_GB);
    for (int i = 0; i < 4; ++i) { const size_t r = r0 + i; const float gs = bf2f(G[r * G_N + n]), gf = bf2f(G[r * G_N + DM + n]);
        ((bf16*)(a.ws + WS_MG))[r * DM + n] = (bf16)f2bf(gs * s[i] + gf * f[i]); }
}
__global__ void __launch_bounds__(256) naive_outproj(Args a, int layer) {
    const int n = blockIdx.x * 256 + threadIdx.x, r0 = blockIdx.y * 4;
    const bf16* A = (const bf16*)(a.ws + WS_MG) + (size_t)r0 * DM; const bf16* B = (const bf16*)(a.ws + WS_WOUT + layer * WOUT_L) + (size_t)n * DM;
    float acc[4] = {0.f, 0.f, 0.f, 0.f};
    dot4(A, A + DM, A + 2 * DM, A + 3 * DM, B, DM, acc);
    const float* HF = (const float*)(a.ws + WS_HF); float* R = (float*)(a.ws + WS_RB);
    for (int i = 0; i < 4; ++i) { const size_t o = (size_t)(r0 + i) * DM + n; R[o] = ALPHA * HF[o] + acc[i]; }
}
__global__ void __launch_bounds__(256) naive_moe_gu(Args a, int layer) {
    const int j = blockIdx.x * 256 + threadIdx.x, s0 = blockIdx.y * 4;
    int e, cnt, ps; if (!moe_find((const unsigned*)(a.ws + WS_CTL), layer, s0, e, cnt, ps)) return;
    const int* elist = (const int*)(a.ws + WS_ELIST) + (size_t)e * MROWS;
    const bf16* HB = (const bf16*)(a.ws + WS_HB);
    const int rank = s0 - ps;
    const bf16* ap0 = HB + (size_t)(rank + 0 < cnt ? elist[rank + 0] : 0) * DM; const bf16* ap1 = HB + (size_t)(rank + 1 < cnt ? elist[rank + 1] : 0) * DM;
    const bf16* ap2 = HB + (size_t)(rank + 2 < cnt ? elist[rank + 2] : 0) * DM; const bf16* ap3 = HB + (size_t)(rank + 3 < cnt ? elist[rank + 3] : 0) * DM;
    const bf16* W = (const bf16*)(a.ws + WS_WGU + layer * WGU_L + e * WGU_E);
    const int rg = 256 * (j >> 7) + (j & 127);
    float g[4] = {0.f, 0.f, 0.f, 0.f}, u[4] = {0.f, 0.f, 0.f, 0.f};
    dot4(ap0, ap1, ap2, ap3, W + (size_t)rg * DM, DM, g);
    dot4(ap0, ap1, ap2, ap3, W + (size_t)(rg + 128) * DM, DM, u);
    bf16* act = (bf16*)(a.ws + WS_ACT);
#pragma unroll
    for (int i = 0; i < 4; ++i) act[(size_t)(s0 + i) * FF + j] = (bf16)f2bf(g[i] * sigmoidf_(g[i]) * u[i]);
}
__global__ void __launch_bounds__(256) naive_moe_down(Args a, int layer) {
    const int n = blockIdx.x * 256 + threadIdx.x, s0 = blockIdx.y * 4;
    int e, cnt, ps; if (!moe_find((const unsigned*)(a.ws + WS_CTL), layer, s0, e, cnt, ps)) return;
    const bf16* A = (const bf16*)(a.ws + WS_ACT) + (size_t)s0 * FF; const bf16* B = (const bf16*)(a.ws + WS_WD + layer * WD_L + e * WD_E) + (size_t)n * FF;
    float acc[4] = {0.f, 0.f, 0.f, 0.f};
    dot4(A, A + FF, A + 2 * FF, A + 3 * FF, B, FF, acc);
    bf16* O = (bf16*)(a.ws + WS_OSL);
#pragma unroll
    for (int i = 0; i < 4; ++i) O[(size_t)(s0 + i) * DM + n] = (bf16)f2bf(acc[i]);
}
__global__ void __launch_bounds__(256) naive_attn(Args a, int nq) {
    const int lane = threadIdx.x & 63, widx = blockIdx.x * 4 + (threadIdx.x >> 6);
    const int th = widx / nq, pq = nq - 1 - (widx % nq);
    if (th >= 16) return;
    const int type = th >> 3, head = th & 7;
    const bf16* QKV = (const bf16*)(a.ws + WS_QKV);
    const int qcol = (type ? 3072 : 0) + head * HD, kcol = qcol + 1024, vcol = qcol + 2048;
    const int rowq = row_of_p(pq);
    u32x4 q[16];
#pragma unroll
    for (int i = 0; i < 16; ++i) q[i] = *(const u32x4*)(QKV + (size_t)rowq * QKV_N + qcol + 8 * i);
    const float* cum = (const float*)(a.ws + WS_CUM) + (size_t)head * MROWS;
    float o0 = 0.f, o1 = 0.f, carry = 0.f, m = -1e30f, l = 0.f;
    const float cq = type ? cum[pq] : 0.f;
    for (int phi = type ? pq : pq - 1; phi >= 0; phi -= 64) {
        const int p = phi - lane; const bool valid = p >= 0; const int pr = row_of_p(valid ? p : 0);
        float u = 0.f;
        const bf16* kp = QKV + (size_t)pr * QKV_N + kcol;
#pragma unroll
        for (int i = 0; i < 16; ++i) u = dot8(q[i], *(const u32x4*)(kp + 8 * i), u);
        float w;
        if (type == 0) {
            const float aa = exp2f(-fabsf(u)), b = log2f(1.0f + aa);
            float lk = fminf(-u, 0.f) - b; const float lb = lk + u;
            if (!valid) lk = 0.f;
            float inc = lk;
#pragma unroll
            for (int off = 1; off < 64; off <<= 1) { const float t = __shfl_up(inc, off); if (lane >= off) inc += t; }
            const float after = carry + inc - lk;
            w = valid ? exp2f(lb + after) : 0.f;
            carry += __shfl(inc, 63);
        } else {
            const float s = valid ? u + cq - cum[valid ? p : 0] : -__builtin_inff();
            const float cm = wave_max(s), mn = fmaxf(m, cm), alpha = exp2f(m - mn);
            w = valid ? exp2f(s - mn) : 0.f;
            l = l * alpha + wave_sum(w); o0 *= alpha; o1 *= alpha; m = mn;
        }
        for (int j = 0; j < 64; ++j) {
            const float wj = __shfl(w, j); const int prj = __shfl(pr, j);
            const unsigned vv = *(const unsigned*)(QKV + (size_t)prj * QKV_N + vcol + 2 * lane);
            o0 = fmaf(wj, bflo(vv), o0); o1 = fmaf(wj, bfhi(vv), o1);
        }
    }
    if (type) { const float rl = 1.0f / l; o0 *= rl; o1 *= rl; }
    *(unsigned*)((bf16*)(a.ws + WS_YB) + (size_t)rowq * DM + type * 1024 + head * HD + 2 * lane) = pk2(o0, o1);
}

#define XB_TMO      128
#define XB_XCNT(j)  (256  + 64 * (j))
#define XB_XSUB(j)  (1280 + 64 * (j))
#define XB_XGEN(j)  (2304 + 64 * (j))
#define XB_TOP      3328
#define XB_TOPGEN   3392
#define XB_SPIN_CAP (1u << 18)
__device__ __forceinline__ unsigned xb_ld(unsigned* p)              { return __hip_atomic_load(p, __ATOMIC_RELAXED, __HIP_MEMORY_SCOPE_AGENT); }
__device__ __forceinline__ unsigned xb_add(unsigned* p, unsigned v) { return __hip_atomic_fetch_add(p, v, __ATOMIC_RELAXED, __HIP_MEMORY_SCOPE_AGENT); }
__device__ __forceinline__ unsigned xb_xcc_id() { return (unsigned)__builtin_amdgcn_s_getreg((3 << 11) | 20) & 0xFu; }
#define XB_SPIN(cond, bar) do { unsigned _sp = 0; while (cond) { __builtin_amdgcn_s_sleep(1); \
    if ((++_sp & 255u) == 0u) { if (xb_ld(&(bar)[XB_TMO])) break; if (_sp > XB_SPIN_CAP) { atomicAdd(&(bar)[XB_TMO], 1u); break; } } } } while (0)
struct XcdBarrier { unsigned* bar; unsigned x; volatile LAS unsigned* st; };
__device__ __forceinline__ XcdBarrier xcd_barrier_post(unsigned* bar, volatile LAS unsigned* st) {
    XcdBarrier b; b.bar = bar; b.x = xb_xcc_id(); b.st = st;
    if (threadIdx.x == 0) (void)xb_add(&bar[XB_XCNT(b.x)], 1u);
    return b;
}
__device__ __forceinline__ void xcd_barrier_complete(unsigned* bar, unsigned x, unsigned& nloc, unsigned& nx) {
    const unsigned G = gridDim.x * gridDim.y * gridDim.z;
    unsigned sum, cnt, mine, sp = 0u;
    for (;;) {
        sum = 0u; cnt = 0u; mine = 0u;
#pragma unroll
        for (unsigned j = 0; j < 16; ++j) { const unsigned c = xb_ld(&bar[XB_XCNT(j)]); sum += c; cnt += (c > 0u) ? 1u : 0u; mine = (j == x) ? c : mine; }
        if (sum == G) break;
        __builtin_amdgcn_s_sleep(1);
        if ((++sp & 255u) == 0u) { if (xb_ld(&bar[XB_TMO])) break; if (sp > XB_SPIN_CAP) { atomicAdd(&bar[XB_TMO], 1u); break; } }
    }
    nloc = mine > 0u ? mine : 1u; nx = cnt > 0u ? cnt : 1u;
}
__device__ __forceinline__ void xcd_barrier(const XcdBarrier& b) {
    asm volatile("s_waitcnt vmcnt(0)" ::: "memory");
    __syncthreads();
    if (threadIdx.x == 0) {
        unsigned* bar = b.bar;
        __builtin_amdgcn_s_waitcnt(0);
        unsigned nloc = b.st[0], nx = b.st[1];
        if (nloc == 0u) { xcd_barrier_complete(bar, b.x, nloc, nx); b.st[0] = nloc; b.st[1] = nx; }
        const unsigned old = xb_add(&bar[XB_XSUB(b.x)], 1u);
        const unsigned gen = old / nloc;
        if (old + 1u == (gen + 1u) * nloc) {
            __builtin_amdgcn_fence(__ATOMIC_RELEASE, "agent");
            asm volatile("s_waitcnt vmcnt(0)" ::: "memory");
            const unsigned og = xb_add(&bar[XB_TOP], 1u);
            const unsigned tg = og / nx;
            if (og + 1u == (tg + 1u) * nx) xb_add(&bar[XB_TOPGEN], 1u);
            else XB_SPIN(xb_ld(&bar[XB_TOPGEN]) == tg, bar);
            __builtin_amdgcn_fence(__ATOMIC_ACQUIRE, "agent");
            xb_add(&bar[XB_XGEN(b.x)], 1u);
            asm volatile("s_waitcnt vmcnt(0)" ::: "memory");
        } else {
            XB_SPIN(xb_ld(&bar[XB_XGEN(b.x)]) == gen, bar);
            __builtin_amdgcn_fence(__ATOMIC_ACQUIRE, "agent");
            asm volatile("s_waitcnt vmcnt(0)" ::: "memory");
        }
    }
    __syncthreads();
}

__device__ __forceinline__ int tid_fresh() { int t = (int)threadIdx.x; asm volatile("" : "+v"(t)); return t; }
__device__ __forceinline__ int lane_id() { return tid_fresh() & 63; }
struct Frame {
    LAS unsigned char* lds; unsigned char* ws; unsigned* ctl;
    int wave, G, gw, NGW;
    const float* const* in; float* out;
};
#define LDS_WAIT() asm volatile("s_waitcnt lgkmcnt(0)" ::: "memory")

__device__ __forceinline__ void transpose_item(const float* W, size_t ldw, bf16* WT, size_t ldt, LAS float* scr, int lane) {
#pragma unroll 8
    for (int i = 0; i < 32; ++i) { const int kk = 2 * i + (lane >> 5); scr[kk * 33 + (lane & 31)] = W[(size_t)kk * ldw + (lane & 31)]; }
    LDS_WAIT(); asm volatile("" ::: "memory");
    const int c = lane & 7;
#pragma unroll
    for (int j = 0; j < 4; ++j) { const int n = (lane >> 3) + 8 * j; const LAS float* s = scr + (8 * c) * 33 + n;
        u32x4 o; o.x = pk2(s[0 * 33], s[1 * 33]); o.y = pk2(s[2 * 33], s[3 * 33]); o.z = pk2(s[4 * 33], s[5 * 33]); o.w = pk2(s[6 * 33], s[7 * 33]);
        *(u32x4*)(WT + (size_t)n * ldt + 8 * c) = o; }
    LDS_WAIT(); asm volatile("" ::: "memory");
}
__device__ __forceinline__ void transpose_item8(const float* W, size_t ldw, unsigned char* WT, size_t ldt, LAS float* scr, int lane) {
    f32x4 r[8];
#pragma unroll
    for (int i = 0; i < 8; ++i) r[i] = __builtin_nontemporal_load((const f32x4*)(W + (size_t)(8 * i + (lane >> 3)) * ldw + 4 * (lane & 7)));
#pragma unroll
    for (int i = 0; i < 8; ++i) { LAS float* d = scr + (8 * i + (lane >> 3)) * 33 + 4 * (lane & 7); d[0] = r[i].x; d[1] = r[i].y; d[2] = r[i].z; d[3] = r[i].w; }
    LDS_WAIT(); asm volatile("" ::: "memory");
    const int c = lane & 3;
#pragma unroll
    for (int j = 0; j < 2; ++j) { const int n = (lane >> 2) + 16 * j; const LAS float* p = scr + (16 * c) * 33 + n;
        u32x4 o;
        o.x = pk4_fp8(p[0 * 33] * W8_SCALE, p[1 * 33] * W8_SCALE, p[2 * 33] * W8_SCALE, p[3 * 33] * W8_SCALE); o.y = pk4_fp8(p[4 * 33] * W8_SCALE, p[5 * 33] * W8_SCALE, p[6 * 33] * W8_SCALE, p[7 * 33] * W8_SCALE);
        o.z = pk4_fp8(p[8 * 33] * W8_SCALE, p[9 * 33] * W8_SCALE, p[10 * 33] * W8_SCALE, p[11 * 33] * W8_SCALE); o.w = pk4_fp8(p[12 * 33] * W8_SCALE, p[13 * 33] * W8_SCALE, p[14 * 33] * W8_SCALE, p[15 * 33] * W8_SCALE);
        __builtin_nontemporal_store(o, (u32x4*)(WT + (size_t)n * ldt + 16 * c)); }
    LDS_WAIT(); asm volatile("" ::: "memory");
}
__device__ __forceinline__ void convert_item(Frame& F, int it, LAS float* scr) {
    constexpr int I_IN = 32 * 320, I_BS = 16 * 64, I_OUT = 32 * 64, I_GE = 32 * 32, I_DE = 16 * 64;
    constexpr int PER_LAYER = I_IN + 2 * I_BS + I_OUT + NE * (2 * I_GE + I_DE);
    const int l = it / PER_LAYER; int r = it % PER_LAYER;
    if (r < I_IN) { const int kb = r / 320, nb = r % 320, nd = 32 * nb, ns = nd + (nd >= FCOL ? 8 : 0);
        transpose_item8(F.in[I_WIN] + (size_t)l * DM * INP_SRC + (size_t)(64 * kb) * INP_SRC + ns, INP_SRC, F.ws + WS_WIN + l * WIN_L + (size_t)nd * DM + 64 * kb, DM, scr, lane_id()); return; }
    r -= I_IN;
    if (r < 2 * I_BS) { const int which = r / I_BS; r %= I_BS; const int kb = r / 64, nb = r % 64;
        transpose_item8((which ? F.in[I_WBFX] : F.in[I_WBSB]) + (size_t)l * 1024 * DM + (size_t)(64 * kb) * DM + 32 * nb, DM, F.ws + WS_WB + l * WB_L + (size_t)(32 * nb) * DM + which * 1024 + 64 * kb, DM, scr, lane_id()); return; }
    r -= 2 * I_BS;
    if (r < I_OUT) { const int kb = r / 64, nb = r % 64;
        transpose_item8(F.in[I_WOUT] + (size_t)l * DM * DM + (size_t)(64 * kb) * DM + 32 * nb, DM, F.ws + WS_WOUT + l * WOUT_L + (size_t)(32 * nb) * DM + 64 * kb, DM, scr, lane_id()); return; }
    r -= I_OUT;
    const int e = r / (2 * I_GE + I_DE); r %= (2 * I_GE + I_DE);
    if (r < 2 * I_GE) { const int which = r / I_GE; r %= I_GE; const int kb = r / 32, nb = r % 32, n0 = 32 * nb, rho = 256 * (n0 >> 7) + (n0 & 127) + which * 128;
        transpose_item8((which ? F.in[I_WU] : F.in[I_WG]) + ((size_t)(l * NE + e) * DM + 64 * kb) * FF + n0, FF, F.ws + WS_WGU + l * WGU_L + e * WGU_E + (size_t)rho * DM + 64 * kb, DM, scr, lane_id()); return; }
    r -= 2 * I_GE;
    { const int kb = r / 64, nb = r % 64;
        transpose_item8(F.in[I_WD] + ((size_t)(l * NE + e) * FF + 64 * kb) * DM + 32 * nb, DM, F.ws + WS_WD + l * WD_L + e * WD_E + (size_t)(32 * nb) * FF + 64 * kb, FF, scr, lane_id()); }
}
constexpr int N_CONVERT_ITEMS = NLAYER * (32 * 320 + 2 * 16 * 64 + 32 * 64 + NE * (2 * 32 * 32 + 16 * 64));
constexpr int CV_PER_LAYER = N_CONVERT_ITEMS / NLAYER, CV_G0_END = 32 * 320, CV_G1_END = CV_PER_LAYER + 32 * 320, CV_BUNDLE = 128;
static_assert((CV_G1_END - CV_G0_END) % CV_BUNDLE == 0 && (N_CONVERT_ITEMS - CV_G1_END) % CV_BUNDLE == 0, "bundles");
__device__ __forceinline__ void convert_bundle(Frame& F, int first_item) {
    LAS float* scr = (LAS float*)(F.lds + F.wave * 16384);
    for (int i = 0; i < CV_BUNDLE / NWAVES; ++i) convert_item(F, first_item + F.wave + NWAVES * i, scr);
}

__device__ __forceinline__ int tab_rowpos(int c) { return (c & 3) * 512 + (c >> 8) * 64 + ((c >> 2) & 63); }
template <int NC> __device__ __forceinline__ void stage_table(Frame& F, const float* src, size_t pitch) {
    constexpr int CH = NC / 4;
    for (int ci = tid_fresh(); ci < DM * CH; ci += NTHREADS) { const int c = ci / CH, q = ci % CH;
        const f32x4 v = *(const f32x4*)(src + (size_t)c * pitch + 4 * q);
        const int sw = (NC == 16) ? ((c >> 4) & 3) : ((c >> 5) & 1);
        *(LAS f32x4*)(F.lds + tab_rowpos(c) * (NC * 4) + ((q ^ sw) << 4)) = v; }
    LDS_WAIT(); __syncthreads();
}
template <int NC> __device__ __forceinline__ void table_dot(Frame& F, const f32x4 (&y)[8], float (&acc)[NC]) {
    constexpr int CH = NC / 4; const int l = lane_id(); const int sw = (NC == 16) ? ((l >> 2) & 3) : ((l >> 3) & 1);
#pragma unroll
    for (int e = 0; e < NC; ++e) acc[e] = 0.f;
#pragma unroll
    for (int j = 0; j < 8; ++j)
#pragma unroll
        for (int i = 0; i < 4; ++i) { const float yv = y[j][i]; const int rp = i * 512 + j * 64 + l; if (i == 0) asm volatile("" ::: "memory");
#pragma unroll
            for (int q = 0; q < CH; ++q) { const f32x4 w = *(const LAS f32x4*)(F.lds + rp * (NC * 4) + ((q ^ sw) << 4));
                acc[4 * q + 0] = fmaf(yv, w.x, acc[4 * q + 0]); acc[4 * q + 1] = fmaf(yv, w.y, acc[4 * q + 1]); acc[4 * q + 2] = fmaf(yv, w.z, acc[4 * q + 2]); acc[4 * q + 3] = fmaf(yv, w.w, acc[4 * q + 3]); } }
#pragma unroll
    for (int e = 0; e < NC; ++e) acc[e] = wave_sum(acc[e]);
}
__device__ __forceinline__ void ln_row(Frame& F, f32x4 (&v)[8], const float* g, const float* b) {
    float s = 0.f;
#pragma unroll
    for (int j = 0; j < 8; ++j) s += (v[j].x + v[j].y) + (v[j].z + v[j].w);
    const float mean = wave_sum(s) * (1.f / DM); float s2 = 0.f;
#pragma unroll
    for (int j = 0; j < 8; ++j) { v[j] = v[j] - mean; s2 += (v[j].x * v[j].x + v[j].y * v[j].y) + (v[j].z * v[j].z + v[j].w * v[j].w); }
    const float rstd = 1.0f / sqrtf(wave_sum(s2) * (1.f / DM) + LN_EPS);
#pragma unroll
    for (int j = 0; j < 8; ++j) { const f32x4 gv = *(const f32x4*)(g + 256 * j + 4 * lane_id()), bv = *(const f32x4*)(b + 256 * j + 4 * lane_id()); v[j] = v[j] * rstd * gv + bv; }
}
__device__ __forceinline__ void store_h(Frame& F, int row, const f32x4 (&y)[8], bool dry = false) {
    bf16* hf = (bf16*)(F.ws + (dry ? WS_YB : WS_HF)) + (size_t)row * DM;
    unsigned char* h8 = F.ws + (dry ? WS_GB + 21 * MiB : WS_H8) + (size_t)row * DM;
#pragma unroll
    for (int j = 0; j < 8; ++j) { u32x2 w; w.x = pk2(y[j].x, y[j].y); w.y = pk2(y[j].z, y[j].w); *(u32x2*)(hf + 256 * j + 4 * lane_id()) = w;
        *(unsigned*)(h8 + 256 * j + 4 * lane_id()) = pk4_fp8(y[j].x * H8_SCALE, y[j].y * H8_SCALE, y[j].z * H8_SCALE, y[j].w * H8_SCALE); }
}
__device__ __forceinline__ void store_logf(Frame& F, int row, const f32x4 (&y)[8], const float* bfor) {
    float acc[8]; table_dot<8>(F, y, acc);
    if (lane_id() < 8) { float a = acc[0];
#pragma unroll
        for (int h = 1; h < 8; ++h) a = (lane_id() == h) ? acc[h] : a;
        const float x = a + bfor[lane_id()];
        const float ls = fminf(x, 0.f) - log1pf(__expf(-fabsf(x)));
        ((float*)(F.ws + WS_LOGF))[(size_t)row * 8 + lane_id()] = ls; }
}

__device__ __forceinline__ void phase_prologue(Frame& F) {
    LAS float* scr = (LAS float*)(F.lds + F.wave * 16384);
    for (int it = F.gw; it < CV_G0_END; it += F.NGW) convert_item(F, it, scr);
    __syncthreads();
    stage_table<8>(F, F.in[I_WIN] + FCOL, INP_SRC);
    for (int row = F.gw; row < NTOK; row += F.NGW) {
        const float* src = row < SEQ ? F.in[I_X] + (size_t)row * DM : F.in[I_META] + (size_t)(row - SEQ) * DM;
        f32x4 v[8];
#pragma unroll
        for (int j = 0; j < 8; ++j) v[j] = *(const f32x4*)(src + 256 * j + 4 * lane_id());
        ln_row(F, v, F.in[I_LNIN_G], F.in[I_LNIN_B]);
        store_h(F, row, v);
        store_logf(F, row, v, F.in[I_BF]);
    }
    for (int row = NTOK + F.gw; row < MROWS; row += F.NGW) { bf16* hb = (bf16*)(F.ws + WS_HB) + (size_t)row * DM;
#pragma unroll
        for (int j = 0; j < 4; ++j) *(u32x4*)(hb + 512 * j + 8 * lane_id()) = (u32x4){0u, 0u, 0u, 0u}; }
    __syncthreads();
}
__device__ __forceinline__ void phase_tilesuf(Frame& F) {
    if (blockIdx.x > SEQ / 64) return;
    const int tile = blockIdx.x, h = F.wave, row = tile * 64 + lane_id();
    const float v = (row < NTOK) ? LOG2E * ((const float*)(F.ws + WS_LOGF))[(size_t)row * 8 + h] : 0.f;
    float inc = v;
#pragma unroll
    for (int off = 1; off < 64; off <<= 1) { const float t = __shfl_down(inc, off); if (lane_id() + off < 64) inc += t; }
    float* base = (float*)(F.ws + WS_CUM);
    base[(size_t)h * MROWS + row] = inc - v;
    if (lane_id() == 0) base[(size_t)NHEAD * MROWS + h * 256 + tile] = inc;
}
__device__ __forceinline__ void phase_cumsum(Frame& F, bool do_scan) {
    if (blockIdx.x >= NHEAD) {
        if (blockIdx.x < NHEAD + 48) { bf16* q = (bf16*)(F.ws + WS_QKV) + (size_t)(NTOK + blockIdx.x - NHEAD) * QKV_N;
            for (int i = tid_fresh(); i < QKV_N / 8; i += NTHREADS) *(u32x4*)(q + 8 * i) = (u32x4){0u, 0u, 0u, 0u}; }
        return; }
    if (!do_scan) return;
    const int h = blockIdx.x; const float* logf = (const float*)(F.ws + WS_LOGF); float* cum = (float*)(F.ws + WS_CUM) + (size_t)h * MROWS;
    constexpr int PER = 17; const int p0 = tid_fresh() * PER;
    float loc[PER]; float s = 0.f;
#pragma unroll
    for (int i = 0; i < PER; ++i) { const int p = p0 + i; const float v = p < NTOK ? logf[(size_t)row_of_p(p) * 8 + h] : 0.f; s += v; loc[i] = s; }
    float inc = s;
#pragma unroll
    for (int off = 1; off < 64; off <<= 1) { const float t = __shfl_up(inc, off); if (lane_id() >= off) inc += t; }
    LAS float* wt = (LAS float*)(F.lds);
    if (lane_id() == 63) wt[F.wave] = inc;
    LDS_WAIT(); __syncthreads();
    float base = inc - s;
    for (int w = 0; w < F.wave; ++w) base += wt[w];
#pragma unroll
    for (int i = 0; i < PER; ++i) { const int p = p0 + i; if (p < NTOK) cum[p] = (base + loc[i]) * LOG2E; }
    LDS_WAIT(); __syncthreads();
}
__device__ __forceinline__ void phase_ln_router(Frame& F, int layer, bool dry = false) {
    stage_table<16>(F, F.in[I_WR], 16);
    const float* g = F.in[I_LNMIX_G] + layer * DM; const float* b = F.in[I_LNMIX_B] + layer * DM;
    const float* rbias = F.in[I_RB];
    const int nrows_e = layer == NLAYER - 1 ? SEQ : NTOK;
    LAS int* lcnt = (LAS int*)(F.lds + RING_BYTES + 4096); LAS int* gbase = lcnt + 16; LAS int* rec = lcnt + 32;
    if (tid_fresh() < 32) lcnt[tid_fresh()] = 0;
    LDS_WAIT(); __syncthreads();
    const bf16* RBp = (const bf16*)(F.ws + WS_RB);
    u32x2 vn[8];
    if (F.gw < nrows_e) { const bf16* src = RBp + (size_t)F.gw * DM;
#pragma unroll
        for (int j = 0; j < 8; ++j) vn[j] = *(const u32x2*)(src + 256 * j + 4 * lane_id()); }
    int k = 0;
    for (int row = F.gw; row < nrows_e; row += F.NGW, ++k) {
        f32x4 v[8];
#pragma unroll
        for (int j = 0; j < 8; ++j) { v[j].x = bflo(vn[j].x); v[j].y = bfhi(vn[j].x); v[j].z = bflo(vn[j].y); v[j].w = bfhi(vn[j].y); }
        if (row + F.NGW < nrows_e) { const bf16* src = RBp + (size_t)(row + F.NGW) * DM;
#pragma unroll
            for (int j = 0; j < 8; ++j) vn[j] = *(const u32x2*)(src + 256 * j + 4 * lane_id()); }
        ln_row(F, v, g, b);
        store_h(F, row, v, dry);
        float lg[16]; table_dot<16>(F, v, lg);
        float aff[16], sel[16];
#pragma unroll
        for (int e = 0; e < 16; ++e) { aff[e] = 1.0f / (1.0f + __expf(-lg[e])); sel[e] = aff[e] + rbias[e]; }
        int bg = 0; float bs = -__builtin_inff();
#pragma unroll
        for (int gi = 0; gi < 4; ++gi) { const float a0 = sel[4 * gi], a1 = sel[4 * gi + 1], a2 = sel[4 * gi + 2], a3 = sel[4 * gi + 3];
            const float h1 = fmaxf(a0, a1), l1 = fminf(a0, a1), h2 = fmaxf(a2, a3), l2 = fminf(a2, a3);
            const float top = fmaxf(h1, h2), sec = fmaxf(fminf(h1, h2), fmaxf(l1, l2)), sc = top + sec;
            if (sc > bs) { bs = sc; bg = gi; } }
        float s4[4], a4[4];
#pragma unroll
        for (int i = 0; i < 4; ++i) { s4[i] = sel[i]; a4[i] = aff[i]; }
#pragma unroll
        for (int gi = 1; gi < 4; ++gi) if (bg == gi) {
#pragma unroll
            for (int i = 0; i < 4; ++i) { s4[i] = sel[4 * gi + i]; a4[i] = aff[4 * gi + i]; } }
        int i1 = 0; float m1 = s4[0];
#pragma unroll
        for (int i = 1; i < 4; ++i) if (s4[i] > m1) { m1 = s4[i]; i1 = i; }
        int i2 = -1; float m2 = -__builtin_inff();
#pragma unroll
        for (int i = 0; i < 4; ++i) if (i != i1 && s4[i] > m2) { m2 = s4[i]; i2 = i; }
        float af1 = a4[0], af2 = a4[0];
#pragma unroll
        for (int i = 1; i < 4; ++i) { if (i1 == i) af1 = a4[i]; if (i2 == i) af2 = a4[i]; }
        const float wsum = af1 + af2, w1 = af1 / wsum, w2 = af2 / wsum;
        const int e1 = 4 * bg + i1, e2 = 4 * bg + i2;
        if (lane_id() == 0 && !dry) { LAS int* rc = rec + (F.wave * 5 + k) * 8;
            rc[0] = e1; rc[1] = e2; rc[2] = __hip_atomic_fetch_add(lcnt + e1, 1, __ATOMIC_RELAXED, __HIP_MEMORY_SCOPE_WORKGROUP); rc[3] = __hip_atomic_fetch_add(lcnt + e2, 1, __ATOMIC_RELAXED, __HIP_MEMORY_SCOPE_WORKGROUP);
            rc[4] = __builtin_bit_cast(int, w1); rc[5] = __builtin_bit_cast(int, w2); rc[6] = row; }
    }
    LDS_WAIT(); __syncthreads();
    if (tid_fresh() < NE && !dry) { const int c = lcnt[tid_fresh()]; gbase[tid_fresh()] = c > 0 ? (int)atomicAdd(F.ctl + CW_CNT + (layer * NE + tid_fresh()) * 64, (unsigned)c) : 0; }
    LDS_WAIT(); __syncthreads();
    if (tid_fresh() < 40 && !dry) { const int w = tid_fresh() / 5, kk = tid_fresh() % 5; const int row = F.gw - F.wave + w + kk * F.NGW;
        if (row < nrows_e) { const LAS int* rc = rec + tid_fresh() * 8; const int e1 = rc[0], e2 = rc[1], r1 = gbase[e1] + rc[2], r2 = gbase[e2] + rc[3];
            int* el = (int*)(F.ws + WS_ELIST); el[(size_t)e1 * MROWS + r1] = row; el[(size_t)e2 * MROWS + r2] = row;
            int* ti = (int*)(F.ws + WS_TOKI) + (size_t)row * 8;
            ti[0] = e1; ti[1] = e2; ti[2] = r1; ti[3] = r2; ti[4] = rc[4]; ti[5] = rc[5]; } }
    __syncthreads();
}
__device__ __forceinline__ void phase_ln_final(Frame& F, int layer, bool dry = false) {
    const bool last = layer == NLAYER - 1;
    if (!last) stage_table<8>(F, F.in[I_WIN] + (size_t)(layer + 1) * DM * INP_SRC + FCOL, INP_SRC);
    const float* g = F.in[I_LNFFN_G] + layer * DM; const float* b = F.in[I_LNFFN_B] + layer * DM;
    const int nrows = last ? SEQ : NTOK;
    const int* TI = (const int*)(F.ws + WS_TOKI); const bf16* OSL = (const bf16*)(F.ws + WS_OSL); const bf16* HFp = (const bf16*)(F.ws + WS_HF);
    int tA[6], tB[6]; u32x2 hvn[8]; u32x2 an[8], cn[8]; float w1n = 0.f, w2n = 0.f;
#define H_LOADTOK(dst, r_) do { _Pragma("unroll") for (int q_ = 0; q_ < 6; ++q_) dst[q_] = TI[(size_t)(r_) * 8 + q_]; } while (0)
#define H_ISSUE(tk, r_) do { const int ps1_ = moe_pstart(F.ctl, layer, tk[0]), ps2_ = moe_pstart(F.ctl, layer, tk[1]); \
        const bf16* o1_ = OSL + (size_t)(ps1_ + tk[2]) * DM; const bf16* o2_ = OSL + (size_t)(ps2_ + tk[3]) * DM; const bf16* hf_ = HFp + (size_t)(r_) * DM; \
        w1n = __builtin_bit_cast(float, tk[4]); w2n = __builtin_bit_cast(float, tk[5]); \
        _Pragma("unroll") for (int j = 0; j < 8; ++j) { hvn[j] = *(const u32x2*)(hf_ + 256 * j + 4 * lane_id()); an[j] = *(const u32x2*)(o1_ + 256 * j + 4 * lane_id()); cn[j] = *(const u32x2*)(o2_ + 256 * j + 4 * lane_id()); } } while (0)
    if (F.gw < nrows) { H_LOADTOK(tA, F.gw); H_ISSUE(tA, F.gw); }
    if (F.gw + F.NGW < nrows) H_LOADTOK(tB, F.gw + F.NGW);
    for (int row = F.gw; row < nrows; row += F.NGW) {
        f32x4 v[8]; const float w1 = w1n, w2 = w2n;
#pragma unroll
        for (int j = 0; j < 8; ++j) { const u32x2 hw = hvn[j]; const u32x2 a = an[j], c = cn[j];
            v[j].x = ALPHA * bflo(hw.x) + w1 * bflo(a.x) + w2 * bflo(c.x); v[j].y = ALPHA * bfhi(hw.x) + w1 * bfhi(a.x) + w2 * bfhi(c.x);
            v[j].z = ALPHA * bflo(hw.y) + w1 * bflo(a.y) + w2 * bflo(c.y); v[j].w = ALPHA * bfhi(hw.y) + w1 * bfhi(a.y) + w2 * bfhi(c.y); }
        if (row + F.NGW < nrows) { H_ISSUE(tB, row + F.NGW); if (row + 2 * F.NGW < nrows) H_LOADTOK(tB, row + 2 * F.NGW); }
        ln_row(F, v, g, b);
        if (dry) { store_h(F, row, v, true); if (!last) { float acc8[8]; table_dot<8>(F, v, acc8); if (lane_id() == 0) ((float*)(F.ws + WS_GB + 60 * MiB))[row] = acc8[0] + acc8[7]; } }
        else if (last) { float* o = F.out + (size_t)row * DM;
#pragma unroll
            for (int j = 0; j < 8; ++j) *(f32x4*)(o + 256 * j + 4 * lane_id()) = v[j]; }
        else { store_h(F, row, v); store_logf(F, row, v, F.in[I_BF] + (layer + 1) * NHEAD); }
    }
#undef H_LOADTOK
#undef H_ISSUE
    __syncthreads();
}

namespace pg8 {
typedef short bf16x8 __attribute__((ext_vector_type(8)));
typedef int i32x4 __attribute__((ext_vector_type(4)));
typedef int i32x8 __attribute__((ext_vector_type(8)));
__device__ __forceinline__ i32x8 ld_frag(const LAS unsigned char* p) { const i32x4 x = *(const LAS i32x4*)p, y = *(const LAS i32x4*)(p + 1024); return __builtin_shufflevector(x, y, 0, 1, 2, 3, 4, 5, 6, 7); }
__device__ __forceinline__ bf16x8 frag_lo(i32x8 f) { return __builtin_bit_cast(bf16x8, (i32x4)__builtin_shufflevector(f, f, 0, 1, 2, 3)); }
__device__ __forceinline__ bf16x8 frag_hi(i32x8 f) { return __builtin_bit_cast(bf16x8, (i32x4)__builtin_shufflevector(f, f, 4, 5, 6, 7)); }
constexpr int BM = 256, BK = 64, HALF = 128, HTB = HALF * BK * 2, STAGE_BYTES = 8 * HTB, NXCD = 8, WGM = 8;
__host__ __device__ __forceinline__ int lds_byte(int r, int c) { const int st = (r >> 4) * 2 + (c >> 5), rr = r & 15, cc = c & 31, ob = rr * 64 + cc * 2; return st * 1024 + (ob ^ (((ob >> 9) & 1) << 5)); }
__host__ __device__ __forceinline__ void stage_rc(int b, int& R, int& C) { const int st = b / 1024, sb = b % 1024, swz = sb ^ (((sb >> 9) & 1) << 5); R = (st >> 1) * 16 + swz / 64; C = (st & 1) * 32 + (swz % 64) / 2; }
__host__ __device__ __forceinline__ int perm32(int rho) { const int n = rho >> 4, i = rho & 15; return 8 * (i >> 2) + 4 * n + (i & 3); }
struct Unit { int pm, pn, aux; };
__device__ __forceinline__ bool static_tile(int nM, int nN, int G, int c, int i, int& pm, int& pn) {
    const int nwg = nM * nN; const long L = (long)i * G + c; if (L >= nwg) return false;
    int wgid = (int)L; { const int q = nwg / NXCD, r = nwg % NXCD, xcd = wgid % NXCD, off = wgid / NXCD; wgid = (xcd < r ? xcd * (q + 1) : r * (q + 1) + (xcd - r) * q) + off; }
    const int nig = WGM * nN, gid = wgid / nig, fm = gid * WGM, gsz = (nM - fm) < WGM ? (nM - fm) : WGM;
    pm = fm + ((wgid % nig) % gsz); pn = (wgid % nig) / gsz; return true;
}
__device__ __forceinline__ unsigned cvt_pk_bf16(float lo, float hi) { unsigned r; asm volatile("v_cvt_pk_bf16_f32 %0, %1, %2" : "=v"(r) : "v"(lo), "v"(hi)); return r; }

template <class P>
__device__ __forceinline__ void gemm_phase(LAS unsigned char* lds, const P& prob) {
    const int tid = tid_fresh(), wid = __builtin_amdgcn_readfirstlane(tid >> 6), lane = tid & 63, wr = wid >> 2, wc = wid & 3, fr = lane & 15, fq = lane >> 4;
    constexpr int ES = P::FP8 ? 1 : 2;
    const int nt = prob.K * ES / (BK * 2);
    unsigned voffA[2], voffA1[2], voffB[2];
#pragma unroll
    for (int i = 0; i < 2; ++i) { int R, C; stage_rc(tid * 16 + i * 8192, R, C); const int Rb = P::PERM ? ((R & ~31) + perm32(R & 31)) : R;
        voffA[i] = (unsigned)(R * prob.lda * ES + C * 2); voffA1[i] = voffA[i]; voffB[i] = (unsigned)(Rb * prob.ldb * ES + C * 2); }
    const size_t kstep = (size_t)(BK * 2);
    const size_t hstepA = P::GATHER ? (size_t)0 : (size_t)HALF * prob.lda * ES, hstepB = (size_t)HALF * prob.ldb * ES;
    const unsigned ldsw = (unsigned)wid * 1024u;
    const int aoff = lds_byte(wr * 64 + fr, fq * 8), boff = lds_byte(wc * 32 + fr, fq * 8);
#define PG8_SA(b, h) (((b) * 2 + (h)) * HTB)
#define PG8_SB(b, h) ((4 + (b) * 2 + (h)) * HTB)
#define PG8_STAGE(bufoff, gbase, voff) do { _Pragma("unroll") for (int _i = 0; _i < 2; ++_i) \
        __builtin_amdgcn_global_load_lds((const unsigned*)((const char*)(gbase) + (voff)[_i]), (LAS unsigned*)(lds + (bufoff) + ldsw + _i * 8192), 16, 0, 0); } while (0)
#define PG8_LDA(dst, b, h) do { _Pragma("unroll") for (int m = 0; m < 4; ++m) dst[m] = ld_frag(lds + PG8_SA(b, h) + aoff + m * 2048); } while (0)
#define PG8_LDB(dst, b, h) do { _Pragma("unroll") for (int n = 0; n < 2; ++n) dst[n] = ld_frag(lds + PG8_SB(b, h) + boff + n * 2048); } while (0)
#define PG8_MMA(ai, bj, At, Bt) do { __builtin_amdgcn_s_setprio(1); _Pragma("unroll") for (int m = 0; m < 4; ++m) _Pragma("unroll") for (int n = 0; n < 2; ++n) { \
        if constexpr (P::FP8) asm volatile("v_mfma_scale_f32_16x16x128_f8f6f4 %0, %1, %2, %0, %3, %4 op_sel_hi:[0,0,0]" : "+v"(acc[ai][bj][m][n]) : "v"(Bt[n]), "v"(At[m]), "v"(scb), "v"(sca)); \
        else { acc[ai][bj][m][n] = __builtin_amdgcn_mfma_f32_16x16x32_bf16(frag_lo(Bt[n]), frag_lo(At[m]), acc[ai][bj][m][n], 0, 0, 0); \
               acc[ai][bj][m][n] = __builtin_amdgcn_mfma_f32_16x16x32_bf16(frag_hi(Bt[n]), frag_hi(At[m]), acc[ai][bj][m][n], 0, 0, 0); } } __builtin_amdgcn_s_setprio(0); } while (0)
#define PG8_WAIT_V(n) asm volatile("s_waitcnt vmcnt(" #n ")" ::: "memory")
#define PG8_WAIT_L(n) asm volatile("s_waitcnt lgkmcnt(" #n ")" ::: "memory")
#define PG8_BAR __builtin_amdgcn_s_barrier()
#define PG8_SCHED __builtin_amdgcn_sched_barrier(0)
#define PG8_GATHER_OFFS(ui_, d0, d1) do { _Pragma("unroll") for (int _i = 0; _i < 2; ++_i) { int R_, C_; stage_rc(tid * 16 + _i * 8192, R_, C_); \
        d0[_i] = (unsigned)(prob.a_row(ui_, R_) * prob.lda * ES + C_ * 2); d1[_i] = (unsigned)(prob.a_row(ui_, HALF + R_) * prob.lda * ES + C_ * 2); } } while (0)
    Unit cur, nxt; int ui = 0;
    if (!prob.next(0, cur)) return;
    f32x4 acc[2][2][4][2];
#pragma unroll
    for (int a = 0; a < 2; ++a)
#pragma unroll
        for (int b = 0; b < 2; ++b)
#pragma unroll
            for (int m = 0; m < 4; ++m)
#pragma unroll
                for (int n = 0; n < 2; ++n) acc[a][b][m][n] = (f32x4){0.f, 0.f, 0.f, 0.f};
    const int sca = prob.sc_a, scb = prob.sc_b;
    i32x8 At[4], B0[2], B1[2];
    const char* cA = prob.a_ptr(cur); const char* cB = prob.b_ptr(cur);
    if constexpr (P::GATHER) PG8_GATHER_OFFS(0, voffA, voffA1);
    PG8_STAGE(PG8_SB(0, 0), cB, voffB); PG8_STAGE(PG8_SB(0, 1), cB + hstepB, voffB); PG8_STAGE(PG8_SA(0, 0), cA, voffA); PG8_STAGE(PG8_SA(0, 1), cA + hstepA, voffA1);
    if (wr == 1) PG8_BAR;
    PG8_WAIT_V(2); PG8_BAR;
    PG8_STAGE(PG8_SB(1, 0), cB + kstep, voffB); PG8_STAGE(PG8_SA(1, 0), cA + kstep, voffA); PG8_STAGE(PG8_SB(1, 1), cB + hstepB + kstep, voffB);
    PG8_WAIT_V(6); PG8_BAR;
    for (;;) {
        const bool has_next = prob.next(ui + 1, nxt);
        const char* nA = has_next ? prob.a_ptr(nxt) : cA; const char* nB = has_next ? prob.b_ptr(nxt) : cB;
        for (int t = 0; t < nt; t += 2) {
            const bool last = (t == nt - 2);
            const char* a1 = cA + (size_t)(t + 1) * kstep;
            const char* a2 = last ? nA : cA + (size_t)(t + 2) * kstep; const char* b2 = last ? nB : cB + (size_t)(t + 2) * kstep;
            const char* a3 = a2 + kstep; const char* b3 = b2 + kstep;
            if constexpr (P::GATHER) {
                unsigned v0[2], v1[2];
#pragma unroll
                for (int i = 0; i < 2; ++i) { v0[i] = voffA[i]; v1[i] = voffA1[i]; }
                if (last && has_next) PG8_GATHER_OFFS(ui + 1, v0, v1);
                PG8_LDB(B0, 0, 0); PG8_LDB(B1, 0, 1); PG8_SCHED; PG8_LDA(At, 0, 0); PG8_STAGE(PG8_SA(1, 1), a1, voffA1);
                PG8_WAIT_V(8); PG8_WAIT_L(0); PG8_BAR; PG8_MMA(0, 0, At, B0); PG8_MMA(0, 1, At, B1); PG8_BAR; PG8_SCHED;
                PG8_LDA(At, 0, 1); PG8_STAGE(PG8_SB(0, 0), b2, voffB); PG8_STAGE(PG8_SB(0, 1), b2 + hstepB, voffB); PG8_STAGE(PG8_SA(0, 0), a2, v0);
                PG8_WAIT_V(8); PG8_WAIT_L(0); PG8_BAR; PG8_MMA(1, 0, At, B0); PG8_MMA(1, 1, At, B1); PG8_BAR; PG8_SCHED;
                PG8_LDB(B0, 1, 0); PG8_LDB(B1, 1, 1); PG8_SCHED; PG8_LDA(At, 1, 0); PG8_STAGE(PG8_SA(0, 1), a2, v1);
                PG8_WAIT_V(8); PG8_WAIT_L(0); PG8_BAR; PG8_MMA(0, 0, At, B0); PG8_MMA(0, 1, At, B1); PG8_BAR; PG8_SCHED;
                PG8_LDA(At, 1, 1); PG8_STAGE(PG8_SB(1, 0), b3, voffB); PG8_STAGE(PG8_SB(1, 1), b3 + hstepB, voffB); PG8_STAGE(PG8_SA(1, 0), a3, v0);
                PG8_WAIT_V(8); PG8_WAIT_L(0); PG8_BAR; PG8_MMA(1, 0, At, B0); PG8_MMA(1, 1, At, B1); PG8_BAR; PG8_SCHED;
#pragma unroll
                for (int i = 0; i < 2; ++i) { voffA[i] = v0[i]; voffA1[i] = v1[i]; }
            } else {
                PG8_LDB(B0, 0, 0); PG8_LDB(B1, 0, 1); PG8_SCHED; PG8_LDA(At, 0, 0); PG8_STAGE(PG8_SA(1, 1), a1 + hstepA, voffA);
                PG8_WAIT_V(8); PG8_WAIT_L(0); PG8_BAR; PG8_MMA(0, 0, At, B0); PG8_MMA(0, 1, At, B1); PG8_BAR; PG8_SCHED;
                PG8_LDA(At, 0, 1); PG8_STAGE(PG8_SB(0, 0), b2, voffB); PG8_STAGE(PG8_SB(0, 1), b2 + hstepB, voffB); PG8_STAGE(PG8_SA(0, 0), a2, voffA);
                PG8_WAIT_V(8); PG8_WAIT_L(0); PG8_BAR; PG8_MMA(1, 0, At, B0); PG8_MMA(1, 1, At, B1); PG8_BAR; PG8_SCHED;
                PG8_LDB(B0, 1, 0); PG8_LDB(B1, 1, 1); PG8_SCHED; PG8_LDA(At, 1, 0); PG8_STAGE(PG8_SA(0, 1), a2 + hstepA, voffA);
                PG8_WAIT_V(8); PG8_WAIT_L(0); PG8_BAR; PG8_MMA(0, 0, At, B0); PG8_MMA(0, 1, At, B1); PG8_BAR; PG8_SCHED;
                PG8_LDA(At, 1, 1); PG8_STAGE(PG8_SB(1, 0), b3, voffB); PG8_STAGE(PG8_SB(1, 1), b3 + hstepB, voffB); PG8_STAGE(PG8_SA(1, 0), a3, voffA);
                PG8_WAIT_V(8); PG8_WAIT_L(0); PG8_BAR; PG8_MMA(1, 0, At, B0); PG8_MMA(1, 1, At, B1); PG8_BAR; PG8_SCHED;
            }
        }
        if (wr == 0) PG8_BAR;
        if constexpr (P::FP8) asm volatile("s_nop 15\n\ts_nop 15" ::: "memory");
        const bool keep = prob.epi(acc, cur, wr, wc, fr, fq);
        if (!has_next) break;
        if (!P::KEEPS || !keep) {
#pragma unroll
            for (int a = 0; a < 2; ++a)
#pragma unroll
                for (int b = 0; b < 2; ++b)
#pragma unroll
                    for (int m = 0; m < 4; ++m)
#pragma unroll
                        for (int n = 0; n < 2; ++n) acc[a][b][m][n] = (f32x4){0.f, 0.f, 0.f, 0.f};
        }
        cur = nxt; cA = nA; cB = nB; ++ui;
        if (wr == 1) PG8_BAR;
    }
    PG8_WAIT_V(0);
    PG8_BAR;
#undef PG8_SA
#undef PG8_SB
#undef PG8_STAGE
#undef PG8_LDA
#undef PG8_LDB
#undef PG8_MMA
#undef PG8_WAIT_V
#undef PG8_WAIT_L
#undef PG8_BAR
#undef PG8_SCHED
#undef PG8_GATHER_OFFS
}
}

template <class Epi>
__device__ __forceinline__ void skinny16_once(LAS unsigned char* lds, const bf16* A, int lda, const bf16* Bt, int ldb, int K, int N, const Epi& epi) {
    const int tid = tid_fresh(), wid = __builtin_amdgcn_readfirstlane(tid >> 6), lane = tid & 63, r = lane & 15, kg = lane >> 4;
    const int kw = K / 8, k0 = wid * kw;
    LAS float* part = (LAS float*)lds;
    for (int ct = blockIdx.x; ct < N / 16; ct += gridDim.x) {
        const bf16* ap = A + (size_t)r * lda + k0 + 8 * kg; const bf16* bp = Bt + (size_t)(16 * ct + r) * ldb + k0 + 8 * kg;
        f32x4 acc = {0.f, 0.f, 0.f, 0.f};
#pragma unroll 8
        for (int ks = 0; ks < kw; ks += 32) acc = __builtin_amdgcn_mfma_f32_16x16x32_bf16(*(const pg8::bf16x8*)(ap + ks), *(const pg8::bf16x8*)(bp + ks), acc, 0, 0, 0);
#pragma unroll
        for (int i = 0; i < 4; ++i) part[wid * 256 + (4 * kg + i) * 16 + r] = acc[i];
        LDS_WAIT(); __syncthreads();
        if (tid < 256) { const float s0 = (part[tid] + part[256 + tid]) + (part[512 + tid] + part[768 + tid]), s1 = (part[1024 + tid] + part[1280 + tid]) + (part[1536 + tid] + part[1792 + tid]);
            epi(tid >> 4, 16 * ct + (tid & 15), s0, s1); }
        LDS_WAIT(); __syncthreads();
    }
}
template <class Epi>
__device__ __forceinline__ void skinny16_f8(LAS unsigned char*, const unsigned char* A, int lda, const unsigned char* Bt, int ldb, int K, int N, int sc_a, int sc_b, const Epi& epi) {
    const int tid = tid_fresh(), wid = __builtin_amdgcn_readfirstlane(tid >> 6), lane = tid & 63, r = lane & 15, kg = lane >> 4;
    const int gw = blockIdx.x + gridDim.x * wid, ngw = gridDim.x * NWAVES;
    for (int ct = gw; ct < N / 16; ct += ngw) {
        const unsigned char* ap = A + (size_t)r * lda + 32 * kg; const unsigned char* bp = Bt + (size_t)(16 * ct + r) * ldb + 32 * kg;
        f32x4 acc0 = {0.f, 0.f, 0.f, 0.f}, acc1 = acc0;
#pragma unroll 4
        for (int ks = 0; ks < K / 2; ks += 128) {
            acc0 = __builtin_amdgcn_mfma_scale_f32_16x16x128_f8f6f4(*(const pg8::i32x8*)(ap + ks), *(const pg8::i32x8*)(bp + ks), acc0, 0, 0, 0, sc_a, 0, sc_b);
            acc1 = __builtin_amdgcn_mfma_scale_f32_16x16x128_f8f6f4(*(const pg8::i32x8*)(ap + K / 2 + ks), *(const pg8::i32x8*)(bp + K / 2 + ks), acc1, 0, 0, 0, sc_a, 0, sc_b); }
#pragma unroll
        for (int i = 0; i < 4; ++i) epi(4 * kg + i, 16 * ct + r, acc0[i], acc1[i]);
    }
}
template <class Epi>
__device__ __forceinline__ void skinny16(LAS unsigned char* lds, const bf16* A, int lda, const bf16* Bt, int ldb, int K, int N, const Epi& epi) {
    skinny16_once(lds, A, lda, Bt, ldb, K, N, epi); if ((DBL_MASK >> 10) & 1u) skinny16_once(lds, A, lda, Bt, ldb, K, N, epi);
}
struct SkinnyInProj { unsigned char* ws; unsigned* kmax; __device__ __forceinline__ void operator()(int j, int n, float s0, float s1) const { inproj_store(ws, SEQ + j, n, s0 + s1, kmax); } };
struct SkinnyBranch { unsigned char* ws; __device__ __forceinline__ void operator()(int j, int n, float s0, float s1) const {
    const size_t r = SEQ + j; const bf16* G = (const bf16*)(ws + WS_GB); const float v = __builtin_amdgcn_fmed3f((bf2f(G[r * G_N + n]) * s0 + bf2f(G[r * G_N + DM + n]) * s1) * MG8_SCALE, -448.f, 448.f);
    (ws + WS_MG)[r * DM + n] = (unsigned char)(__builtin_amdgcn_cvt_pk_fp8_f32(v, 0.f, 0, false) & 0xff); } };
struct SkinnyOut { unsigned char* ws; __device__ __forceinline__ void operator()(int j, int n, float s0, float s1) const {
    const size_t o = (size_t)(SEQ + j) * DM + n; ((bf16*)(ws + WS_RB))[o] = (bf16)f2bf(ALPHA * bf2f(((const bf16*)(ws + WS_HF))[o]) + (s0 + s1)); } };

constexpr int KN_OFF = RING_BYTES + 4096;
using pg8::Unit;
struct ProbInProj {
    static constexpr bool PERM = true, GATHER = false, KEEPS = false, FP8 = true;
    int K, lda, ldb, G, c; const unsigned char* A; const unsigned char* B; unsigned char* ws; int sc_a, sc_b; unsigned* kmax; LAS unsigned char* lds;
    __device__ __forceinline__ bool next(int i, Unit& u) const { u.aux = 0; return pg8::static_tile(SEQ / 256, INP_N / 256, G, c, i, u.pm, u.pn); }
    __device__ __forceinline__ const char* a_ptr(const Unit& u) const { return (const char*)(A + (size_t)u.pm * 256 * lda); }
    __device__ __forceinline__ const char* b_ptr(const Unit& u) const { return (const char*)(B + (size_t)u.pn * 256 * ldb); }
    __device__ __forceinline__ bool epi(f32x4 (&acc)[2][2][4][2], const Unit& u, int wr, int wc, int fr, int fq) const {
        const int row0 = u.pm * 256 + wr * 64 + fr, ct = u.pn * 256 + wc * 32 + 8 * fq;
        const bool isg = u.pn >= 24, isq = (u.pn < 4) || (u.pn >= 12 && u.pn < 16);
        if (u.pn >= 16 && u.pn < 20) {
            LAS float* P = (LAS float*)(lds + KN_OFF);
#pragma unroll
            for (int bj = 0; bj < 2; ++bj) {
#pragma unroll
                for (int ai = 0; ai < 2; ++ai)
#pragma unroll
                    for (int m = 0; m < 4; ++m) { float q = 0.f;
#pragma unroll
                        for (int n = 0; n < 2; ++n)
#pragma unroll
                            for (int j = 0; j < 4; ++j) q = fmaf(acc[ai][bj][m][n][j], acc[ai][bj][m][n][j], q);
                        q += __shfl_xor(q, 16); q += __shfl_xor(q, 32);
                        if (fq == 0) P[(ai * 128 + wr * 64 + m * 16 + fr) * 4 + wc] = q; }
                asm volatile("s_waitcnt lgkmcnt(0)" ::: "memory"); __builtin_amdgcn_s_barrier(); asm volatile("" ::: "memory");
                if (threadIdx.x < 256) { const f32x4 v = *(const LAS f32x4*)(P + threadIdx.x * 4); float t = (v.x + v.y) + (v.z + v.w); t = wave_max(t);
                    if ((threadIdx.x & 63) == 0) atomicMax(kmax + (2 * (u.pn - 16) + bj) * 64, __builtin_bit_cast(unsigned, t)); }
                asm volatile("s_waitcnt lgkmcnt(0)" ::: "memory"); __builtin_amdgcn_s_barrier(); asm volatile("" ::: "memory"); } }
        bf16* base = isg ? (bf16*)(ws + WS_GB) + (ct - QKV_N) : (bf16*)(ws + WS_QKV) + ct; const int ldc = isg ? G_N : QKV_N; const float sc = isq ? QSCALE : 1.0f;
#pragma unroll
        for (int ai = 0; ai < 2; ++ai)
#pragma unroll
            for (int m = 0; m < 4; ++m) { bf16* rowp = base + (size_t)(row0 + ai * 128 + m * 16) * ldc;
#pragma unroll
                for (int bj = 0; bj < 2; ++bj) { f32x4 v0 = acc[ai][bj][m][0], v1 = acc[ai][bj][m][1];
                    if (isg) {
#pragma unroll
                        for (int j = 0; j < 4; ++j) { v0[j] = __builtin_amdgcn_rcpf(1.0f + __builtin_amdgcn_exp2f(-LOG2E * v0[j])); v1[j] = __builtin_amdgcn_rcpf(1.0f + __builtin_amdgcn_exp2f(-LOG2E * v1[j])); } }
                    else { v0 = v0 * sc; v1 = v1 * sc; }
                    u32x4 w; w.x = pg8::cvt_pk_bf16(v0[0], v0[1]); w.y = pg8::cvt_pk_bf16(v0[2], v0[3]); w.z = pg8::cvt_pk_bf16(v1[0], v1[1]); w.w = pg8::cvt_pk_bf16(v1[2], v1[3]);
                    *(u32x4*)(rowp + bj * 128) = w; } }
        return false;
    }
};
struct ProbOutProj {
    static constexpr bool PERM = false, GATHER = false, KEEPS = false, FP8 = true;
    int K, lda, ldb, G, c; const unsigned char* A; const unsigned char* B; unsigned char* ws; int sc_a, sc_b;
    __device__ __forceinline__ bool next(int i, Unit& u) const { u.aux = 0; return pg8::static_tile(SEQ / 256, DM / 256, G, c, i, u.pm, u.pn); }
    __device__ __forceinline__ const char* a_ptr(const Unit& u) const { return (const char*)(A + (size_t)u.pm * 256 * lda); }
    __device__ __forceinline__ const char* b_ptr(const Unit& u) const { return (const char*)(B + (size_t)u.pn * 256 * ldb); }
    __device__ __forceinline__ bool epi(f32x4 (&acc)[2][2][4][2], const Unit& u, int wr, int wc, int fr, int fq) const {
        const int row0 = u.pm * 256 + wr * 64 + fr, col0 = u.pn * 256 + wc * 32 + 4 * fq;
        const bf16* HF = (const bf16*)(ws + WS_HF); bf16* R = (bf16*)(ws + WS_RB);
#pragma unroll
        for (int ai = 0; ai < 2; ++ai)
#pragma unroll
            for (int m = 0; m < 4; ++m) { const size_t off = (size_t)(row0 + ai * 128 + m * 16) * DM + col0;
#pragma unroll
                for (int bj = 0; bj < 2; ++bj)
#pragma unroll
                    for (int n = 0; n < 2; ++n) { const u32x2 hw = *(const u32x2*)(HF + off + bj * 128 + n * 16); const f32x4 hv = {bflo(hw.x), bfhi(hw.x), bflo(hw.y), bfhi(hw.y)}; const f32x4 rv = hv * ALPHA + acc[ai][bj][m][n];
                        u32x2 w; w.x = pg8::cvt_pk_bf16(rv[0], rv[1]); w.y = pg8::cvt_pk_bf16(rv[2], rv[3]); *(u32x2*)(R + off + bj * 128 + n * 16) = w; }
                asm volatile("" ::: "memory"); }
        return false;
    }
};

struct ProbBranch {
    static constexpr bool PERM = true, GATHER = false, KEEPS = true, FP8 = true;
    int K, lda, ldb, G, c; const unsigned char* A; const unsigned char* B; unsigned char* ws; int sc_a, sc_b;
    __device__ __forceinline__ bool next(int i, Unit& u) const { u.aux = i & 1; return pg8::static_tile(SEQ / 256, DM / 256, G, c, i >> 1, u.pm, u.pn); }
    __device__ __forceinline__ const char* a_ptr(const Unit& u) const { return (const char*)(A + (size_t)u.pm * 256 * lda + u.aux * 1024); }
    __device__ __forceinline__ const char* b_ptr(const Unit& u) const { return (const char*)(B + (size_t)u.pn * 256 * ldb + u.aux * 1024); }
    __device__ __forceinline__ bool epi(f32x4 (&acc)[2][2][4][2], const Unit& u, int wr, int wc, int fr, int fq) const {
        const int row0 = u.pm * 256 + wr * 64 + fr, ct = u.pn * 256 + wc * 32 + 8 * fq;
        const bf16* Gs = (const bf16*)(ws + WS_GB) + ct; const bf16* Gf = Gs + DM; unsigned char* MG = ws + WS_MG + ct;
        const bool first = u.aux == 0;
#pragma unroll
        for (int ai = 0; ai < 2; ++ai)
#pragma unroll
            for (int m = 0; m < 4; ++m) { const size_t r = (size_t)(row0 + ai * 128 + m * 16);
#pragma unroll
                for (int bj = 0; bj < 2; ++bj) { const u32x4 gf = *(const u32x4*)(Gf + r * G_N + bj * 128);
                    f32x4 f0 = {bflo(gf.x), bfhi(gf.x), bflo(gf.y), bfhi(gf.y)}, f1 = {bflo(gf.z), bfhi(gf.z), bflo(gf.w), bfhi(gf.w)};
                    if (first) { const u32x4 gs = *(const u32x4*)(Gs + r * G_N + bj * 128);
                        const f32x4 s0 = {bflo(gs.x), bfhi(gs.x), bflo(gs.y), bfhi(gs.y)}, s1 = {bflo(gs.z), bfhi(gs.z), bflo(gs.w), bfhi(gs.w)};
#pragma unroll
                        for (int j = 0; j < 4; ++j) { acc[ai][bj][m][0][j] *= s0[j] * __builtin_amdgcn_rcpf(fmaxf(f0[j], 1e-30f)); acc[ai][bj][m][1][j] *= s1[j] * __builtin_amdgcn_rcpf(fmaxf(f1[j], 1e-30f)); } }
                    else { const f32x4 v0 = acc[ai][bj][m][0] * f0 * MG8_SCALE, v1 = acc[ai][bj][m][1] * f1 * MG8_SCALE;
                        u32x2 w; w.x = pk4_fp8(v0[0], v0[1], v0[2], v0[3]); w.y = pk4_fp8(v1[0], v1[1], v1[2], v1[3]);
                        *(u32x2*)(MG + r * DM + bj * 128) = w; } }
                asm volatile("" ::: "memory"); }
        return first;
    }
};
constexpr int IDX_OFF = RING_BYTES + 1024, MOE_MAXU = 3;
struct ProbMoeGU {
    static constexpr bool PERM = true, GATHER = true, KEEPS = false, FP8 = true;
    int K, lda, ldb, G, c, layer; const unsigned char* A; const unsigned char* B; unsigned char* ws; const unsigned* ctl; LAS unsigned char* lds; int sc_a, sc_b;
    __device__ __forceinline__ bool next(int i, Unit& u) const { const int L = i * G + c; u.pm = L >> 3; u.pn = L & 7; int cnt, ps; return moe_find(ctl, layer, u.pm * 256, u.aux, cnt, ps); }
    __device__ __forceinline__ const char* a_ptr(const Unit&) const { return (const char*)A; }
    __device__ __forceinline__ const char* b_ptr(const Unit& u) const { return (const char*)(B + (size_t)u.aux * WGU_E + (size_t)u.pn * 256 * ldb); }
    __device__ __forceinline__ int a_row(int ui, int r) const { return *(const LAS int*)(lds + IDX_OFF + (ui * 256 + r) * 4); }
    __device__ __forceinline__ void fill_idx(int tid) const {
        for (int ui = 0; ui < MOE_MAXU; ++ui) { const int L = ui * G + c; int e, cnt, ps; if (!moe_find(ctl, layer, (L >> 3) * 256, e, cnt, ps)) break;
            if (tid < 256) { const int rank = (L >> 3) * 256 - ps + tid; *(LAS int*)(lds + IDX_OFF + (ui * 256 + tid) * 4) = rank < cnt ? ((const int*)(ws + WS_ELIST))[(size_t)e * MROWS + rank] : 0; } }
        LDS_WAIT(); __syncthreads();
    }
    __device__ __forceinline__ bool epi(f32x4 (&acc)[2][2][4][2], const Unit& u, int wr, int wc, int fr, int fq) const {
        const int row0 = u.pm * 256 + wr * 64 + fr, ct = u.pn * 128 + wc * 32 + 8 * fq; unsigned char* act = ws + WS_ACT + ct;
#pragma unroll
        for (int ai = 0; ai < 2; ++ai)
#pragma unroll
            for (int m = 0; m < 4; ++m) { f32x4 v[2];
#pragma unroll
                for (int n = 0; n < 2; ++n)
#pragma unroll
                    for (int j = 0; j < 4; ++j) { const float g = acc[ai][0][m][n][j]; v[n][j] = g * __builtin_amdgcn_rcpf(1.0f + __builtin_amdgcn_exp2f(-LOG2E * g)) * acc[ai][1][m][n][j]; }
                u32x2 w; w.x = pk4_fp8(v[0][0] * ACT8_SCALE, v[0][1] * ACT8_SCALE, v[0][2] * ACT8_SCALE, v[0][3] * ACT8_SCALE); w.y = pk4_fp8(v[1][0] * ACT8_SCALE, v[1][1] * ACT8_SCALE, v[1][2] * ACT8_SCALE, v[1][3] * ACT8_SCALE);
                *(u32x2*)(act + (size_t)(row0 + ai * 128 + m * 16) * FF) = w; }
        return false;
    }
};
struct ProbMoeDown {
    static constexpr bool PERM = true, GATHER = false, KEEPS = false, FP8 = true;
    int K, lda, ldb, G, c, layer; const unsigned char* A; const unsigned char* B; unsigned char* ws; const unsigned* ctl; int sc_a, sc_b;
    __device__ __forceinline__ bool next(int i, Unit& u) const { const int L = i * G + c; u.pm = L >> 3; u.pn = L & 7; int cnt, ps; return moe_find(ctl, layer, u.pm * 256, u.aux, cnt, ps); }
    __device__ __forceinline__ const char* a_ptr(const Unit& u) const { return (const char*)(A + (size_t)u.pm * 256 * lda); }
    __device__ __forceinline__ const char* b_ptr(const Unit& u) const { return (const char*)(B + (size_t)u.aux * WD_E + (size_t)u.pn * 256 * ldb); }
    __device__ __forceinline__ bool epi(f32x4 (&acc)[2][2][4][2], const Unit& u, int wr, int wc, int fr, int fq) const {
        const int row0 = u.pm * 256 + wr * 64 + fr, ct = u.pn * 256 + wc * 32 + 8 * fq; bf16* O = (bf16*)(ws + WS_OSL) + ct;
#pragma unroll
        for (int ai = 0; ai < 2; ++ai)
#pragma unroll
            for (int m = 0; m < 4; ++m)
#pragma unroll
                for (int bj = 0; bj < 2; ++bj) { const f32x4 v0 = acc[ai][bj][m][0], v1 = acc[ai][bj][m][1];
                    u32x4 w; w.x = pg8::cvt_pk_bf16(v0[0], v0[1]); w.y = pg8::cvt_pk_bf16(v0[2], v0[3]); w.z = pg8::cvt_pk_bf16(v1[0], v1[1]); w.w = pg8::cvt_pk_bf16(v1[2], v1[3]);
                    *(u32x4*)(O + (size_t)(row0 + ai * 128 + m * 16) * DM + bj * 128) = w; }
        return false;
    }
};

#ifndef ATT_DBL
#define ATT_DBL 0
#endif
namespace att {
typedef short bf16x8 __attribute__((ext_vector_type(8)));
typedef short s16x4 __attribute__((ext_vector_type(4)));
typedef float f32x16 __attribute__((ext_vector_type(16)));
constexpr int TILE_B = 16384;
constexpr float EXIT_THR = -140.f;
constexpr int L_V = 0, L_K = 3 * TILE_B, L_C2 = 6 * TILE_B, L_WS = L_C2 + 1024, L_END = L_WS + 8 * 256, L_ITEM = 131072 + 8192, L_VOTE = L_ITEM + 16, L_FT = L_VOTE + 64, L_KN = L_FT + 16;
#define KSWZ(row, colB) ((row) * 256 + ((colB) ^ (((row) & 7) << 4)))
#define SBAR() __builtin_amdgcn_sched_barrier(0)
__device__ __forceinline__ int v_st(int k, int c) { const int kk = (k & ~0xC) | ((k & 4) << 1) | ((k & 8) >> 1); return ((kk >> 3) * 4 + (c >> 5)) * 512 + ((kk & 7) * 32 + (c & 31)) * 2; }
__device__ __forceinline__ int v_rd_base(int lane) { return ((lane & 3) << 3) | (((lane >> 2) & 3) << 6) | (((lane >> 4) & 1) << 5) | (((lane >> 5) & 1) << 8); }
constexpr int v_rd_off(int d0, int ks, int half) { return d0 * 512 + ks * 4096 + half * 2048; }
__device__ __forceinline__ int crow(int r, int hi) { return (r & 3) + 8 * (r >> 2) + 4 * hi; }
__device__ __forceinline__ unsigned cvtpk(float lo, float hi) { unsigned r; asm volatile("v_cvt_pk_bf16_f32 %0, %1, %2" : "=v"(r) : "v"(lo), "v"(hi)); return r; }
__device__ __forceinline__ float xchg_sum(float v) { auto rr = __builtin_amdgcn_permlane32_swap(__float_as_uint(v), __float_as_uint(v), false, false); return __uint_as_float(rr[0]) + __uint_as_float(rr[1]); }
__device__ __forceinline__ float xchg_max(float v) { auto rr = __builtin_amdgcn_permlane32_swap(__float_as_uint(v), __float_as_uint(v), false, false); return fmaxf(__uint_as_float(rr[0]), __uint_as_float(rr[1])); }
#define PK4(P, B_, OUT) do { unsigned a0 = cvtpk(P[B_+0], P[B_+1]), a1 = cvtpk(P[B_+2], P[B_+3]); unsigned b0 = cvtpk(P[B_+4], P[B_+5]), b1 = cvtpk(P[B_+6], P[B_+7]); \
        auto r0 = __builtin_amdgcn_permlane32_swap(a0, b0, false, false); auto r1 = __builtin_amdgcn_permlane32_swap(a1, b1, false, false); \
        u32x4 w = {r0[0], r1[0], r0[1], r1[1]}; OUT = *reinterpret_cast<bf16x8*>(&w); } while (0)
__device__ __forceinline__ void qkt(f32x16& p0, f32x16& p1, const LAS unsigned char* kt, int r32, int hi, const bf16x8* qr) {
    p0 = f32x16{}; p1 = f32x16{};
    const LAS unsigned char* kb[4];
#pragma unroll
    for (int dd = 0; dd < 4; ++dd) kb[dd] = kt + KSWZ(r32, (dd * 16 + hi * 8) * 2);
#pragma unroll
    for (int d0 = 0; d0 < 8; ++d0) { const LAS unsigned char* a = kb[d0 & 3] + (d0 >> 2) * 128;
        const bf16x8 b0 = *(const LAS bf16x8*)(a); const bf16x8 b1 = *(const LAS bf16x8*)(a + 32 * 256);
        p0 = __builtin_amdgcn_mfma_f32_32x32x16_bf16(b0, qr[d0], p0, 0, 0, 0);
        p1 = __builtin_amdgcn_mfma_f32_32x32x16_bf16(b1, qr[d0], p1, 0, 0, 0); }
}
__device__ __forceinline__ void pv_tile(f32x16* o, unsigned vb0, bf16x8 pa0, bf16x8 pa1, bf16x8 pa2, bf16x8 pa3) {
#define TRRD(dst, off) asm volatile("ds_read_b64_tr_b16 %0, %1 offset:%2" : "=&v"(dst) : "v"(vb0), "i"(off) : "memory")
#define PV_D0(d0) do { s16x4 l0, l1, l2, l3, h0, h1, h2, h3; constexpr int b_ = v_rd_off(d0, 0, 0); \
        TRRD(l0, b_); TRRD(h0, b_ + 2048); TRRD(l1, b_ + 4096); TRRD(h1, b_ + 6144); TRRD(l2, b_ + 8192); TRRD(h2, b_ + 10240); TRRD(l3, b_ + 12288); TRRD(h3, b_ + 14336); \
        asm volatile("s_waitcnt lgkmcnt(0)" ::: "memory"); SBAR(); \
        o[d0] = __builtin_amdgcn_mfma_f32_32x32x16_bf16(pa0, (bf16x8){l0[0], l0[1], l0[2], l0[3], h0[0], h0[1], h0[2], h0[3]}, o[d0], 0, 0, 0); \
        o[d0] = __builtin_amdgcn_mfma_f32_32x32x16_bf16(pa1, (bf16x8){l1[0], l1[1], l1[2], l1[3], h1[0], h1[1], h1[2], h1[3]}, o[d0], 0, 0, 0); \
        o[d0] = __builtin_amdgcn_mfma_f32_32x32x16_bf16(pa2, (bf16x8){l2[0], l2[1], l2[2], l2[3], h2[0], h2[1], h2[2], h2[3]}, o[d0], 0, 0, 0); \
        o[d0] = __builtin_amdgcn_mfma_f32_32x32x16_bf16(pa3, (bf16x8){l3[0], l3[1], l3[2], l3[3], h3[0], h3[1], h3[2], h3[3]}, o[d0], 0, 0, 0); } while (0)
    PV_D0(0); PV_D0(1); PV_D0(2); PV_D0(3);
#undef PV_D0
#undef TRRD
}
#define VIS(cc) (((dqh) - (cc)) >= NEED && (cc) < (nvh))
__device__ __forceinline__ void sb_tile(f32x16& p0, f32x16& p1, float& carry, bool domask, int dqh, int nvh, int hi, bf16x8& pa0, bf16x8& pa1, bf16x8& pa2, bf16x8& pa3) {
    constexpr int NEED = 1;
    f32x16 x0, x1;
#pragma unroll
    for (int r = 0; r < 16; ++r) {
        { const float u = __builtin_amdgcn_fmed3f(p0[r], -126.f, 126.f), b = __builtin_amdgcn_logf(1.0f + __builtin_amdgcn_exp2f(-u)); x0[r] = -b; p0[r] = -u - b; }
        { const float u = __builtin_amdgcn_fmed3f(p1[r], -126.f, 126.f), b = __builtin_amdgcn_logf(1.0f + __builtin_amdgcn_exp2f(-u)); x1[r] = -b; p1[r] = -u - b; } }
    if (domask) { const float NEG = -__builtin_inff();
#pragma unroll
        for (int r = 0; r < 16; ++r) { const int cc = (r & 3) + 8 * (r >> 2);
            if (!VIS(cc)) { p0[r] = 0.f; x0[r] = NEG; }
            if (!VIS(cc + 32)) { p1[r] = 0.f; x1[r] = NEG; } } }
    float A[9]; A[8] = 0.f;
#pragma unroll
    for (int g = 3; g >= 0; --g) A[4 + g] = A[5 + g] + ((p1[4 * g] + p1[4 * g + 1]) + (p1[4 * g + 2] + p1[4 * g + 3]));
#pragma unroll
    for (int g = 3; g >= 0; --g) A[g] = A[1 + g] + ((p0[4 * g] + p0[4 * g + 1]) + (p0[4 * g + 2] + p0[4 * g + 3]));
    float off[8];
#pragma unroll
    for (int i = 0; i < 8; ++i) { auto rr = __builtin_amdgcn_permlane32_swap(__float_as_uint(A[i]), __float_as_uint(A[i + 1]), false, false);
        const float recv = hi ? __uint_as_float(rr[0]) : __uint_as_float(rr[1]); off[i] = carry + A[i + 1] + recv; }
    carry += xchg_sum(A[0]);
#pragma unroll
    for (int g = 0; g < 4; ++g) {
        { float af = off[g]; const float l3 = p0[4 * g + 3], l2 = p0[4 * g + 2], l1 = p0[4 * g + 1];
          x0[4 * g + 3] = __builtin_amdgcn_exp2f(x0[4 * g + 3] + af); af += l3; x0[4 * g + 2] = __builtin_amdgcn_exp2f(x0[4 * g + 2] + af); af += l2;
          x0[4 * g + 1] = __builtin_amdgcn_exp2f(x0[4 * g + 1] + af); af += l1; x0[4 * g] = __builtin_amdgcn_exp2f(x0[4 * g] + af); }
        { float af = off[4 + g]; const float l3 = p1[4 * g + 3], l2 = p1[4 * g + 2], l1 = p1[4 * g + 1];
          x1[4 * g + 3] = __builtin_amdgcn_exp2f(x1[4 * g + 3] + af); af += l3; x1[4 * g + 2] = __builtin_amdgcn_exp2f(x1[4 * g + 2] + af); af += l2;
          x1[4 * g + 1] = __builtin_amdgcn_exp2f(x1[4 * g + 1] + af); af += l1; x1[4 * g] = __builtin_amdgcn_exp2f(x1[4 * g] + af); } }
    PK4(x0, 0, pa0); PK4(x0, 8, pa1); PK4(x1, 0, pa2); PK4(x1, 8, pa3);
}
__device__ __forceinline__ float fox_tile(f32x16& p0, f32x16& p1, const LAS float* c2t, float& m_reg, float& l_reg, bool domask, int dqh, int nvh, int hi, bf16x8& pa0, bf16x8& pa1, bf16x8& pa2, bf16x8& pa3) {
    constexpr int NEED = 0;
#pragma unroll
    for (int g = 0; g < 4; ++g) { const f32x4 c0 = *(const LAS f32x4*)(c2t + 8 * g + 4 * hi), c1 = *(const LAS f32x4*)(c2t + 32 + 8 * g + 4 * hi);
#pragma unroll
        for (int j = 0; j < 4; ++j) { p0[4 * g + j] -= c0[j]; p1[4 * g + j] -= c1[j]; } }
    if (domask) { const float NEG = -__builtin_inff();
#pragma unroll
        for (int r = 0; r < 16; ++r) { const int cc = (r & 3) + 8 * (r >> 2);
            if (!VIS(cc)) p0[r] = NEG;
            if (!VIS(cc + 32)) p1[r] = NEG; } }
    float pmax = p0[0];
#pragma unroll
    for (int r = 1; r < 16; ++r) pmax = fmaxf(pmax, p0[r]);
#pragma unroll
    for (int r = 0; r < 16; ++r) pmax = fmaxf(pmax, p1[r]);
    pmax = xchg_max(pmax);
    const float mn = fmaxf(m_reg, pmax), alpha = __builtin_amdgcn_exp2f(m_reg - mn); m_reg = mn;
    float ps = 0.f;
#pragma unroll
    for (int r = 0; r < 16; ++r) { p0[r] = __builtin_amdgcn_exp2f(p0[r] - mn); p1[r] = __builtin_amdgcn_exp2f(p1[r] - mn); ps += p0[r] + p1[r]; }
    l_reg = l_reg * alpha + xchg_sum(ps);
    PK4(p0, 0, pa0); PK4(p0, 8, pa1); PK4(p1, 0, pa2); PK4(p1, 8, pa3);
    return alpha;
}
#undef VIS
template <int TYPE>
__device__ __forceinline__ void attn_unit(LAS unsigned char* lds, unsigned char* ws, const unsigned* kmaxw, int head, int qb) {
    const int tid = tid_fresh(), wid = __builtin_amdgcn_readfirstlane(tid >> 6), lane = tid & 63, r32 = lane & 31, hi = lane >> 5;
    const bool grpY = wid >= 4;
    const bf16* QKV = (const bf16*)(ws + WS_QKV);
    const int qcol = (TYPE ? 3072 : 0) + head * HD, kcol = qcol + 1024, vcol = qcol + 2048;
    const float* fsuf = (const float*)(ws + WS_CUM) + (size_t)head * MROWS; const float* ftot = (const float*)(ws + WS_CUM) + (size_t)NHEAD * MROWS + head * 256;
    float fcarry = 0.f, st_tot = 0.f;
    LAS int* vote = (LAS int*)(lds + L_VOTE); LAS float* ftl = (LAS float*)(lds + L_FT);
    const int qrow0 = qb * 256, NT = qb < 32 ? 4 * qb + 5 : 1;
    const int qbase = qb < 32 ? qrow0 : -NMETA;
    const int qlo = qbase + wid * 32, qpos = qlo + r32;
    LAS unsigned char* V_lds = lds + L_V; LAS unsigned char* K_lds = lds + L_K; LAS float* c2_lds = (LAS float*)(lds + L_C2);
    LAS float* wsl = (LAS float*)(lds + L_WS) + wid * 64;
    bf16x8 qr[8];
#pragma unroll
    for (int d0 = 0; d0 < 8; ++d0) qr[d0] = *(const bf16x8*)(QKV + (size_t)(qrow0 + wid * 32 + r32) * QKV_N + qcol + d0 * 16 + hi * 8);
    const int sr = tid >> 4, sc = (tid & 15) * 8, vst0 = v_st(sr, sc), vst1 = v_st(32 + sr, sc), kws = KSWZ(sr, sc * 2);
    const unsigned vrd = (unsigned)(size_t)V_lds + (unsigned)v_rd_base(lane);
    bf16x8 st_k0, st_k1, st_v0, st_v1; float st_c = 0.f;
    float ub = 0.f;
    if (TYPE == 1) { float s1 = 0.f;
#pragma unroll
        for (int d0 = 0; d0 < 8; ++d0) { const u32x4 w = __builtin_bit_cast(u32x4, qr[d0]);
            s1 += (bflo(w.x) * bflo(w.x) + bfhi(w.x) * bfhi(w.x)) + (bflo(w.y) * bflo(w.y) + bfhi(w.y) * bfhi(w.y)) + (bflo(w.z) * bflo(w.z) + bfhi(w.z) * bfhi(w.z)) + (bflo(w.w) * bflo(w.w) + bfhi(w.w) * bfhi(w.w)); }
        ub = 1.02f * sqrtf(xchg_sum(s1) * ((const LAS float*)(lds + L_KN))[head]); }
#define TISMETA(t) ((t) == NT - 1)
#define SLOAD(t) do { const int row_ = TISMETA(t) ? SEQ : 64 * (4 * qb + 3 - (t)); const bf16* kp_ = QKV + (size_t)(row_ + sr) * QKV_N + sc; \
        st_k0 = *(const bf16x8*)(kp_ + kcol); st_k1 = *(const bf16x8*)(kp_ + (size_t)32 * QKV_N + kcol); st_v0 = *(const bf16x8*)(kp_ + vcol); st_v1 = *(const bf16x8*)(kp_ + (size_t)32 * QKV_N + vcol); \
        if (TYPE == 1 && tid < 64) { st_c = fsuf[row_ + tid]; st_tot = ftot[row_ >> 6]; } } while (0)
#define SWRITE(bo) do { *(LAS bf16x8*)(K_lds + (bo) + kws) = st_k0; *(LAS bf16x8*)(K_lds + (bo) + kws + 32 * 256) = st_k1; \
        *(LAS bf16x8*)(V_lds + (bo) + vst0) = st_v0; *(LAS bf16x8*)(V_lds + (bo) + vst1) = st_v1; if (TYPE == 1 && tid < 64) { c2_lds[((bo) >> 8) + tid] = -(fcarry + st_c); fcarry += st_tot; if (tid == 0) ftl[(bo) >> 14] = fcarry; } } while (0)
#define BAR() asm volatile("s_waitcnt lgkmcnt(0)\n\ts_barrier" ::: "memory")
    SLOAD(0); SWRITE(0);
    if (NT > 1) { SLOAD(1); SWRITE(TILE_B); }
    __builtin_amdgcn_s_waitcnt(0x0F70);
    if (NT > 2) SLOAD(2);
    BAR();
    if (grpY) BAR();
    f32x16 o[4] = {}; float carry = 0.f, m_reg = -1e30f, l_reg = 0.f;
    constexpr int NEEDW = TYPE == 0 ? 1 : 0;
#define KBASE(t) (TISMETA(t) ? -NMETA : 64 * (4 * qb + 3 - (t)))
#define ACTW(t) ((qlo + 31 - KBASE(t)) >= NEEDW && (qb < 32 || wid == 0))
    f32x16 p0, p1;
    if (ACTW(0)) qkt(p0, p1, K_lds, r32, hi, qr);
    int bo = 0, bo1 = TILE_B, bo2 = 2 * TILE_B;
    for (int t = 0; t < NT; ++t) {
        BAR();
        if (t > 0) { const LAS int* vp = vote + ((t - 1) & 1) * 8; const int all8 = (vp[0] & vp[1]) & (vp[2] & vp[3]) & (vp[4] & vp[5]) & (vp[6] & vp[7]); if (__builtin_amdgcn_readfirstlane(all8)) break; }
        const int kbase = KBASE(t), nvalid = TISMETA(t) ? NMETA : 64;
        const bool actw = ACTW(t);
        const bool domask = (qlo - (kbase + 63) < NEEDW) || nvalid < 64;
        bf16x8 pa0, pa1, pa2, pa3;
        if (actw) {
            const int dqh = qpos - kbase - 4 * hi, nvh = nvalid - 4 * hi;
            if (TYPE == 0) sb_tile(p0, p1, carry, domask, dqh, nvh, hi, pa0, pa1, pa2, pa3);
            else { const float alpha = fox_tile(p0, p1, c2_lds + (bo >> 8), m_reg, l_reg, domask, dqh, nvh, hi, pa0, pa1, pa2, pa3);
                if (__any(alpha < 1.f)) { if (hi == 0) wsl[r32] = alpha; asm volatile("s_waitcnt lgkmcnt(0)" ::: "memory");
#pragma unroll
                    for (int r = 0; r < 16; ++r) { const float al = wsl[crow(r, hi)];
#pragma unroll
                        for (int d = 0; d < 4; ++d) o[d][r] *= al; } } }
        }
        { const bool done = TYPE == 0 ? __all(carry < EXIT_THR) : __all(ub + ftl[bo >> 14] - m_reg < EXIT_THR);
          if (lane == 0) vote[(t & 1) * 8 + wid] = (done && qb < 32) ? 1 : 0; }
        BAR();
        if (t + 2 < NT) SWRITE(bo2);
        if (t + 3 < NT) SLOAD(t + 3);
        if (actw) pv_tile(o, vrd + bo, pa0, pa1, pa2, pa3);
        if (t + 1 < NT) { if (ACTW(t + 1)) qkt(p0, p1, K_lds + bo1, r32, hi, qr); }
        { const int tmp = bo; bo = bo1; bo1 = bo2; bo2 = tmp; }
    }
    if (!grpY) BAR();
    float rli[16];
    if (TYPE == 1) { if (hi == 0) wsl[32 + r32] = l_reg; asm volatile("s_waitcnt lgkmcnt(0)" ::: "memory");
#pragma unroll
        for (int r = 0; r < 16; ++r) rli[r] = __builtin_amdgcn_rcpf(wsl[32 + crow(r, hi)]); }
    unsigned char* Yw = ws + WS_YB + (size_t)(qrow0 + wid * 32) * DM + TYPE * 1024 + head * HD;
    if (qb < 32 || wid == 0)
#pragma unroll
    for (int r = 0; r < 16; ++r) { const int orow = crow(r, hi);
#pragma unroll
        for (int d0 = 0; d0 < 4; ++d0) { const float v = __builtin_amdgcn_fmed3f((TYPE == 1 ? o[d0][r] * rli[r] : o[d0][r]) * Y8_SCALE, -448.f, 448.f); const float vn = __shfl_xor(v, 1);
            const int p = __builtin_amdgcn_cvt_pk_fp8_f32(v, vn, 0, false) & 0xffff; const int p2 = __shfl_xor(p, 2);
            if ((r32 & 3) == 0) *(unsigned*)(Yw + (size_t)orow * DM + d0 * 32 + r32) = (unsigned)p | ((unsigned)p2 << 16); } }
#undef TISMETA
#undef SLOAD
#undef SWRITE
#undef BAR
#undef KBASE
#undef ACTW
}
constexpr int CW_ATTNQ = 3072;
__device__ __forceinline__ void copy_loop(Frame& F, int layer, int cv0, int NB_, int limit = 1 << 30) {
    LAS int* itemw = (LAS int*)(F.lds + L_ITEM);
    for (int n = 0; n < limit; ++n) {
        __syncthreads();
        if (threadIdx.x == 0) *itemw = (int)atomicAdd(F.ctl + CW_ATTNQ + layer * 64 + 16, 1u);
        asm volatile("s_waitcnt lgkmcnt(0)" ::: "memory"); __syncthreads();
        const int j = __builtin_amdgcn_readfirstlane(*itemw);
        if (j >= NB_) break;
        convert_bundle(F, cv0 + j * CV_BUNDLE);
    }
}
__device__ __forceinline__ void attn_phase(Frame& F, int layer, int qoff, bool nocopy = false, int only = 0) {
    LAS unsigned char* lds = F.lds; unsigned char* ws = F.ws; unsigned* ctl = F.ctl; const int G = F.G, b = blockIdx.x;
    const int NA = 512 + (layer == 0 ? 16 : 0);
    const int cv0 = layer == 0 ? CV_G0_END : CV_G1_END, NB_ = ((layer == 0 ? CV_G1_END : N_CONVERT_ITEMS) - cv0) / CV_BUNDLE;
    const bool copier = (b & 1) == 1 && !nocopy; const int nfree = nocopy ? G : G - G / 2;
    LAS int* itemw = (LAS int*)(lds + L_ITEM); const unsigned* kmaxw = ctl + CW_KMAX + layer * 8 * 64;
    int hperm = 0;
    { const float* ftot = (const float*)(ws + WS_CUM) + (size_t)NHEAD * MROWS; const int lane = threadIdx.x & 63; float d[8];
#pragma unroll
        for (int h = 0; h < 8; ++h) { float v = ftot[h * 256 + lane] + ftot[h * 256 + 64 + lane] + (lane == 0 ? ftot[h * 256 + 128] : 0.f); d[h] = wave_sum(v); }
#pragma unroll
        for (int h = 0; h < 8; ++h) { int rank = 0;
#pragma unroll
            for (int g = 0; g < 8; ++g) rank += (d[g] > d[h] || (d[g] == d[h] && g < h)) ? 1 : 0;
            hperm |= h << (4 * rank); }
        hperm = __builtin_amdgcn_readfirstlane(hperm); }
    { const int w = F.wave, lane = threadIdx.x & 63, mr = lane >> 2, part = lane & 3;
      const bf16* kp = (const bf16*)(ws + WS_QKV) + (size_t)(SEQ + mr) * QKV_N + 4096 + w * HD + part * 32; float q = 0.f;
#pragma unroll
      for (int i = 0; i < 4; ++i) { const u32x4 v = *(const u32x4*)(kp + 8 * i);
          q += (bflo(v.x) * bflo(v.x) + bfhi(v.x) * bfhi(v.x)) + (bflo(v.y) * bflo(v.y) + bfhi(v.y) * bfhi(v.y)) + (bflo(v.z) * bflo(v.z) + bfhi(v.z) * bfhi(v.z)) + (bflo(v.w) * bflo(v.w) + bfhi(v.w) * bfhi(v.w)); }
      q += __shfl_xor(q, 1); q += __shfl_xor(q, 2); q = wave_max(q);
      if (lane == 0) ((LAS float*)(lds + L_KN))[w] = fmaxf(q, __builtin_bit_cast(float, kmaxw[w * 64]));
      asm volatile("s_waitcnt lgkmcnt(0)" ::: "memory"); __syncthreads(); }
    int it;
    if (copier) {
        copy_loop(F, layer, cv0, NB_);
        __syncthreads();
        if (threadIdx.x == 0) *itemw = nfree + (int)atomicAdd(ctl + CW_ATTNQ + layer * 64 + qoff, 1u);
        asm volatile("s_waitcnt lgkmcnt(0)" ::: "memory"); __syncthreads();
        it = __builtin_amdgcn_readfirstlane(*itemw);
    } else it = nocopy ? b : b >> 1;
    while (it < NA) {
        if (only == 1 && it >= 256) break; if (only == 2) { if (it + 256 >= NA) break; it += 256; }
        int qb, th; if (it < 256) { qb = 31 - (it & 31); th = 8 + ((hperm >> (4 * (it >> 5))) & 7); } else if (it < 512) { qb = 31 - ((it - 256) >> 3); th = it & 7; } else { qb = 32; th = it - 512; }
        if (th < 8) attn_unit<0>(lds, ws, kmaxw, th, qb); else attn_unit<1>(lds, ws, kmaxw, th - 8, qb);
        __syncthreads();
        if (threadIdx.x == 0) *itemw = nfree + (int)atomicAdd(ctl + CW_ATTNQ + layer * 64 + qoff, 1u);
        asm volatile("s_waitcnt lgkmcnt(0)" ::: "memory"); __syncthreads();
        it = __builtin_amdgcn_readfirstlane(*itemw);
    }
}
#undef KSWZ
#undef SBAR
#undef PK4
}

__global__ void __launch_bounds__(NTHREADS, 2) mk_fwd(Args args) {
    extern __shared__ __attribute__((aligned(16))) unsigned char lds_raw[];
    Frame F;
    F.lds = (LAS unsigned char*)lds_raw; F.ws = args.ws; F.ctl = (unsigned*)(args.ws + WS_CTL);
     F.wave = __builtin_amdgcn_readfirstlane(tid_fresh() >> 6);
    F.G = gridDim.x; F.gw = blockIdx.x * NWAVES + F.wave; F.NGW = F.G * NWAVES;
    F.in = (const float* const*)__builtin_amdgcn_kernarg_segment_ptr();
    F.out = args.out;
    volatile LAS unsigned* MISC = (volatile LAS unsigned*)(F.lds + MISC_OFF);
    for (int u = tid_fresh(); u < (LDS_BYTES - RING_BYTES) / 4; u += NTHREADS) ((LAS unsigned*)(F.lds + RING_BYTES))[u] = 0u;
    __syncthreads();
    XcdBarrier bar = xcd_barrier_post(F.ctl + CW_BAR + args.li * XCD_BAR_WORDS, MISC + 8);
    const int lo = args.ph_lo, hi = args.ph_hi; const unsigned naive = args.naive;
#define IN(k) (lo <= (k) && (k) < hi)
#define SEAM(k) do { if (IN(k) && IN((k) + 1)) { xcd_barrier(bar); if ((DBL_MASK >> 9) & 1u) xcd_barrier(bar); } } while (0)
#define NAIVE(t) ((naive >> (t)) & 1u)
    if (IN(0)) { phase_prologue(F); SEAM(0); }
#define LAYER_PHASES(l, pb) do { \
        if (IN(pb + PH_A)) { phase_cumsum(F, NAIVE(PH_B)); if (!NAIVE(PH_B)) phase_tilesuf(F); \
            if (!NAIVE(PH_A)) { skinny16_f8(F.lds, F.ws + WS_H8 + (size_t)SEQ * DM, DM, F.ws + WS_WIN + l * WIN_L, DM, DM, INP_N, SC_H, SC_W, SkinnyInProj{F.ws, F.ctl + CW_KMAX + l * 8 * 64}); \
              ProbInProj P{DM, DM, DM, F.G, (int)blockIdx.x, F.ws + WS_H8, F.ws + WS_WIN + l * WIN_L, F.ws, SC_H, SC_W, F.ctl + CW_KMAX + l * 8 * 64, F.lds}; pg8::gemm_phase(F.lds, P); if ((DBL_MASK >> PH_A) & 1u) pg8::gemm_phase(F.lds, P); } \
            SEAM(pb + PH_A); } \
        if (IN(pb + PH_B)) { \
            if (!NAIVE(PH_B)) { att::attn_phase(F, l, 0); if ((DBL_MASK >> PH_B) & 1u) att::attn_phase(F, l, 32, true, (int)((DBL_MASK >> 12) & 3u)); } \
            SEAM(pb + PH_B); } \
        if (IN(pb + PH_C)) { \
            if (!NAIVE(PH_C)) { if (l == 0) skinny16_f8(F.lds, F.ws + WS_YB + (size_t)SEQ * DM, DM, F.ws + WS_WB + l * WB_L, DM, DM, DM, SC_Y, SC_W, SkinnyBranch{F.ws}); \
              ProbBranch P{1024, DM, DM, F.G, (int)blockIdx.x, F.ws + WS_YB, F.ws + WS_WB + l * WB_L, F.ws, SC_Y, SC_W}; pg8::gemm_phase(F.lds, P); if ((DBL_MASK >> PH_C) & 1u) pg8::gemm_phase(F.lds, P); } \
            SEAM(pb + PH_C); } \
        if (IN(pb + PH_D)) { \
            if (!NAIVE(PH_D)) { if (l == 0) skinny16_f8(F.lds, F.ws + WS_MG + (size_t)SEQ * DM, DM, F.ws + WS_WOUT + l * WOUT_L, DM, DM, DM, SC_MG, SC_W, SkinnyOut{F.ws}); \
              ProbOutProj P{DM, DM, DM, F.G, (int)blockIdx.x, F.ws + WS_MG, F.ws + WS_WOUT + l * WOUT_L, F.ws, SC_MG, SC_W}; pg8::gemm_phase(F.lds, P); if ((DBL_MASK >> PH_D) & 1u) pg8::gemm_phase(F.lds, P); } \
            SEAM(pb + PH_D); } \
        if (IN(pb + PH_E)) { if ((DBL_MASK >> PH_E) & 1u) phase_ln_router(F, l, true); phase_ln_router(F, l); SEAM(pb + PH_E); } \
        if (IN(pb + PH_F)) { \
            if (!NAIVE(PH_F)) { ProbMoeGU P{DM, DM, DM, F.G, (int)blockIdx.x, l, F.ws + WS_H8, F.ws + WS_WGU + l * WGU_L, F.ws, F.ctl, F.lds, SC_H, SC_W}; P.fill_idx(tid_fresh()); pg8::gemm_phase(F.lds, P); if ((DBL_MASK >> PH_F) & 1u) pg8::gemm_phase(F.lds, P);  } \
            SEAM(pb + PH_F); } \
        if (IN(pb + PH_G)) { \
            if (!NAIVE(PH_G)) { ProbMoeDown P{FF, FF, FF, F.G, (int)blockIdx.x, l, F.ws + WS_ACT, F.ws + WS_WD + l * WD_L, F.ws, F.ctl, SC_ACT, SC_W}; pg8::gemm_phase(F.lds, P); if ((DBL_MASK >> PH_G) & 1u) pg8::gemm_phase(F.lds, P);  } \
            SEAM(pb + PH_G); } \
        if (IN(pb + PH_H)) { if ((DBL_MASK >> PH_H) & 1u) phase_ln_final(F, l, true); phase_ln_final(F, l); SEAM(pb + PH_H); } \
    } while (0)
    LAYER_PHASES(0, 1);
    LAYER_PHASES(1, 9);
#undef LAYER_PHASES
#undef IN
#undef SEAM
#undef NAIVE
}

static void launch_naive(int type, int layer, const Args& a, hipStream_t stream) {
    switch (type) {
    case PH_A: hipLaunchKernelGGL(naive_inproj, dim3(INP_N / 256, MROWS / 4), dim3(256), 0, stream, a, layer); break;
    case PH_B: { const int nq = NTOK; hipLaunchKernelGGL(naive_attn, dim3((16 * nq + 3) / 4), dim3(256), 0, stream, a, nq); } break;
    case PH_C: hipLaunchKernelGGL(naive_branch, dim3(DM / 256, MROWS / 4), dim3(256), 0, stream, a, layer); break;
    case PH_D: hipLaunchKernelGGL(naive_outproj, dim3(DM / 256, MROWS / 4), dim3(256), 0, stream, a, layer); break;
    case PH_F: hipLaunchKernelGGL(naive_moe_gu, dim3(FF / 256, NSLOT_MAX / 4), dim3(256), 0, stream, a, layer); break;
    case PH_G: hipLaunchKernelGGL(naive_moe_down, dim3(DM / 256, NSLOT_MAX / 4), dim3(256), 0, stream, a, layer); break;
    default: break;
    }
}
extern "C" void kernel_launch(void* const* d_in, const int* in_sizes, int n_in, void* d_out, int out_size, void* d_ws, size_t ws_size, hipStream_t stream) {
    static int grid = 0;
    if (grid == 0) {
        if (n_in != 18 || out_size != SEQ * DM || ws_size < WS_END) { fprintf(stderr, "kernel_launch: unexpected shapes (n_in %d out %d ws %zu)\n", n_in, out_size, ws_size); grid = -1; return; }
        int dev = 0, cus = 0;
        if (hipGetDevice(&dev) != hipSuccess || hipDeviceGetAttribute(&cus, hipDeviceAttributeMultiprocessorCount, dev) != hipSuccess) { grid = -1; return; }
        if (hipFuncSetAttribute((const void*)mk_fwd, hipFuncAttributeMaxDynamicSharedMemorySize, LDS_BYTES) != hipSuccess) { fprintf(stderr, "kernel_launch: hipFuncSetAttribute failed\n"); grid = -1; return; }
        int per_cu = 0;
        if (hipOccupancyMaxActiveBlocksPerMultiprocessor(&per_cu, (const void*)mk_fwd, NTHREADS, LDS_BYTES) != hipSuccess || per_cu < 1) fprintf(stderr, "kernel_launch: occupancy query says %d\n", per_cu);
        (void)hipGetLastError();
        grid = cus;
    }
    if (grid < 0) return;
    (void)hipMemsetAsync((char*)d_ws + WS_CTL, 0, CTL_ZERO_BYTES, stream);
    Args a{};
    for (int i = 0; i < 18; ++i) a.in[i] = (const float*)d_in[i];
    a.out = (float*)d_out; a.ws = (unsigned char*)d_ws; a.naive = NAIVE_MASK;
    int li = 0, lo = 0;
    auto flush = [&](int hi) { if (hi > lo) { a.ph_lo = lo; a.ph_hi = hi; a.li = li++; hipLaunchKernelGGL(mk_fwd, dim3(grid), dim3(NTHREADS), LDS_BYTES, stream, a); } lo = hi; };
    for (int ph = 1; ph < NPHASE; ++ph) {
        const int type = (ph - 1) & 7, layer = (ph - 1) >> 3;
        if ((NAIVE_MASK >> type) & 1u) {
            if (type == PH_A) flush(ph + 1); else { flush(ph); lo = ph + 1; }
            launch_naive(type, layer, a, stream); }
    }
    flush(NPHASE);
}
```
